# Optimizing an MI355X kernel written in HIP

```python
import math
import jax
import jax.numpy as jnp
from jax import lax
import numpy as np

D_MODEL = 1024
BATCH = 2
SEQ = 8192
DEPTH = 1

CTX_LEN = 256
GRID_W = 64

S5_GROUP_CH = 16
S5_STATE = 64
S5_WIDTH = D_MODEL // 2
S5_GROUPS = S5_WIDTH // S5_GROUP_CH
S5_DT_MIN = 1e-3
S5_DT_MAX = 1e-1

HEAD_DIM = 128
N_HEADS = D_MODEL // HEAD_DIM
N_KV_HEADS = 2
GQA_GROUP = N_HEADS // N_KV_HEADS
ATTN_WIDTH = N_HEADS * HEAD_DIM
KV_WIDTH = N_KV_HEADS * HEAD_DIM
Q_BLOCK = 128
ROPE_THETA = 10000.0
ROPE_AXIS_DIM = HEAD_DIM // 2
ROPE_AXIS_FREQS = ROPE_AXIS_DIM // 2

N_BRANCHES = 2
IN_SPLITS = (S5_WIDTH, S5_WIDTH + ATTN_WIDTH, S5_WIDTH + ATTN_WIDTH + KV_WIDTH,
             S5_WIDTH + ATTN_WIDTH + 2 * KV_WIDTH)
IN_WIDTH = S5_WIDTH + ATTN_WIDTH + 2 * KV_WIDTH + N_BRANCHES * D_MODEL

N_EXPERT_GROUPS = 4
EXPERTS_PER_GROUP = 8
N_EXPERTS = N_EXPERT_GROUPS * EXPERTS_PER_GROUP
EXPERT_TOP_K = 2
D_EXPERT = D_MODEL // 2

N_MOD = 6
NORM_EPS = 1e-6

kernel_name = "hybrid_s5_gqa_hmoe_flow_block"


def _layer_norm(x):
    xf = x.astype(jnp.float32)
    mu = jnp.mean(xf, axis=-1, keepdims=True)
    var = jnp.mean(jnp.square(xf - mu), axis=-1, keepdims=True)
    return ((xf - mu) * lax.rsqrt(var + NORM_EPS)).astype(x.dtype)


def _post_norm(x, g, b):
    return _layer_norm(x) * g + b


def _modulate(x, shift, scale):
    return _layer_norm(x) * (1.0 + scale) + shift


def _adaln(cond, w, b):
    return jax.nn.silu(cond) @ w + b


def _rms_norm(x, g):
    xf = x.astype(jnp.float32)
    return (xf * lax.rsqrt(jnp.mean(xf * xf, axis=-1, keepdims=True) + NORM_EPS)).astype(x.dtype) * g


def _axial_rope_tables(rows, dtype):
    row = jnp.repeat(jnp.arange(rows, dtype=jnp.float32), GRID_W)
    col = jnp.tile(jnp.arange(GRID_W, dtype=jnp.float32), rows)
    inv = ROPE_THETA ** (-jnp.arange(0, ROPE_AXIS_DIM, 2, dtype=jnp.float32) / ROPE_AXIS_DIM)
    ang = jnp.stack([row[:, None] * inv, col[:, None] * inv], axis=1)
    return jnp.cos(ang)[:, None].astype(dtype), jnp.sin(ang)[:, None].astype(dtype)


def _rope(x, cos, sin):
    xs = x.reshape(x.shape[:-1] + (2, 2, ROPE_AXIS_FREQS))
    x1, x2 = xs[..., 0, :], xs[..., 1, :]
    out = jnp.stack([x1 * cos - x2 * sin, x1 * sin + x2 * cos], axis=-2)
    return out.reshape(x.shape)


def _block_attention(q, k, v):
    bsz, n_q = q.shape[:2]
    n_blk = n_q // Q_BLOCK
    scale = HEAD_DIM ** -0.5
    qb = q.reshape(bsz, n_blk, Q_BLOCK, N_KV_HEADS, GQA_GROUP, HEAD_DIM).transpose(1, 0, 2, 3, 4, 5)

    def attend(q_blk):
        s = jnp.einsum('bqhgd,bkhd->bhgqk', q_blk, k).astype(jnp.float32) * scale
        p = jax.nn.softmax(s, axis=-1).astype(v.dtype)
        return jnp.einsum('bhgqk,bkhd->bqhgd', p, v)

    o = lax.map(attend, qb)
    return o.transpose(1, 0, 2, 3, 4, 5).reshape(bsz, n_q, N_HEADS * HEAD_DIM)


def _s5_discretise(a_re, a_im, log_dt, b_re, b_im):
    dt = jnp.exp(log_dt)[:, None]
    ea = jnp.exp(a_re * dt)
    ab_re, ab_im = ea * jnp.cos(a_im * dt), ea * jnp.sin(a_im * dt)
    den = a_re * a_re + a_im * a_im
    nr, ni = ab_re - 1.0, ab_im
    rr = (nr * a_re + ni * a_im) / den
    ri = (ni * a_re - nr * a_im) / den
    bb_re = rr[..., None] * b_re - ri[..., None] * b_im
    bb_im = rr[..., None] * b_im + ri[..., None] * b_re
    return ab_re, ab_im, bb_re, bb_im


def _complex_affine_combine(e1, e2):
    a1r, a1i, b1r, b1i = e1
    a2r, a2i, b2r, b2i = e2
    return (a2r * a1r - a2i * a1i, a2r * a1i + a2i * a1r,
            a2r * b1r - a2i * b1i + b2r, a2r * b1i + a2i * b1r + b2i)


def _s5_scan(u, ab_re, ab_im, bb_re, bb_im, reverse, init=None):
    bsz, n = u.shape[:2]
    ug = u.reshape(bsz, n, S5_GROUPS, S5_GROUP_CH)
    bu_re = jnp.einsum('gpc,blgc->blgp', bb_re, ug)
    bu_im = jnp.einsum('gpc,blgc->blgp', bb_im, ug)
    a_re = jnp.broadcast_to(ab_re, (1, n) + ab_re.shape)
    a_im = jnp.broadcast_to(ab_im, (1, n) + ab_im.shape)
    acum_re, acum_im, h_re, h_im = lax.associative_scan(
        _complex_affine_combine, (a_re, a_im, bu_re, bu_im), reverse=reverse, axis=1)
    if init is not None:
        s_re, s_im = init
        h_re = h_re + acum_re * s_re - acum_im * s_im
        h_im = h_im + acum_re * s_im + acum_im * s_re
    return h_re, h_im


def _s5_readout(h_re, h_im, c_re, c_im):
    bsz, n = h_re.shape[:2]
    y = jnp.einsum('gcp,blgp->blgc', c_re, h_re) - jnp.einsum('gcp,blgp->blgc', c_im, h_im)
    return y.reshape(bsz, n, S5_WIDTH)


def _merge(y_ssm, o, gate_logits, w_glu_a, w_glu_b, w_attn_o, w_out):
    g = jax.nn.gelu(y_ssm)
    ssm_branch = (g @ w_glu_a) * jax.nn.sigmoid(g @ w_glu_b)
    attn_branch = o @ w_attn_o
    gate_ssm, gate_attn = jnp.split(jax.nn.sigmoid(gate_logits), N_BRANCHES, axis=-1)
    return (gate_ssm * ssm_branch + gate_attn * attn_branch) @ w_out


def _hier_moe(h, w_rg, b_rg, w_re, b_re, w_gate, w_up, w_down):
    shape = h.shape
    hf = h.reshape(-1, shape[-1])
    n_tok = hf.shape[0]
    g_logits = (hf @ w_rg + b_rg).astype(jnp.float32)
    g_idx = jnp.argmax(g_logits, axis=-1)
    g_w = jnp.take_along_axis(jax.nn.softmax(g_logits, axis=-1), g_idx[:, None], axis=-1)
    e_logits = (hf @ w_re + b_re).astype(jnp.float32).reshape(n_tok, N_EXPERT_GROUPS, EXPERTS_PER_GROUP)
    e_in = jnp.take_along_axis(e_logits, g_idx[:, None, None], axis=1)[:, 0]
    top_v, top_i = lax.top_k(e_in, EXPERT_TOP_K)
    top_w = jax.nn.softmax(top_v, axis=-1) * g_w
    expert_id = g_idx[:, None] * EXPERTS_PER_GROUP + top_i
    combine = jnp.sum(jax.nn.one_hot(expert_id, N_EXPERTS, dtype=jnp.float32) * top_w[..., None],
                      axis=1).astype(h.dtype)
    y = jnp.zeros_like(hf)
    for gi in range(N_EXPERT_GROUPS):
        sl = slice(gi * EXPERTS_PER_GROUP, (gi + 1) * EXPERTS_PER_GROUP)
        a = jnp.einsum('td,edf->tef', hf, w_gate[sl])
        b = jnp.einsum('td,edf->tef', hf, w_up[sl])
        y = y + jnp.einsum('tef,efd->td', jax.nn.silu(a) * b * combine[:, sl, None], w_down[sl])
    return y.reshape(shape)


def setup_inputs(seed: int = 0) -> dict:
    key = jax.random.key(seed)
    ks = list(jax.random.split(key, 40))
    f32 = jnp.float32

    def nrm(shape):
        return jax.random.normal(ks.pop(), shape, f32)

    beta = (8.0 * DEPTH) ** -0.25
    L = DEPTH
    n_idx = jnp.arange(S5_STATE, dtype=f32)
    log_dt = jax.random.uniform(ks.pop(), (L, 2, S5_GROUPS), f32, math.log(S5_DT_MIN), math.log(S5_DT_MAX))
    return {
        "x": nrm((BATCH, SEQ, D_MODEL)),
        "c": nrm((BATCH, D_MODEL)),
        "ctx": nrm((BATCH, CTX_LEN, D_MODEL)),
        "c_ctx": nrm((D_MODEL,)),
        "w_mod": nrm((L, D_MODEL, N_MOD * D_MODEL)) * (0.5 * D_MODEL ** -0.5),
        "b_mod": 0.02 * nrm((L, N_MOD * D_MODEL)),
        "w_in": nrm((L, D_MODEL, IN_WIDTH)) * D_MODEL ** -0.5,
        "s5_a_re": -0.5 + 0.01 * nrm((L, 2, S5_GROUPS, S5_STATE)),
        "s5_a_im": math.pi * n_idx + 0.01 * nrm((L, 2, S5_GROUPS, S5_STATE)),
        "s5_log_dt": log_dt,
        "s5_b_re": nrm((L, 2, S5_GROUPS, S5_STATE, S5_GROUP_CH)) * (2.0 * S5_GROUP_CH) ** -0.5,
        "s5_b_im": nrm((L, 2, S5_GROUPS, S5_STATE, S5_GROUP_CH)) * (2.0 * S5_GROUP_CH) ** -0.5,
        "s5_c_re": nrm((L, 2, S5_GROUPS, S5_GROUP_CH, S5_STATE)) * S5_STATE ** -0.5,
        "s5_c_im": nrm((L, 2, S5_GROUPS, S5_GROUP_CH, S5_STATE)) * S5_STATE ** -0.5,
        "s5_d": nrm((L, S5_WIDTH)),
        "w_glu_a": nrm((L, S5_WIDTH, D_MODEL)) * S5_WIDTH ** -0.5,
        "w_glu_b": nrm((L, S5_WIDTH, D_MODEL)) * S5_WIDTH ** -0.5,
        "q_gain": 1.0 + 0.02 * nrm((L, HEAD_DIM)),
        "k_gain": 1.0 + 0.02 * nrm((L, HEAD_DIM)),
        "w_attn_o": nrm((L, ATTN_WIDTH, D_MODEL)) * ATTN_WIDTH ** -0.5,
        "w_out": nrm((L, D_MODEL, D_MODEL)) * (beta * D_MODEL ** -0.5),
        "ln1_g": 1.0 + 0.02 * nrm((L, D_MODEL)),
        "ln1_b": 0.02 * nrm((L, D_MODEL)),
        "w_router_group": nrm((L, D_MODEL, N_EXPERT_GROUPS)) * D_MODEL ** -0.5,
        "b_router_group": 0.01 * nrm((L, N_EXPERT_GROUPS)),
        "w_router_expert": nrm((L, D_MODEL, N_EXPERTS)) * D_MODEL ** -0.5,
        "b_router_expert": 0.01 * nrm((L, N_EXPERTS)),
        "w_exp_gate": nrm((L, N_EXPERTS, D_MODEL, D_EXPERT)) * D_MODEL ** -0.5,
        "w_exp_up": nrm((L, N_EXPERTS, D_MODEL, D_EXPERT)) * D_MODEL ** -0.5,
        "w_exp_down": nrm((L, N_EXPERTS, D_EXPERT, D_MODEL)) * (beta * D_EXPERT ** -0.5),
        "ln2_g": 1.0 + 0.02 * nrm((L, D_MODEL)),
        "ln2_b": 0.02 * nrm((L, D_MODEL)),
    }


def reference(x, c, ctx, c_ctx, w_mod, b_mod, w_in, s5_a_re, s5_a_im, s5_log_dt, s5_b_re, s5_b_im,
              s5_c_re, s5_c_im, s5_d, w_glu_a, w_glu_b, q_gain, k_gain, w_attn_o, w_out, ln1_g, ln1_b,
              w_router_group, b_router_group, w_router_expert, b_router_expert, w_exp_gate, w_exp_up,
              w_exp_down, ln2_g, ln2_b):
    bsz, n_lat, _ = x.shape
    n_ctx = ctx.shape[1]
    rows = n_lat // GRID_W
    cos, sin = _axial_rope_tables(rows, x.dtype)
    alpha = (2.0 * DEPTH) ** 0.25
    for i in range(DEPTH):
        is_last = i == DEPTH - 1
        sh1, sc1, g1, sh2, sc2, g2 = jnp.split(_adaln(c, w_mod[i], b_mod[i])[:, None, :], N_MOD, axis=-1)
        sh1c, sc1c, g1c, sh2c, sc2c, g2c = jnp.split(_adaln(c_ctx, w_mod[i], b_mod[i]), N_MOD, axis=-1)

        h = _modulate(x, sh1, sc1)
        hc = _modulate(ctx, sh1c, sc1c)
        u, q, k, v, gate_logits = jnp.split(h @ w_in[i], IN_SPLITS, axis=-1)
        uc, qc, kc, vc, gate_logits_c = jnp.split(hc @ w_in[i], IN_SPLITS, axis=-1)

        y_ssm = u * s5_d[i]
        ctx_states = []
        for d, reverse in enumerate((False, True)):
            disc = _s5_discretise(s5_a_re[i, d], s5_a_im[i, d], s5_log_dt[i, d], s5_b_re[i, d], s5_b_im[i, d])
            hc_re, hc_im = _s5_scan(uc, *disc, reverse=reverse)
            edge = slice(0, 1) if reverse else slice(n_ctx - 1, n_ctx)
            hl_re, hl_im = _s5_scan(u, *disc, reverse=reverse, init=(hc_re[:, edge], hc_im[:, edge]))
            y_ssm = y_ssm + _s5_readout(hl_re, hl_im, s5_c_re[i, d], s5_c_im[i, d])
            if not is_last:
                ctx_states.append((hc_re, hc_im))

        q = _rope(_rms_norm(q.reshape(bsz, n_lat, N_HEADS, HEAD_DIM), q_gain[i]), cos, sin)
        k = _rope(_rms_norm(k.reshape(bsz, n_lat, N_KV_HEADS, HEAD_DIM), k_gain[i]), cos, sin)
        v = v.reshape(bsz, n_lat, N_KV_HEADS, HEAD_DIM)
        kc = _rms_norm(kc.reshape(bsz, n_ctx, N_KV_HEADS, HEAD_DIM), k_gain[i])
        vc = vc.reshape(bsz, n_ctx, N_KV_HEADS, HEAD_DIM)
        o = _block_attention(q, jnp.concatenate([k, kc], axis=1), jnp.concatenate([v, vc], axis=1))

        mix = _merge(y_ssm, o, gate_logits, w_glu_a[i], w_glu_b[i], w_attn_o[i], w_out[i])
        x = _post_norm(alpha * x + g1 * mix, ln1_g[i], ln1_b[i])

        if not is_last:
            y_ssm_c = uc * s5_d[i]
            for d, (hc_re, hc_im) in enumerate(ctx_states):
                y_ssm_c = y_ssm_c + _s5_readout(hc_re, hc_im, s5_c_re[i, d], s5_c_im[i, d])
            qc = _rms_norm(qc.reshape(bsz, n_ctx, N_HEADS, HEAD_DIM), q_gain[i])
            oc = _block_attention(qc, kc, vc)
            mix_c = _merge(y_ssm_c, oc, gate_logits_c, w_glu_a[i], w_glu_b[i], w_attn_o[i], w_out[i])
            ctx = _post_norm(alpha * ctx + g1c * mix_c, ln1_g[i], ln1_b[i])

        moe_w = (w_router_group[i], b_router_group[i], w_router_expert[i], b_router_expert[i],
                 w_exp_gate[i], w_exp_up[i], w_exp_down[i])
        x = _post_norm(alpha * x + g2 * _hier_moe(_modulate(x, sh2, sc2), *moe_w), ln2_g[i], ln2_b[i])
        if not is_last:
            ctx = _post_norm(alpha * ctx + g2c * _hier_moe(_modulate(ctx, sh2c, sc2c), *moe_w),
                             ln2_g[i], ln2_b[i])
    return x
```

```cpp
#include <hip/hip_runtime.h>
#include <hip/hip_bf16.h>
#include <cstdint>
#include <cstdio>

typedef unsigned short bf16_t;
__device__ __forceinline__ float bf2f(bf16_t v) { return __uint_as_float(((unsigned)v) << 16); }
__device__ __forceinline__ bf16_t f2bf(float f) { unsigned u = __float_as_uint(f); return (bf16_t)((u + 0x7fffu + ((u >> 16) & 1u)) >> 16); }

constexpr int DM = 1024, NB = 2, SEQ = 8192, NCTX = 256;
constexpr int NLAT = NB * SEQ, NCT = NB * NCTX, NTOK = NLAT + NCT;
constexpr int SKV = SEQ + NCTX;
constexpr int INW = 4096;
constexpr int NMOD = 6 * DM;
constexpr float LN_EPS = 1e-6f;
constexpr float ALPHA = 1.189207115002721f;

constexpr size_t MiB = 1u << 20;
constexpr size_t WS_MOD = 1 * MiB;
constexpr size_t WS_S5T = 2 * MiB;
constexpr size_t WS_ROUTE = 3 * MiB;
constexpr size_t WS_H = 4 * MiB;
constexpr size_t WS_U = 40 * MiB;
constexpr size_t WS_Q = 58 * MiB;
constexpr size_t WS_K = 92 * MiB;
constexpr size_t WS_V = 101 * MiB;
constexpr size_t WS_G = 110 * MiB;
constexpr size_t WS_GY = 178 * MiB;
constexpr size_t WS_T1 = 196 * MiB;
constexpr size_t WS_END = 264 * MiB;

struct Params {
  const float* in[32];
  float* out;
  unsigned char* ws;
};
enum { I_X = 0, I_C, I_CTX, I_CCTX, I_WMOD, I_BMOD, I_WIN, I_SARE, I_SAIM, I_SLDT, I_SBRE, I_SBIM, I_SCRE, I_SCIM, I_SD,
       I_WGA, I_WGB, I_QG, I_KG, I_WAO, I_WOUT, I_LN1G, I_LN1B, I_WRG, I_BRG, I_WRE, I_BRE, I_WEG, I_WEU, I_WED, I_LN2G, I_LN2B };

__device__ __forceinline__ float wave_sum(float v) {
#pragma unroll
  for (int o = 1; o < 64; o <<= 1) v += __shfl_xor(v, o);
  return v;
}
__device__ __forceinline__ float sigmoidf_(float x) { return 1.f / (1.f + __expf(-x)); }
__device__ __forceinline__ float siluf_(float x) { return x / (1.f + __expf(-x)); }
__device__ __forceinline__ float gelu_tanh(float x) {
  const float k0 = 0.7978845608028654f, k1 = 0.044715f;
  float t = tanhf(k0 * (x + k1 * x * x * x));
  return 0.5f * x * (1.f + t);
}

__global__ __launch_bounds__(256) void k_mod(Params p) {
  float* mod = (float*)(p.ws + WS_MOD);
  const int j = blockIdx.x * 256 + threadIdx.x;
  __shared__ float s[3][DM];
  for (int i = threadIdx.x; i < DM; i += 256) {
    s[0][i] = siluf_(p.in[I_C][i]); s[1][i] = siluf_(p.in[I_C][DM + i]); s[2][i] = siluf_(p.in[I_CCTX][i]);
  }
  __syncthreads();
  const float* w = p.in[I_WMOD];
  float a0 = 0, a1 = 0, a2 = 0;
  for (int k = 0; k < DM; ++k) { float wv = w[(size_t)k * NMOD + j]; a0 += s[0][k] * wv; a1 += s[1][k] * wv; a2 += s[2][k] * wv; }
  float b = p.in[I_BMOD][j];
  mod[j] = a0 + b; mod[NMOD + j] = a1 + b; mod[2 * NMOD + j] = a2 + b;
}

__global__ __launch_bounds__(64) void k_s5disc(Params p) {
  float* tab = (float*)(p.ws + WS_S5T);
  float* abar = tab;
  float* bbar = tab + 2 * 32 * 64 * 2;
  const int dg = blockIdx.x, pi = threadIdx.x;
  const float are = p.in[I_SARE][dg * 64 + pi], aim = p.in[I_SAIM][dg * 64 + pi];
  const float dt = expf(p.in[I_SLDT][dg]);
  const float ea = expf(are * dt);
  float sn, cs; sincosf(aim * dt, &sn, &cs);
  const float abr = ea * cs, abi = ea * sn;
  const float den = are * are + aim * aim;
  const float nr = abr - 1.f, ni = abi;
  const float rr = (nr * are + ni * aim) / den, ri = (ni * are - nr * aim) / den;
  abar[(dg * 64 + pi) * 2 + 0] = abr; abar[(dg * 64 + pi) * 2 + 1] = abi;
  for (int c = 0; c < 16; ++c) {
    const float bre = p.in[I_SBRE][(dg * 64 + pi) * 16 + c], bim = p.in[I_SBIM][(dg * 64 + pi) * 16 + c];
    bbar[((dg * 64 + pi) * 16 + c) * 2 + 0] = rr * bre - ri * bim;
    bbar[((dg * 64 + pi) * 16 + c) * 2 + 1] = rr * bim + ri * bre;
  }
}

__global__ __launch_bounds__(256) void k_lnmod(Params p) {
  const float* mod = (const float*)(p.ws + WS_MOD);
  bf16_t* H = (bf16_t*)(p.ws + WS_H);
  const int lane = threadIdx.x & 63, wv = threadIdx.x >> 6;
  const int row = blockIdx.x * 4 + wv;
  if (row >= NTOK) return;
  const float* xr; const float* mrow;
  if (row < NLAT) { xr = p.in[I_X] + (size_t)row * DM; mrow = mod + (row / SEQ) * NMOD; }
  else { xr = p.in[I_CTX] + (size_t)(row - NLAT) * DM; mrow = mod + 2 * NMOD; }
  float4 v[4]; float s = 0;
#pragma unroll
  for (int j = 0; j < 4; ++j) { v[j] = ((const float4*)xr)[lane + 64 * j]; s += (v[j].x + v[j].y) + (v[j].z + v[j].w); }
  const float mean = wave_sum(s) * (1.f / DM); float s2 = 0;
#pragma unroll
  for (int j = 0; j < 4; ++j) { v[j].x -= mean; v[j].y -= mean; v[j].z -= mean; v[j].w -= mean; s2 += (v[j].x * v[j].x + v[j].y * v[j].y) + (v[j].z * v[j].z + v[j].w * v[j].w); }
  const float rstd = rsqrtf(wave_sum(s2) * (1.f / DM) + LN_EPS);
#pragma unroll
  for (int j = 0; j < 4; ++j) {
    const int col = (lane + 64 * j) * 4;
    const float4 sh = *(const float4*)(mrow + col), sc = *(const float4*)(mrow + DM + col);
    ushort4 o;
    o.x = f2bf(v[j].x * rstd * (1.f + sc.x) + sh.x); o.y = f2bf(v[j].y * rstd * (1.f + sc.y) + sh.y);
    o.z = f2bf(v[j].z * rstd * (1.f + sc.z) + sh.z); o.w = f2bf(v[j].w * rstd * (1.f + sc.w) + sh.w);
    *(ushort4*)(H + (size_t)row * DM + col) = o;
  }
}

template <class EP>
__global__ __launch_bounds__(256) void k_gemm_naive(const bf16_t* A, int lda, const float* B, int ldb, int K, EP ep) {
  __shared__ float As[16][68]; __shared__ float Bs[16][68];
  const int tid = threadIdx.x, tx = tid & 15, ty = tid >> 4;
  const int m0 = blockIdx.y * 64, n0 = blockIdx.x * 64;
  float acc[4][4];
#pragma unroll
  for (int i = 0; i < 4; ++i)
#pragma unroll
    for (int j = 0; j < 4; ++j) acc[i][j] = 0.f;
  for (int k0 = 0; k0 < K; k0 += 16) {
#pragma unroll
    for (int i = 0; i < 4; ++i) { const int idx = tid + i * 256; const int m = idx >> 4, k = idx & 15; As[k][m] = bf2f(A[(size_t)(m0 + m) * lda + k0 + k]); }
#pragma unroll
    for (int i = 0; i < 4; ++i) { const int idx = tid + i * 256; const int k = idx >> 6, n = idx & 63; Bs[k][n] = B[(size_t)(k0 + k) * ldb + n0 + n]; }
    __syncthreads();
#pragma unroll
    for (int k = 0; k < 16; ++k) {
      float a[4], b[4];
#pragma unroll
      for (int i = 0; i < 4; ++i) { a[i] = As[k][ty * 4 + i]; b[i] = Bs[k][tx * 4 + i]; }
#pragma unroll
      for (int i = 0; i < 4; ++i)
#pragma unroll
        for (int j = 0; j < 4; ++j) acc[i][j] += a[i] * b[j];
    }
    __syncthreads();
  }
#pragma unroll
  for (int i = 0; i < 4; ++i)
#pragma unroll
    for (int j = 0; j < 4; ++j) ep(m0 + ty * 4 + i, n0 + tx * 4 + j, acc[i][j]);
}

struct EpIn {
  bf16_t* U; float* QRAW; float* KRAW; bf16_t* V; bf16_t* G;
  __device__ void operator()(int row, int col, float v) const {
    if (col < 512) U[(size_t)row * 512 + col] = f2bf(v);
    else if (col < 1536) { if (row < NLAT) QRAW[(size_t)row * 1024 + col - 512] = v; }
    else if (col < 1792) KRAW[(size_t)row * 256 + col - 1536] = v;
    else if (col < 2048) {
      int b, pos; if (row < NLAT) { b = row / SEQ; pos = row % SEQ; } else { b = (row - NLAT) / NCTX; pos = SEQ + (row - NLAT) % NCTX; }
      V[((size_t)b * SKV + pos) * 256 + col - 1792] = f2bf(v);
    } else { if (row < NLAT) G[(size_t)row * 2048 + col - 2048] = f2bf(sigmoidf_(v)); }
  }
};
struct EpGluA { float* T1; __device__ void operator()(int row, int col, float v) const { T1[(size_t)row * 1024 + col] = v; } };
struct EpGluB { float* T1; const bf16_t* G;
  __device__ void operator()(int row, int col, float v) const { size_t i = (size_t)row * 1024 + col; T1[i] = bf2f(G[(size_t)row * 2048 + col]) * T1[i] * sigmoidf_(v); } };
struct EpAttnO { const float* T1; const bf16_t* G; bf16_t* Z;
  __device__ void operator()(int row, int col, float v) const { size_t i = (size_t)row * 1024 + col; Z[i] = f2bf(T1[i] + bf2f(G[(size_t)row * 2048 + 1024 + col]) * v); } };
struct EpOut { const float* X; const float* mod; float* R1;
  __device__ void operator()(int row, int col, float v) const { size_t i = (size_t)row * 1024 + col; R1[i] = ALPHA * X[i] + mod[(row / SEQ) * NMOD + 2 * DM + col] * v; } };

__global__ __launch_bounds__(256) void k_qknorm(Params p) {
  const float* QRAW = p.out; const float* KRAW = (const float*)(p.ws + WS_GY);
  bf16_t* Q = (bf16_t*)(p.ws + WS_Q); bf16_t* Kb = (bf16_t*)(p.ws + WS_K);
  const int lane = threadIdx.x & 63, wv = threadIdx.x >> 6;
  const long item = (long)blockIdx.x * 4 + wv;
  const long nlat_items = (long)NLAT * 10;
  int row, slot; bool isctx;
  if (item < nlat_items) { row = (int)(item / 10); slot = (int)(item % 10); isctx = false; }
  else { long it = item - nlat_items; if (it >= (long)NCT * 2) return; row = NLAT + (int)(it / 2); slot = 8 + (int)(it % 2); isctx = true; }
  const int axis = lane >> 5, f = lane & 31, e1 = axis * 64 + f, e2 = e1 + 32;
  float x1, x2; const float* gain;
  if (slot < 8) { x1 = QRAW[(size_t)row * 1024 + slot * 128 + e1]; x2 = QRAW[(size_t)row * 1024 + slot * 128 + e2]; gain = p.in[I_QG]; }
  else { x1 = KRAW[(size_t)row * 256 + (slot - 8) * 128 + e1]; x2 = KRAW[(size_t)row * 256 + (slot - 8) * 128 + e2]; gain = p.in[I_KG]; }
  const float ss = wave_sum(x1 * x1 + x2 * x2);
  const float r = rsqrtf(ss * (1.f / 128.f) + LN_EPS);
  x1 = x1 * r * gain[e1]; x2 = x2 * r * gain[e2];
  float o1 = x1, o2 = x2;
  int b, pos;
  if (!isctx) {
    b = row / SEQ; pos = row % SEQ;
    const float posf = (axis == 0) ? (float)(pos / 64) : (float)(pos % 64);
    const float inv = powf(10000.f, -(float)(2 * f) / 64.f);
    float sn, cs; sincosf(posf * inv, &sn, &cs);
    o1 = x1 * cs - x2 * sn; o2 = x1 * sn + x2 * cs;
  } else { b = (row - NLAT) / NCTX; pos = SEQ + (row - NLAT) % NCTX; }
  if (slot < 8) { Q[(size_t)row * 1024 + slot * 128 + e1] = f2bf(o1); Q[(size_t)row * 1024 + slot * 128 + e2] = f2bf(o2); }
  else { size_t o = ((size_t)b * SKV + pos) * 256 + (slot - 8) * 128; Kb[o + e1] = f2bf(o1); Kb[o + e2] = f2bf(o2); }
}

__global__ __launch_bounds__(64) void k_s5_naive(Params p) {
  const float* tab = (const float*)(p.ws + WS_S5T);
  const float* abar = tab; const float* bbar = tab + 2 * 32 * 64 * 2;
  const bf16_t* U = (const bf16_t*)(p.ws + WS_U);
  float* Y = (float*)(p.ws + WS_T1);
  bf16_t* GY = (bf16_t*)(p.ws + WS_GY);
  const int b = blockIdx.x / 32, g = blockIdx.x % 32, lane = threadIdx.x;
  const int cown = 8 * (lane & 1) + 4 * ((lane >> 1) & 1) + 2 * ((lane >> 2) & 1) + ((lane >> 3) & 1);
  for (int d = 0; d < 2; ++d) {
    const int dg = d * 32 + g;
    const float ar = abar[(dg * 64 + lane) * 2], ai = abar[(dg * 64 + lane) * 2 + 1];
    float br[16], bi[16], cr[16], ci[16];
#pragma unroll
    for (int c = 0; c < 16; ++c) {
      br[c] = bbar[((dg * 64 + lane) * 16 + c) * 2]; bi[c] = bbar[((dg * 64 + lane) * 16 + c) * 2 + 1];
      cr[c] = p.in[I_SCRE][(dg * 16 + c) * 64 + lane]; ci[c] = p.in[I_SCIM][(dg * 16 + c) * 64 + lane];
    }
    float hr = 0.f, hi = 0.f;
    const float dval = p.in[I_SD][g * 16 + cown];
    for (int step = 0; step < NCTX + SEQ; ++step) {
      int row; bool lat;
      if (step < NCTX) { const int t = (d == 0) ? step : (NCTX - 1 - step); row = NLAT + b * NCTX + t; lat = false; }
      else { const int s2 = step - NCTX; const int t = (d == 0) ? s2 : (SEQ - 1 - s2); row = b * SEQ + t; lat = true; }
      const bf16_t* ur = U + (size_t)row * 512 + g * 16;
      float u[16];
      {
        const uint4 w0 = *(const uint4*)ur, w1 = *(const uint4*)(ur + 8);
        const unsigned ww[8] = {w0.x, w0.y, w0.z, w0.w, w1.x, w1.y, w1.z, w1.w};
#pragma unroll
        for (int i = 0; i < 8; ++i) { u[2 * i] = __uint_as_float(ww[i] << 16); u[2 * i + 1] = __uint_as_float(ww[i] & 0xffff0000u); }
      }
      float bur = 0.f, bui = 0.f;
#pragma unroll
      for (int c = 0; c < 16; ++c) { bur += br[c] * u[c]; bui += bi[c] * u[c]; }
      const float nr = ar * hr - ai * hi + bur, ni = ar * hi + ai * hr + bui;
      hr = nr; hi = ni;
      if (lat) {
        float v[16];
#pragma unroll
        for (int c = 0; c < 16; ++c) v[c] = cr[c] * hr - ci[c] * hi;
        float w8[8];
        { const bool up = lane & 1;
#pragma unroll
          for (int i = 0; i < 8; ++i) { const float send = up ? v[i] : v[i + 8], keep = up ? v[i + 8] : v[i]; w8[i] = keep + __shfl_xor(send, 1); } }
        float w4[4];
        { const bool up = lane & 2;
#pragma unroll
          for (int i = 0; i < 4; ++i) { const float send = up ? w8[i] : w8[i + 4], keep = up ? w8[i + 4] : w8[i]; w4[i] = keep + __shfl_xor(send, 2); } }
        float w2[2];
        { const bool up = lane & 4;
#pragma unroll
          for (int i = 0; i < 2; ++i) { const float send = up ? w4[i] : w4[i + 2], keep = up ? w4[i + 2] : w4[i]; w2[i] = keep + __shfl_xor(send, 4); } }
        float w1;
        { const bool up = lane & 8; const float send = up ? w2[0] : w2[1], keep = up ? w2[1] : w2[0]; w1 = keep + __shfl_xor(send, 8); }
        w1 += __shfl_xor(w1, 16); w1 += __shfl_xor(w1, 32);
        float uo = 0.f;
#pragma unroll
        for (int c = 0; c < 16; ++c) uo = (c == cown) ? u[c] : uo;
        if (lane < 16) {
          const size_t yi = (size_t)row * 512 + g * 16 + cown;
          if (d == 0) Y[yi] = w1 + uo * dval;
          else GY[yi] = f2bf(gelu_tanh(Y[yi] + w1));
        }
      }
    }
  }
}

namespace att {
using bf16x8 = __attribute__((ext_vector_type(8))) short;
using s16x4 = __attribute__((ext_vector_type(4))) short;
using f32x16 = __attribute__((ext_vector_type(16))) float;
using u32x4 = __attribute__((ext_vector_type(4))) unsigned;
constexpr int D = 128, NW = 8, QBLK = 32, KVBLK = 64;
constexpr float SCALE = 0.088388347648318440f;
constexpr float THR = 8.f;
constexpr int LDQ = 1024, LDK = 256, LDO = 1024;
constexpr size_t SHM_V = KVBLK * D * 2, SHM_K = KVBLK * D * 2, SHM_ATTN = 2 * SHM_V + 2 * SHM_K + NW * 64 * 4;
#define KSWZ(row, colB) ((row) * 256 + ((colB) ^ (((row) & 7) << 4)))
#define SBAR() __builtin_amdgcn_sched_barrier(0)
__device__ __forceinline__ int crow(int r, int hi) { return (r & 3) + 8 * (r >> 2) + 4 * hi; }
__device__ __forceinline__ unsigned cvtpk(float lo, float hi) { unsigned r; asm volatile("v_cvt_pk_bf16_f32 %0, %1, %2" : "=v"(r) : "v"(lo), "v"(hi)); return r; }
__device__ __forceinline__ void partialSM(f32x16& p0, f32x16& p1, float& m_reg, float& mn, float& alpha) {
  constexpr float C = SCALE * 1.4426950408889634f;
  float pmax = p0[0]; for (int r = 1; r < 16; ++r) pmax = fmaxf(pmax, p0[r]); for (int r = 0; r < 16; ++r) pmax = fmaxf(pmax, p1[r]);
  { auto rr = __builtin_amdgcn_permlane32_swap(__float_as_uint(pmax), __float_as_uint(pmax), false, false);
    pmax = fmaxf(__uint_as_float(rr[0]), __uint_as_float(rr[1])); }
  if (__builtin_expect(__all(pmax - m_reg <= THR / SCALE), 1)) { mn = m_reg; alpha = 1.f; }
  else { mn = fmaxf(m_reg, pmax); alpha = __builtin_amdgcn_exp2f((m_reg - mn) * C); m_reg = mn; }
  float mnC = -mn * C;
  for (int r = 0; r < 16; ++r) p0[r] = fmaf(p0[r], C, mnC); for (int r = 0; r < 16; ++r) p1[r] = fmaf(p1[r], C, mnC);
  for (int r = 0; r < 16; ++r) p0[r] = __builtin_amdgcn_exp2f(p0[r]);
}
__device__ __forceinline__ void finishSM(f32x16& p0, f32x16& p1, float alpha, float& l_reg, bf16x8& pa0, bf16x8& pa1, bf16x8& pa2, bf16x8& pa3) {
  for (int r = 0; r < 16; ++r) p1[r] = __builtin_amdgcn_exp2f(p1[r]);
  float ps = 0; for (int r = 0; r < 16; ++r) ps += p0[r]; for (int r = 0; r < 16; ++r) ps += p1[r];
  { auto rr = __builtin_amdgcn_permlane32_swap(__float_as_uint(ps), __float_as_uint(ps), false, false);
    ps = __uint_as_float(rr[0]) + __uint_as_float(rr[1]); }
  l_reg = l_reg * alpha + ps;
#define PK4(P, BASE, OUT) do { unsigned a0 = cvtpk(P[BASE + 0], P[BASE + 1]), a1 = cvtpk(P[BASE + 2], P[BASE + 3]);   \
    unsigned b0 = cvtpk(P[BASE + 4], P[BASE + 5]), b1 = cvtpk(P[BASE + 6], P[BASE + 7]);                              \
    auto r0 = __builtin_amdgcn_permlane32_swap(a0, b0, false, false); auto r1 = __builtin_amdgcn_permlane32_swap(a1, b1, false, false); \
    u32x4 w = {r0[0], r1[0], r0[1], r1[1]}; OUT = *reinterpret_cast<bf16x8*>(&w); } while (0)
  PK4(p0, 0, pa0); PK4(p0, 8, pa1); PK4(p1, 0, pa2); PK4(p1, 8, pa3);
#undef PK4
}
__device__ __forceinline__ void qkt(f32x16& p0, f32x16& p1, const bf16_t* Ks, const bf16x8* qr, int r32, int hi) {
  p0 = f32x16{}; p1 = f32x16{};
  for (int d0 = 0; d0 < 8; ++d0) { int cb = (d0 * 16 + hi * 8) * 2;
    bf16x8 b0 = *reinterpret_cast<const bf16x8*>((const char*)Ks + KSWZ(r32, cb));
    bf16x8 b1 = *reinterpret_cast<const bf16x8*>((const char*)Ks + KSWZ(32 + r32, cb));
    p0 = __builtin_amdgcn_mfma_f32_32x32x16_bf16(b0, qr[d0], p0, 0, 0, 0);
    p1 = __builtin_amdgcn_mfma_f32_32x32x16_bf16(b1, qr[d0], p1, 0, 0, 0); }
}
__device__ __forceinline__ int v_st(int k, int c) { const int kk = (k & ~0xC) | ((k & 4) << 1) | ((k & 8) >> 1); return ((kk >> 3) * 4 + (c >> 5)) * 512 + ((kk & 7) * 32 + (c & 31)) * 2; }
__device__ __forceinline__ int v_rd_base(int lane) { return ((lane & 3) << 3) | (((lane >> 2) & 3) << 6) | (((lane >> 4) & 1) << 5) | (((lane >> 5) & 1) << 8); }
constexpr int v_rd_off(int d0, int ks, int half) { return d0 * 512 + ks * 4096 + half * 2048; }
template <int OFF> __device__ __forceinline__ s16x4 tr_read(int vb) {
  s16x4 r; asm volatile("ds_read_b64_tr_b16 %0, %1 offset:%2" : "=&v"(r) : "v"(vb), "i"(OFF) : "memory"); return r;
}
template <int D0> __device__ __forceinline__ void pv_one(f32x16& od, int vb, bf16x8 pa0, bf16x8 pa1, bf16x8 pa2, bf16x8 pa3) {
  const s16x4 l0 = tr_read<v_rd_off(D0, 0, 0)>(vb), h0 = tr_read<v_rd_off(D0, 0, 1)>(vb), l1 = tr_read<v_rd_off(D0, 1, 0)>(vb), h1 = tr_read<v_rd_off(D0, 1, 1)>(vb);
  const s16x4 l2 = tr_read<v_rd_off(D0, 2, 0)>(vb), h2 = tr_read<v_rd_off(D0, 2, 1)>(vb), l3 = tr_read<v_rd_off(D0, 3, 0)>(vb), h3 = tr_read<v_rd_off(D0, 3, 1)>(vb);
  asm volatile("s_waitcnt lgkmcnt(0)" ::: "memory"); SBAR();
#define PK(L, H) (bf16x8){L[0], L[1], L[2], L[3], H[0], H[1], H[2], H[3]}
  od = __builtin_amdgcn_mfma_f32_32x32x16_bf16(pa0, PK(l0, h0), od, 0, 0, 0);
  od = __builtin_amdgcn_mfma_f32_32x32x16_bf16(pa1, PK(l1, h1), od, 0, 0, 0);
  od = __builtin_amdgcn_mfma_f32_32x32x16_bf16(pa2, PK(l2, h2), od, 0, 0, 0);
  od = __builtin_amdgcn_mfma_f32_32x32x16_bf16(pa3, PK(l3, h3), od, 0, 0, 0);
#undef PK
}
__device__ __forceinline__ void pv_d0(f32x16* o, int vb, bf16x8 pa0, bf16x8 pa1, bf16x8 pa2, bf16x8 pa3) {
  pv_one<0>(o[0], vb, pa0, pa1, pa2, pa3); pv_one<1>(o[1], vb, pa0, pa1, pa2, pa3); pv_one<2>(o[2], vb, pa0, pa1, pa2, pa3); pv_one<3>(o[3], vb, pa0, pa1, pa2, pa3);
}
__device__ __forceinline__ void attn_dense_body(const bf16_t* __restrict__ Qb, const bf16_t* __restrict__ Kh, const bf16_t* __restrict__ Vh, bf16_t* __restrict__ Ob, int seq, char* lds) {
  const int tid = threadIdx.x, wid = tid >> 6, lane = tid & 63, r32 = lane & 31, hi = lane >> 5;
  bf16_t* V_lds = (bf16_t*)lds; bf16_t* K_lds = (bf16_t*)(lds + 2 * SHM_V);
  float* ws = (float*)(lds + 2 * SHM_V + 2 * SHM_K) + wid * 64; float* li_l = ws; float* al_l = ws + 32;
  float m_reg = -1e30f, l_reg = 0; f32x16 o[4] = {}; bf16x8 qr[8];
  const bf16_t* Qw = Qb + (long)(wid * QBLK + r32) * LDQ + hi * 8;
#pragma unroll
  for (int d0 = 0; d0 < 8; ++d0) qr[d0] = *reinterpret_cast<const bf16x8*>(Qw + d0 * 16);
  const int sr = tid >> 4, sc = (tid & 15) * 8, vst0 = v_st(sr, sc), vst1 = v_st(32 + sr, sc);
  const int vb0 = (int)(uintptr_t)V_lds + v_rd_base(lane);
  struct { bf16x8 vs0, vs1, ks0, ks1; } sr_[2];
#define SLOAD(i, k0) do { sr_[i].vs0 = *(const bf16x8*)(&Vh[(long)((k0) + sr) * LDK + sc]); sr_[i].vs1 = *(const bf16x8*)(&Vh[(long)((k0) + 32 + sr) * LDK + sc]); \
    sr_[i].ks0 = *(const bf16x8*)(&Kh[(long)((k0) + sr) * LDK + sc]); sr_[i].ks1 = *(const bf16x8*)(&Kh[(long)((k0) + 32 + sr) * LDK + sc]); } while (0)
#define SWRITE(b, i) do { *(bf16x8*)((char*)V_lds + (b) * SHM_V + vst0) = sr_[i].vs0;          \
    *(bf16x8*)((char*)V_lds + (b) * SHM_V + vst1) = sr_[i].vs1; int kc = sc * 2;               \
    *(bf16x8*)((char*)K_lds + (b) * SHM_K + KSWZ(sr, kc)) = sr_[i].ks0;                       \
    *(bf16x8*)((char*)K_lds + (b) * SHM_K + KSWZ(32 + sr, kc)) = sr_[i].ks1; } while (0)
#define SWAIT() asm volatile("s_waitcnt vmcnt(4)" ::: "memory")
#define RESC(a) do { if (__any((a) < 1.f)) { if (hi == 0) al_l[r32] = (a); asm volatile("s_waitcnt lgkmcnt(0)" ::: "memory"); \
    for (int d = 0; d < 4; ++d) for (int r = 0; r < 16; ++r) o[d][r] *= al_l[crow(r, hi)]; } } while (0)
  f32x16 pA0, pA1, pB0, pB1; float mnA, mnB, alA, alB; bf16x8 pa0, pa1, pa2, pa3; const int NT = seq / KVBLK;
  constexpr int SE = 0, SO = 1;
  SLOAD(SE, 0); asm volatile("s_waitcnt vmcnt(0)" ::: "memory"); SWRITE(0, SE); __syncthreads();
  qkt(pA0, pA1, K_lds, qr, r32, hi); partialSM(pA0, pA1, m_reg, mnA, alA);
  SLOAD(SO, KVBLK); if (2 < NT) SLOAD(SE, 2 * KVBLK);
  SWAIT(); SWRITE(1, SO); __syncthreads();
  for (int j = 1; j + 1 < NT; j += 2) {
    SBAR(); qkt(pB0, pB1, (bf16_t*)((char*)K_lds + SHM_K), qr, r32, hi);
    finishSM(pA0, pA1, alA, l_reg, pa0, pa1, pa2, pa3); SBAR();
    SLOAD(SO, (j + 2) * KVBLK); SBAR();
    pv_d0(o, vb0, pa0, pa1, pa2, pa3); partialSM(pB0, pB1, m_reg, mnB, alB);
    __syncthreads(); SWAIT(); SWRITE(0, SE);
    RESC(alB); __syncthreads();
    SBAR(); qkt(pA0, pA1, K_lds, qr, r32, hi);
    finishSM(pB0, pB1, alB, l_reg, pa0, pa1, pa2, pa3); SBAR();
    if (j + 3 < NT) SLOAD(SE, (j + 3) * KVBLK); SBAR();
    pv_d0(o, vb0 + (int)SHM_V, pa0, pa1, pa2, pa3); partialSM(pA0, pA1, m_reg, mnA, alA);
    __syncthreads(); SWAIT(); SWRITE(1, SO);
    RESC(alA); __syncthreads();
  }
  SBAR(); qkt(pB0, pB1, (bf16_t*)((char*)K_lds + SHM_K), qr, r32, hi);
  finishSM(pA0, pA1, alA, l_reg, pa0, pa1, pa2, pa3); SBAR();
  pv_d0(o, vb0, pa0, pa1, pa2, pa3); partialSM(pB0, pB1, m_reg, mnB, alB);
  __syncthreads(); RESC(alB);
  finishSM(pB0, pB1, alB, l_reg, pa0, pa1, pa2, pa3); SBAR();
  pv_d0(o, vb0 + (int)SHM_V, pa0, pa1, pa2, pa3);
  if (hi == 0) li_l[r32] = l_reg; asm volatile("s_waitcnt lgkmcnt(0)" ::: "memory");
  float rli[16];
#pragma unroll
  for (int r = 0; r < 16; ++r) rli[r] = __builtin_amdgcn_rcpf(li_l[crow(r, hi)]);
  bf16_t* Ow = Ob + (long)(wid * QBLK) * LDO;
#pragma unroll
  for (int r = 0; r < 16; ++r) { int orow = crow(r, hi);
    for (int d0 = 0; d0 < 4; ++d0) Ow[(long)orow * LDO + d0 * 32 + r32] = f2bf(o[d0][r] * rli[r]); }
  __syncthreads();
#undef SLOAD
#undef SWRITE
#undef SWAIT
#undef RESC
}
}

__global__ __launch_bounds__(512, 1) void k_attn(Params p) {
  extern __shared__ __attribute__((aligned(16))) char shm[];
  const int qb = blockIdx.x, h = blockIdx.y, b = blockIdx.z;
  bf16_t* Q = (bf16_t*)(p.ws + WS_Q); const bf16_t* Kb = (const bf16_t*)(p.ws + WS_K); const bf16_t* Vb = (const bf16_t*)(p.ws + WS_V);
  const size_t q0 = ((size_t)(b * SEQ + qb * 256)) * 1024 + h * 128;
  const size_t k0 = (size_t)b * SKV * 256 + (h / 4) * 128;
  int seq = SKV; asm volatile("" : "+s"(seq));
  att::attn_dense_body(Q + q0, Kb + k0, Vb + k0, Q + q0, seq, shm);
}

__global__ __launch_bounds__(256) void k_ln1_router(Params p) {
  const float* mod = (const float*)(p.ws + WS_MOD);
  float* R1 = p.out;
  bf16_t* H2 = (bf16_t*)(p.ws + WS_Q);
  int* eid = (int*)(p.ws + WS_ROUTE); float* ew = (float*)(p.ws + WS_ROUTE + NLAT * 2 * 4);
  const int lane = threadIdx.x & 63, wv = threadIdx.x >> 6;
  const int row = blockIdx.x * 4 + wv;
  if (row >= NLAT) return;
  const float* mrow = mod + (row / SEQ) * NMOD;
  float4 v[4]; float s = 0;
#pragma unroll
  for (int j = 0; j < 4; ++j) { v[j] = ((const float4*)(R1 + (size_t)row * DM))[lane + 64 * j]; s += (v[j].x + v[j].y) + (v[j].z + v[j].w); }
  float mean = wave_sum(s) * (1.f / DM); float s2 = 0;
#pragma unroll
  for (int j = 0; j < 4; ++j) { v[j].x -= mean; v[j].y -= mean; v[j].z -= mean; v[j].w -= mean; s2 += (v[j].x * v[j].x + v[j].y * v[j].y) + (v[j].z * v[j].z + v[j].w * v[j].w); }
  float rstd = rsqrtf(wave_sum(s2) * (1.f / DM) + LN_EPS);
  s = 0;
#pragma unroll
  for (int j = 0; j < 4; ++j) {
    const int col = (lane + 64 * j) * 4;
    const float4 g = *(const float4*)(p.in[I_LN1G] + col), bb = *(const float4*)(p.in[I_LN1B] + col);
    v[j].x = v[j].x * rstd * g.x + bb.x; v[j].y = v[j].y * rstd * g.y + bb.y; v[j].z = v[j].z * rstd * g.z + bb.z; v[j].w = v[j].w * rstd * g.w + bb.w;
    ((float4*)(R1 + (size_t)row * DM))[lane + 64 * j] = v[j];
    s += (v[j].x + v[j].y) + (v[j].z + v[j].w);
  }
  mean = wave_sum(s) * (1.f / DM); s2 = 0;
#pragma unroll
  for (int j = 0; j < 4; ++j) { v[j].x -= mean; v[j].y -= mean; v[j].z -= mean; v[j].w -= mean; s2 += (v[j].x * v[j].x + v[j].y * v[j].y) + (v[j].z * v[j].z + v[j].w * v[j].w); }
  rstd = rsqrtf(wave_sum(s2) * (1.f / DM) + LN_EPS);
  float lg[36];
#pragma unroll
  for (int i = 0; i < 36; ++i) lg[i] = 0.f;
#pragma unroll
  for (int j = 0; j < 4; ++j) {
    const int col = (lane + 64 * j) * 4;
    const float4 sh = *(const float4*)(mrow + 3 * DM + col), sc = *(const float4*)(mrow + 4 * DM + col);
    float hv[4] = {v[j].x * rstd * (1.f + sc.x) + sh.x, v[j].y * rstd * (1.f + sc.y) + sh.y, v[j].z * rstd * (1.f + sc.z) + sh.z, v[j].w * rstd * (1.f + sc.w) + sh.w};
    ushort4 o; o.x = f2bf(hv[0]); o.y = f2bf(hv[1]); o.z = f2bf(hv[2]); o.w = f2bf(hv[3]);
    *(ushort4*)(H2 + (size_t)row * DM + col) = o;
#pragma unroll
    for (int e = 0; e < 4; ++e) {
      const float4 wg = *(const float4*)(p.in[I_WRG] + (size_t)(col + e) * 4);
      lg[0] += hv[e] * wg.x; lg[1] += hv[e] * wg.y; lg[2] += hv[e] * wg.z; lg[3] += hv[e] * wg.w;
      const float4* we = (const float4*)(p.in[I_WRE] + (size_t)(col + e) * 32);
#pragma unroll
      for (int q = 0; q < 8; ++q) { const float4 w4 = we[q]; lg[4 + 4 * q] += hv[e] * w4.x; lg[5 + 4 * q] += hv[e] * w4.y; lg[6 + 4 * q] += hv[e] * w4.z; lg[7 + 4 * q] += hv[e] * w4.w; }
    }
  }
#pragma unroll
  for (int i = 0; i < 36; ++i) lg[i] = wave_sum(lg[i]);
  if (lane == 0) {
    float gl[4]; int gi = 0;
#pragma unroll
    for (int i = 0; i < 4; ++i) gl[i] = lg[i] + p.in[I_BRG][i];
    float gm = gl[0];
#pragma unroll
    for (int i = 1; i < 4; ++i) if (gl[i] > gm) { gm = gl[i]; gi = i; }
    float den = 0.f;
#pragma unroll
    for (int i = 0; i < 4; ++i) den += expf(gl[i] - gm);
    const float gw = 1.f / den;
    float el[8];
#pragma unroll
    for (int i = 0; i < 8; ++i) {
      float t = 0.f;
#pragma unroll
      for (int gq = 0; gq < 4; ++gq) if (gq == gi) t = lg[4 + gq * 8 + i] + p.in[I_BRE][gq * 8 + i];
      el[i] = t;
    }
    int i1 = 0; float v1 = el[0];
#pragma unroll
    for (int i = 1; i < 8; ++i) if (el[i] > v1) { v1 = el[i]; i1 = i; }
    int i2 = -1; float v2 = -3.0e38f;
#pragma unroll
    for (int i = 0; i < 8; ++i) if (i != i1 && el[i] > v2) { v2 = el[i]; i2 = i; }
    const float e2 = expf(v2 - v1); const float w1 = 1.f / (1.f + e2), w2 = e2 / (1.f + e2);
    eid[row * 2] = gi * 8 + i1; eid[row * 2 + 1] = gi * 8 + i2;
    ew[row * 2] = w1 * gw; ew[row * 2 + 1] = w2 * gw;
  }
}

__global__ __launch_bounds__(256) void k_moe_naive(Params p) {
  const bf16_t* H2 = (const bf16_t*)(p.ws + WS_Q);
  const int* eid = (const int*)(p.ws + WS_ROUTE); const float* ew = (const float*)(p.ws + WS_ROUTE + NLAT * 2 * 4);
  float* YM = (float*)(p.ws + WS_T1);
  __shared__ float hs[DM]; __shared__ float act[512];
  const int row = blockIdx.x, t = threadIdx.x;
  for (int i = t; i < DM; i += 256) hs[i] = bf2f(H2[(size_t)row * DM + i]);
  float y[4] = {0.f, 0.f, 0.f, 0.f};
  for (int k = 0; k < 2; ++k) {
    const int e = eid[row * 2 + k]; const float w = ew[row * 2 + k];
    const float* Wg = p.in[I_WEG] + (size_t)e * DM * 512; const float* Wu = p.in[I_WEU] + (size_t)e * DM * 512; const float* Wd = p.in[I_WED] + (size_t)e * 512 * DM;
    __syncthreads();
    float a0 = 0, a1 = 0, b0 = 0, b1 = 0;
    for (int kk = 0; kk < DM; ++kk) { const float h = hs[kk]; a0 += h * Wg[(size_t)kk * 512 + t]; a1 += h * Wg[(size_t)kk * 512 + 256 + t]; b0 += h * Wu[(size_t)kk * 512 + t]; b1 += h * Wu[(size_t)kk * 512 + 256 + t]; }
    act[t] = siluf_(a0) * b0 * w; act[256 + t] = siluf_(a1) * b1 * w;
    __syncthreads();
    for (int f = 0; f < 512; ++f) { const float a = act[f];
#pragma unroll
      for (int i = 0; i < 4; ++i) y[i] += a * Wd[(size_t)f * DM + t + 256 * i]; }
  }
#pragma unroll
  for (int i = 0; i < 4; ++i) YM[(size_t)row * DM + t + 256 * i] = y[i];
}

__global__ __launch_bounds__(256) void k_final(Params p) {
  const float* mod = (const float*)(p.ws + WS_MOD);
  const float* YM = (const float*)(p.ws + WS_T1);
  float* X1 = p.out;
  const int lane = threadIdx.x & 63, wv = threadIdx.x >> 6;
  const int row = blockIdx.x * 4 + wv;
  if (row >= NLAT) return;
  const float* mrow = mod + (row / SEQ) * NMOD;
  float4 v[4]; float s = 0;
#pragma unroll
  for (int j = 0; j < 4; ++j) {
    const int col = (lane + 64 * j) * 4;
    const float4 x1 = ((const float4*)(X1 + (size_t)row * DM))[lane + 64 * j], ym = ((const float4*)(YM + (size_t)row * DM))[lane + 64 * j];
    const float4 g2 = *(const float4*)(mrow + 5 * DM + col);
    v[j].x = ALPHA * x1.x + g2.x * ym.x; v[j].y = ALPHA * x1.y + g2.y * ym.y; v[j].z = ALPHA * x1.z + g2.z * ym.z; v[j].w = ALPHA * x1.w + g2.w * ym.w;
    s += (v[j].x + v[j].y) + (v[j].z + v[j].w);
  }
  const float mean = wave_sum(s) * (1.f / DM); float s2 = 0;
#pragma unroll
  for (int j = 0; j < 4; ++j) { v[j].x -= mean; v[j].y -= mean; v[j].z -= mean; v[j].w -= mean; s2 += (v[j].x * v[j].x + v[j].y * v[j].y) + (v[j].z * v[j].z + v[j].w * v[j].w); }
  const float rstd = rsqrtf(wave_sum(s2) * (1.f / DM) + LN_EPS);
#pragma unroll
  for (int j = 0; j < 4; ++j) {
    const int col = (lane + 64 * j) * 4;
    const float4 g = *(const float4*)(p.in[I_LN2G] + col), bb = *(const float4*)(p.in[I_LN2B] + col);
    float4 o; o.x = v[j].x * rstd * g.x + bb.x; o.y = v[j].y * rstd * g.y + bb.y; o.z = v[j].z * rstd * g.z + bb.z; o.w = v[j].w * rstd * g.w + bb.w;
    ((float4*)(X1 + (size_t)row * DM))[lane + 64 * j] = o;
  }
}

extern "C" void kernel_launch(void* const* d_in, const int* in_sizes, int n_in, void* d_out, int out_size, void* d_ws, size_t ws_size, hipStream_t stream) {
  static int ok = 0;
  if (!ok) {
    if (n_in != 32 || out_size != NLAT * DM || ws_size < WS_END) { fprintf(stderr, "kernel_launch: unexpected shapes n_in %d out %d ws %zu\n", n_in, out_size, ws_size); return; }
    if (hipFuncSetAttribute((const void*)k_attn, hipFuncAttributeMaxDynamicSharedMemorySize, (int)att::SHM_ATTN) != hipSuccess) { fprintf(stderr, "kernel_launch: hipFuncSetAttribute failed\n"); return; }
    ok = 1;
  }
  Params p{};
  for (int i = 0; i < 32; ++i) p.in[i] = (const float*)d_in[i];
  p.out = (float*)d_out; p.ws = (unsigned char*)d_ws;
  unsigned char* ws = p.ws;
  hipLaunchKernelGGL(k_mod, dim3(NMOD / 256), dim3(256), 0, stream, p);
  hipLaunchKernelGGL(k_s5disc, dim3(64), dim3(64), 0, stream, p);
  hipLaunchKernelGGL(k_lnmod, dim3(NTOK / 4), dim3(256), 0, stream, p);
  {
    EpIn ep{(bf16_t*)(ws + WS_U), p.out, (float*)(ws + WS_GY), (bf16_t*)(ws + WS_V), (bf16_t*)(ws + WS_G)};
    hipLaunchKernelGGL(k_gemm_naive<EpIn>, dim3(INW / 64, NTOK / 64), dim3(256), 0, stream, (const bf16_t*)(ws + WS_H), DM, p.in[I_WIN], INW, DM, ep);
  }
  hipLaunchKernelGGL(k_qknorm, dim3((NLAT * 10 + NCT * 2) / 4), dim3(256), 0, stream, p);
  hipLaunchKernelGGL(k_s5_naive, dim3(64), dim3(64), 0, stream, p);
  hipLaunchKernelGGL(k_attn, dim3(SEQ / 256, 8, NB), dim3(512), att::SHM_ATTN, stream, p);
  {
    EpGluA ea{(float*)(ws + WS_T1)};
    hipLaunchKernelGGL(k_gemm_naive<EpGluA>, dim3(DM / 64, NLAT / 64), dim3(256), 0, stream, (const bf16_t*)(ws + WS_GY), 512, p.in[I_WGA], DM, 512, ea);
    EpGluB eb{(float*)(ws + WS_T1), (const bf16_t*)(ws + WS_G)};
    hipLaunchKernelGGL(k_gemm_naive<EpGluB>, dim3(DM / 64, NLAT / 64), dim3(256), 0, stream, (const bf16_t*)(ws + WS_GY), 512, p.in[I_WGB], DM, 512, eb);
    EpAttnO eo{(const float*)(ws + WS_T1), (const bf16_t*)(ws + WS_G), (bf16_t*)(ws + WS_H)};
    hipLaunchKernelGGL(k_gemm_naive<EpAttnO>, dim3(DM / 64, NLAT / 64), dim3(256), 0, stream, (const bf16_t*)(ws + WS_Q), DM, p.in[I_WAO], DM, DM, eo);
    EpOut ee{p.in[I_X], (const float*)(ws + WS_MOD), p.out};
    hipLaunchKernelGGL(k_gemm_naive<EpOut>, dim3(DM / 64, NLAT / 64), dim3(256), 0, stream, (const bf16_t*)(ws + WS_H), DM, p.in[I_WOUT], DM, DM, ee);
  }
  hipLaunchKernelGGL(k_ln1_router, dim3(NLAT / 4), dim3(256), 0, stream, p);
  hipLaunchKernelGGL(k_moe_naive, dim3(NLAT), dim3(256), 0, stream, p);
  hipLaunchKernelGGL(k_final, dim3(NLAT / 4), dim3(256), 0, stream, p);
}
```

```cpp
#include <hip/hip_runtime.h>
#include <hip/hip_bf16.h>
#include <cstdint>
#include <cstdio>

typedef unsigned short bf16_t;
#define LAS __attribute__((address_space(3)))
typedef short bf16x8 __attribute__((ext_vector_type(8)));
typedef float f32x4 __attribute__((ext_vector_type(4)));
typedef float f32x2 __attribute__((ext_vector_type(2)));
typedef unsigned u32x4 __attribute__((ext_vector_type(4)));
typedef unsigned u32x2 __attribute__((ext_vector_type(2)));

__device__ __forceinline__ float bf2f(bf16_t v) { return __uint_as_float(((unsigned)v) << 16); }
__device__ __forceinline__ bf16_t f2bf(float f) { unsigned u = __float_as_uint(f); return (bf16_t)((u + 0x7fffu + ((u >> 16) & 1u)) >> 16); }
__device__ __forceinline__ unsigned cvt_pk_bf16(float lo, float hi) { unsigned r; asm volatile("v_cvt_pk_bf16_f32 %0, %1, %2" : "=v"(r) : "v"(lo), "v"(hi)); return r; }

constexpr int DM = 1024, NB = 2, SEQ = 8192, NCTX = 256;
constexpr int NLAT = NB * SEQ;
constexpr int SKV = SEQ + NCTX;
constexpr int NROW = NB * SKV;
constexpr int INW = 4096;
constexpr int NMOD = 6 * DM;
constexpr int PLD = 3584;
constexpr int PC_Q = 0, PC_K = 1024, PC_V = 1280, PC_G = 1536;
constexpr int NCHUNK = NROW / 16;
constexpr float LN_EPS = 1e-6f;
constexpr float ALPHA = 1.189207115002721f;

constexpr size_t MiB = 1u << 20;
constexpr size_t WS_CTL = 0;
constexpr size_t WS_MOD = 1 * MiB;
constexpr size_t WS_ROUTE = 2 * MiB;
constexpr size_t WS_S5AB = 5 * MiB;
constexpr size_t WS_S5T = 6 * MiB;
constexpr size_t WS_S5E = 14 * MiB;
constexpr size_t WS_WIN = 18 * MiB;
constexpr size_t WS_WGLU = 26 * MiB;
constexpr size_t WS_WAO = 28 * MiB;
constexpr size_t WS_WOUT = 30 * MiB;
constexpr size_t WS_WGU = 32 * MiB;
constexpr size_t WS_WD = 96 * MiB;
constexpr size_t WS_RH = 128 * MiB;
constexpr size_t WS_P = 162 * MiB;
constexpr size_t WS_END = 280 * MiB;
constexpr size_t DO_YA = 0, DO_GY = 34 * MiB;

struct Params {
  const float* in[32];
  float* out;
  unsigned char* ws;
};
enum { I_X = 0, I_C, I_CTX, I_CCTX, I_WMOD, I_BMOD, I_WIN, I_SARE, I_SAIM, I_SLDT, I_SBRE, I_SBIM, I_SCRE, I_SCIM, I_SD,
       I_WGA, I_WGB, I_QG, I_KG, I_WAO, I_WOUT, I_LN1G, I_LN1B, I_WRG, I_BRG, I_WRE, I_BRE, I_WEG, I_WEU, I_WED, I_LN2G, I_LN2B };

__device__ __forceinline__ float wave_sum(float v) {
#pragma unroll
  for (int o = 1; o < 64; o <<= 1) v += __shfl_xor(v, o);
  return v;
}
__device__ __forceinline__ float sigmoidf_(float x) { return 1.f / (1.f + __expf(-x)); }
__device__ __forceinline__ float siluf_(float x) { return x / (1.f + __expf(-x)); }
__device__ __forceinline__ float gelu_tanh(float x) {
  const float k0 = 0.7978845608028654f, k1 = 0.044715f;
  const float z = k0 * (x + k1 * x * x * x);
  return x / (1.f + __expf(-2.f * z));
}
__device__ __forceinline__ int lat2pad(int lr) { return lr + (lr / SEQ) * NCTX; }
namespace pg {
constexpr int BM = 256, BK = 64, HALF = 128, HTB = HALF * BK * 2, STAGE_BYTES = 8 * HTB;
__host__ __device__ __forceinline__ int lds_byte(int r, int c) { const int st = (r >> 4) * 2 + (c >> 5), rr = r & 15, cc = c & 31, ob = rr * 64 + cc * 2; return st * 1024 + (ob ^ (((ob >> 9) & 1) << 5)); }
__host__ __device__ __forceinline__ void stage_rc(int b, int& R, int& C) { const int st = b / 1024, sb = b % 1024, swz = sb ^ (((sb >> 9) & 1) << 5); R = (st >> 1) * 16 + swz / 64; C = (st & 1) * 32 + (swz % 64) / 2; }
__host__ __device__ __forceinline__ int perm32(int rho) { const int n = rho >> 4, i = rho & 15; return 8 * (i >> 2) + 4 * n + (i & 3); }

struct Unit { int pm, pn, aux; };
struct Addr {
  const bf16_t* A; int lda; size_t a_gs; const bf16_t* Bt; int K; size_t b_gs;
  __device__ __forceinline__ const char* a_base(const Unit& u) const { return (const char*)(A + (size_t)u.aux * a_gs + (size_t)u.pm * BM * lda); }
  __device__ __forceinline__ const char* b_base(const Unit& u) const { return (const char*)(Bt + (size_t)u.aux * b_gs + (size_t)u.pn * BM * K); }
};
typedef f32x4 Acc[2][2][4][2];

template <class Epi, class Sched>
__device__ __forceinline__ void gemm_phase(LAS unsigned char* lds, const Addr AD, const Sched& S, const Epi& E) {
  const int tid = threadIdx.x, wid = __builtin_amdgcn_readfirstlane(tid >> 6), lane = tid & 63, wr = wid >> 2, wc = wid & 3, fr = lane & 15, fq = lane >> 4;
  const int K = AD.K, nt = K / BK, lda = AD.lda;
  unsigned voffA[2], voffB[2];
#pragma unroll
  for (int i = 0; i < 2; ++i) { int R, C; stage_rc(tid * 16 + i * 8192, R, C); const int Rb = Epi::PERM ? ((R & ~31) + perm32(R & 31)) : R;
    voffA[i] = (unsigned)(R * lda + C) * 2u; voffB[i] = (unsigned)(Rb * K + C) * 2u; }
  const size_t kstep = (size_t)(BK * 2);
  const size_t hstepA = (size_t)HALF * lda * 2, hstepB = (size_t)HALF * K * 2;
  const unsigned ldsw = (unsigned)wid * 1024u;
  const int aoff = lds_byte(wr * 64 + fr, fq * 8), boff = lds_byte(wc * 32 + fr, fq * 8);
#define PG_SA(b, h) (((b) * 2 + (h)) * HTB)
#define PG_SB(b, h) ((4 + (b) * 2 + (h)) * HTB)
#define PG_STAGE(bufoff, gbase, voff) do { _Pragma("unroll") for (int _i = 0; _i < 2; ++_i) \
    __builtin_amdgcn_global_load_lds((const unsigned*)((const char*)(gbase) + (voff)[_i]), (LAS unsigned*)(lds + (bufoff) + ldsw + _i * 8192), 16, 0, 0); } while (0)
#define PG_LDA(dst, b, h) do { _Pragma("unroll") for (int m = 0; m < 4; ++m) _Pragma("unroll") for (int k = 0; k < 2; ++k) dst[m][k] = *(const LAS bf16x8*)(lds + PG_SA(b, h) + aoff + m * 2048 + k * 1024); } while (0)
#define PG_LDB(dst, b, h) do { _Pragma("unroll") for (int n = 0; n < 2; ++n) _Pragma("unroll") for (int k = 0; k < 2; ++k) dst[n][k] = *(const LAS bf16x8*)(lds + PG_SB(b, h) + boff + n * 2048 + k * 1024); } while (0)
#define PG_MMA(ai, bj, At, Bt) do { __builtin_amdgcn_s_setprio(1); _Pragma("unroll") for (int m = 0; m < 4; ++m) _Pragma("unroll") for (int n = 0; n < 2; ++n) _Pragma("unroll") for (int k = 0; k < 2; ++k) \
    acc[ai][bj][m][n] = __builtin_amdgcn_mfma_f32_16x16x32_bf16(Bt[n][k], At[m][k], acc[ai][bj][m][n], 0, 0, 0); __builtin_amdgcn_s_setprio(0); } while (0)
#define PG_WAIT_V(n) asm volatile("s_waitcnt vmcnt(" #n ")" ::: "memory")
#define PG_WAIT_L(n) asm volatile("s_waitcnt lgkmcnt(" #n ")" ::: "memory")
#define PG_BAR __builtin_amdgcn_s_barrier()
#define PG_SCHED __builtin_amdgcn_sched_barrier(0)
  Unit cur, nxt; int ui = 0;
  if (!S.next(0, cur)) return;
  Acc acc;
#pragma unroll
  for (int a = 0; a < 2; ++a)
#pragma unroll
    for (int b = 0; b < 2; ++b)
#pragma unroll
      for (int m = 0; m < 4; ++m)
#pragma unroll
        for (int n = 0; n < 2; ++n) acc[a][b][m][n] = (f32x4){0.f, 0.f, 0.f, 0.f};
  bf16x8 At[4][2], B0[2][2], B1[2][2];
  const char* cA = AD.a_base(cur); const char* cB = AD.b_base(cur);
  PG_STAGE(PG_SB(0, 0), cB, voffB); PG_STAGE(PG_SB(0, 1), cB + hstepB, voffB); PG_STAGE(PG_SA(0, 0), cA, voffA); PG_STAGE(PG_SA(0, 1), cA + hstepA, voffA);
  if (wr == 1) PG_BAR;
  PG_WAIT_V(2); PG_BAR;
  PG_STAGE(PG_SB(1, 0), cB + kstep, voffB); PG_STAGE(PG_SA(1, 0), cA + kstep, voffA); PG_STAGE(PG_SB(1, 1), cB + hstepB + kstep, voffB);
  PG_WAIT_V(6); PG_BAR;
  for (;;) {
    const bool has_next = S.next(ui + 1, nxt);
    const char* nA = has_next ? AD.a_base(nxt) : cA; const char* nB = has_next ? AD.b_base(nxt) : cB;
    for (int t = 0; t < nt; t += 2) {
      const bool last = (t == nt - 2);
      const char* a1 = cA + (size_t)(t + 1) * kstep;
      const char* a2 = last ? nA : cA + (size_t)(t + 2) * kstep; const char* b2 = last ? nB : cB + (size_t)(t + 2) * kstep;
      const char* a3 = a2 + kstep; const char* b3 = b2 + kstep;
      PG_LDB(B0, 0, 0); PG_LDB(B1, 0, 1); PG_SCHED; PG_LDA(At, 0, 0); PG_STAGE(PG_SA(1, 1), a1 + hstepA, voffA);
      PG_WAIT_V(8); PG_WAIT_L(0); PG_BAR; PG_MMA(0, 0, At, B0); PG_MMA(0, 1, At, B1); PG_BAR; PG_SCHED;
      PG_LDA(At, 0, 1); PG_STAGE(PG_SB(0, 0), b2, voffB); PG_STAGE(PG_SB(0, 1), b2 + hstepB, voffB); PG_STAGE(PG_SA(0, 0), a2, voffA);
      PG_WAIT_V(8); PG_WAIT_L(0); PG_BAR; PG_MMA(1, 0, At, B0); PG_MMA(1, 1, At, B1); PG_BAR; PG_SCHED;
      PG_LDB(B0, 1, 0); PG_LDB(B1, 1, 1); PG_SCHED; PG_LDA(At, 1, 0); PG_STAGE(PG_SA(0, 1), a2 + hstepA, voffA);
      PG_WAIT_V(8); PG_WAIT_L(0); PG_BAR; PG_MMA(0, 0, At, B0); PG_MMA(0, 1, At, B1); PG_BAR; PG_SCHED;
      PG_LDA(At, 1, 1); PG_STAGE(PG_SB(1, 0), b3, voffB); PG_STAGE(PG_SB(1, 1), b3 + hstepB, voffB); PG_STAGE(PG_SA(1, 0), a3, voffA);
      PG_WAIT_V(8); PG_WAIT_L(0); PG_BAR; PG_MMA(1, 0, At, B0); PG_MMA(1, 1, At, B1); PG_BAR; PG_SCHED;
    }
    if (wr == 0) PG_BAR;
    E(acc, cur, wr, wc, fr, fq);
    if (!has_next) break;
#pragma unroll
    for (int a = 0; a < 2; ++a)
#pragma unroll
      for (int b = 0; b < 2; ++b)
#pragma unroll
        for (int m = 0; m < 4; ++m)
#pragma unroll
          for (int n = 0; n < 2; ++n) acc[a][b][m][n] = (f32x4){0.f, 0.f, 0.f, 0.f};
    cur = nxt; cA = nA; cB = nB; ++ui;
    if (wr == 1) PG_BAR;
  }
  PG_WAIT_V(0);
  PG_BAR;
#undef PG_SA
#undef PG_SB
#undef PG_STAGE
#undef PG_LDA
#undef PG_LDB
#undef PG_MMA
#undef PG_WAIT_V
#undef PG_WAIT_L
#undef PG_BAR
#undef PG_SCHED
}
}
namespace att {
using bf16x8 = __attribute__((ext_vector_type(8))) short;
using s16x4 = __attribute__((ext_vector_type(4))) short;
using f32x16 = __attribute__((ext_vector_type(16))) float;
using u32x4 = __attribute__((ext_vector_type(4))) unsigned;
constexpr int D = 128, NW = 8, QBLK = 32, KVBLK = 64;
constexpr float SCALE = 0.088388347648318440f;
constexpr float THR = 8.f;
constexpr int LDQ = PLD, LDK = PLD, LDO = PLD;
constexpr size_t SHM_V = KVBLK * D * 2, SHM_K = KVBLK * D * 2, SHM_ATTN = 2 * SHM_V + 2 * SHM_K + NW * 64 * 4;
#define KSWZ(row, colB) ((row) * 256 + ((colB) ^ (((row) & 7) << 4)))
#define SBAR() __builtin_amdgcn_sched_barrier(0)
__device__ __forceinline__ int crow(int r, int hi) { return (r & 3) + 8 * (r >> 2) + 4 * hi; }
__device__ __forceinline__ unsigned cvtpk(float lo, float hi) { unsigned r; asm volatile("v_cvt_pk_bf16_f32 %0, %1, %2" : "=v"(r) : "v"(lo), "v"(hi)); return r; }
__device__ __forceinline__ void partialSM(f32x16& p0, f32x16& p1, float& m_reg, float& mn, float& alpha) {
  constexpr float C = SCALE * 1.4426950408889634f;
  float pmax = p0[0]; for (int r = 1; r < 16; ++r) pmax = fmaxf(pmax, p0[r]); for (int r = 0; r < 16; ++r) pmax = fmaxf(pmax, p1[r]);
  { auto rr = __builtin_amdgcn_permlane32_swap(__float_as_uint(pmax), __float_as_uint(pmax), false, false);
    pmax = fmaxf(__uint_as_float(rr[0]), __uint_as_float(rr[1])); }
  if (__builtin_expect(__all(pmax - m_reg <= THR / SCALE), 1)) { mn = m_reg; alpha = 1.f; }
  else { mn = fmaxf(m_reg, pmax); alpha = __builtin_amdgcn_exp2f((m_reg - mn) * C); m_reg = mn; }
  float mnC = -mn * C;
  for (int r = 0; r < 16; ++r) p0[r] = fmaf(p0[r], C, mnC); for (int r = 0; r < 16; ++r) p1[r] = fmaf(p1[r], C, mnC);
  for (int r = 0; r < 16; ++r) p0[r] = __builtin_amdgcn_exp2f(p0[r]);
}
__device__ __forceinline__ void finishSM(f32x16& p0, f32x16& p1, float alpha, float& l_reg, bf16x8& pa0, bf16x8& pa1, bf16x8& pa2, bf16x8& pa3) {
  for (int r = 0; r < 16; ++r) p1[r] = __builtin_amdgcn_exp2f(p1[r]);
  float ps = 0; for (int r = 0; r < 16; ++r) ps += p0[r]; for (int r = 0; r < 16; ++r) ps += p1[r];
  { auto rr = __builtin_amdgcn_permlane32_swap(__float_as_uint(ps), __float_as_uint(ps), false, false);
    ps = __uint_as_float(rr[0]) + __uint_as_float(rr[1]); }
  l_reg = l_reg * alpha + ps;
#define PK4(P, BASE, OUT) do { unsigned a0 = cvtpk(P[BASE + 0], P[BASE + 1]), a1 = cvtpk(P[BASE + 2], P[BASE + 3]);   \
    unsigned b0 = cvtpk(P[BASE + 4], P[BASE + 5]), b1 = cvtpk(P[BASE + 6], P[BASE + 7]);                              \
    auto r0 = __builtin_amdgcn_permlane32_swap(a0, b0, false, false); auto r1 = __builtin_amdgcn_permlane32_swap(a1, b1, false, false); \
    u32x4 w = {r0[0], r1[0], r0[1], r1[1]}; OUT = *reinterpret_cast<bf16x8*>(&w); } while (0)
  PK4(p0, 0, pa0); PK4(p0, 8, pa1); PK4(p1, 0, pa2); PK4(p1, 8, pa3);
#undef PK4
}
__device__ __forceinline__ void qkt(f32x16& p0, f32x16& p1, const bf16_t* Ks, const bf16x8* qr, int r32, int hi) {
  p0 = f32x16{}; p1 = f32x16{};
  for (int d0 = 0; d0 < 8; ++d0) { int cb = (d0 * 16 + hi * 8) * 2;
    bf16x8 b0 = *reinterpret_cast<const bf16x8*>((const char*)Ks + KSWZ(r32, cb));
    bf16x8 b1 = *reinterpret_cast<const bf16x8*>((const char*)Ks + KSWZ(32 + r32, cb));
    p0 = __builtin_amdgcn_mfma_f32_32x32x16_bf16(b0, qr[d0], p0, 0, 0, 0);
    p1 = __builtin_amdgcn_mfma_f32_32x32x16_bf16(b1, qr[d0], p1, 0, 0, 0); }
}
__device__ __forceinline__ int v_st(int k, int c) { const int kk = (k & ~0xC) | ((k & 4) << 1) | ((k & 8) >> 1); return ((kk >> 3) * 4 + (c >> 5)) * 512 + ((kk & 7) * 32 + (c & 31)) * 2; }
__device__ __forceinline__ int v_rd_base(int lane) { return ((lane & 3) << 3) | (((lane >> 2) & 3) << 6) | (((lane >> 4) & 1) << 5) | (((lane >> 5) & 1) << 8); }
constexpr int v_rd_off(int d0, int ks, int half) { return d0 * 512 + ks * 4096 + half * 2048; }
template <int OFF> __device__ __forceinline__ s16x4 tr_read(int vb) {
  s16x4 r; asm volatile("ds_read_b64_tr_b16 %0, %1 offset:%2" : "=&v"(r) : "v"(vb), "i"(OFF) : "memory"); return r;
}
template <int D0> __device__ __forceinline__ void pv_one(f32x16& od, int vb, bf16x8 pa0, bf16x8 pa1, bf16x8 pa2, bf16x8 pa3) {
  const s16x4 l0 = tr_read<v_rd_off(D0, 0, 0)>(vb), h0 = tr_read<v_rd_off(D0, 0, 1)>(vb), l1 = tr_read<v_rd_off(D0, 1, 0)>(vb), h1 = tr_read<v_rd_off(D0, 1, 1)>(vb);
  const s16x4 l2 = tr_read<v_rd_off(D0, 2, 0)>(vb), h2 = tr_read<v_rd_off(D0, 2, 1)>(vb), l3 = tr_read<v_rd_off(D0, 3, 0)>(vb), h3 = tr_read<v_rd_off(D0, 3, 1)>(vb);
  asm volatile("s_waitcnt lgkmcnt(0)" ::: "memory"); SBAR();
#define PK(L, H) (bf16x8){L[0], L[1], L[2], L[3], H[0], H[1], H[2], H[3]}
  od = __builtin_amdgcn_mfma_f32_32x32x16_bf16(pa0, PK(l0, h0), od, 0, 0, 0);
  od = __builtin_amdgcn_mfma_f32_32x32x16_bf16(pa1, PK(l1, h1), od, 0, 0, 0);
  od = __builtin_amdgcn_mfma_f32_32x32x16_bf16(pa2, PK(l2, h2), od, 0, 0, 0);
  od = __builtin_amdgcn_mfma_f32_32x32x16_bf16(pa3, PK(l3, h3), od, 0, 0, 0);
#undef PK
}
__device__ __forceinline__ void pv_d0(f32x16* o, int vb, bf16x8 pa0, bf16x8 pa1, bf16x8 pa2, bf16x8 pa3) {
  pv_one<0>(o[0], vb, pa0, pa1, pa2, pa3); pv_one<1>(o[1], vb, pa0, pa1, pa2, pa3); pv_one<2>(o[2], vb, pa0, pa1, pa2, pa3); pv_one<3>(o[3], vb, pa0, pa1, pa2, pa3);
}
__device__ __forceinline__ void attn_dense_body(const bf16_t* __restrict__ Qb, const bf16_t* __restrict__ Kh, const bf16_t* __restrict__ Vh, bf16_t* __restrict__ Ob, int seq, char* lds) {
  const int tid = threadIdx.x, wid = tid >> 6, lane = tid & 63, r32 = lane & 31, hi = lane >> 5;
  bf16_t* V_lds = (bf16_t*)lds; bf16_t* K_lds = (bf16_t*)(lds + 2 * SHM_V);
  float* ws = (float*)(lds + 2 * SHM_V + 2 * SHM_K) + wid * 64; float* li_l = ws; float* al_l = ws + 32;
  float m_reg = -1e30f, l_reg = 0; f32x16 o[4] = {}; bf16x8 qr[8];
  const bf16_t* Qw = Qb + (long)(wid * QBLK + r32) * LDQ + hi * 8;
#pragma unroll
  for (int d0 = 0; d0 < 8; ++d0) qr[d0] = *reinterpret_cast<const bf16x8*>(Qw + d0 * 16);
  const int sr = tid >> 4, sc = (tid & 15) * 8, vst0 = v_st(sr, sc), vst1 = v_st(32 + sr, sc);
  const int vb0 = (int)(uintptr_t)V_lds + v_rd_base(lane);
  struct { bf16x8 vs0, vs1, ks0, ks1; } sr_[2];
#define SLOAD(i, k0) do { sr_[i].vs0 = *(const bf16x8*)(&Vh[(long)((k0) + sr) * LDK + sc]); sr_[i].vs1 = *(const bf16x8*)(&Vh[(long)((k0) + 32 + sr) * LDK + sc]); \
    sr_[i].ks0 = *(const bf16x8*)(&Kh[(long)((k0) + sr) * LDK + sc]); sr_[i].ks1 = *(const bf16x8*)(&Kh[(long)((k0) + 32 + sr) * LDK + sc]); } while (0)
#define SWRITE(b, i) do { *(bf16x8*)((char*)V_lds + (b) * SHM_V + vst0) = sr_[i].vs0;          \
    *(bf16x8*)((char*)V_lds + (b) * SHM_V + vst1) = sr_[i].vs1; int kc = sc * 2;               \
    *(bf16x8*)((char*)K_lds + (b) * SHM_K + KSWZ(sr, kc)) = sr_[i].ks0;                       \
    *(bf16x8*)((char*)K_lds + (b) * SHM_K + KSWZ(32 + sr, kc)) = sr_[i].ks1; } while (0)
#define SWAIT() asm volatile("s_waitcnt vmcnt(4)" ::: "memory")
#define RESC(a) do { if (__any((a) < 1.f)) { if (hi == 0) al_l[r32] = (a); asm volatile("s_waitcnt lgkmcnt(0)" ::: "memory"); \
    for (int d = 0; d < 4; ++d) for (int r = 0; r < 16; ++r) o[d][r] *= al_l[crow(r, hi)]; } } while (0)
  f32x16 pA0, pA1, pB0, pB1; float mnA, mnB, alA, alB; bf16x8 pa0, pa1, pa2, pa3; const int NT = seq / KVBLK;
  constexpr int SE = 0, SO = 1;
  SLOAD(SE, 0); asm volatile("s_waitcnt vmcnt(0)" ::: "memory"); SWRITE(0, SE); __syncthreads();
  qkt(pA0, pA1, K_lds, qr, r32, hi); partialSM(pA0, pA1, m_reg, mnA, alA);
  SLOAD(SO, KVBLK); if (2 < NT) SLOAD(SE, 2 * KVBLK);
  SWAIT(); SWRITE(1, SO); __syncthreads();
  for (int j = 1; j + 1 < NT; j += 2) {
    SBAR(); qkt(pB0, pB1, (bf16_t*)((char*)K_lds + SHM_K), qr, r32, hi);
    finishSM(pA0, pA1, alA, l_reg, pa0, pa1, pa2, pa3); SBAR();
    SLOAD(SO, (j + 2) * KVBLK); SBAR();
    pv_d0(o, vb0, pa0, pa1, pa2, pa3); partialSM(pB0, pB1, m_reg, mnB, alB);
    __syncthreads(); SWAIT(); SWRITE(0, SE);
    RESC(alB); __syncthreads();
    SBAR(); qkt(pA0, pA1, K_lds, qr, r32, hi);
    finishSM(pB0, pB1, alB, l_reg, pa0, pa1, pa2, pa3); SBAR();
    if (j + 3 < NT) SLOAD(SE, (j + 3) * KVBLK); SBAR();
    pv_d0(o, vb0 + (int)SHM_V, pa0, pa1, pa2, pa3); partialSM(pA0, pA1, m_reg, mnA, alA);
    __syncthreads(); SWAIT(); SWRITE(1, SO);
    RESC(alA); __syncthreads();
  }
  SBAR(); qkt(pB0, pB1, (bf16_t*)((char*)K_lds + SHM_K), qr, r32, hi);
  finishSM(pA0, pA1, alA, l_reg, pa0, pa1, pa2, pa3); SBAR();
  pv_d0(o, vb0, pa0, pa1, pa2, pa3); partialSM(pB0, pB1, m_reg, mnB, alB);
  __syncthreads(); RESC(alB);
  finishSM(pB0, pB1, alB, l_reg, pa0, pa1, pa2, pa3); SBAR();
  pv_d0(o, vb0 + (int)SHM_V, pa0, pa1, pa2, pa3);
  if (hi == 0) li_l[r32] = l_reg; asm volatile("s_waitcnt lgkmcnt(0)" ::: "memory");
  float rli[16];
#pragma unroll
  for (int r = 0; r < 16; ++r) rli[r] = __builtin_amdgcn_rcpf(li_l[crow(r, hi)]);
  bf16_t* Ow = Ob + (long)(wid * QBLK) * LDO;
#pragma unroll
  for (int r = 0; r < 16; ++r) { int orow = crow(r, hi);
    for (int d0 = 0; d0 < 4; ++d0) Ow[(long)orow * LDO + d0 * 32 + r32] = f2bf(o[d0][r] * rli[r]); }
  __syncthreads();
#undef SLOAD
#undef SWRITE
#undef SWAIT
#undef RESC
}
}

constexpr int NWAVES = 8;
constexpr int LDS_STAGE = 131072;
constexpr int LDS_BYTES = 147456;

__device__ __forceinline__ void map_static(int L, int nM, int nN, int& pm, int& pn) {
  const int nwg = nM * nN; int wgid = L;
  { const int q = nwg / 8, r = nwg % 8, xcd = wgid % 8, off = wgid / 8; wgid = (xcd < r ? xcd * (q + 1) : r * (q + 1) + (xcd - r) * q) + off; }
  const int nig = 8 * nN, gid = wgid / nig, fm = gid * 8, gsz = (nM - fm) < 8 ? (nM - fm) : 8;
  pm = fm + ((wgid % nig) % gsz); pn = (wgid % nig) / gsz;
}

__device__ __forceinline__ void cvt_item(const float* W, int ldw, bf16_t* dst, int ldd, int k0, int n0, LAS float* scr, int lane) {
#pragma unroll 8
  for (int i = 0; i < 32; ++i) { const int kk = 2 * i + (lane >> 5); scr[kk * 33 + (lane & 31)] = W[(size_t)(k0 + kk) * ldw + n0 + (lane & 31)]; }
  asm volatile("s_waitcnt lgkmcnt(0)" ::: "memory");
  const int c = lane & 7;
#pragma unroll
  for (int j = 0; j < 4; ++j) { const int n = (lane >> 3) + 8 * j; const LAS float* s = scr + (8 * c) * 33 + n;
    u32x4 o; o.x = cvt_pk_bf16(s[0 * 33], s[1 * 33]); o.y = cvt_pk_bf16(s[2 * 33], s[3 * 33]); o.z = cvt_pk_bf16(s[4 * 33], s[5 * 33]); o.w = cvt_pk_bf16(s[6 * 33], s[7 * 33]);
    *(u32x4*)(dst + (size_t)n * ldd + k0 + 8 * c) = o; }
  asm volatile("s_waitcnt lgkmcnt(0)" ::: "memory");
}
__device__ __forceinline__ int ilv_row(int n, int second) { return (n >> 7) * 256 + (n & 127) + second * 128; }

constexpr int CV_WIN = (1024 / 64) * (4096 / 32);
constexpr int CV_GLU = (512 / 64) * (1024 / 32);
constexpr int CV_SQ = (1024 / 64) * (1024 / 32);
constexpr int CV_EGU = (1024 / 64) * (512 / 32);
constexpr int CV_ED = (512 / 64) * (1024 / 32);
constexpr int CV_SMALL = CV_WIN + 2 * CV_GLU + 2 * CV_SQ;
constexpr int CV_TOTAL = CV_SMALL + 32 * (2 * CV_EGU + CV_ED);

__device__ __forceinline__ void cvt_dispatch(const Params& p, int it, LAS float* scr, int lane) {
  unsigned char* ws = p.ws;
  if (it < CV_WIN) { const int nb = 4096 / 32; cvt_item(p.in[I_WIN], 4096, (bf16_t*)(ws + WS_WIN) + (size_t)(32 * (it % nb)) * 1024, 1024, 64 * (it / nb), 32 * (it % nb), scr, lane); return; }
  it -= CV_WIN;
  if (it < 2 * CV_GLU) { const int second = it / CV_GLU; it %= CV_GLU; const int nb = 1024 / 32, n0 = 32 * (it % nb);
    cvt_item(p.in[second ? I_WGB : I_WGA], 1024, (bf16_t*)(ws + WS_WGLU) + (size_t)ilv_row(n0, second) * 512, 512, 64 * (it / nb), n0, scr, lane); return; }
  it -= 2 * CV_GLU;
  if (it < 2 * CV_SQ) { const int second = it / CV_SQ; it %= CV_SQ; const int nb = 1024 / 32, n0 = 32 * (it % nb);
    cvt_item(p.in[second ? I_WOUT : I_WAO], 1024, (bf16_t*)(ws + (second ? WS_WOUT : WS_WAO)) + (size_t)n0 * 1024, 1024, 64 * (it / nb), n0, scr, lane); return; }
  it -= 2 * CV_SQ;
  const int per_e = 2 * CV_EGU + CV_ED, e = it / per_e; it %= per_e;
  if (it < 2 * CV_EGU) { const int second = it / CV_EGU; it %= CV_EGU; const int nb = 512 / 32, n0 = 32 * (it % nb);
    cvt_item(p.in[second ? I_WEU : I_WEG] + (size_t)e * 1024 * 512, 512, (bf16_t*)(ws + WS_WGU) + ((size_t)e * 1024 + ilv_row(n0, second)) * 1024, 1024, 64 * (it / nb), n0, scr, lane); return; }
  it -= 2 * CV_EGU;
  { const int nb = 1024 / 32, n0 = 32 * (it % nb);
    cvt_item(p.in[I_WED] + (size_t)e * 512 * 1024, 1024, (bf16_t*)(ws + WS_WD) + ((size_t)e * 1024 + n0) * 512, 512, 64 * (it / nb), n0, scr, lane); }
}

__device__ __forceinline__ void phase0(const Params& p, LAS unsigned char* lds) {
  const int tid = threadIdx.x, lane = tid & 63, wave = tid >> 6, c = blockIdx.x, G = gridDim.x;
  LAS float* red = (LAS float*)lds;
  for (int cg = c; cg < NMOD / 24; cg += G) {
    const int col = tid % 24, sl = tid / 24;
    float a0 = 0.f, a1 = 0.f, a2 = 0.f;
    if (sl < 21) {
      const float* w = p.in[I_WMOD] + cg * 24 + col;
      for (int k = sl; k < DM; k += 21) { const float wv = w[(size_t)k * NMOD];
        a0 += siluf_(p.in[I_C][k]) * wv; a1 += siluf_(p.in[I_C][DM + k]) * wv; a2 += siluf_(p.in[I_CCTX][k]) * wv; }
      red[(sl * 24 + col) * 3 + 0] = a0; red[(sl * 24 + col) * 3 + 1] = a1; red[(sl * 24 + col) * 3 + 2] = a2;
    }
    __syncthreads();
    if (tid < 72) { const int cc = tid / 3, r = tid % 3; float s = 0.f;
      for (int q = 0; q < 21; ++q) s += red[(q * 24 + cc) * 3 + r];
      ((float*)(p.ws + WS_MOD))[r * NMOD + cg * 24 + cc] = s + p.in[I_BMOD][cg * 24 + cc]; }
    __syncthreads();
  }
  {
    float* tab = (float*)(p.ws + WS_S5AB); float* abar = tab; float* bbar = tab + 2 * 32 * 64 * 2;
    for (int idx = c * 512 + tid; idx < 2 * 32 * 64; idx += G * 512) {
      const int dg = idx >> 6;
      const float are = p.in[I_SARE][idx], aim = p.in[I_SAIM][idx];
      const float dt = expf(p.in[I_SLDT][dg]);
      const float ea = expf(are * dt);
      float sn, cs; sincosf(aim * dt, &sn, &cs);
      const float abr = ea * cs, abi = ea * sn;
      const float den = are * are + aim * aim;
      const float nr = abr - 1.f, ni = abi;
      const float rr = (nr * are + ni * aim) / den, ri = (ni * are - nr * aim) / den;
      abar[idx * 2 + 0] = abr; abar[idx * 2 + 1] = abi;
      for (int cc = 0; cc < 16; ++cc) {
        const float bre = p.in[I_SBRE][idx * 16 + cc], bim = p.in[I_SBIM][idx * 16 + cc];
        bbar[(idx * 16 + cc) * 2 + 0] = rr * bre - ri * bim;
        bbar[(idx * 16 + cc) * 2 + 1] = rr * bim + ri * bre;
      }
    }
  }
  {
    LAS float* scr = (LAS float*)(lds + 8192) + wave * (64 * 33);
    const int gw = c * NWAVES + wave, NGW = G * NWAVES;
    for (int it = gw; it < CV_TOTAL; it += NGW) cvt_dispatch(p, it, scr, lane);
  }
}

__device__ __forceinline__ void phase1(const Params& p) {
  const float* mod = (const float*)(p.ws + WS_MOD);
  bf16_t* H = (bf16_t*)(p.ws + WS_RH);
  const int lane = threadIdx.x & 63, wave = threadIdx.x >> 6;
  const int gw = blockIdx.x * NWAVES + wave, NGW = gridDim.x * NWAVES;
  for (int pr = gw; pr < NROW; pr += NGW) {
    const int b = pr / SKV, t = pr % SKV;
    const float* xr; const float* mrow;
    if (t < SEQ) { xr = p.in[I_X] + ((size_t)b * SEQ + t) * DM; mrow = mod + b * NMOD; }
    else { xr = p.in[I_CTX] + ((size_t)b * NCTX + (t - SEQ)) * DM; mrow = mod + 2 * NMOD; }
    f32x4 v[4]; float s = 0;
#pragma unroll
    for (int j = 0; j < 4; ++j) { v[j] = ((const f32x4*)xr)[lane + 64 * j]; s += (v[j].x + v[j].y) + (v[j].z + v[j].w); }
    const float mean = wave_sum(s) * (1.f / DM); float s2 = 0;
#pragma unroll
    for (int j = 0; j < 4; ++j) { v[j] = v[j] - mean; s2 += (v[j].x * v[j].x + v[j].y * v[j].y) + (v[j].z * v[j].z + v[j].w * v[j].w); }
    const float rstd = rsqrtf(wave_sum(s2) * (1.f / DM) + LN_EPS);
#pragma unroll
    for (int j = 0; j < 4; ++j) {
      const int col = (lane + 64 * j) * 4;
      const f32x4 sh = *(const f32x4*)(mrow + col), sc = *(const f32x4*)(mrow + DM + col);
      const f32x4 o = v[j] * rstd * (sc + 1.f) + sh;
      u32x2 w; w.x = cvt_pk_bf16(o.x, o.y); w.y = cvt_pk_bf16(o.z, o.w);
      *(u32x2*)(H + (size_t)pr * DM + col) = w;
    }
  }
}

struct SchedIn {
  int G, c;
  __device__ __forceinline__ bool next(int i, pg::Unit& u) const {
    const int L = i * G + c; u.aux = 0;
    if (L < 1024) { int lm, pn; map_static(L, 64, 16, lm, pn); u.pm = lm + (lm >> 5); u.pn = pn; return true; }
    if (L < 1032) { const int j = L - 1024; u.pm = (j < 4) ? 32 : 65; const int q = j & 3; u.pn = (q < 2) ? q : q + 4; return true; }
    return false;
  }
};
struct EpiIn {
  static constexpr bool PERM = true;
  bf16_t* YA; bf16_t* P;
  __device__ __forceinline__ void operator()(const pg::Acc& acc, const pg::Unit& u, int wr, int wc, int fr, int fq) const {
    const int row0 = u.pm * 256 + wr * 64 + fr;
    if (u.pn < 2) {
#pragma unroll
      for (int ai = 0; ai < 2; ++ai)
#pragma unroll
        for (int m = 0; m < 4; ++m) { const int r = row0 + ai * 128 + m * 16, chunk = r >> 4, ti = r & 15;
#pragma unroll
          for (int bj = 0; bj < 2; ++bj) { const int ch = u.pn * 256 + bj * 128 + wc * 32 + 8 * fq, g = ch >> 4, off = ch & 15;
            const f32x4 v0 = acc[ai][bj][m][0], v1 = acc[ai][bj][m][1];
            u32x4 w; w.x = cvt_pk_bf16(v0[0], v0[1]); w.y = cvt_pk_bf16(v0[2], v0[3]); w.z = cvt_pk_bf16(v1[0], v1[1]); w.w = cvt_pk_bf16(v1[2], v1[3]);
            *(u32x4*)(YA + ((size_t)g * NCHUNK + chunk) * 512 + ti * 16 + off) = w; } }
    } else {
      const int colb = (u.pn - 2) * 256 + wc * 32 + 8 * fq; const bool sig = u.pn >= 8;
#pragma unroll
      for (int ai = 0; ai < 2; ++ai)
#pragma unroll
        for (int m = 0; m < 4; ++m) { bf16_t* rowp = P + (size_t)(row0 + ai * 128 + m * 16) * PLD + colb;
#pragma unroll
          for (int bj = 0; bj < 2; ++bj) { f32x4 v0 = acc[ai][bj][m][0], v1 = acc[ai][bj][m][1];
            if (sig) {
#pragma unroll
              for (int e = 0; e < 4; ++e) { v0[e] = __builtin_amdgcn_rcpf(1.f + __builtin_amdgcn_exp2f(-1.4426950408889634f * v0[e])); v1[e] = __builtin_amdgcn_rcpf(1.f + __builtin_amdgcn_exp2f(-1.4426950408889634f * v1[e])); } }
            u32x4 w; w.x = cvt_pk_bf16(v0[0], v0[1]); w.y = cvt_pk_bf16(v0[2], v0[3]); w.z = cvt_pk_bf16(v1[0], v1[1]); w.w = cvt_pk_bf16(v1[2], v1[3]);
            *(u32x4*)(rowp + bj * 128) = w; } }
    }
  }
};
__device__ __forceinline__ void phase2(const Params& p, LAS unsigned char* lds) {
  pg::Addr AD{(const bf16_t*)(p.ws + WS_RH), DM, 0, (const bf16_t*)(p.ws + WS_WIN), DM, 0};
  SchedIn S{(int)gridDim.x, (int)blockIdx.x};
  EpiIn E{(bf16_t*)((unsigned char*)p.out + DO_YA), (bf16_t*)(p.ws + WS_P)};
  pg::gemm_phase(lds, AD, S, E);
}

__device__ __forceinline__ void phase_qknorm(const Params& p) {
  bf16_t* P = (bf16_t*)(p.ws + WS_P);
  const int lane = threadIdx.x & 63, wave = threadIdx.x >> 6;
  const int gw = blockIdx.x * NWAVES + wave, NGW = gridDim.x * NWAVES;
  const int axis = lane >> 5, f = lane & 31, e1 = axis * 64 + f, e2 = e1 + 32;
  const float inv = exp2f(-(float)(2 * f) * (13.287712379549449f / 64.f));
  const float gq1 = p.in[I_QG][e1], gq2 = p.in[I_QG][e2], gk1 = p.in[I_KG][e1], gk2 = p.in[I_KG][e2];
  for (int item = gw; item < NROW * 10; item += NGW) {
    const int pr = item / 10, slot = item % 10, t = pr % SKV;
    const bool isctx = t >= SEQ;
    if (isctx && slot < 8) continue;
    bf16_t* base = P + (size_t)pr * PLD + (slot < 8 ? PC_Q + slot * 128 : PC_K + (slot - 8) * 128);
    float x1 = bf2f(base[e1]), x2 = bf2f(base[e2]);
    const float ss = wave_sum(x1 * x1 + x2 * x2);
    const float r = rsqrtf(ss * (1.f / 128.f) + LN_EPS);
    x1 = x1 * r * (slot < 8 ? gq1 : gk1); x2 = x2 * r * (slot < 8 ? gq2 : gk2);
    float o1 = x1, o2 = x2;
    if (!isctx) {
      const float posf = (axis == 0) ? (float)(t >> 6) : (float)(t & 63);
      float sn, cs; sincosf(posf * inv, &sn, &cs);
      o1 = x1 * cs - x2 * sn; o2 = x1 * sn + x2 * cs;
    }
    base[e1] = f2bf(o1); base[e2] = f2bf(o2);
  }
}
__device__ __forceinline__ void phase_attn(const Params& p, char* lds) {
  bf16_t* P = (bf16_t*)(p.ws + WS_P);
  int seq = SKV; asm volatile("" : "+s"(seq));
  for (int unit = blockIdx.x; unit < NB * 8 * (SEQ / 256); unit += gridDim.x) {
    const int qb = unit % 32, h = (unit / 32) % 8, b = unit / 256;
    bf16_t* Qp = P + ((size_t)b * SKV + qb * 256) * PLD + PC_Q + h * 128;
    const bf16_t* Kp = P + (size_t)b * SKV * PLD + PC_K + (h >> 2) * 128;
    const bf16_t* Vp = P + (size_t)b * SKV * PLD + PC_V + (h >> 2) * 128;
    att::attn_dense_body(Qp, Kp, Vp, Qp, seq, lds);
  }
}

__global__ __launch_bounds__(64) void k_s5_naive(Params p) {
  const float* tab = (const float*)(p.ws + WS_S5AB);
  const float* abar = tab; const float* bbar = tab + 2 * 32 * 64 * 2;
  const bf16_t* YA = (const bf16_t*)((unsigned char*)p.out + DO_YA);
  float* Y = (float*)(p.ws + WS_RH);
  bf16_t* GY = (bf16_t*)((unsigned char*)p.out + DO_GY);
  const int b = blockIdx.x / 32, g = blockIdx.x % 32, lane = threadIdx.x;
  const int cown = 8 * (lane & 1) + 4 * ((lane >> 1) & 1) + 2 * ((lane >> 2) & 1) + ((lane >> 3) & 1);
  for (int d = 0; d < 2; ++d) {
    const int dg = d * 32 + g;
    const float ar = abar[(dg * 64 + lane) * 2], ai = abar[(dg * 64 + lane) * 2 + 1];
    float br[16], bi[16], cr[16], ci[16];
#pragma unroll
    for (int c = 0; c < 16; ++c) {
      br[c] = bbar[((dg * 64 + lane) * 16 + c) * 2]; bi[c] = bbar[((dg * 64 + lane) * 16 + c) * 2 + 1];
      cr[c] = p.in[I_SCRE][(dg * 16 + c) * 64 + lane]; ci[c] = p.in[I_SCIM][(dg * 16 + c) * 64 + lane];
    }
    float hr = 0.f, hi = 0.f;
    const float dval = p.in[I_SD][g * 16 + cown];
    for (int step = 0; step < NCTX + SEQ; ++step) {
      int t; bool lat;
      if (step < NCTX) { t = SEQ + ((d == 0) ? step : (NCTX - 1 - step)); lat = false; }
      else { const int s2 = step - NCTX; t = (d == 0) ? s2 : (SEQ - 1 - s2); lat = true; }
      const int pr = b * SKV + t;
      const bf16_t* ur = YA + ((size_t)g * NCHUNK + (pr >> 4)) * 512 + (pr & 15) * 16;
      float u[16];
      {
        const uint4 w0 = *(const uint4*)ur, w1 = *(const uint4*)(ur + 8);
        const unsigned ww[8] = {w0.x, w0.y, w0.z, w0.w, w1.x, w1.y, w1.z, w1.w};
#pragma unroll
        for (int i = 0; i < 8; ++i) { u[2 * i] = __uint_as_float(ww[i] << 16); u[2 * i + 1] = __uint_as_float(ww[i] & 0xffff0000u); }
      }
      float bur = 0.f, bui = 0.f;
#pragma unroll
      for (int c = 0; c < 16; ++c) { bur += br[c] * u[c]; bui += bi[c] * u[c]; }
      const float nr = ar * hr - ai * hi + bur, ni = ar * hi + ai * hr + bui;
      hr = nr; hi = ni;
      if (lat) {
        float v[16];
#pragma unroll
        for (int c = 0; c < 16; ++c) v[c] = cr[c] * hr - ci[c] * hi;
        float w8[8];
        { const bool up = lane & 1;
#pragma unroll
          for (int i = 0; i < 8; ++i) { const float send = up ? v[i] : v[i + 8], keep = up ? v[i + 8] : v[i]; w8[i] = keep + __shfl_xor(send, 1); } }
        float w4[4];
        { const bool up = lane & 2;
#pragma unroll
          for (int i = 0; i < 4; ++i) { const float send = up ? w8[i] : w8[i + 4], keep = up ? w8[i + 4] : w8[i]; w4[i] = keep + __shfl_xor(send, 2); } }
        float w2[2];
        { const bool up = lane & 4;
#pragma unroll
          for (int i = 0; i < 2; ++i) { const float send = up ? w4[i] : w4[i + 2], keep = up ? w4[i + 2] : w4[i]; w2[i] = keep + __shfl_xor(send, 4); } }
        float w1;
        { const bool up = lane & 8; const float send = up ? w2[0] : w2[1], keep = up ? w2[1] : w2[0]; w1 = keep + __shfl_xor(send, 8); }
        w1 += __shfl_xor(w1, 16); w1 += __shfl_xor(w1, 32);
        float uo = 0.f;
#pragma unroll
        for (int c = 0; c < 16; ++c) uo = (c == cown) ? u[c] : uo;
        if (lane < 16) {
          const size_t yi = (size_t)pr * 512 + g * 16 + cown;
          if (d == 0) Y[yi] = w1 + uo * dval;
          else GY[yi] = f2bf(gelu_tanh(Y[yi] + w1));
        }
      }
    }
  }
}

template <class EP>
__global__ __launch_bounds__(256) void k_gemm_naive(const bf16_t* A, int lda, const float* B, int ldb, int K, EP ep) {
  __shared__ float As[16][68]; __shared__ float Bs[16][68];
  const int tid = threadIdx.x, tx = tid & 15, ty = tid >> 4;
  const int m0 = blockIdx.y * 64, n0 = blockIdx.x * 64, m0p = lat2pad(m0);
  float acc[4][4];
#pragma unroll
  for (int i = 0; i < 4; ++i)
#pragma unroll
    for (int j = 0; j < 4; ++j) acc[i][j] = 0.f;
  for (int k0 = 0; k0 < K; k0 += 16) {
#pragma unroll
    for (int i = 0; i < 4; ++i) { const int idx = tid + i * 256; const int m = idx >> 4, k = idx & 15; As[k][m] = bf2f(A[(size_t)(m0p + m) * lda + k0 + k]); }
#pragma unroll
    for (int i = 0; i < 4; ++i) { const int idx = tid + i * 256; const int k = idx >> 6, n = idx & 63; Bs[k][n] = B[(size_t)(k0 + k) * ldb + n0 + n]; }
    __syncthreads();
#pragma unroll
    for (int k = 0; k < 16; ++k) {
      float a[4], b[4];
#pragma unroll
      for (int i = 0; i < 4; ++i) { a[i] = As[k][ty * 4 + i]; b[i] = Bs[k][tx * 4 + i]; }
#pragma unroll
      for (int i = 0; i < 4; ++i)
#pragma unroll
        for (int j = 0; j < 4; ++j) acc[i][j] += a[i] * b[j];
    }
    __syncthreads();
  }
#pragma unroll
  for (int i = 0; i < 4; ++i)
#pragma unroll
    for (int j = 0; j < 4; ++j) ep(m0 + ty * 4 + i, m0p + ty * 4 + i, n0 + tx * 4 + j, acc[i][j]);
}
struct EpGluA { float* T1; __device__ void operator()(int lr, int pr, int col, float v) const { T1[(size_t)lr * 1024 + col] = v; } };
struct EpGluB { float* T1; const bf16_t* P;
  __device__ void operator()(int lr, int pr, int col, float v) const { size_t i = (size_t)lr * 1024 + col; T1[i] = bf2f(P[(size_t)pr * PLD + PC_G + col]) * T1[i] * sigmoidf_(v); } };
struct EpAttnO { const float* T1; const bf16_t* P; bf16_t* Z;
  __device__ void operator()(int lr, int pr, int col, float v) const { size_t i = (size_t)lr * 1024 + col; Z[(size_t)pr * 1024 + col] = f2bf(T1[i] + bf2f(P[(size_t)pr * PLD + PC_G + 1024 + col]) * v); } };
struct EpOut { const float* X; const float* mod; float* R1;
  __device__ void operator()(int lr, int pr, int col, float v) const { size_t i = (size_t)lr * 1024 + col; R1[i] = ALPHA * X[i] + mod[(lr / SEQ) * NMOD + 2 * DM + col] * v; } };

__device__ __forceinline__ void phase_ln1_router(const Params& p) {
  const float* mod = (const float*)(p.ws + WS_MOD);
  float* R1 = p.out;
  bf16_t* H2 = (bf16_t*)(p.ws + WS_RH);
  int* eid = (int*)(p.ws + WS_ROUTE); float* ew = (float*)(p.ws + WS_ROUTE + NLAT * 2 * 4);
  const int lane = threadIdx.x & 63, wave = threadIdx.x >> 6;
  const int gw = blockIdx.x * NWAVES + wave, NGW = gridDim.x * NWAVES;
  for (int row = gw; row < NLAT; row += NGW) {
    const float* mrow = mod + (row / SEQ) * NMOD;
    const int pr = lat2pad(row);
    f32x4 v[4]; float s = 0;
#pragma unroll
    for (int j = 0; j < 4; ++j) { v[j] = ((const f32x4*)(R1 + (size_t)row * DM))[lane + 64 * j]; s += (v[j].x + v[j].y) + (v[j].z + v[j].w); }
    float mean = wave_sum(s) * (1.f / DM); float s2 = 0;
#pragma unroll
    for (int j = 0; j < 4; ++j) { v[j] = v[j] - mean; s2 += (v[j].x * v[j].x + v[j].y * v[j].y) + (v[j].z * v[j].z + v[j].w * v[j].w); }
    float rstd = rsqrtf(wave_sum(s2) * (1.f / DM) + LN_EPS);
    s = 0;
#pragma unroll
    for (int j = 0; j < 4; ++j) {
      const int col = (lane + 64 * j) * 4;
      const f32x4 g = *(const f32x4*)(p.in[I_LN1G] + col), bb = *(const f32x4*)(p.in[I_LN1B] + col);
      v[j] = v[j] * rstd * g + bb;
      ((f32x4*)(R1 + (size_t)row * DM))[lane + 64 * j] = v[j];
      s += (v[j].x + v[j].y) + (v[j].z + v[j].w);
    }
    mean = wave_sum(s) * (1.f / DM); s2 = 0;
#pragma unroll
    for (int j = 0; j < 4; ++j) { v[j] = v[j] - mean; s2 += (v[j].x * v[j].x + v[j].y * v[j].y) + (v[j].z * v[j].z + v[j].w * v[j].w); }
    rstd = rsqrtf(wave_sum(s2) * (1.f / DM) + LN_EPS);
    float lg[36];
#pragma unroll
    for (int i = 0; i < 36; ++i) lg[i] = 0.f;
#pragma unroll
    for (int j = 0; j < 4; ++j) {
      const int col = (lane + 64 * j) * 4;
      const f32x4 sh = *(const f32x4*)(mrow + 3 * DM + col), sc = *(const f32x4*)(mrow + 4 * DM + col);
      const f32x4 hv = v[j] * rstd * (sc + 1.f) + sh;
      u32x2 w; w.x = cvt_pk_bf16(hv.x, hv.y); w.y = cvt_pk_bf16(hv.z, hv.w);
      *(u32x2*)(H2 + (size_t)pr * DM + col) = w;
#pragma unroll
      for (int e = 0; e < 4; ++e) {
        const f32x4 wg = *(const f32x4*)(p.in[I_WRG] + (size_t)(col + e) * 4);
        lg[0] += hv[e] * wg.x; lg[1] += hv[e] * wg.y; lg[2] += hv[e] * wg.z; lg[3] += hv[e] * wg.w;
        const f32x4* we = (const f32x4*)(p.in[I_WRE] + (size_t)(col + e) * 32);
#pragma unroll
        for (int q = 0; q < 8; ++q) { const f32x4 w4 = we[q]; lg[4 + 4 * q] += hv[e] * w4.x; lg[5 + 4 * q] += hv[e] * w4.y; lg[6 + 4 * q] += hv[e] * w4.z; lg[7 + 4 * q] += hv[e] * w4.w; }
      }
    }
#pragma unroll
    for (int i = 0; i < 36; ++i) lg[i] = wave_sum(lg[i]);
    if (lane == 0) {
      float gl[4]; int gi = 0;
#pragma unroll
      for (int i = 0; i < 4; ++i) gl[i] = lg[i] + p.in[I_BRG][i];
      float gm = gl[0];
#pragma unroll
      for (int i = 1; i < 4; ++i) if (gl[i] > gm) { gm = gl[i]; gi = i; }
      float den = 0.f;
#pragma unroll
      for (int i = 0; i < 4; ++i) den += expf(gl[i] - gm);
      const float gw_ = 1.f / den;
      float el[8];
#pragma unroll
      for (int i = 0; i < 8; ++i) {
        float t = 0.f;
#pragma unroll
        for (int gq = 0; gq < 4; ++gq) if (gq == gi) t = lg[4 + gq * 8 + i] + p.in[I_BRE][gq * 8 + i];
        el[i] = t;
      }
      int i1 = 0; float v1 = el[0];
#pragma unroll
      for (int i = 1; i < 8; ++i) if (el[i] > v1) { v1 = el[i]; i1 = i; }
      int i2 = -1; float v2 = -3.0e38f;
#pragma unroll
      for (int i = 0; i < 8; ++i) if (i != i1 && el[i] > v2) { v2 = el[i]; i2 = i; }
      const float e2 = expf(v2 - v1); const float w1 = 1.f / (1.f + e2), w2 = e2 / (1.f + e2);
      eid[row * 2] = gi * 8 + i1; eid[row * 2 + 1] = gi * 8 + i2;
      ew[row * 2] = w1 * gw_; ew[row * 2 + 1] = w2 * gw_;
    }
  }
}

__global__ __launch_bounds__(256) void k_moe_naive(Params p, float* YM) {
  const bf16_t* H2 = (const bf16_t*)(p.ws + WS_RH);
  const int* eid = (const int*)(p.ws + WS_ROUTE); const float* ew = (const float*)(p.ws + WS_ROUTE + NLAT * 2 * 4);
  __shared__ float hs[DM]; __shared__ float act[512];
  const int row = blockIdx.x, t = threadIdx.x, pr = lat2pad(row);
  for (int i = t; i < DM; i += 256) hs[i] = bf2f(H2[(size_t)pr * DM + i]);
  float y[4] = {0.f, 0.f, 0.f, 0.f};
  for (int k = 0; k < 2; ++k) {
    const int e = eid[row * 2 + k]; const float w = ew[row * 2 + k];
    const float* Wg = p.in[I_WEG] + (size_t)e * DM * 512; const float* Wu = p.in[I_WEU] + (size_t)e * DM * 512; const float* Wd = p.in[I_WED] + (size_t)e * 512 * DM;
    __syncthreads();
    float a0 = 0, a1 = 0, b0 = 0, b1 = 0;
    for (int kk = 0; kk < DM; ++kk) { const float h = hs[kk]; a0 += h * Wg[(size_t)kk * 512 + t]; a1 += h * Wg[(size_t)kk * 512 + 256 + t]; b0 += h * Wu[(size_t)kk * 512 + t]; b1 += h * Wu[(size_t)kk * 512 + 256 + t]; }
    act[t] = siluf_(a0) * b0 * w; act[256 + t] = siluf_(a1) * b1 * w;
    __syncthreads();
    for (int f = 0; f < 512; ++f) { const float a = act[f];
#pragma unroll
      for (int i = 0; i < 4; ++i) y[i] += a * Wd[(size_t)f * DM + t + 256 * i]; }
  }
#pragma unroll
  for (int i = 0; i < 4; ++i) YM[(size_t)row * DM + t + 256 * i] = y[i];
}

__global__ __launch_bounds__(256) void k_final_naive(Params p, const float* YM) {
  const float* mod = (const float*)(p.ws + WS_MOD);
  float* X1 = p.out;
  const int lane = threadIdx.x & 63, wv = threadIdx.x >> 6;
  const int row = blockIdx.x * 4 + wv;
  if (row >= NLAT) return;
  const float* mrow = mod + (row / SEQ) * NMOD;
  f32x4 v[4]; float s = 0;
#pragma unroll
  for (int j = 0; j < 4; ++j) {
    const int col = (lane + 64 * j) * 4;
    const f32x4 x1 = ((const f32x4*)(X1 + (size_t)row * DM))[lane + 64 * j], ym = ((const f32x4*)(YM + (size_t)row * DM))[lane + 64 * j];
    const f32x4 g2 = *(const f32x4*)(mrow + 5 * DM + col);
    v[j] = x1 * ALPHA + g2 * ym;
    s += (v[j].x + v[j].y) + (v[j].z + v[j].w);
  }
  const float mean = wave_sum(s) * (1.f / DM); float s2 = 0;
#pragma unroll
  for (int j = 0; j < 4; ++j) { v[j] = v[j] - mean; s2 += (v[j].x * v[j].x + v[j].y * v[j].y) + (v[j].z * v[j].z + v[j].w * v[j].w); }
  const float rstd = rsqrtf(wave_sum(s2) * (1.f / DM) + LN_EPS);
#pragma unroll
  for (int j = 0; j < 4; ++j) {
    const int col = (lane + 64 * j) * 4;
    const f32x4 g = *(const f32x4*)(p.in[I_LN2G] + col), bb = *(const f32x4*)(p.in[I_LN2B] + col);
    ((f32x4*)(X1 + (size_t)row * DM))[lane + 64 * j] = v[j] * rstd * g + bb;
  }
}

template <int PH> __global__ __launch_bounds__(512, 2) void k_phase(Params p) {
  extern __shared__ __attribute__((aligned(16))) unsigned char lds_raw[];
  LAS unsigned char* lds = (LAS unsigned char*)lds_raw;
  if constexpr (PH == 0) phase0(p, lds);
  if constexpr (PH == 1) phase1(p);
  if constexpr (PH == 2) phase2(p, lds);
  if constexpr (PH == 3) phase_qknorm(p);
  if constexpr (PH == 4) phase_attn(p, (char*)lds_raw);
  if constexpr (PH == 9) phase_ln1_router(p);
}

extern "C" void kernel_launch(void* const* d_in, const int* in_sizes, int n_in, void* d_out, int out_size, void* d_ws, size_t ws_size, hipStream_t stream) {
  static int grid = 0;
  if (grid == 0) {
    if (n_in != 32 || out_size != NLAT * DM || ws_size < WS_END) { fprintf(stderr, "kernel_launch: unexpected shapes n_in %d out %d ws %zu\n", n_in, out_size, ws_size); grid = -1; return; }
    bool ok = true;
    ok &= hipFuncSetAttribute((const void*)k_phase<0>, hipFuncAttributeMaxDynamicSharedMemorySize, LDS_BYTES) == hipSuccess;
    ok &= hipFuncSetAttribute((const void*)k_phase<1>, hipFuncAttributeMaxDynamicSharedMemorySize, LDS_BYTES) == hipSuccess;
    ok &= hipFuncSetAttribute((const void*)k_phase<2>, hipFuncAttributeMaxDynamicSharedMemorySize, LDS_BYTES) == hipSuccess;
    ok &= hipFuncSetAttribute((const void*)k_phase<3>, hipFuncAttributeMaxDynamicSharedMemorySize, LDS_BYTES) == hipSuccess;
    ok &= hipFuncSetAttribute((const void*)k_phase<4>, hipFuncAttributeMaxDynamicSharedMemorySize, LDS_BYTES) == hipSuccess;
    ok &= hipFuncSetAttribute((const void*)k_phase<9>, hipFuncAttributeMaxDynamicSharedMemorySize, LDS_BYTES) == hipSuccess;
    if (!ok) { fprintf(stderr, "kernel_launch: hipFuncSetAttribute failed\n"); grid = -1; return; }
    int dev = 0, cus = 0;
    hipGetDevice(&dev); hipDeviceGetAttribute(&cus, hipDeviceAttributeMultiprocessorCount, dev);
    grid = cus > 0 ? cus : 256;
  }
  if (grid < 0) return;
  Params p{};
  for (int i = 0; i < 32; ++i) p.in[i] = (const float*)d_in[i];
  p.out = (float*)d_out; p.ws = (unsigned char*)d_ws;
  unsigned char* ws = p.ws;
  hipLaunchKernelGGL(k_phase<0>, dim3(grid), dim3(512), LDS_BYTES, stream, p);
  hipLaunchKernelGGL(k_phase<1>, dim3(grid), dim3(512), LDS_BYTES, stream, p);
  hipLaunchKernelGGL(k_phase<2>, dim3(grid), dim3(512), LDS_BYTES, stream, p);
  hipLaunchKernelGGL(k_phase<3>, dim3(grid), dim3(512), LDS_BYTES, stream, p);
  hipLaunchKernelGGL(k_s5_naive, dim3(64), dim3(64), 0, stream, p);
  hipLaunchKernelGGL(k_phase<4>, dim3(grid), dim3(512), LDS_BYTES, stream, p);
  {
    float* T1 = (float*)(ws + WS_WGU);
    bf16_t* Z = (bf16_t*)(ws + WS_WGU + 64 * MiB);
    const bf16_t* P = (const bf16_t*)(ws + WS_P);
    const bf16_t* GY = (const bf16_t*)((unsigned char*)d_out + DO_GY);
    EpGluA ea{T1};
    hipLaunchKernelGGL(k_gemm_naive<EpGluA>, dim3(DM / 64, NLAT / 64), dim3(256), 0, stream, GY, 512, p.in[I_WGA], DM, 512, ea);
    EpGluB eb{T1, P};
    hipLaunchKernelGGL(k_gemm_naive<EpGluB>, dim3(DM / 64, NLAT / 64), dim3(256), 0, stream, GY, 512, p.in[I_WGB], DM, 512, eb);
    EpAttnO eo{T1, P, Z};
    hipLaunchKernelGGL(k_gemm_naive<EpAttnO>, dim3(DM / 64, NLAT / 64), dim3(256), 0, stream, P + PC_Q, PLD, p.in[I_WAO], DM, DM, eo);
    EpOut ee{p.in[I_X], (const float*)(ws + WS_MOD), p.out};
    hipLaunchKernelGGL(k_gemm_naive<EpOut>, dim3(DM / 64, NLAT / 64), dim3(256), 0, stream, Z, DM, p.in[I_WOUT], DM, DM, ee);
    hipLaunchKernelGGL(k_phase<9>, dim3(grid), dim3(512), LDS_BYTES, stream, p);
    hipLaunchKernelGGL(k_moe_naive, dim3(NLAT), dim3(256), 0, stream, p, T1);
    hipLaunchKernelGGL(k_final_naive, dim3(NLAT / 4), dim3(256), 0, stream, p, (const float*)T1);
  }
}
```

```cpp
#include <hip/hip_runtime.h>
#include <hip/hip_bf16.h>
#include <cstdint>
#include <cstdio>

typedef unsigned short bf16_t;
#define LAS __attribute__((address_space(3)))
typedef short bf16x8 __attribute__((ext_vector_type(8)));
typedef float f32x4 __attribute__((ext_vector_type(4)));
typedef float f32x2 __attribute__((ext_vector_type(2)));
typedef unsigned u32x4 __attribute__((ext_vector_type(4)));
typedef unsigned u32x2 __attribute__((ext_vector_type(2)));

__device__ __forceinline__ float bf2f(bf16_t v) { return __uint_as_float(((unsigned)v) << 16); }
__device__ __forceinline__ bf16_t f2bf(float f) { unsigned u = __float_as_uint(f); return (bf16_t)((u + 0x7fffu + ((u >> 16) & 1u)) >> 16); }
__device__ __forceinline__ unsigned cvt_pk_bf16(float lo, float hi) { unsigned r; asm volatile("v_cvt_pk_bf16_f32 %0, %1, %2" : "=v"(r) : "v"(lo), "v"(hi)); return r; }

constexpr int DM = 1024, NB = 2, SEQ = 8192, NCTX = 256;
constexpr int NLAT = NB * SEQ;
constexpr int SKV = SEQ + NCTX;
constexpr int NROW = NB * SKV;
constexpr int INW = 4096;
constexpr int NMOD = 6 * DM;
constexpr int PLD = 3584;
constexpr int PC_Q = 0, PC_K = 1024, PC_V = 1280, PC_G = 1536;
constexpr int NCHUNK = NROW / 16;
constexpr float LN_EPS = 1e-6f;
constexpr float ALPHA = 1.189207115002721f;

constexpr size_t MiB = 1u << 20;
constexpr size_t WS_CTL = 0;
constexpr size_t WS_MOD = 1 * MiB;
constexpr size_t WS_ROUTE = 2 * MiB;
constexpr size_t WS_S5AB = 5 * MiB;
constexpr size_t WS_S5T = 6 * MiB;
constexpr size_t WS_S5E = 14 * MiB;
constexpr size_t WS_WIN = 18 * MiB;
constexpr size_t WS_WGLU = 26 * MiB;
constexpr size_t WS_WAO = 28 * MiB;
constexpr size_t WS_WOUT = 30 * MiB;
constexpr size_t WS_WGU = 32 * MiB;
constexpr size_t WS_WD = 96 * MiB;
constexpr size_t WS_RH = 128 * MiB;
constexpr size_t WS_P = 162 * MiB;
constexpr size_t WS_END = 280 * MiB;
constexpr size_t DO_YA = 0, DO_GY = 34 * MiB;

struct Params {
  const float* in[32];
  float* out;
  unsigned char* ws;
};
enum { I_X = 0, I_C, I_CTX, I_CCTX, I_WMOD, I_BMOD, I_WIN, I_SARE, I_SAIM, I_SLDT, I_SBRE, I_SBIM, I_SCRE, I_SCIM, I_SD,
       I_WGA, I_WGB, I_QG, I_KG, I_WAO, I_WOUT, I_LN1G, I_LN1B, I_WRG, I_BRG, I_WRE, I_BRE, I_WEG, I_WEU, I_WED, I_LN2G, I_LN2B };

__device__ __forceinline__ float wave_sum(float v) {
#pragma unroll
  for (int o = 1; o < 64; o <<= 1) v += __shfl_xor(v, o);
  return v;
}
__device__ __forceinline__ float sigmoidf_(float x) { return 1.f / (1.f + __expf(-x)); }
__device__ __forceinline__ float siluf_(float x) { return x / (1.f + __expf(-x)); }
__device__ __forceinline__ float gelu_tanh(float x) {
  const float k0 = 0.7978845608028654f, k1 = 0.044715f;
  const float z = k0 * (x + k1 * x * x * x);
  return x / (1.f + __expf(-2.f * z));
}
__device__ __forceinline__ int lat2pad(int lr) { return lr + (lr / SEQ) * NCTX; }

constexpr int NWAVES = 8;
constexpr int LDS_STAGE = 131072;
constexpr int LDS_BYTES = 147456;

namespace pg {
constexpr int BM = 256, BK = 64, HALF = 128, HTB = HALF * BK * 2, STAGE_BYTES = 8 * HTB;
__host__ __device__ __forceinline__ int lds_byte(int r, int c) { const int st = (r >> 4) * 2 + (c >> 5), rr = r & 15, cc = c & 31, ob = rr * 64 + cc * 2; return st * 1024 + (ob ^ (((ob >> 9) & 1) << 5)); }
__host__ __device__ __forceinline__ void stage_rc(int b, int& R, int& C) { const int st = b / 1024, sb = b % 1024, swz = sb ^ (((sb >> 9) & 1) << 5); R = (st >> 1) * 16 + swz / 64; C = (st & 1) * 32 + (swz % 64) / 2; }
__host__ __device__ __forceinline__ int perm32(int rho) { const int n = rho >> 4, i = rho & 15; return 8 * (i >> 2) + 4 * n + (i & 3); }

struct Unit { int pm, pn, aux, arow; };
struct Addr {
  const bf16_t* A; int lda; size_t a_gs; const bf16_t* Bt; int K; size_t b_gs;
  bool gather;
  __device__ __forceinline__ const char* a_base(const Unit& u) const { return gather ? (const char*)A : (const char*)(A + (size_t)u.aux * a_gs + (size_t)u.arow * lda); }
  __device__ __forceinline__ const char* b_base(const Unit& u) const { return (const char*)(Bt + (size_t)u.aux * b_gs + (size_t)u.pn * BM * K); }
};
typedef f32x4 Acc[2][2][4][2];

template <class Epi, class Sched>
__device__ __forceinline__ void gemm_phase(LAS unsigned char* lds, const Addr AD, const Sched& S, const Epi& E) {
  const int tid = threadIdx.x, wid = __builtin_amdgcn_readfirstlane(tid >> 6), lane = tid & 63, wr = wid >> 2, wc = wid & 3, fr = lane & 15, fq = lane >> 4;
  const int K = AD.K, nt = K / BK, lda = AD.lda;
  unsigned voffB[2]; int Rp[2], Cp[2];
#pragma unroll
  for (int i = 0; i < 2; ++i) { int R, C; stage_rc(tid * 16 + i * 8192, R, C); const int Rb = Epi::PERM ? ((R & ~31) + perm32(R & 31)) : R;
    Rp[i] = R; Cp[i] = C; voffB[i] = (unsigned)(Rb * K + C) * 2u; }
  unsigned vA[2][2], vAn[2][2];
#define PG_SETV(v, u) do { _Pragma("unroll") for (int _h = 0; _h < 2; ++_h) _Pragma("unroll") for (int _i = 0; _i < 2; ++_i) { \
    if constexpr (Sched::GATHER) v[_h][_i] = (unsigned)(S.arow(u, _h * HALF + Rp[_i]) * lda + Cp[_i]) * 2u; \
    else v[_h][_i] = (unsigned)((_h * HALF + Rp[_i]) * lda + Cp[_i]) * 2u; } } while (0)
  const size_t kstep = (size_t)(BK * 2);
  const size_t hstepB = (size_t)HALF * K * 2;
  const unsigned ldsw = (unsigned)wid * 1024u;
  const int aoff = lds_byte(wr * 64 + fr, fq * 8), boff = lds_byte(wc * 32 + fr, fq * 8);
#define PG_SA(b, h) (((b) * 2 + (h)) * HTB)
#define PG_SB(b, h) ((4 + (b) * 2 + (h)) * HTB)
#define PG_STAGE(bufoff, gbase, voff) do { _Pragma("unroll") for (int _i = 0; _i < 2; ++_i) \
    __builtin_amdgcn_global_load_lds((const unsigned*)((const char*)(gbase) + (voff)[_i]), (LAS unsigned*)(lds + (bufoff) + ldsw + _i * 8192), 16, 0, 0); } while (0)
#define PG_LDA(dst, b, h) do { _Pragma("unroll") for (int m = 0; m < 4; ++m) _Pragma("unroll") for (int k = 0; k < 2; ++k) dst[m][k] = *(const LAS bf16x8*)(lds + PG_SA(b, h) + aoff + m * 2048 + k * 1024); } while (0)
#define PG_LDB(dst, b, h) do { _Pragma("unroll") for (int n = 0; n < 2; ++n) _Pragma("unroll") for (int k = 0; k < 2; ++k) dst[n][k] = *(const LAS bf16x8*)(lds + PG_SB(b, h) + boff + n * 2048 + k * 1024); } while (0)
#define PG_MMA(ai, bj, At, Bt) do { __builtin_amdgcn_s_setprio(1); _Pragma("unroll") for (int m = 0; m < 4; ++m) _Pragma("unroll") for (int n = 0; n < 2; ++n) _Pragma("unroll") for (int k = 0; k < 2; ++k) \
    acc[ai][bj][m][n] = __builtin_amdgcn_mfma_f32_16x16x32_bf16(Bt[n][k], At[m][k], acc[ai][bj][m][n], 0, 0, 0); __builtin_amdgcn_s_setprio(0); } while (0)
#define PG_WAIT_V(n) asm volatile("s_waitcnt vmcnt(" #n ")" ::: "memory")
#define PG_WAIT_L(n) asm volatile("s_waitcnt lgkmcnt(" #n ")" ::: "memory")
#define PG_BAR __builtin_amdgcn_s_barrier()
#define PG_SCHED __builtin_amdgcn_sched_barrier(0)
  Unit cur, nxt; int ui = 0;
  if (!S.next(0, cur)) return;
  Acc acc;
#pragma unroll
  for (int a = 0; a < 2; ++a)
#pragma unroll
    for (int b = 0; b < 2; ++b)
#pragma unroll
      for (int m = 0; m < 4; ++m)
#pragma unroll
        for (int n = 0; n < 2; ++n) acc[a][b][m][n] = (f32x4){0.f, 0.f, 0.f, 0.f};
  bf16x8 At[4][2], B0[2][2], B1[2][2];
  const char* cA = AD.a_base(cur); const char* cB = AD.b_base(cur);
  PG_SETV(vA, cur);
  PG_STAGE(PG_SB(0, 0), cB, voffB); PG_STAGE(PG_SB(0, 1), cB + hstepB, voffB); PG_STAGE(PG_SA(0, 0), cA, vA[0]); PG_STAGE(PG_SA(0, 1), cA, vA[1]);
  if (wr == 1) PG_BAR;
  PG_WAIT_V(2); PG_BAR;
  PG_STAGE(PG_SB(1, 0), cB + kstep, voffB); PG_STAGE(PG_SA(1, 0), cA + kstep, vA[0]); PG_STAGE(PG_SB(1, 1), cB + hstepB + kstep, voffB);
  PG_WAIT_V(6); PG_BAR;
#define PG_KPAIR(a1, a2, b2, a3, b3, VN) do { \
      PG_LDB(B0, 0, 0); PG_LDB(B1, 0, 1); PG_SCHED; PG_LDA(At, 0, 0); PG_STAGE(PG_SA(1, 1), a1, vA[1]); \
      PG_WAIT_V(8); PG_WAIT_L(0); PG_BAR; PG_MMA(0, 0, At, B0); PG_MMA(0, 1, At, B1); PG_BAR; PG_SCHED; \
      PG_LDA(At, 0, 1); PG_STAGE(PG_SB(0, 0), b2, voffB); PG_STAGE(PG_SB(0, 1), (b2) + hstepB, voffB); PG_STAGE(PG_SA(0, 0), a2, VN[0]); \
      PG_WAIT_V(8); PG_WAIT_L(0); PG_BAR; PG_MMA(1, 0, At, B0); PG_MMA(1, 1, At, B1); PG_BAR; PG_SCHED; \
      PG_LDB(B0, 1, 0); PG_LDB(B1, 1, 1); PG_SCHED; PG_LDA(At, 1, 0); PG_STAGE(PG_SA(0, 1), a2, VN[1]); \
      PG_WAIT_V(8); PG_WAIT_L(0); PG_BAR; PG_MMA(0, 0, At, B0); PG_MMA(0, 1, At, B1); PG_BAR; PG_SCHED; \
      PG_LDA(At, 1, 1); PG_STAGE(PG_SB(1, 0), b3, voffB); PG_STAGE(PG_SB(1, 1), (b3) + hstepB, voffB); PG_STAGE(PG_SA(1, 0), a3, VN[0]); \
      PG_WAIT_V(8); PG_WAIT_L(0); PG_BAR; PG_MMA(1, 0, At, B0); PG_MMA(1, 1, At, B1); PG_BAR; PG_SCHED; } while (0)
  for (;;) {
    const bool has_next = S.next(ui + 1, nxt);
    const char* nA = has_next ? AD.a_base(nxt) : cA; const char* nB = has_next ? AD.b_base(nxt) : cB;
    if constexpr (Sched::GATHER) { if (has_next) PG_SETV(vAn, nxt); else {
#pragma unroll
      for (int _h = 0; _h < 2; ++_h)
#pragma unroll
        for (int _i = 0; _i < 2; ++_i) vAn[_h][_i] = vA[_h][_i]; } }
    if constexpr (Sched::GATHER) {
      for (int t = 0; t < nt - 2; t += 2) {
        const char* a1 = cA + (size_t)(t + 1) * kstep; const char* a2 = cA + (size_t)(t + 2) * kstep; const char* b2 = cB + (size_t)(t + 2) * kstep;
        PG_KPAIR(a1, a2, b2, a2 + kstep, b2 + kstep, vA);
      }
      { const char* a1 = cA + (size_t)(nt - 1) * kstep;
        PG_KPAIR(a1, nA, nB, nA + kstep, nB + kstep, vAn); }
    } else {
      for (int t = 0; t < nt; t += 2) {
        const bool last = (t == nt - 2);
        const char* a1 = cA + (size_t)(t + 1) * kstep;
        const char* a2 = last ? nA : cA + (size_t)(t + 2) * kstep; const char* b2 = last ? nB : cB + (size_t)(t + 2) * kstep;
        PG_KPAIR(a1, a2, b2, a2 + kstep, b2 + kstep, vA);
      }
    }
    if (wr == 0) PG_BAR;
    E(acc, cur, wr, wc, fr, fq);
    if (!has_next) break;
#pragma unroll
    for (int a = 0; a < 2; ++a)
#pragma unroll
      for (int b = 0; b < 2; ++b)
#pragma unroll
        for (int m = 0; m < 4; ++m)
#pragma unroll
          for (int n = 0; n < 2; ++n) acc[a][b][m][n] = (f32x4){0.f, 0.f, 0.f, 0.f};
    cur = nxt; cA = nA; cB = nB; ++ui;
    if constexpr (Sched::GATHER) {
#pragma unroll
      for (int _h = 0; _h < 2; ++_h)
#pragma unroll
        for (int _i = 0; _i < 2; ++_i) vA[_h][_i] = vAn[_h][_i]; }
    if (wr == 1) PG_BAR;
  }
  PG_WAIT_V(0);
  PG_BAR;
#undef PG_SETV
#undef PG_KPAIR
#undef PG_SA
#undef PG_SB
#undef PG_STAGE
#undef PG_LDA
#undef PG_LDB
#undef PG_MMA
#undef PG_WAIT_V
#undef PG_WAIT_L
#undef PG_BAR
#undef PG_SCHED
}
}
namespace att {
using bf16x8 = __attribute__((ext_vector_type(8))) short;
using s16x4 = __attribute__((ext_vector_type(4))) short;
using f32x16 = __attribute__((ext_vector_type(16))) float;
using u32x4 = __attribute__((ext_vector_type(4))) unsigned;
constexpr int D = 128, NW = 8, QBLK = 32, KVBLK = 64;
constexpr float SCALE = 0.088388347648318440f;
constexpr float THR = 8.f;
constexpr int LDQ = PLD, LDK = PLD, LDO = PLD;
constexpr size_t SHM_V = KVBLK * D * 2, SHM_K = KVBLK * D * 2, SHM_ATTN = 2 * SHM_V + 2 * SHM_K + NW * 64 * 4;
#define KSWZ(row, colB) ((row) * 256 + ((colB) ^ (((row) & 7) << 4)))
#define SBAR() __builtin_amdgcn_sched_barrier(0)
__device__ __forceinline__ int crow(int r, int hi) { return (r & 3) + 8 * (r >> 2) + 4 * hi; }
__device__ __forceinline__ unsigned cvtpk(float lo, float hi) { unsigned r; asm volatile("v_cvt_pk_bf16_f32 %0, %1, %2" : "=v"(r) : "v"(lo), "v"(hi)); return r; }
__device__ __forceinline__ void partialSM(f32x16& p0, f32x16& p1, float& m_reg, float& mn, float& alpha) {
  constexpr float C = SCALE * 1.4426950408889634f;
  float pmax = p0[0]; for (int r = 1; r < 16; ++r) pmax = fmaxf(pmax, p0[r]); for (int r = 0; r < 16; ++r) pmax = fmaxf(pmax, p1[r]);
  { auto rr = __builtin_amdgcn_permlane32_swap(__float_as_uint(pmax), __float_as_uint(pmax), false, false);
    pmax = fmaxf(__uint_as_float(rr[0]), __uint_as_float(rr[1])); }
  if (__builtin_expect(__all(pmax - m_reg <= THR / SCALE), 1)) { mn = m_reg; alpha = 1.f; }
  else { mn = fmaxf(m_reg, pmax); alpha = __builtin_amdgcn_exp2f((m_reg - mn) * C); m_reg = mn; }
  float mnC = -mn * C;
  for (int r = 0; r < 16; ++r) p0[r] = fmaf(p0[r], C, mnC); for (int r = 0; r < 16; ++r) p1[r] = fmaf(p1[r], C, mnC);
  for (int r = 0; r < 16; ++r) p0[r] = __builtin_amdgcn_exp2f(p0[r]);
}
__device__ __forceinline__ void finishSM(f32x16& p0, f32x16& p1, float alpha, float& l_reg, bf16x8& pa0, bf16x8& pa1, bf16x8& pa2, bf16x8& pa3) {
  for (int r = 0; r < 16; ++r) p1[r] = __builtin_amdgcn_exp2f(p1[r]);
  float ps = 0; for (int r = 0; r < 16; ++r) ps += p0[r]; for (int r = 0; r < 16; ++r) ps += p1[r];
  { auto rr = __builtin_amdgcn_permlane32_swap(__float_as_uint(ps), __float_as_uint(ps), false, false);
    ps = __uint_as_float(rr[0]) + __uint_as_float(rr[1]); }
  l_reg = l_reg * alpha + ps;
#define PK4(P, BASE, OUT) do { unsigned a0 = cvtpk(P[BASE + 0], P[BASE + 1]), a1 = cvtpk(P[BASE + 2], P[BASE + 3]);   \
    unsigned b0 = cvtpk(P[BASE + 4], P[BASE + 5]), b1 = cvtpk(P[BASE + 6], P[BASE + 7]);                              \
    auto r0 = __builtin_amdgcn_permlane32_swap(a0, b0, false, false); auto r1 = __builtin_amdgcn_permlane32_swap(a1, b1, false, false); \
    u32x4 w = {r0[0], r1[0], r0[1], r1[1]}; OUT = *reinterpret_cast<bf16x8*>(&w); } while (0)
  PK4(p0, 0, pa0); PK4(p0, 8, pa1); PK4(p1, 0, pa2); PK4(p1, 8, pa3);
#undef PK4
}
__device__ __forceinline__ void qkt(f32x16& p0, f32x16& p1, const bf16_t* Ks, const bf16x8* qr, int r32, int hi) {
  p0 = f32x16{}; p1 = f32x16{};
  for (int d0 = 0; d0 < 8; ++d0) { int cb = (d0 * 16 + hi * 8) * 2;
    bf16x8 b0 = *reinterpret_cast<const bf16x8*>((const char*)Ks + KSWZ(r32, cb));
    bf16x8 b1 = *reinterpret_cast<const bf16x8*>((const char*)Ks + KSWZ(32 + r32, cb));
    p0 = __builtin_amdgcn_mfma_f32_32x32x16_bf16(b0, qr[d0], p0, 0, 0, 0);
    p1 = __builtin_amdgcn_mfma_f32_32x32x16_bf16(b1, qr[d0], p1, 0, 0, 0); }
}
__device__ __forceinline__ int v_st(int k, int c) { const int kk = (k & ~0xC) | ((k & 4) << 1) | ((k & 8) >> 1); return ((kk >> 3) * 4 + (c >> 5)) * 512 + ((kk & 7) * 32 + (c & 31)) * 2; }
__device__ __forceinline__ int v_rd_base(int lane) { return ((lane & 3) << 3) | (((lane >> 2) & 3) << 6) | (((lane >> 4) & 1) << 5) | (((lane >> 5) & 1) << 8); }
constexpr int v_rd_off(int d0, int ks, int half) { return d0 * 512 + ks * 4096 + half * 2048; }
template <int OFF> __device__ __forceinline__ s16x4 tr_read(int vb) {
  s16x4 r; asm volatile("ds_read_b64_tr_b16 %0, %1 offset:%2" : "=&v"(r) : "v"(vb), "i"(OFF) : "memory"); return r;
}
template <int D0> __device__ __forceinline__ void pv_one(f32x16& od, int vb, bf16x8 pa0, bf16x8 pa1, bf16x8 pa2, bf16x8 pa3) {
  const s16x4 l0 = tr_read<v_rd_off(D0, 0, 0)>(vb), h0 = tr_read<v_rd_off(D0, 0, 1)>(vb), l1 = tr_read<v_rd_off(D0, 1, 0)>(vb), h1 = tr_read<v_rd_off(D0, 1, 1)>(vb);
  const s16x4 l2 = tr_read<v_rd_off(D0, 2, 0)>(vb), h2 = tr_read<v_rd_off(D0, 2, 1)>(vb), l3 = tr_read<v_rd_off(D0, 3, 0)>(vb), h3 = tr_read<v_rd_off(D0, 3, 1)>(vb);
  asm volatile("s_waitcnt lgkmcnt(0)" ::: "memory"); SBAR();
#define PK(L, H) (bf16x8){L[0], L[1], L[2], L[3], H[0], H[1], H[2], H[3]}
  od = __builtin_amdgcn_mfma_f32_32x32x16_bf16(pa0, PK(l0, h0), od, 0, 0, 0);
  od = __builtin_amdgcn_mfma_f32_32x32x16_bf16(pa1, PK(l1, h1), od, 0, 0, 0);
  od = __builtin_amdgcn_mfma_f32_32x32x16_bf16(pa2, PK(l2, h2), od, 0, 0, 0);
  od = __builtin_amdgcn_mfma_f32_32x32x16_bf16(pa3, PK(l3, h3), od, 0, 0, 0);
#undef PK
}
__device__ __forceinline__ void pv_d0(f32x16* o, int vb, bf16x8 pa0, bf16x8 pa1, bf16x8 pa2, bf16x8 pa3) {
  pv_one<0>(o[0], vb, pa0, pa1, pa2, pa3); pv_one<1>(o[1], vb, pa0, pa1, pa2, pa3); pv_one<2>(o[2], vb, pa0, pa1, pa2, pa3); pv_one<3>(o[3], vb, pa0, pa1, pa2, pa3);
}
__device__ __forceinline__ void attn_dense_body(const bf16_t* __restrict__ Qb, const bf16_t* __restrict__ Kh, const bf16_t* __restrict__ Vh, bf16_t* __restrict__ Ob, int seq, char* lds) {
  const int tid = threadIdx.x, wid = tid >> 6, lane = tid & 63, r32 = lane & 31, hi = lane >> 5;
  bf16_t* V_lds = (bf16_t*)lds; bf16_t* K_lds = (bf16_t*)(lds + 2 * SHM_V);
  float* ws = (float*)(lds + 2 * SHM_V + 2 * SHM_K) + wid * 64; float* li_l = ws; float* al_l = ws + 32;
  float m_reg = -1e30f, l_reg = 0; f32x16 o[4] = {}; bf16x8 qr[8];
  const bf16_t* Qw = Qb + (long)(wid * QBLK + r32) * LDQ + hi * 8;
#pragma unroll
  for (int d0 = 0; d0 < 8; ++d0) qr[d0] = *reinterpret_cast<const bf16x8*>(Qw + d0 * 16);
  const int sr = tid >> 4, sc = (tid & 15) * 8, vst0 = v_st(sr, sc), vst1 = v_st(32 + sr, sc);
  const int vb0 = (int)(uintptr_t)V_lds + v_rd_base(lane);
  struct { bf16x8 vs0, vs1, ks0, ks1; } sr_[2];
#define SLOAD(i, k0) do { sr_[i].vs0 = *(const bf16x8*)(&Vh[(long)((k0) + sr) * LDK + sc]); sr_[i].vs1 = *(const bf16x8*)(&Vh[(long)((k0) + 32 + sr) * LDK + sc]); \
    sr_[i].ks0 = *(const bf16x8*)(&Kh[(long)((k0) + sr) * LDK + sc]); sr_[i].ks1 = *(const bf16x8*)(&Kh[(long)((k0) + 32 + sr) * LDK + sc]); } while (0)
#define SWRITE(b, i) do { *(bf16x8*)((char*)V_lds + (b) * SHM_V + vst0) = sr_[i].vs0;          \
    *(bf16x8*)((char*)V_lds + (b) * SHM_V + vst1) = sr_[i].vs1; int kc = sc * 2;               \
    *(bf16x8*)((char*)K_lds + (b) * SHM_K + KSWZ(sr, kc)) = sr_[i].ks0;                       \
    *(bf16x8*)((char*)K_lds + (b) * SHM_K + KSWZ(32 + sr, kc)) = sr_[i].ks1; } while (0)
#define SWAIT() asm volatile("s_waitcnt vmcnt(4)" ::: "memory")
#define RESC(a) do { if (__any((a) < 1.f)) { if (hi == 0) al_l[r32] = (a); asm volatile("s_waitcnt lgkmcnt(0)" ::: "memory"); \
    for (int d = 0; d < 4; ++d) for (int r = 0; r < 16; ++r) o[d][r] *= al_l[crow(r, hi)]; } } while (0)
  f32x16 pA0, pA1, pB0, pB1; float mnA, mnB, alA, alB; bf16x8 pa0, pa1, pa2, pa3; const int NT = seq / KVBLK;
  constexpr int SE = 0, SO = 1;
  SLOAD(SE, 0); asm volatile("s_waitcnt vmcnt(0)" ::: "memory"); SWRITE(0, SE); __syncthreads();
  qkt(pA0, pA1, K_lds, qr, r32, hi); partialSM(pA0, pA1, m_reg, mnA, alA);
  SLOAD(SO, KVBLK); if (2 < NT) SLOAD(SE, 2 * KVBLK);
  SWAIT(); SWRITE(1, SO); __syncthreads();
  for (int j = 1; j + 1 < NT; j += 2) {
    SBAR(); qkt(pB0, pB1, (bf16_t*)((char*)K_lds + SHM_K), qr, r32, hi);
    finishSM(pA0, pA1, alA, l_reg, pa0, pa1, pa2, pa3); SBAR();
    SLOAD(SO, (j + 2) * KVBLK); SBAR();
    pv_d0(o, vb0, pa0, pa1, pa2, pa3); partialSM(pB0, pB1, m_reg, mnB, alB);
    __syncthreads(); SWAIT(); SWRITE(0, SE);
    RESC(alB); __syncthreads();
    SBAR(); qkt(pA0, pA1, K_lds, qr, r32, hi);
    finishSM(pB0, pB1, alB, l_reg, pa0, pa1, pa2, pa3); SBAR();
    if (j + 3 < NT) SLOAD(SE, (j + 3) * KVBLK); SBAR();
    pv_d0(o, vb0 + (int)SHM_V, pa0, pa1, pa2, pa3); partialSM(pA0, pA1, m_reg, mnA, alA);
    __syncthreads(); SWAIT(); SWRITE(1, SO);
    RESC(alA); __syncthreads();
  }
  SBAR(); qkt(pB0, pB1, (bf16_t*)((char*)K_lds + SHM_K), qr, r32, hi);
  finishSM(pA0, pA1, alA, l_reg, pa0, pa1, pa2, pa3); SBAR();
  pv_d0(o, vb0, pa0, pa1, pa2, pa3); partialSM(pB0, pB1, m_reg, mnB, alB);
  __syncthreads(); RESC(alB);
  finishSM(pB0, pB1, alB, l_reg, pa0, pa1, pa2, pa3); SBAR();
  pv_d0(o, vb0 + (int)SHM_V, pa0, pa1, pa2, pa3);
  if (hi == 0) li_l[r32] = l_reg; asm volatile("s_waitcnt lgkmcnt(0)" ::: "memory");
  float rli[16];
#pragma unroll
  for (int r = 0; r < 16; ++r) rli[r] = __builtin_amdgcn_rcpf(li_l[crow(r, hi)]);
  bf16_t* Ow = Ob + (long)(wid * QBLK) * LDO;
#pragma unroll
  for (int r = 0; r < 16; ++r) { int orow = crow(r, hi);
    for (int d0 = 0; d0 < 4; ++d0) Ow[(long)orow * LDO + d0 * 32 + r32] = f2bf(o[d0][r] * rli[r]); }
  __syncthreads();
#undef SLOAD
#undef SWRITE
#undef SWAIT
#undef RESC
}
}


__device__ __forceinline__ void s5_build_tables(const Params& p, LAS unsigned char* lds, int g) {
  const int tid = threadIdx.x;
  LAS float* Bb = (LAS float*)lds;
  LAS float* Cc = Bb + 4096;
  LAS float* PW = Cc + 4096;
  LAS float* KK = PW + 4352;
  if (tid < 128) {
    const int d = tid >> 6, pi = tid & 63, dg = d * 32 + g, idx = dg * 64 + pi;
    const float are = p.in[I_SARE][idx], aim = p.in[I_SAIM][idx];
    const float dt = expf(p.in[I_SLDT][dg]);
    const float lam = are * dt, om = aim * dt;
    for (int n = 0; n <= 16; ++n) { const float ea = expf(lam * (float)n); float sn, cs; sincosf(om * (float)n, &sn, &cs);
      PW[((d * 17 + n) * 64 + pi) * 2] = ea * cs; PW[((d * 17 + n) * 64 + pi) * 2 + 1] = ea * sn; }
    const float abr = PW[((d * 17 + 1) * 64 + pi) * 2], abi = PW[((d * 17 + 1) * 64 + pi) * 2 + 1];
    const float den = are * are + aim * aim;
    const float nr = abr - 1.f, ni = abi;
    const float rr = (nr * are + ni * aim) / den, ri = (ni * are - nr * aim) / den;
    for (int c = 0; c < 16; ++c) {
      const float bre = p.in[I_SBRE][idx * 16 + c], bim = p.in[I_SBIM][idx * 16 + c];
      Bb[((d * 64 + pi) * 16 + c) * 2] = rr * bre - ri * bim; Bb[((d * 64 + pi) * 16 + c) * 2 + 1] = rr * bim + ri * bre;
      Cc[((d * 16 + c) * 64 + pi) * 2] = p.in[I_SCRE][(dg * 16 + c) * 64 + pi]; Cc[((d * 16 + c) * 64 + pi) * 2 + 1] = p.in[I_SCIM][(dg * 16 + c) * 64 + pi];
    }
  }
  __syncthreads();
  for (int o = tid; o < 8192; o += 512) {
    const int d = o >> 12, tau = (o >> 8) & 15, c = (o >> 4) & 15, c2 = o & 15;
    float s = 0.f;
    for (int pi = 0; pi < 64; ++pi) {
      const float cr = Cc[((d * 16 + c) * 64 + pi) * 2], ci = Cc[((d * 16 + c) * 64 + pi) * 2 + 1];
      const float ar = PW[((d * 17 + tau) * 64 + pi) * 2], ai = PW[((d * 17 + tau) * 64 + pi) * 2 + 1];
      const float br = Bb[((d * 64 + pi) * 16 + c2) * 2], bi = Bb[((d * 64 + pi) * 16 + c2) * 2 + 1];
      const float mr = ar * br - ai * bi, mi = ar * bi + ai * br;
      s += cr * mr - ci * mi;
    }
    KK[o] = s;
  }
  __syncthreads();
  bf16_t* T = (bf16_t*)(p.ws + WS_S5T) + (size_t)g * 256 * 512;
  for (int o = tid; o < 256 * 256; o += 512) {
    const int n = o >> 8, k = (o & 255) * 2, i = n >> 4, c = n & 15;
    float v[2];
#pragma unroll
    for (int q = 0; q < 2; ++q) { const int kk = k + q; float x;
      if (kk < 256) { const int j = kk >> 4, c2 = kk & 15; x = 0.f;
        if (i >= j) x += KK[((0 * 16 + (i - j)) * 16 + c) * 16 + c2];
        if (j >= i) x += KK[((1 * 16 + (j - i)) * 16 + c) * 16 + c2];
        if (i == j && c == c2) x += p.in[I_SD][g * 16 + c];
      } else { const int d = (kk - 256) >> 7, qq = (kk - 256) & 127, part = qq >> 6, pi = qq & 63, n_pw = d ? (16 - i) : (i + 1);
        const float cr = Cc[((d * 16 + c) * 64 + pi) * 2], ci = Cc[((d * 16 + c) * 64 + pi) * 2 + 1];
        const float ar = PW[((d * 17 + n_pw) * 64 + pi) * 2], ai = PW[((d * 17 + n_pw) * 64 + pi) * 2 + 1];
        x = part ? -(cr * ai + ci * ar) : (cr * ar - ci * ai); }
      v[q] = x; }
    *(unsigned*)(T + (size_t)n * 512 + k) = cvt_pk_bf16(v[0], v[1]);
  }
  bf16_t* E = (bf16_t*)(p.ws + WS_S5E) + (size_t)g * 256 * 256;
  for (int o = tid; o < 256 * 128; o += 512) {
    const int n = o >> 7, k = (o & 127) * 2, d = n >> 7, part = (n >> 6) & 1, pi = n & 63;
    float v[2];
#pragma unroll
    for (int q = 0; q < 2; ++q) { const int kk = k + q, j = kk >> 4, c2 = kk & 15, n_pw = d ? j : (15 - j);
      const float ar = PW[((d * 17 + n_pw) * 64 + pi) * 2], ai = PW[((d * 17 + n_pw) * 64 + pi) * 2 + 1];
      const float br = Bb[((d * 64 + pi) * 16 + c2) * 2], bi = Bb[((d * 64 + pi) * 16 + c2) * 2 + 1];
      v[q] = part ? (ar * bi + ai * br) : (ar * br - ai * bi); }
    *(unsigned*)(E + (size_t)n * 256 + k) = cvt_pk_bf16(v[0], v[1]);
  }
  __syncthreads();
}

struct SchedS5S {
  static constexpr bool GATHER = false;
  int G, c;
  __device__ __forceinline__ bool next(int i, pg::Unit& u) const {
    const int L = i * G + c; if (L >= 160) return false;
    u.aux = L / 5; u.pm = L % 5; u.pn = 0; u.arow = u.pm * 256; return true;
  }
};
struct EpiS5S {
  static constexpr bool PERM = false;
  float* S;
  __device__ __forceinline__ void operator()(const pg::Acc& acc, const pg::Unit& u, int wr, int wc, int fr, int fq) const {
    const int row0 = u.arow + wr * 64 + fr, col0 = wc * 32 + 4 * fq;
#pragma unroll
    for (int ai = 0; ai < 2; ++ai)
#pragma unroll
      for (int m = 0; m < 4; ++m) { const int r = row0 + ai * 128 + m * 16;
        if (r < NCHUNK) { float* rowp = S + ((size_t)u.aux * NCHUNK + r) * 256 + col0;
#pragma unroll
          for (int bj = 0; bj < 2; ++bj)
#pragma unroll
            for (int n = 0; n < 2; ++n) *(f32x4*)(rowp + bj * 128 + n * 16) = acc[ai][bj][m][n]; } }
  }
};
__device__ __forceinline__ void phase_s5s(const Params& p, LAS unsigned char* lds) {
  pg::Addr AD{(const bf16_t*)((unsigned char*)p.out + DO_YA), 512, (size_t)NCHUNK * 512, (const bf16_t*)(p.ws + WS_S5E), 256, (size_t)256 * 256, false};
  SchedS5S S{(int)gridDim.x, (int)blockIdx.x};
  EpiS5S E{(float*)(p.ws + WS_RH)};
  pg::gemm_phase(lds, AD, S, E);
}

__device__ __forceinline__ void s5_scan_item(const Params& p, int item, int lane) {
  const int d = item & 1, g = (item >> 1) & 31, b = item >> 6;
  const float* S = (const float*)(p.ws + WS_RH) + (size_t)g * NCHUNK * 256 + d * 128 + lane;
  bf16_t* YA = (bf16_t*)((unsigned char*)p.out + DO_YA) + (size_t)g * NCHUNK * 512 + 256 + d * 128 + lane;
  const int idx = (d * 32 + g) * 64 + lane;
  const float dt = expf(p.in[I_SLDT][d * 32 + g]);
  const float ea = expf(p.in[I_SARE][idx] * dt * 16.f); float sn, cs; sincosf(p.in[I_SAIM][idx] * dt * 16.f, &sn, &cs);
  const float ar = ea * cs, ai = ea * sn;
  float hr = 0.f, hi = 0.f;
  const int r0 = b * 528;
#pragma unroll 4
  for (int s = 0; s < 16; ++s) { const int r = r0 + 512 + (d ? 15 - s : s);
    const float sr = S[(size_t)r * 256], si = S[(size_t)r * 256 + 64];
    const float nr = ar * hr - ai * hi + sr, ni = ar * hi + ai * hr + si; hr = nr; hi = ni; }
#pragma unroll 8
  for (int s = 0; s < 512; ++s) { const int r = r0 + (d ? 511 - s : s);
    const float sr = S[(size_t)r * 256], si = S[(size_t)r * 256 + 64];
    YA[(size_t)r * 512] = f2bf(hr); YA[(size_t)r * 512 + 64] = f2bf(hi);
    const float nr = ar * hr - ai * hi + sr, ni = ar * hi + ai * hr + si; hr = nr; hi = ni; }
}
__device__ __forceinline__ void phase_s5scan(const Params& p) {
  const int lane = threadIdx.x & 63, wave = threadIdx.x >> 6;
  const int gw = blockIdx.x * NWAVES + wave;
  if (gw < 128) s5_scan_item(p, gw, lane);
}

struct SchedS5Y {
  static constexpr bool GATHER = false;
  int G, c;
  __device__ __forceinline__ bool next(int i, pg::Unit& u) const {
    const int L = i * G + c; if (L >= 128) return false;
    u.aux = L >> 2; u.pm = L & 3; u.pn = 0; u.arow = (u.pm >> 1) * 528 + (u.pm & 1) * 256; return true;
  }
};
struct EpiS5Y {
  static constexpr bool PERM = true;
  bf16_t* GY;
  __device__ __forceinline__ void operator()(const pg::Acc& acc, const pg::Unit& u, int wr, int wc, int fr, int fq) const {
    const int row0 = u.arow + wr * 64 + fr;
#pragma unroll
    for (int ai = 0; ai < 2; ++ai)
#pragma unroll
      for (int m = 0; m < 4; ++m) { const int chunk = row0 + ai * 128 + m * 16;
#pragma unroll
        for (int bj = 0; bj < 2; ++bj) { const int col = bj * 128 + wc * 32 + 8 * fq, ti = col >> 4, c0 = col & 15;
          float o[8];
#pragma unroll
          for (int n = 0; n < 2; ++n)
#pragma unroll
            for (int e = 0; e < 4; ++e) o[n * 4 + e] = gelu_tanh(acc[ai][bj][m][n][e]);
          u32x4 w; w.x = cvt_pk_bf16(o[0], o[1]); w.y = cvt_pk_bf16(o[2], o[3]); w.z = cvt_pk_bf16(o[4], o[5]); w.w = cvt_pk_bf16(o[6], o[7]);
          *(u32x4*)(GY + (size_t)(chunk * 16 + ti) * 512 + u.aux * 16 + c0) = w; } }
  }
};
__device__ __forceinline__ void phase_s5y(const Params& p, LAS unsigned char* lds) {
  pg::Addr AD{(const bf16_t*)((unsigned char*)p.out + DO_YA), 512, (size_t)NCHUNK * 512, (const bf16_t*)(p.ws + WS_S5T), 512, (size_t)256 * 512, false};
  SchedS5Y S{(int)gridDim.x, (int)blockIdx.x};
  EpiS5Y E{(bf16_t*)((unsigned char*)p.out + DO_GY)};
  pg::gemm_phase(lds, AD, S, E);
}
__device__ __forceinline__ void map_static(int L, int nM, int nN, int& pm, int& pn) {
  const int nwg = nM * nN; int wgid = L;
  { const int q = nwg / 8, r = nwg % 8, xcd = wgid % 8, off = wgid / 8; wgid = (xcd < r ? xcd * (q + 1) : r * (q + 1) + (xcd - r) * q) + off; }
  const int nig = 8 * nN, gid = wgid / nig, fm = gid * 8, gsz = (nM - fm) < 8 ? (nM - fm) : 8;
  pm = fm + ((wgid % nig) % gsz); pn = (wgid % nig) / gsz;
}

__device__ __forceinline__ void cvt_item(const float* W, int ldw, bf16_t* dst, int ldd, int k0, int n0, LAS float* scr, int lane) {
#pragma unroll 8
  for (int i = 0; i < 32; ++i) { const int kk = 2 * i + (lane >> 5); scr[kk * 33 + (lane & 31)] = W[(size_t)(k0 + kk) * ldw + n0 + (lane & 31)]; }
  asm volatile("s_waitcnt lgkmcnt(0)" ::: "memory");
  const int c = lane & 7;
#pragma unroll
  for (int j = 0; j < 4; ++j) { const int n = (lane >> 3) + 8 * j; const LAS float* s = scr + (8 * c) * 33 + n;
    u32x4 o; o.x = cvt_pk_bf16(s[0 * 33], s[1 * 33]); o.y = cvt_pk_bf16(s[2 * 33], s[3 * 33]); o.z = cvt_pk_bf16(s[4 * 33], s[5 * 33]); o.w = cvt_pk_bf16(s[6 * 33], s[7 * 33]);
    *(u32x4*)(dst + (size_t)n * ldd + k0 + 8 * c) = o; }
  asm volatile("s_waitcnt lgkmcnt(0)" ::: "memory");
}
__device__ __forceinline__ int ilv_row(int n, int second) { return (n >> 7) * 256 + (n & 127) + second * 128; }

constexpr int CV_WIN = (1024 / 64) * (4096 / 32);
constexpr int CV_GLU = (512 / 64) * (1024 / 32);
constexpr int CV_SQ = (1024 / 64) * (1024 / 32);
constexpr int CV_EGU = (1024 / 64) * (512 / 32);
constexpr int CV_ED = (512 / 64) * (1024 / 32);
constexpr int CV_SMALL = CV_WIN + 2 * CV_GLU + 2 * CV_SQ;
constexpr int CV_TOTAL = CV_SMALL + 32 * (2 * CV_EGU + CV_ED);

__device__ __forceinline__ void cvt_dispatch(const Params& p, int it, LAS float* scr, int lane) {
  unsigned char* ws = p.ws;
  if (it < CV_WIN) { const int nb = 4096 / 32; cvt_item(p.in[I_WIN], 4096, (bf16_t*)(ws + WS_WIN) + (size_t)(32 * (it % nb)) * 1024, 1024, 64 * (it / nb), 32 * (it % nb), scr, lane); return; }
  it -= CV_WIN;
  if (it < 2 * CV_GLU) { const int second = it / CV_GLU; it %= CV_GLU; const int nb = 1024 / 32, n0 = 32 * (it % nb);
    cvt_item(p.in[second ? I_WGB : I_WGA], 1024, (bf16_t*)(ws + WS_WGLU) + (size_t)ilv_row(n0, second) * 512, 512, 64 * (it / nb), n0, scr, lane); return; }
  it -= 2 * CV_GLU;
  if (it < 2 * CV_SQ) { const int second = it / CV_SQ; it %= CV_SQ; const int nb = 1024 / 32, n0 = 32 * (it % nb);
    cvt_item(p.in[second ? I_WOUT : I_WAO], 1024, (bf16_t*)(ws + (second ? WS_WOUT : WS_WAO)) + (size_t)n0 * 1024, 1024, 64 * (it / nb), n0, scr, lane); return; }
  it -= 2 * CV_SQ;
  const int per_e = 2 * CV_EGU + CV_ED, e = it / per_e; it %= per_e;
  if (it < 2 * CV_EGU) { const int second = it / CV_EGU; it %= CV_EGU; const int nb = 512 / 32, n0 = 32 * (it % nb);
    cvt_item(p.in[second ? I_WEU : I_WEG] + (size_t)e * 1024 * 512, 512, (bf16_t*)(ws + WS_WGU) + ((size_t)e * 1024 + ilv_row(n0, second)) * 1024, 1024, 64 * (it / nb), n0, scr, lane); return; }
  it -= 2 * CV_EGU;
  { const int nb = 1024 / 32, n0 = 32 * (it % nb);
    cvt_item(p.in[I_WED] + (size_t)e * 512 * 1024, 1024, (bf16_t*)(ws + WS_WD) + ((size_t)e * 1024 + n0) * 512, 512, 64 * (it / nb), n0, scr, lane); }
}

__device__ __forceinline__ void phase0(const Params& p, LAS unsigned char* lds) {
  const int tid = threadIdx.x, lane = tid & 63, wave = tid >> 6, c = blockIdx.x, G = gridDim.x;
  LAS float* red = (LAS float*)lds;
  for (int cg = c; cg < NMOD / 24; cg += G) {
    const int col = tid % 24, sl = tid / 24;
    float a0 = 0.f, a1 = 0.f, a2 = 0.f;
    if (sl < 21) {
      const float* w = p.in[I_WMOD] + cg * 24 + col;
      for (int k = sl; k < DM; k += 21) { const float wv = w[(size_t)k * NMOD];
        a0 += siluf_(p.in[I_C][k]) * wv; a1 += siluf_(p.in[I_C][DM + k]) * wv; a2 += siluf_(p.in[I_CCTX][k]) * wv; }
      red[(sl * 24 + col) * 3 + 0] = a0; red[(sl * 24 + col) * 3 + 1] = a1; red[(sl * 24 + col) * 3 + 2] = a2;
    }
    __syncthreads();
    if (tid < 72) { const int cc = tid / 3, r = tid % 3; float s = 0.f;
      for (int q = 0; q < 21; ++q) s += red[(q * 24 + cc) * 3 + r];
      ((float*)(p.ws + WS_MOD))[r * NMOD + cg * 24 + cc] = s + p.in[I_BMOD][cg * 24 + cc]; }
    __syncthreads();
  }
  const int nb = (G >= 64) ? 32 : 0;
  for (int g = c; g < 32; g += G) s5_build_tables(p, lds, g);
  if (c >= nb) {
    LAS float* scr = (LAS float*)(lds + 8192) + wave * (64 * 33);
    const int gw = (c - nb) * NWAVES + wave, NGW = (G - nb) * NWAVES;
    for (int it = gw; it < CV_TOTAL; it += NGW) cvt_dispatch(p, it, scr, lane);
  }
}

__device__ __forceinline__ void phase1(const Params& p) {
  const float* mod = (const float*)(p.ws + WS_MOD);
  bf16_t* H = (bf16_t*)(p.ws + WS_RH);
  const int lane = threadIdx.x & 63, wave = threadIdx.x >> 6;
  const int gw = blockIdx.x * NWAVES + wave, NGW = gridDim.x * NWAVES;
  for (int pr = gw; pr < NROW; pr += NGW) {
    const int b = pr / SKV, t = pr % SKV;
    const float* xr; const float* mrow;
    if (t < SEQ) { xr = p.in[I_X] + ((size_t)b * SEQ + t) * DM; mrow = mod + b * NMOD; }
    else { xr = p.in[I_CTX] + ((size_t)b * NCTX + (t - SEQ)) * DM; mrow = mod + 2 * NMOD; }
    f32x4 v[4]; float s = 0;
#pragma unroll
    for (int j = 0; j < 4; ++j) { v[j] = ((const f32x4*)xr)[lane + 64 * j]; s += (v[j].x + v[j].y) + (v[j].z + v[j].w); }
    const float mean = wave_sum(s) * (1.f / DM); float s2 = 0;
#pragma unroll
    for (int j = 0; j < 4; ++j) { v[j] = v[j] - mean; s2 += (v[j].x * v[j].x + v[j].y * v[j].y) + (v[j].z * v[j].z + v[j].w * v[j].w); }
    const float rstd = rsqrtf(wave_sum(s2) * (1.f / DM) + LN_EPS);
#pragma unroll
    for (int j = 0; j < 4; ++j) {
      const int col = (lane + 64 * j) * 4;
      const f32x4 sh = *(const f32x4*)(mrow + col), sc = *(const f32x4*)(mrow + DM + col);
      const f32x4 o = v[j] * rstd * (sc + 1.f) + sh;
      u32x2 w; w.x = cvt_pk_bf16(o.x, o.y); w.y = cvt_pk_bf16(o.z, o.w);
      *(u32x2*)(H + (size_t)pr * DM + col) = w;
    }
  }
}

struct SchedIn {
  static constexpr bool GATHER = false;
  int G, c;
  __device__ __forceinline__ bool next(int i, pg::Unit& u) const {
    const int L = i * G + c; u.aux = 0;
    if (L < 1024) { int lm, pn; map_static(L, 64, 16, lm, pn); u.pm = lm + (lm >> 5); u.pn = pn; u.arow = u.pm * 256; return true; }
    if (L < 1032) { const int j = L - 1024; u.pm = (j < 4) ? 32 : 65; const int q = j & 3; u.pn = (q < 2) ? q : q + 4; u.arow = u.pm * 256; return true; }
    return false;
  }
};
struct EpiIn {
  static constexpr bool PERM = true;
  bf16_t* YA; bf16_t* P;
  __device__ __forceinline__ void operator()(const pg::Acc& acc, const pg::Unit& u, int wr, int wc, int fr, int fq) const {
    const int row0 = u.pm * 256 + wr * 64 + fr;
    if (u.pn < 2) {
#pragma unroll
      for (int ai = 0; ai < 2; ++ai)
#pragma unroll
        for (int m = 0; m < 4; ++m) { const int r = row0 + ai * 128 + m * 16, chunk = r >> 4, ti = r & 15;
#pragma unroll
          for (int bj = 0; bj < 2; ++bj) { const int ch = u.pn * 256 + bj * 128 + wc * 32 + 8 * fq, g = ch >> 4, off = ch & 15;
            const f32x4 v0 = acc[ai][bj][m][0], v1 = acc[ai][bj][m][1];
            u32x4 w; w.x = cvt_pk_bf16(v0[0], v0[1]); w.y = cvt_pk_bf16(v0[2], v0[3]); w.z = cvt_pk_bf16(v1[0], v1[1]); w.w = cvt_pk_bf16(v1[2], v1[3]);
            *(u32x4*)(YA + ((size_t)g * NCHUNK + chunk) * 512 + ti * 16 + off) = w; } }
    } else {
      const int colb = (u.pn - 2) * 256 + wc * 32 + 8 * fq; const bool sig = u.pn >= 8;
#pragma unroll
      for (int ai = 0; ai < 2; ++ai)
#pragma unroll
        for (int m = 0; m < 4; ++m) { bf16_t* rowp = P + (size_t)(row0 + ai * 128 + m * 16) * PLD + colb;
#pragma unroll
          for (int bj = 0; bj < 2; ++bj) { f32x4 v0 = acc[ai][bj][m][0], v1 = acc[ai][bj][m][1];
            if (sig) {
#pragma unroll
              for (int e = 0; e < 4; ++e) { v0[e] = __builtin_amdgcn_rcpf(1.f + __builtin_amdgcn_exp2f(-1.4426950408889634f * v0[e])); v1[e] = __builtin_amdgcn_rcpf(1.f + __builtin_amdgcn_exp2f(-1.4426950408889634f * v1[e])); } }
            u32x4 w; w.x = cvt_pk_bf16(v0[0], v0[1]); w.y = cvt_pk_bf16(v0[2], v0[3]); w.z = cvt_pk_bf16(v1[0], v1[1]); w.w = cvt_pk_bf16(v1[2], v1[3]);
            *(u32x4*)(rowp + bj * 128) = w; } }
    }
  }
};
__device__ __forceinline__ void phase2(const Params& p, LAS unsigned char* lds) {
  pg::Addr AD{(const bf16_t*)(p.ws + WS_RH), DM, 0, (const bf16_t*)(p.ws + WS_WIN), DM, 0, false};
  SchedIn S{(int)gridDim.x, (int)blockIdx.x};
  EpiIn E{(bf16_t*)((unsigned char*)p.out + DO_YA), (bf16_t*)(p.ws + WS_P)};
  pg::gemm_phase(lds, AD, S, E);
}

__device__ __forceinline__ void phase_qknorm(const Params& p) {
  bf16_t* P = (bf16_t*)(p.ws + WS_P);
  const int lane = threadIdx.x & 63, wave = threadIdx.x >> 6;
  const int gw = blockIdx.x * NWAVES + wave, NGW = gridDim.x * NWAVES;
  const int axis = lane >> 5, f = lane & 31, e1 = axis * 64 + f, e2 = e1 + 32;
  const float inv = exp2f(-(float)(2 * f) * (13.287712379549449f / 64.f));
  const float gq1 = p.in[I_QG][e1], gq2 = p.in[I_QG][e2], gk1 = p.in[I_KG][e1], gk2 = p.in[I_KG][e2];
  for (int item = gw; item < NROW * 10; item += NGW) {
    const int pr = item / 10, slot = item % 10, t = pr % SKV;
    const bool isctx = t >= SEQ;
    if (isctx && slot < 8) continue;
    bf16_t* base = P + (size_t)pr * PLD + (slot < 8 ? PC_Q + slot * 128 : PC_K + (slot - 8) * 128);
    float x1 = bf2f(base[e1]), x2 = bf2f(base[e2]);
    const float ss = wave_sum(x1 * x1 + x2 * x2);
    const float r = rsqrtf(ss * (1.f / 128.f) + LN_EPS);
    x1 = x1 * r * (slot < 8 ? gq1 : gk1); x2 = x2 * r * (slot < 8 ? gq2 : gk2);
    float o1 = x1, o2 = x2;
    if (!isctx) {
      const float posf = (axis == 0) ? (float)(t >> 6) : (float)(t & 63);
      float sn, cs; sincosf(posf * inv, &sn, &cs);
      o1 = x1 * cs - x2 * sn; o2 = x1 * sn + x2 * cs;
    }
    base[e1] = f2bf(o1); base[e2] = f2bf(o2);
  }
}
struct SchedLat {
  static constexpr bool GATHER = false;
  int G, c, nN;
  __device__ __forceinline__ bool next(int i, pg::Unit& u) const {
    const int L = i * G + c; u.aux = 0;
    if (L >= 64 * nN) return false;
    int lm, pn; map_static(L, 64, nN, lm, pn); u.pm = lm + (lm >> 5); u.pn = pn; u.arow = u.pm * 256; return true;
  }
};
struct EpiGlu {
  static constexpr bool PERM = true;
  const bf16_t* P; bf16_t* Z;
  __device__ __forceinline__ void operator()(const pg::Acc& acc, const pg::Unit& u, int wr, int wc, int fr, int fq) const {
    const int row0 = u.pm * 256 + wr * 64 + fr, ch = u.pn * 128 + wc * 32 + 8 * fq;
#pragma unroll
    for (int ai = 0; ai < 2; ++ai)
#pragma unroll
      for (int m = 0; m < 4; ++m) { const int r = row0 + ai * 128 + m * 16;
        const u32x4 gw = *(const u32x4*)(P + (size_t)r * PLD + PC_G + ch);
        float gt[8] = {__uint_as_float(gw.x << 16), __uint_as_float(gw.x & 0xffff0000u), __uint_as_float(gw.y << 16), __uint_as_float(gw.y & 0xffff0000u),
                       __uint_as_float(gw.z << 16), __uint_as_float(gw.z & 0xffff0000u), __uint_as_float(gw.w << 16), __uint_as_float(gw.w & 0xffff0000u)};
        float o[8];
#pragma unroll
        for (int n = 0; n < 2; ++n)
#pragma unroll
          for (int e = 0; e < 4; ++e) { const float a = acc[ai][0][m][n][e], b = acc[ai][1][m][n][e];
            o[n * 4 + e] = gt[n * 4 + e] * a * __builtin_amdgcn_rcpf(1.f + __builtin_amdgcn_exp2f(-1.4426950408889634f * b)); }
        u32x4 w; w.x = cvt_pk_bf16(o[0], o[1]); w.y = cvt_pk_bf16(o[2], o[3]); w.z = cvt_pk_bf16(o[4], o[5]); w.w = cvt_pk_bf16(o[6], o[7]);
        *(u32x4*)(Z + (size_t)r * DM + ch) = w; }
  }
};
struct EpiMix {
  static constexpr bool PERM = true;
  const bf16_t* P; bf16_t* Z;
  __device__ __forceinline__ void operator()(const pg::Acc& acc, const pg::Unit& u, int wr, int wc, int fr, int fq) const {
    const int row0 = u.pm * 256 + wr * 64 + fr, col0 = u.pn * 256 + wc * 32 + 8 * fq;
#pragma unroll
    for (int ai = 0; ai < 2; ++ai)
#pragma unroll
      for (int m = 0; m < 4; ++m) { const int r = row0 + ai * 128 + m * 16;
#pragma unroll
        for (int bj = 0; bj < 2; ++bj) { const int c = col0 + bj * 128;
          const u32x4 gw = *(const u32x4*)(P + (size_t)r * PLD + PC_G + 1024 + c);
          const u32x4 zw = *(const u32x4*)(Z + (size_t)r * DM + c);
          const unsigned gq[4] = {gw.x, gw.y, gw.z, gw.w}, zq[4] = {zw.x, zw.y, zw.z, zw.w};
          unsigned ow[4];
#pragma unroll
          for (int q = 0; q < 4; ++q) { const float a0 = acc[ai][bj][m][q >> 1][(q & 1) * 2], a1 = acc[ai][bj][m][q >> 1][(q & 1) * 2 + 1];
            ow[q] = cvt_pk_bf16(__uint_as_float(zq[q] << 16) + __uint_as_float(gq[q] << 16) * a0, __uint_as_float(zq[q] & 0xffff0000u) + __uint_as_float(gq[q] & 0xffff0000u) * a1); }
          *(u32x4*)(Z + (size_t)r * DM + c) = (u32x4){ow[0], ow[1], ow[2], ow[3]}; } }
  }
};
struct EpiOut {
  static constexpr bool PERM = false;
  const float* X; const float* mod; float* R1;
  __device__ __forceinline__ void operator()(const pg::Acc& acc, const pg::Unit& u, int wr, int wc, int fr, int fq) const {
    const int b = u.pm / 33, lrow0 = (u.pm - b) * 256 + wr * 64 + fr, col0 = u.pn * 256 + wc * 32 + 4 * fq;
    const float* g1 = mod + b * NMOD + 2 * DM;
    f32x4 gv[2][2];
#pragma unroll
    for (int bj = 0; bj < 2; ++bj)
#pragma unroll
      for (int n = 0; n < 2; ++n) gv[bj][n] = *(const f32x4*)(g1 + col0 + bj * 128 + n * 16);
#pragma unroll
    for (int ai = 0; ai < 2; ++ai)
#pragma unroll
      for (int m = 0; m < 4; ++m) { const size_t off = (size_t)(lrow0 + ai * 128 + m * 16) * DM + col0;
#pragma unroll
        for (int bj = 0; bj < 2; ++bj)
#pragma unroll
          for (int n = 0; n < 2; ++n) { const f32x4 xv = *(const f32x4*)(X + off + bj * 128 + n * 16);
            *(f32x4*)(R1 + off + bj * 128 + n * 16) = xv * ALPHA + gv[bj][n] * acc[ai][bj][m][n]; } }
  }
};
__device__ __forceinline__ void phase_g1(const Params& p, LAS unsigned char* lds) {
  pg::Addr AD{(const bf16_t*)((unsigned char*)p.out + DO_GY), 512, 0, (const bf16_t*)(p.ws + WS_WGLU), 512, 0, false};
  SchedLat S{(int)gridDim.x, (int)blockIdx.x, 8};
  EpiGlu E{(const bf16_t*)(p.ws + WS_P), (bf16_t*)(p.ws + WS_RH)};
  pg::gemm_phase(lds, AD, S, E);
}
__device__ __forceinline__ void phase_g2(const Params& p, LAS unsigned char* lds) {
  pg::Addr AD{(const bf16_t*)(p.ws + WS_P) + PC_Q, PLD, 0, (const bf16_t*)(p.ws + WS_WAO), DM, 0, false};
  SchedLat S{(int)gridDim.x, (int)blockIdx.x, 4};
  EpiMix E{(const bf16_t*)(p.ws + WS_P), (bf16_t*)(p.ws + WS_RH)};
  pg::gemm_phase(lds, AD, S, E);
}
__device__ __forceinline__ void phase_g3(const Params& p, LAS unsigned char* lds) {
  pg::Addr AD{(const bf16_t*)(p.ws + WS_RH), DM, 0, (const bf16_t*)(p.ws + WS_WOUT), DM, 0, false};
  SchedLat S{(int)gridDim.x, (int)blockIdx.x, 4};
  EpiOut E{p.in[I_X], (const float*)(p.ws + WS_MOD), p.out};
  pg::gemm_phase(lds, AD, S, E);
}

constexpr size_t RT_EW = 0, RT_LIST = 256 * 1024;
constexpr int CTL_CNT = 1024;
constexpr int ACT_TILES_MAX = 160;
constexpr size_t PR_ACT = 66 * MiB;

struct MoeTab { const LAS int* tb; const LAS int* cn; };
__device__ __forceinline__ MoeTab moe_tables(const Params& p, LAS unsigned char* lds) {
  LAS int* tb = (LAS int*)(lds + LDS_STAGE); LAS int* cn = tb + 64;
  const unsigned* cnt = (const unsigned*)(p.ws + WS_CTL) + CTL_CNT;
  if (threadIdx.x == 0) { int acc = 0; for (int e = 0; e < 32; ++e) { const int c = (int)cnt[e]; cn[e] = c; tb[e] = acc; acc += (c + 255) >> 8; } tb[32] = acc; }
  __syncthreads();
  return MoeTab{tb, cn};
}
struct SchedMoe {
  static constexpr bool GATHER_ = true;
  int G, c, nN; MoeTab tab; const int* lists;
  __device__ __forceinline__ bool next_(int i, pg::Unit& u) const {
    const int L = i * G + c, T = L / nN;
    if (T >= tab.tb[32]) return false;
    int e = 0;
#pragma unroll 1
    for (int q = 1; q < 32; ++q) e = (tab.tb[q] <= T) ? q : e;
    u.pm = T; u.pn = L % nN; u.aux = e; u.arow = T * 256; return true;
  }
  __device__ __forceinline__ int arow_(const pg::Unit& u, int r) const {
    const int slot = (u.pm - tab.tb[u.aux]) * 256 + r;
    if (slot >= tab.cn[u.aux]) return 0;
    return lat2pad(lists[u.aux * NLAT + slot] >> 1);
  }
};
struct SchedMoeUp : SchedMoe { static constexpr bool GATHER = true;
  __device__ __forceinline__ bool next(int i, pg::Unit& u) const { return next_(i, u); }
  __device__ __forceinline__ int arow(const pg::Unit& u, int r) const { return arow_(u, r); } };
struct SchedMoeDown : SchedMoe { static constexpr bool GATHER = false;
  __device__ __forceinline__ bool next(int i, pg::Unit& u) const { return next_(i, u); } };
struct EpiGU {
  static constexpr bool PERM = true;
  bf16_t* ACT;
  __device__ __forceinline__ void operator()(const pg::Acc& acc, const pg::Unit& u, int wr, int wc, int fr, int fq) const {
    const int row0 = u.pm * 256 + wr * 64 + fr, ch = u.pn * 128 + wc * 32 + 8 * fq;
#pragma unroll
    for (int ai = 0; ai < 2; ++ai)
#pragma unroll
      for (int m = 0; m < 4; ++m) { const int r = row0 + ai * 128 + m * 16;
        float o[8];
#pragma unroll
        for (int n = 0; n < 2; ++n)
#pragma unroll
          for (int e = 0; e < 4; ++e) { const float a = acc[ai][0][m][n][e], b = acc[ai][1][m][n][e];
            o[n * 4 + e] = a * b * __builtin_amdgcn_rcpf(1.f + __builtin_amdgcn_exp2f(-1.4426950408889634f * a)); }
        u32x4 w; w.x = cvt_pk_bf16(o[0], o[1]); w.y = cvt_pk_bf16(o[2], o[3]); w.z = cvt_pk_bf16(o[4], o[5]); w.w = cvt_pk_bf16(o[6], o[7]);
        *(u32x4*)(ACT + (size_t)r * 512 + ch) = w; }
  }
};
struct EpiDown {
  static constexpr bool PERM = true;
  bf16_t* Y2; const int* lists; const float* ew; MoeTab tab;
  __device__ __forceinline__ void operator()(const pg::Acc& acc, const pg::Unit& u, int wr, int wc, int fr, int fq) const {
    const int slot0 = (u.pm - tab.tb[u.aux]) * 256 + wr * 64 + fr, n_e = tab.cn[u.aux], col0 = u.pn * 256 + wc * 32 + 8 * fq;
#pragma unroll
    for (int ai = 0; ai < 2; ++ai)
#pragma unroll
      for (int m = 0; m < 4; ++m) { const int slot = slot0 + ai * 128 + m * 16;
        if (slot < n_e) { const int id = lists[u.aux * NLAT + slot]; const float w = ew[id];
#pragma unroll
          for (int bj = 0; bj < 2; ++bj) { const f32x4 v0 = acc[ai][bj][m][0] * w, v1 = acc[ai][bj][m][1] * w;
            u32x4 o; o.x = cvt_pk_bf16(v0[0], v0[1]); o.y = cvt_pk_bf16(v0[2], v0[3]); o.z = cvt_pk_bf16(v1[0], v1[1]); o.w = cvt_pk_bf16(v1[2], v1[3]);
            *(u32x4*)(Y2 + (size_t)id * DM + col0 + bj * 128) = o; } } }
  }
};
__device__ __forceinline__ void phase_moe_up(const Params& p, LAS unsigned char* lds) {
  const MoeTab tab = moe_tables(p, lds);
  pg::Addr AD{(const bf16_t*)(p.ws + WS_RH), DM, 0, (const bf16_t*)(p.ws + WS_WGU), DM, (size_t)1024 * 1024, true};
  SchedMoeUp S; S.G = gridDim.x; S.c = blockIdx.x; S.nN = 4; S.tab = tab; S.lists = (const int*)(p.ws + WS_ROUTE + RT_LIST);
  EpiGU E{(bf16_t*)(p.ws + WS_P + PR_ACT)};
  pg::gemm_phase(lds, AD, S, E);
}
__device__ __forceinline__ void phase_moe_down(const Params& p, LAS unsigned char* lds) {
  const MoeTab tab = moe_tables(p, lds);
  pg::Addr AD{(const bf16_t*)(p.ws + WS_P + PR_ACT), 512, 0, (const bf16_t*)(p.ws + WS_WD), 512, (size_t)1024 * 512, false};
  SchedMoeDown S; S.G = gridDim.x; S.c = blockIdx.x; S.nN = 4; S.tab = tab; S.lists = (const int*)(p.ws + WS_ROUTE + RT_LIST);
  EpiDown E{(bf16_t*)(p.ws + WS_P), (const int*)(p.ws + WS_ROUTE + RT_LIST), (const float*)(p.ws + WS_ROUTE + RT_EW), tab};
  pg::gemm_phase(lds, AD, S, E);
}

__device__ __forceinline__ void phase_final(const Params& p) {
  const float* mod = (const float*)(p.ws + WS_MOD);
  const bf16_t* Y2 = (const bf16_t*)(p.ws + WS_P);
  float* X1 = p.out;
  const int lane = threadIdx.x & 63, wave = threadIdx.x >> 6;
  const int gw = blockIdx.x * NWAVES + wave, NGW = gridDim.x * NWAVES;
  for (int row = gw; row < NLAT; row += NGW) {
    const float* mrow = mod + (row / SEQ) * NMOD;
    f32x4 v[4]; float s = 0;
#pragma unroll
    for (int j = 0; j < 4; ++j) {
      const int col = (lane + 64 * j) * 4;
      const f32x4 x1 = ((const f32x4*)(X1 + (size_t)row * DM))[lane + 64 * j];
      const u32x2 ya = *(const u32x2*)(Y2 + (size_t)(2 * row) * DM + col), yb = *(const u32x2*)(Y2 + (size_t)(2 * row + 1) * DM + col);
      f32x4 ym;
      ym.x = __uint_as_float(ya.x << 16) + __uint_as_float(yb.x << 16); ym.y = __uint_as_float(ya.x & 0xffff0000u) + __uint_as_float(yb.x & 0xffff0000u);
      ym.z = __uint_as_float(ya.y << 16) + __uint_as_float(yb.y << 16); ym.w = __uint_as_float(ya.y & 0xffff0000u) + __uint_as_float(yb.y & 0xffff0000u);
      const f32x4 g2 = *(const f32x4*)(mrow + 5 * DM + col);
      v[j] = x1 * ALPHA + g2 * ym;
      s += (v[j].x + v[j].y) + (v[j].z + v[j].w);
    }
    const float mean = wave_sum(s) * (1.f / DM); float s2 = 0;
#pragma unroll
    for (int j = 0; j < 4; ++j) { v[j] = v[j] - mean; s2 += (v[j].x * v[j].x + v[j].y * v[j].y) + (v[j].z * v[j].z + v[j].w * v[j].w); }
    const float rstd = rsqrtf(wave_sum(s2) * (1.f / DM) + LN_EPS);
#pragma unroll
    for (int j = 0; j < 4; ++j) {
      const int col = (lane + 64 * j) * 4;
      const f32x4 g = *(const f32x4*)(p.in[I_LN2G] + col), bb = *(const f32x4*)(p.in[I_LN2B] + col);
      ((f32x4*)(X1 + (size_t)row * DM))[lane + 64 * j] = v[j] * rstd * g + bb;
    }
  }
}
__device__ __forceinline__ void phase_attn(const Params& p, char* lds) {
  bf16_t* P = (bf16_t*)(p.ws + WS_P);
  int seq = SKV; asm volatile("" : "+s"(seq));
  for (int unit = blockIdx.x; unit < NB * 8 * (SEQ / 256); unit += gridDim.x) {
    const int qb = unit % 32, h = (unit / 32) % 8, b = unit / 256;
    bf16_t* Qp = P + ((size_t)b * SKV + qb * 256) * PLD + PC_Q + h * 128;
    const bf16_t* Kp = P + (size_t)b * SKV * PLD + PC_K + (h >> 2) * 128;
    const bf16_t* Vp = P + (size_t)b * SKV * PLD + PC_V + (h >> 2) * 128;
    att::attn_dense_body(Qp, Kp, Vp, Qp, seq, lds);
  }
}

__device__ __forceinline__ void phase_ln1_router(const Params& p) {
  const float* mod = (const float*)(p.ws + WS_MOD);
  float* R1 = p.out;
  bf16_t* H2 = (bf16_t*)(p.ws + WS_RH);
  float* ew = (float*)(p.ws + WS_ROUTE + RT_EW); int* lists = (int*)(p.ws + WS_ROUTE + RT_LIST);
  unsigned* cnt = (unsigned*)(p.ws + WS_CTL) + CTL_CNT;
  const int lane = threadIdx.x & 63, wave = threadIdx.x >> 6;
  const int gw = blockIdx.x * NWAVES + wave, NGW = gridDim.x * NWAVES;
  for (int row = gw; row < NLAT; row += NGW) {
    const float* mrow = mod + (row / SEQ) * NMOD;
    const int pr = lat2pad(row);
    f32x4 v[4]; float s = 0;
#pragma unroll
    for (int j = 0; j < 4; ++j) { v[j] = ((const f32x4*)(R1 + (size_t)row * DM))[lane + 64 * j]; s += (v[j].x + v[j].y) + (v[j].z + v[j].w); }
    float mean = wave_sum(s) * (1.f / DM); float s2 = 0;
#pragma unroll
    for (int j = 0; j < 4; ++j) { v[j] = v[j] - mean; s2 += (v[j].x * v[j].x + v[j].y * v[j].y) + (v[j].z * v[j].z + v[j].w * v[j].w); }
    float rstd = rsqrtf(wave_sum(s2) * (1.f / DM) + LN_EPS);
    s = 0;
#pragma unroll
    for (int j = 0; j < 4; ++j) {
      const int col = (lane + 64 * j) * 4;
      const f32x4 g = *(const f32x4*)(p.in[I_LN1G] + col), bb = *(const f32x4*)(p.in[I_LN1B] + col);
      v[j] = v[j] * rstd * g + bb;
      ((f32x4*)(R1 + (size_t)row * DM))[lane + 64 * j] = v[j];
      s += (v[j].x + v[j].y) + (v[j].z + v[j].w);
    }
    mean = wave_sum(s) * (1.f / DM); s2 = 0;
#pragma unroll
    for (int j = 0; j < 4; ++j) { v[j] = v[j] - mean; s2 += (v[j].x * v[j].x + v[j].y * v[j].y) + (v[j].z * v[j].z + v[j].w * v[j].w); }
    rstd = rsqrtf(wave_sum(s2) * (1.f / DM) + LN_EPS);
    float lg[36];
#pragma unroll
    for (int i = 0; i < 36; ++i) lg[i] = 0.f;
#pragma unroll
    for (int j = 0; j < 4; ++j) {
      const int col = (lane + 64 * j) * 4;
      const f32x4 sh = *(const f32x4*)(mrow + 3 * DM + col), sc = *(const f32x4*)(mrow + 4 * DM + col);
      const f32x4 hv = v[j] * rstd * (sc + 1.f) + sh;
      u32x2 w; w.x = cvt_pk_bf16(hv.x, hv.y); w.y = cvt_pk_bf16(hv.z, hv.w);
      *(u32x2*)(H2 + (size_t)pr * DM + col) = w;
#pragma unroll
      for (int e = 0; e < 4; ++e) {
        const f32x4 wg = *(const f32x4*)(p.in[I_WRG] + (size_t)(col + e) * 4);
        lg[0] += hv[e] * wg.x; lg[1] += hv[e] * wg.y; lg[2] += hv[e] * wg.z; lg[3] += hv[e] * wg.w;
        const f32x4* we = (const f32x4*)(p.in[I_WRE] + (size_t)(col + e) * 32);
#pragma unroll
        for (int q = 0; q < 8; ++q) { const f32x4 w4 = we[q]; lg[4 + 4 * q] += hv[e] * w4.x; lg[5 + 4 * q] += hv[e] * w4.y; lg[6 + 4 * q] += hv[e] * w4.z; lg[7 + 4 * q] += hv[e] * w4.w; }
      }
    }
#pragma unroll
    for (int i = 0; i < 36; ++i) lg[i] = wave_sum(lg[i]);
    if (lane == 0) {
      float gl[4]; int gi = 0;
#pragma unroll
      for (int i = 0; i < 4; ++i) gl[i] = lg[i] + p.in[I_BRG][i];
      float gm = gl[0];
#pragma unroll
      for (int i = 1; i < 4; ++i) if (gl[i] > gm) { gm = gl[i]; gi = i; }
      float den = 0.f;
#pragma unroll
      for (int i = 0; i < 4; ++i) den += expf(gl[i] - gm);
      const float gw_ = 1.f / den;
      float el[8];
#pragma unroll
      for (int i = 0; i < 8; ++i) {
        float t = 0.f;
#pragma unroll
        for (int gq = 0; gq < 4; ++gq) if (gq == gi) t = lg[4 + gq * 8 + i] + p.in[I_BRE][gq * 8 + i];
        el[i] = t;
      }
      int i1 = 0; float v1 = el[0];
#pragma unroll
      for (int i = 1; i < 8; ++i) if (el[i] > v1) { v1 = el[i]; i1 = i; }
      int i2 = -1; float v2 = -3.0e38f;
#pragma unroll
      for (int i = 0; i < 8; ++i) if (i != i1 && el[i] > v2) { v2 = el[i]; i2 = i; }
      const float e2 = expf(v2 - v1); const float w1 = 1.f / (1.f + e2), w2 = e2 / (1.f + e2);
      const int ea = gi * 8 + i1, eb = gi * 8 + i2;
      const unsigned pa = atomicAdd(cnt + ea, 1u), pb = atomicAdd(cnt + eb, 1u);
      lists[ea * NLAT + pa] = row * 2; lists[eb * NLAT + pb] = row * 2 + 1;
      ew[row * 2] = w1 * gw_; ew[row * 2 + 1] = w2 * gw_;
    }
  }
}

enum { PH_PRO = 0, PH_LN, PH_GIN, PH_QK, PH_ATT, PH_G1, PH_G2, PH_G3, PH_RT, PH_UP, PH_DOWN, PH_FIN, PH_S5S, PH_SCAN, PH_S5Y, PH_COUNT };
template <int PH> __device__ __forceinline__ void run_phase(const Params& p, unsigned char* lds_raw) {
  LAS unsigned char* lds = (LAS unsigned char*)lds_raw;
  if constexpr (PH == PH_PRO) phase0(p, lds);
  if constexpr (PH == PH_LN) phase1(p);
  if constexpr (PH == PH_GIN) phase2(p, lds);
  if constexpr (PH == PH_QK) phase_qknorm(p);
  if constexpr (PH == PH_ATT) phase_attn(p, (char*)lds_raw);
  if constexpr (PH == PH_G1) phase_g1(p, lds);
  if constexpr (PH == PH_G2) phase_g2(p, lds);
  if constexpr (PH == PH_G3) phase_g3(p, lds);
  if constexpr (PH == PH_RT) phase_ln1_router(p);
  if constexpr (PH == PH_UP) phase_moe_up(p, lds);
  if constexpr (PH == PH_DOWN) phase_moe_down(p, lds);
  if constexpr (PH == PH_FIN) phase_final(p);
  if constexpr (PH == PH_S5S) phase_s5s(p, lds);
  if constexpr (PH == PH_SCAN) phase_s5scan(p);
  if constexpr (PH == PH_S5Y) phase_s5y(p, lds);
}
template <int PH> __global__ __launch_bounds__(512, 2) void k_phase(Params p) {
  extern __shared__ __attribute__((aligned(16))) unsigned char lds_raw[];
  run_phase<PH>(p, lds_raw);
}
template <int PH> static bool set_lds() { return hipFuncSetAttribute((const void*)k_phase<PH>, hipFuncAttributeMaxDynamicSharedMemorySize, LDS_BYTES) == hipSuccess; }
template <int PH> static void launch_ph(int grid, hipStream_t stream, const Params& p) { hipLaunchKernelGGL(k_phase<PH>, dim3(grid), dim3(512), LDS_BYTES, stream, p); }

extern "C" void kernel_launch(void* const* d_in, const int* in_sizes, int n_in, void* d_out, int out_size, void* d_ws, size_t ws_size, hipStream_t stream) {
  static int grid = 0;
  if (grid == 0) {
    if (n_in != 32 || out_size != NLAT * DM || ws_size < WS_END) { fprintf(stderr, "kernel_launch: unexpected shapes n_in %d out %d ws %zu\n", n_in, out_size, ws_size); grid = -1; return; }
    bool ok = set_lds<0>() && set_lds<1>() && set_lds<2>() && set_lds<3>() && set_lds<4>() && set_lds<5>() && set_lds<6>() && set_lds<7>() && set_lds<8>() && set_lds<9>() && set_lds<10>() && set_lds<11>() && set_lds<12>() && set_lds<13>() && set_lds<14>();
    if (!ok) { fprintf(stderr, "kernel_launch: hipFuncSetAttribute failed\n"); grid = -1; return; }
    int dev = 0, cus = 0;
    hipGetDevice(&dev); hipDeviceGetAttribute(&cus, hipDeviceAttributeMultiprocessorCount, dev);
    grid = cus > 0 ? cus : 256;
  }
  if (grid < 0) return;
  Params p{};
  for (int i = 0; i < 32; ++i) p.in[i] = (const float*)d_in[i];
  p.out = (float*)d_out; p.ws = (unsigned char*)d_ws;
  hipMemsetAsync((char*)d_ws + WS_CTL, 0, 1 * MiB, stream);
  launch_ph<PH_PRO>(grid, stream, p);
  launch_ph<PH_LN>(grid, stream, p);
  launch_ph<PH_GIN>(grid, stream, p);
  launch_ph<PH_QK>(grid, stream, p);
  launch_ph<PH_S5S>(grid, stream, p);
  launch_ph<PH_SCAN>(grid, stream, p);
  launch_ph<PH_ATT>(grid, stream, p);
  launch_ph<PH_S5Y>(grid, stream, p);
  launch_ph<PH_G1>(grid, stream, p);
  launch_ph<PH_G2>(grid, stream, p);
  launch_ph<PH_G3>(grid, stream, p);
  launch_ph<PH_RT>(grid, stream, p);
  launch_ph<PH_UP>(grid, stream, p);
  launch_ph<PH_DOWN>(grid, stream, p);
  launch_ph<PH_FIN>(grid, stream, p);
}
```

```cpp
#include <hip/hip_runtime.h>
#include <hip/hip_bf16.h>
#include <hip/hip_cooperative_groups.h>
#include <cstdint>
#include <cstdio>

typedef unsigned short bf16_t;
#define LAS __attribute__((address_space(3)))
typedef short bf16x8 __attribute__((ext_vector_type(8)));
typedef float f32x4 __attribute__((ext_vector_type(4)));
typedef float f32x2 __attribute__((ext_vector_type(2)));
typedef unsigned u32x4 __attribute__((ext_vector_type(4)));
typedef unsigned u32x2 __attribute__((ext_vector_type(2)));

__device__ __forceinline__ float bf2f(bf16_t v) { return __uint_as_float(((unsigned)v) << 16); }
__device__ __forceinline__ bf16_t f2bf(float f) { unsigned u = __float_as_uint(f); return (bf16_t)((u + 0x7fffu + ((u >> 16) & 1u)) >> 16); }
__device__ __forceinline__ unsigned cvt_pk_bf16(float lo, float hi) { unsigned r; asm volatile("v_cvt_pk_bf16_f32 %0, %1, %2" : "=v"(r) : "v"(lo), "v"(hi)); return r; }

constexpr int DM = 1024, NB = 2, SEQ = 8192, NCTX = 256;
constexpr int NLAT = NB * SEQ;
constexpr int SKV = SEQ + NCTX;
constexpr int NROW = NB * SKV;
constexpr int INW = 4096;
constexpr int NMOD = 6 * DM;
constexpr int PLD = 3584;
constexpr int PC_Q = 0, PC_K = 1024, PC_V = 1280, PC_G = 1536;
constexpr int NCHUNK = NROW / 16;
constexpr float LN_EPS = 1e-6f;
constexpr float ALPHA = 1.189207115002721f;

constexpr size_t MiB = 1u << 20;
constexpr size_t WS_CTL = 0;
constexpr size_t WS_MOD = 1 * MiB;
constexpr size_t WS_ROUTE = 2 * MiB;
constexpr size_t WS_S5AB = 5 * MiB;
constexpr size_t WS_S5T = 6 * MiB;
constexpr size_t WS_S5E = 14 * MiB;
constexpr size_t WS_WIN = 18 * MiB;
constexpr size_t WS_WGLU = 26 * MiB;
constexpr size_t WS_WAO = 28 * MiB;
constexpr size_t WS_WOUT = 30 * MiB;
constexpr size_t WS_WGU = 32 * MiB;
constexpr size_t WS_WD = 96 * MiB;
constexpr size_t WS_RH = 128 * MiB;
constexpr size_t WS_P = 162 * MiB;
constexpr size_t WS_END = 280 * MiB;
constexpr size_t DO_YA = 0, DO_GY = 34 * MiB;

struct Params {
  const float* in[32];
  float* out;
  unsigned char* ws;
};
enum { I_X = 0, I_C, I_CTX, I_CCTX, I_WMOD, I_BMOD, I_WIN, I_SARE, I_SAIM, I_SLDT, I_SBRE, I_SBIM, I_SCRE, I_SCIM, I_SD,
       I_WGA, I_WGB, I_QG, I_KG, I_WAO, I_WOUT, I_LN1G, I_LN1B, I_WRG, I_BRG, I_WRE, I_BRE, I_WEG, I_WEU, I_WED, I_LN2G, I_LN2B };

__device__ __forceinline__ float wave_sum(float v) {
#pragma unroll
  for (int o = 1; o < 64; o <<= 1) v += __shfl_xor(v, o);
  return v;
}
__device__ __forceinline__ float sigmoidf_(float x) { return 1.f / (1.f + __expf(-x)); }
__device__ __forceinline__ float siluf_(float x) { return x / (1.f + __expf(-x)); }
__device__ __forceinline__ float gelu_tanh(float x) {
  const float k0 = 0.7978845608028654f, k1 = 0.044715f;
  const float z = k0 * (x + k1 * x * x * x);
  return x / (1.f + __expf(-2.f * z));
}
__device__ __forceinline__ int lat2pad(int lr) { return lr + (lr / SEQ) * NCTX; }

constexpr int NWAVES = 8;
constexpr int LDS_STAGE = 131072;
constexpr int LDS_BYTES = 147456;


__device__ __forceinline__ int opaque_tid() { int t = threadIdx.x; asm volatile("" : "+v"(t)); return t; }
namespace pg {
constexpr int BM = 256, BK = 64, HALF = 128, HTB = HALF * BK * 2, STAGE_BYTES = 8 * HTB;
__host__ __device__ __forceinline__ int lds_byte(int r, int c) { const int st = (r >> 4) * 2 + (c >> 5), rr = r & 15, cc = c & 31, ob = rr * 64 + cc * 2; return st * 1024 + (ob ^ (((ob >> 9) & 1) << 5)); }
__host__ __device__ __forceinline__ void stage_rc(int b, int& R, int& C) { const int st = b / 1024, sb = b % 1024, swz = sb ^ (((sb >> 9) & 1) << 5); R = (st >> 1) * 16 + swz / 64; C = (st & 1) * 32 + (swz % 64) / 2; }
__host__ __device__ __forceinline__ int perm32(int rho) { const int n = rho >> 4, i = rho & 15; return 8 * (i >> 2) + 4 * n + (i & 3); }

struct Unit { int pm, pn, aux, arow; };
struct Addr {
  const bf16_t* A; int lda; size_t a_gs; const bf16_t* Bt; int K; size_t b_gs;
  bool gather;
  __device__ __forceinline__ const char* a_base(const Unit& u) const { return gather ? (const char*)A : (const char*)(A + (size_t)u.aux * a_gs + (size_t)u.arow * lda); }
  __device__ __forceinline__ const char* b_base(const Unit& u) const { return (const char*)(Bt + (size_t)u.aux * b_gs + (size_t)u.pn * BM * K); }
};
typedef f32x4 Acc[2][2][4][2];

template <class Epi, class Sched>
__device__ __forceinline__ void gemm_phase(LAS unsigned char* lds, const Addr AD, const Sched& S, const Epi& E) {
  const int tid = opaque_tid(), wid = __builtin_amdgcn_readfirstlane(tid >> 6), lane = tid & 63, wr = wid >> 2, wc = wid & 3, fr = lane & 15, fq = lane >> 4;
  int K_ = AD.K; asm volatile("" : "+s"(K_));
  const int K = K_, nt = K / BK, lda = AD.lda;
  int R0, C0; stage_rc(tid * 16, R0, C0);
  const unsigned voffB0 = (unsigned)(((Epi::PERM ? ((R0 & ~31) + perm32(R0 & 31)) : R0)) * K + C0) * 2u;
  const size_t pstepB = (size_t)64 * K * 2, pstepA = (size_t)64 * lda * 2, hstepA = (size_t)HALF * lda * 2;
  unsigned vA[2][2], vAn[2][2];
  const unsigned voffA0 = (unsigned)(R0 * lda + C0) * 2u;
#define PG_SETV(v, u) do { if constexpr (Sched::GATHER) { _Pragma("unroll") for (int _h = 0; _h < 2; ++_h) _Pragma("unroll") for (int _i = 0; _i < 2; ++_i) \
    v[_h][_i] = (unsigned)(S.arow(u, _h * HALF + _i * 64 + R0) * lda + C0) * 2u; } } while (0)
  const size_t kstep = (size_t)(BK * 2);
  const size_t hstepB = (size_t)HALF * K * 2;
  const unsigned ldsw = (unsigned)wid * 1024u;
  const int aoff = lds_byte(wr * 64 + fr, fq * 8), boff = lds_byte(wc * 32 + fr, fq * 8);
#define PG_SA(b, h) (((b) * 2 + (h)) * HTB)
#define PG_SB(b, h) ((4 + (b) * 2 + (h)) * HTB)
#define PG_STAGE_B(bufoff, gbase) do { _Pragma("unroll") for (int _i = 0; _i < 2; ++_i) \
    __builtin_amdgcn_global_load_lds((const unsigned*)((const char*)(gbase) + _i * pstepB + voffB0), (LAS unsigned*)(lds + (bufoff) + ldsw + _i * 8192), 16, 0, 0); } while (0)
#define PG_STAGE_A(b, h, gbase, V) do { _Pragma("unroll") for (int _i = 0; _i < 2; ++_i) { \
    if constexpr (Sched::GATHER) __builtin_amdgcn_global_load_lds((const unsigned*)((const char*)(gbase) + V[h][_i]), (LAS unsigned*)(lds + PG_SA(b, h) + ldsw + _i * 8192), 16, 0, 0); \
    else __builtin_amdgcn_global_load_lds((const unsigned*)((const char*)(gbase) + (h) * hstepA + _i * pstepA + voffA0), (LAS unsigned*)(lds + PG_SA(b, h) + ldsw + _i * 8192), 16, 0, 0); } } while (0)
#define PG_LDA(dst, b, h) do { _Pragma("unroll") for (int m = 0; m < 4; ++m) _Pragma("unroll") for (int k = 0; k < 2; ++k) dst[m][k] = *(const LAS bf16x8*)(lds + PG_SA(b, h) + aoff + m * 2048 + k * 1024); } while (0)
#define PG_LDB(dst, b, h) do { _Pragma("unroll") for (int n = 0; n < 2; ++n) _Pragma("unroll") for (int k = 0; k < 2; ++k) dst[n][k] = *(const LAS bf16x8*)(lds + PG_SB(b, h) + boff + n * 2048 + k * 1024); } while (0)
#define PG_MMA(ai, bj, At, Bt) do { __builtin_amdgcn_s_setprio(1); _Pragma("unroll") for (int m = 0; m < 4; ++m) _Pragma("unroll") for (int n = 0; n < 2; ++n) _Pragma("unroll") for (int k = 0; k < 2; ++k) \
    acc[ai][bj][m][n] = __builtin_amdgcn_mfma_f32_16x16x32_bf16(Bt[n][k], At[m][k], acc[ai][bj][m][n], 0, 0, 0); __builtin_amdgcn_s_setprio(0); } while (0)
#define PG_WAIT_V(n) asm volatile("s_waitcnt vmcnt(" #n ")" ::: "memory")
#define PG_WAIT_L(n) asm volatile("s_waitcnt lgkmcnt(" #n ")" ::: "memory")
#define PG_BAR __builtin_amdgcn_s_barrier()
#define PG_SCHED __builtin_amdgcn_sched_barrier(0)
  Unit cur, nxt; int ui = 0;
  if (!S.next(0, cur)) return;
  Acc acc;
#pragma unroll
  for (int a = 0; a < 2; ++a)
#pragma unroll
    for (int b = 0; b < 2; ++b)
#pragma unroll
      for (int m = 0; m < 4; ++m)
#pragma unroll
        for (int n = 0; n < 2; ++n) acc[a][b][m][n] = (f32x4){0.f, 0.f, 0.f, 0.f};
  bf16x8 At[4][2], B0[2][2], B1[2][2];
  const char* cA = AD.a_base(cur); const char* cB = AD.b_base(cur);
  PG_SETV(vA, cur);
  PG_STAGE_B(PG_SB(0, 0), cB); PG_STAGE_B(PG_SB(0, 1), cB + hstepB); PG_STAGE_A(0, 0, cA, vA); PG_STAGE_A(0, 1, cA, vA);
  if (wr == 1) PG_BAR;
  PG_WAIT_V(2); PG_BAR;
  PG_STAGE_B(PG_SB(1, 0), cB + kstep); PG_STAGE_A(1, 0, cA + kstep, vA); PG_STAGE_B(PG_SB(1, 1), cB + hstepB + kstep);
  PG_WAIT_V(6); PG_BAR;
#define PG_KPAIR(a1, a2, b2, a3, b3, VN) do { \
      PG_LDB(B0, 0, 0); PG_LDB(B1, 0, 1); PG_SCHED; PG_LDA(At, 0, 0); PG_STAGE_A(1, 1, a1, vA); \
      PG_WAIT_V(8); PG_WAIT_L(0); PG_BAR; PG_MMA(0, 0, At, B0); PG_MMA(0, 1, At, B1); PG_BAR; PG_SCHED; \
      PG_LDA(At, 0, 1); PG_STAGE_B(PG_SB(0, 0), b2); PG_STAGE_B(PG_SB(0, 1), (b2) + hstepB); PG_STAGE_A(0, 0, a2, VN); \
      PG_WAIT_V(8); PG_WAIT_L(0); PG_BAR; PG_MMA(1, 0, At, B0); PG_MMA(1, 1, At, B1); PG_BAR; PG_SCHED; \
      PG_LDB(B0, 1, 0); PG_LDB(B1, 1, 1); PG_SCHED; PG_LDA(At, 1, 0); PG_STAGE_A(0, 1, a2, VN); \
      PG_WAIT_V(8); PG_WAIT_L(0); PG_BAR; PG_MMA(0, 0, At, B0); PG_MMA(0, 1, At, B1); PG_BAR; PG_SCHED; \
      PG_LDA(At, 1, 1); PG_STAGE_B(PG_SB(1, 0), b3); PG_STAGE_B(PG_SB(1, 1), (b3) + hstepB); PG_STAGE_A(1, 0, a3, VN); \
      PG_WAIT_V(8); PG_WAIT_L(0); PG_BAR; PG_MMA(1, 0, At, B0); PG_MMA(1, 1, At, B1); PG_BAR; PG_SCHED; } while (0)
  for (;;) {
    const bool has_next = S.next(ui + 1, nxt);
    const char* nA = has_next ? AD.a_base(nxt) : cA; const char* nB = has_next ? AD.b_base(nxt) : cB;
    if constexpr (Sched::GATHER) { if (has_next) PG_SETV(vAn, nxt); else {
#pragma unroll
      for (int _h = 0; _h < 2; ++_h)
#pragma unroll
        for (int _i = 0; _i < 2; ++_i) vAn[_h][_i] = vA[_h][_i]; } }
    if constexpr (Sched::GATHER) {
      for (int t = 0; t < nt - 2; t += 2) {
        const char* a1 = cA + (size_t)(t + 1) * kstep; const char* a2 = cA + (size_t)(t + 2) * kstep; const char* b2 = cB + (size_t)(t + 2) * kstep;
        PG_KPAIR(a1, a2, b2, a2 + kstep, b2 + kstep, vA);
      }
      { const char* a1 = cA + (size_t)(nt - 1) * kstep;
        PG_KPAIR(a1, nA, nB, nA + kstep, nB + kstep, vAn); }
    } else {
      for (int t = 0; t < nt; t += 2) {
        const bool last = (t == nt - 2);
        const char* a1 = cA + (size_t)(t + 1) * kstep;
        const char* a2 = last ? nA : cA + (size_t)(t + 2) * kstep; const char* b2 = last ? nB : cB + (size_t)(t + 2) * kstep;
        PG_KPAIR(a1, a2, b2, a2 + kstep, b2 + kstep, vA);
      }
    }
    if (wr == 0) PG_BAR;
    E(acc, cur, wr, wc, fr, fq);
    if (!has_next) break;
#pragma unroll
    for (int a = 0; a < 2; ++a)
#pragma unroll
      for (int b = 0; b < 2; ++b)
#pragma unroll
        for (int m = 0; m < 4; ++m)
#pragma unroll
          for (int n = 0; n < 2; ++n) acc[a][b][m][n] = (f32x4){0.f, 0.f, 0.f, 0.f};
    cur = nxt; cA = nA; cB = nB; ++ui;
    if constexpr (Sched::GATHER) {
#pragma unroll
      for (int _h = 0; _h < 2; ++_h)
#pragma unroll
        for (int _i = 0; _i < 2; ++_i) vA[_h][_i] = vAn[_h][_i]; }
    if (wr == 1) PG_BAR;
  }
  PG_WAIT_V(0);
  PG_BAR;
#undef PG_SETV
#undef PG_KPAIR
#undef PG_SA
#undef PG_SB
#undef PG_STAGE_A
#undef PG_STAGE_B
#undef PG_LDA
#undef PG_LDB
#undef PG_MMA
#undef PG_WAIT_V
#undef PG_WAIT_L
#undef PG_BAR
#undef PG_SCHED
}
}
namespace att {
using bf16x8 = __attribute__((ext_vector_type(8))) short;
using s16x4 = __attribute__((ext_vector_type(4))) short;
using f32x16 = __attribute__((ext_vector_type(16))) float;
using u32x4 = __attribute__((ext_vector_type(4))) unsigned;
constexpr int D = 128, NW = 8, QBLK = 32, KVBLK = 64;
constexpr float SCALE = 0.088388347648318440f;
constexpr float THR = 8.f;
constexpr int LDQ = PLD, LDK = PLD, LDO = PLD;
constexpr size_t SHM_V = KVBLK * D * 2, SHM_K = KVBLK * D * 2, SHM_ATTN = 2 * SHM_V + 2 * SHM_K + NW * 64 * 4;
#define KSWZ(row, colB) ((row) * 256 + ((colB) ^ (((row) & 7) << 4)))
#define SBAR() __builtin_amdgcn_sched_barrier(0)
__device__ __forceinline__ int crow(int r, int hi) { return (r & 3) + 8 * (r >> 2) + 4 * hi; }
__device__ __forceinline__ unsigned cvtpk(float lo, float hi) { unsigned r; asm volatile("v_cvt_pk_bf16_f32 %0, %1, %2" : "=v"(r) : "v"(lo), "v"(hi)); return r; }
__device__ __forceinline__ void partialSM(f32x16& p0, f32x16& p1, float& m_reg, float& mn, float& alpha) {
  constexpr float C = SCALE * 1.4426950408889634f;
  float pmax = p0[0]; for (int r = 1; r < 16; ++r) pmax = fmaxf(pmax, p0[r]); for (int r = 0; r < 16; ++r) pmax = fmaxf(pmax, p1[r]);
  { auto rr = __builtin_amdgcn_permlane32_swap(__float_as_uint(pmax), __float_as_uint(pmax), false, false);
    pmax = fmaxf(__uint_as_float(rr[0]), __uint_as_float(rr[1])); }
  if (__builtin_expect(__all(pmax - m_reg <= THR / SCALE), 1)) { mn = m_reg; alpha = 1.f; }
  else { mn = fmaxf(m_reg, pmax); alpha = __builtin_amdgcn_exp2f((m_reg - mn) * C); m_reg = mn; }
  float mnC = -mn * C;
  for (int r = 0; r < 16; ++r) p0[r] = fmaf(p0[r], C, mnC); for (int r = 0; r < 16; ++r) p1[r] = fmaf(p1[r], C, mnC);
  for (int r = 0; r < 16; ++r) p0[r] = __builtin_amdgcn_exp2f(p0[r]);
}
__device__ __forceinline__ void finishSM(f32x16& p0, f32x16& p1, float alpha, float& l_reg, bf16x8& pa0, bf16x8& pa1, bf16x8& pa2, bf16x8& pa3) {
  for (int r = 0; r < 16; ++r) p1[r] = __builtin_amdgcn_exp2f(p1[r]);
  float ps = 0; for (int r = 0; r < 16; ++r) ps += p0[r]; for (int r = 0; r < 16; ++r) ps += p1[r];
  { auto rr = __builtin_amdgcn_permlane32_swap(__float_as_uint(ps), __float_as_uint(ps), false, false);
    ps = __uint_as_float(rr[0]) + __uint_as_float(rr[1]); }
  l_reg = l_reg * alpha + ps;
#define PK4(P, BASE, OUT) do { unsigned a0 = cvtpk(P[BASE + 0], P[BASE + 1]), a1 = cvtpk(P[BASE + 2], P[BASE + 3]);   \
    unsigned b0 = cvtpk(P[BASE + 4], P[BASE + 5]), b1 = cvtpk(P[BASE + 6], P[BASE + 7]);                              \
    auto r0 = __builtin_amdgcn_permlane32_swap(a0, b0, false, false); auto r1 = __builtin_amdgcn_permlane32_swap(a1, b1, false, false); \
    u32x4 w = {r0[0], r1[0], r0[1], r1[1]}; OUT = *reinterpret_cast<bf16x8*>(&w); } while (0)
  PK4(p0, 0, pa0); PK4(p0, 8, pa1); PK4(p1, 0, pa2); PK4(p1, 8, pa3);
#undef PK4
}
__device__ __forceinline__ void qkt(f32x16& p0, f32x16& p1, const bf16_t* Ks, const bf16x8* qr, int r32, int hi) {
  p0 = f32x16{}; p1 = f32x16{};
  for (int d0 = 0; d0 < 8; ++d0) { int cb = (d0 * 16 + hi * 8) * 2;
    bf16x8 b0 = *reinterpret_cast<const bf16x8*>((const char*)Ks + KSWZ(r32, cb));
    bf16x8 b1 = *reinterpret_cast<const bf16x8*>((const char*)Ks + KSWZ(32 + r32, cb));
    p0 = __builtin_amdgcn_mfma_f32_32x32x16_bf16(b0, qr[d0], p0, 0, 0, 0);
    p1 = __builtin_amdgcn_mfma_f32_32x32x16_bf16(b1, qr[d0], p1, 0, 0, 0); }
}
__device__ __forceinline__ int v_st(int k, int c) { const int kk = (k & ~0xC) | ((k & 4) << 1) | ((k & 8) >> 1); return ((kk >> 3) * 4 + (c >> 5)) * 512 + ((kk & 7) * 32 + (c & 31)) * 2; }
__device__ __forceinline__ int v_rd_base(int lane) { return ((lane & 3) << 3) | (((lane >> 2) & 3) << 6) | (((lane >> 4) & 1) << 5) | (((lane >> 5) & 1) << 8); }
constexpr int v_rd_off(int d0, int ks, int half) { return d0 * 512 + ks * 4096 + half * 2048; }
template <int OFF> __device__ __forceinline__ s16x4 tr_read(int vb) {
  s16x4 r; asm volatile("ds_read_b64_tr_b16 %0, %1 offset:%2" : "=&v"(r) : "v"(vb), "i"(OFF) : "memory"); return r;
}
template <int D0> __device__ __forceinline__ void pv_one(f32x16& od, int vb, bf16x8 pa0, bf16x8 pa1, bf16x8 pa2, bf16x8 pa3) {
  const s16x4 l0 = tr_read<v_rd_off(D0, 0, 0)>(vb), h0 = tr_read<v_rd_off(D0, 0, 1)>(vb), l1 = tr_read<v_rd_off(D0, 1, 0)>(vb), h1 = tr_read<v_rd_off(D0, 1, 1)>(vb);
  const s16x4 l2 = tr_read<v_rd_off(D0, 2, 0)>(vb), h2 = tr_read<v_rd_off(D0, 2, 1)>(vb), l3 = tr_read<v_rd_off(D0, 3, 0)>(vb), h3 = tr_read<v_rd_off(D0, 3, 1)>(vb);
  asm volatile("s_waitcnt lgkmcnt(0)" ::: "memory"); SBAR();
#define PK(L, H) (bf16x8){L[0], L[1], L[2], L[3], H[0], H[1], H[2], H[3]}
  od = __builtin_amdgcn_mfma_f32_32x32x16_bf16(pa0, PK(l0, h0), od, 0, 0, 0);
  od = __builtin_amdgcn_mfma_f32_32x32x16_bf16(pa1, PK(l1, h1), od, 0, 0, 0);
  od = __builtin_amdgcn_mfma_f32_32x32x16_bf16(pa2, PK(l2, h2), od, 0, 0, 0);
  od = __builtin_amdgcn_mfma_f32_32x32x16_bf16(pa3, PK(l3, h3), od, 0, 0, 0);
#undef PK
}
__device__ __forceinline__ void pv_d0(f32x16* o, int vb, bf16x8 pa0, bf16x8 pa1, bf16x8 pa2, bf16x8 pa3) {
  pv_one<0>(o[0], vb, pa0, pa1, pa2, pa3); pv_one<1>(o[1], vb, pa0, pa1, pa2, pa3); pv_one<2>(o[2], vb, pa0, pa1, pa2, pa3); pv_one<3>(o[3], vb, pa0, pa1, pa2, pa3);
}
__device__ __forceinline__ void attn_dense_body(const bf16_t* __restrict__ Qb, const bf16_t* __restrict__ Kh, const bf16_t* __restrict__ Vh, bf16_t* __restrict__ Ob, int seq, char* lds) {
  const int tid = threadIdx.x, wid = tid >> 6, lane = tid & 63, r32 = lane & 31, hi = lane >> 5;
  bf16_t* V_lds = (bf16_t*)lds; bf16_t* K_lds = (bf16_t*)(lds + 2 * SHM_V);
  float* ws = (float*)(lds + 2 * SHM_V + 2 * SHM_K) + wid * 64; float* li_l = ws; float* al_l = ws + 32;
  float m_reg = -1e30f, l_reg = 0; f32x16 o[4] = {}; bf16x8 qr[8];
  const bf16_t* Qw = Qb + (long)(wid * QBLK + r32) * LDQ + hi * 8;
#pragma unroll
  for (int d0 = 0; d0 < 8; ++d0) qr[d0] = *reinterpret_cast<const bf16x8*>(Qw + d0 * 16);
  const int sr = tid >> 4, sc = (tid & 15) * 8, vst0 = v_st(sr, sc), vst1 = v_st(32 + sr, sc);
  const int vb0 = (int)(uintptr_t)V_lds + v_rd_base(lane);
  struct { bf16x8 vs0, vs1, ks0, ks1; } sr_[2];
#define SLOAD(i, k0) do { sr_[i].vs0 = *(const bf16x8*)(&Vh[(long)((k0) + sr) * LDK + sc]); sr_[i].vs1 = *(const bf16x8*)(&Vh[(long)((k0) + 32 + sr) * LDK + sc]); \
    sr_[i].ks0 = *(const bf16x8*)(&Kh[(long)((k0) + sr) * LDK + sc]); sr_[i].ks1 = *(const bf16x8*)(&Kh[(long)((k0) + 32 + sr) * LDK + sc]); } while (0)
#define SWRITE(b, i) do { *(bf16x8*)((char*)V_lds + (b) * SHM_V + vst0) = sr_[i].vs0;          \
    *(bf16x8*)((char*)V_lds + (b) * SHM_V + vst1) = sr_[i].vs1; int kc = sc * 2;               \
    *(bf16x8*)((char*)K_lds + (b) * SHM_K + KSWZ(sr, kc)) = sr_[i].ks0;                       \
    *(bf16x8*)((char*)K_lds + (b) * SHM_K + KSWZ(32 + sr, kc)) = sr_[i].ks1; } while (0)
#define SWAIT() asm volatile("s_waitcnt vmcnt(4)" ::: "memory")
#define RESC(a) do { if (__any((a) < 1.f)) { if (hi == 0) al_l[r32] = (a); asm volatile("s_waitcnt lgkmcnt(0)" ::: "memory"); \
    for (int d = 0; d < 4; ++d) for (int r = 0; r < 16; ++r) o[d][r] *= al_l[crow(r, hi)]; } } while (0)
  f32x16 pA0, pA1, pB0, pB1; float mnA, mnB, alA, alB; bf16x8 pa0, pa1, pa2, pa3; const int NT = seq / KVBLK;
  constexpr int SE = 0, SO = 1;
  SLOAD(SE, 0); asm volatile("s_waitcnt vmcnt(0)" ::: "memory"); SWRITE(0, SE); __syncthreads();
  qkt(pA0, pA1, K_lds, qr, r32, hi); partialSM(pA0, pA1, m_reg, mnA, alA);
  SLOAD(SO, KVBLK); if (2 < NT) SLOAD(SE, 2 * KVBLK);
  SWAIT(); SWRITE(1, SO); __syncthreads();
  for (int j = 1; j + 1 < NT; j += 2) {
    SBAR(); qkt(pB0, pB1, (bf16_t*)((char*)K_lds + SHM_K), qr, r32, hi);
    finishSM(pA0, pA1, alA, l_reg, pa0, pa1, pa2, pa3); SBAR();
    SLOAD(SO, (j + 2) * KVBLK); SBAR();
    pv_d0(o, vb0, pa0, pa1, pa2, pa3); partialSM(pB0, pB1, m_reg, mnB, alB);
    __syncthreads(); SWAIT(); SWRITE(0, SE);
    RESC(alB); __syncthreads();
    SBAR(); qkt(pA0, pA1, K_lds, qr, r32, hi);
    finishSM(pB0, pB1, alB, l_reg, pa0, pa1, pa2, pa3); SBAR();
    if (j + 3 < NT) SLOAD(SE, (j + 3) * KVBLK); SBAR();
    pv_d0(o, vb0 + (int)SHM_V, pa0, pa1, pa2, pa3); partialSM(pA0, pA1, m_reg, mnA, alA);
    __syncthreads(); SWAIT(); SWRITE(1, SO);
    RESC(alA); __syncthreads();
  }
  SBAR(); qkt(pB0, pB1, (bf16_t*)((char*)K_lds + SHM_K), qr, r32, hi);
  finishSM(pA0, pA1, alA, l_reg, pa0, pa1, pa2, pa3); SBAR();
  pv_d0(o, vb0, pa0, pa1, pa2, pa3); partialSM(pB0, pB1, m_reg, mnB, alB);
  __syncthreads(); RESC(alB);
  finishSM(pB0, pB1, alB, l_reg, pa0, pa1, pa2, pa3); SBAR();
  pv_d0(o, vb0 + (int)SHM_V, pa0, pa1, pa2, pa3);
  if (hi == 0) li_l[r32] = l_reg; asm volatile("s_waitcnt lgkmcnt(0)" ::: "memory");
  float rli[16];
#pragma unroll
  for (int r = 0; r < 16; ++r) rli[r] = __builtin_amdgcn_rcpf(li_l[crow(r, hi)]);
  bf16_t* Ow = Ob + (long)(wid * QBLK) * LDO;
#pragma unroll
  for (int r = 0; r < 16; ++r) { int orow = crow(r, hi);
    for (int d0 = 0; d0 < 4; ++d0) Ow[(long)orow * LDO + d0 * 32 + r32] = f2bf(o[d0][r] * rli[r]); }
  __syncthreads();
#undef SLOAD
#undef SWRITE
#undef SWAIT
#undef RESC
}
}


__device__ __forceinline__ void s5_build_tables(const Params& p, LAS unsigned char* lds, int g) {
  const int tid = opaque_tid();
  LAS float* Bb = (LAS float*)lds;
  LAS float* Cc = Bb + 4096;
  LAS float* PW = Cc + 4096;
  LAS float* KK = PW + 4352;
  if (tid < 128) {
    const int d = tid >> 6, pi = tid & 63, dg = d * 32 + g, idx = dg * 64 + pi;
    const float are = p.in[I_SARE][idx], aim = p.in[I_SAIM][idx];
    const float dt = expf(p.in[I_SLDT][dg]);
    const float lam = are * dt, om = aim * dt;
    for (int n = 0; n <= 16; ++n) { const float ea = expf(lam * (float)n); float sn, cs; sincosf(om * (float)n, &sn, &cs);
      PW[((d * 17 + n) * 64 + pi) * 2] = ea * cs; PW[((d * 17 + n) * 64 + pi) * 2 + 1] = ea * sn; }
    const float abr = PW[((d * 17 + 1) * 64 + pi) * 2], abi = PW[((d * 17 + 1) * 64 + pi) * 2 + 1];
    const float den = are * are + aim * aim;
    const float nr = abr - 1.f, ni = abi;
    const float rr = (nr * are + ni * aim) / den, ri = (ni * are - nr * aim) / den;
    for (int c = 0; c < 16; ++c) {
      const float bre = p.in[I_SBRE][idx * 16 + c], bim = p.in[I_SBIM][idx * 16 + c];
      Bb[((d * 64 + pi) * 16 + c) * 2] = rr * bre - ri * bim; Bb[((d * 64 + pi) * 16 + c) * 2 + 1] = rr * bim + ri * bre;
      Cc[((d * 16 + c) * 64 + pi) * 2] = p.in[I_SCRE][(dg * 16 + c) * 64 + pi]; Cc[((d * 16 + c) * 64 + pi) * 2 + 1] = p.in[I_SCIM][(dg * 16 + c) * 64 + pi];
    }
  }
  __syncthreads();
  for (int o = tid; o < 8192; o += 512) {
    const int d = o >> 12, tau = (o >> 8) & 15, c = (o >> 4) & 15, c2 = o & 15;
    float s = 0.f;
    for (int pi = 0; pi < 64; ++pi) {
      const float cr = Cc[((d * 16 + c) * 64 + pi) * 2], ci = Cc[((d * 16 + c) * 64 + pi) * 2 + 1];
      const float ar = PW[((d * 17 + tau) * 64 + pi) * 2], ai = PW[((d * 17 + tau) * 64 + pi) * 2 + 1];
      const float br = Bb[((d * 64 + pi) * 16 + c2) * 2], bi = Bb[((d * 64 + pi) * 16 + c2) * 2 + 1];
      const float mr = ar * br - ai * bi, mi = ar * bi + ai * br;
      s += cr * mr - ci * mi;
    }
    KK[o] = s;
  }
  __syncthreads();
  bf16_t* T = (bf16_t*)(p.ws + WS_S5T) + (size_t)g * 256 * 512;
  for (int o = tid; o < 256 * 256; o += 512) {
    const int n = o >> 8, k = (o & 255) * 2, i = n >> 4, c = n & 15;
    float v[2];
#pragma unroll
    for (int q = 0; q < 2; ++q) { const int kk = k + q; float x;
      if (kk < 256) { const int j = kk >> 4, c2 = kk & 15; x = 0.f;
        if (i >= j) x += KK[((0 * 16 + (i - j)) * 16 + c) * 16 + c2];
        if (j >= i) x += KK[((1 * 16 + (j - i)) * 16 + c) * 16 + c2];
        if (i == j && c == c2) x += p.in[I_SD][g * 16 + c];
      } else { const int d = (kk - 256) >> 7, qq = (kk - 256) & 127, part = qq >> 6, pi = qq & 63, n_pw = d ? (16 - i) : (i + 1);
        const float cr = Cc[((d * 16 + c) * 64 + pi) * 2], ci = Cc[((d * 16 + c) * 64 + pi) * 2 + 1];
        const float ar = PW[((d * 17 + n_pw) * 64 + pi) * 2], ai = PW[((d * 17 + n_pw) * 64 + pi) * 2 + 1];
        x = part ? -(cr * ai + ci * ar) : (cr * ar - ci * ai); }
      v[q] = x; }
    *(unsigned*)(T + (size_t)n * 512 + k) = cvt_pk_bf16(v[0], v[1]);
  }
  bf16_t* E = (bf16_t*)(p.ws + WS_S5E) + (size_t)g * 256 * 256;
  for (int o = tid; o < 256 * 128; o += 512) {
    const int n = o >> 7, k = (o & 127) * 2, d = n >> 7, part = (n >> 6) & 1, pi = n & 63;
    float v[2];
#pragma unroll
    for (int q = 0; q < 2; ++q) { const int kk = k + q, j = kk >> 4, c2 = kk & 15, n_pw = d ? j : (15 - j);
      const float ar = PW[((d * 17 + n_pw) * 64 + pi) * 2], ai = PW[((d * 17 + n_pw) * 64 + pi) * 2 + 1];
      const float br = Bb[((d * 64 + pi) * 16 + c2) * 2], bi = Bb[((d * 64 + pi) * 16 + c2) * 2 + 1];
      v[q] = part ? (ar * bi + ai * br) : (ar * br - ai * bi); }
    *(unsigned*)(E + (size_t)n * 256 + k) = cvt_pk_bf16(v[0], v[1]);
  }
  __syncthreads();
}

struct SchedS5S {
  static constexpr bool GATHER = false;
  int G, c;
  __device__ __forceinline__ bool next(int i, pg::Unit& u) const {
    const int L = i * G + c; if (L >= 160) return false;
    u.aux = L / 5; u.pm = L % 5; u.pn = 0; u.arow = u.pm * 256; return true;
  }
};
struct EpiS5S {
  static constexpr bool PERM = false;
  float* S;
  __device__ __forceinline__ void operator()(const pg::Acc& acc, const pg::Unit& u, int wr, int wc, int fr, int fq) const {
    const int row0 = u.arow + wr * 64 + fr, col0 = wc * 32 + 4 * fq;
#pragma unroll
    for (int ai = 0; ai < 2; ++ai)
#pragma unroll
      for (int m = 0; m < 4; ++m) { const int r = row0 + ai * 128 + m * 16;
        if (r < NCHUNK) { float* rowp = S + ((size_t)u.aux * NCHUNK + r) * 256 + col0;
#pragma unroll
          for (int bj = 0; bj < 2; ++bj)
#pragma unroll
            for (int n = 0; n < 2; ++n) *(f32x4*)(rowp + bj * 128 + n * 16) = acc[ai][bj][m][n]; } }
  }
};
__device__ __forceinline__ void phase_s5s(const Params& p, LAS unsigned char* lds) {
  pg::Addr AD{(const bf16_t*)((unsigned char*)p.out + DO_YA), 512, (size_t)NCHUNK * 512, (const bf16_t*)(p.ws + WS_S5E), 256, (size_t)256 * 256, false};
  SchedS5S S{(int)gridDim.x, (int)blockIdx.x};
  EpiS5S E{(float*)(p.ws + WS_RH)};
  pg::gemm_phase(lds, AD, S, E);
}

__device__ __forceinline__ void s5_scan_item(const Params& p, int item, int lane) {
  const int d = item & 1, g = (item >> 1) & 31, b = item >> 6;
  const float* S = (const float*)(p.ws + WS_RH) + (size_t)g * NCHUNK * 256 + d * 128 + lane;
  bf16_t* YA = (bf16_t*)((unsigned char*)p.out + DO_YA) + (size_t)g * NCHUNK * 512 + 256 + d * 128 + lane;
  const int idx = (d * 32 + g) * 64 + lane;
  const float dt = expf(p.in[I_SLDT][d * 32 + g]);
  const float ea = expf(p.in[I_SARE][idx] * dt * 16.f); float sn, cs; sincosf(p.in[I_SAIM][idx] * dt * 16.f, &sn, &cs);
  const float ar = ea * cs, ai = ea * sn;
  float hr = 0.f, hi = 0.f;
  const int r0 = b * 528;
#pragma unroll 4
  for (int s = 0; s < 16; ++s) { const int r = r0 + 512 + (d ? 15 - s : s);
    const float sr = S[(size_t)r * 256], si = S[(size_t)r * 256 + 64];
    const float nr = ar * hr - ai * hi + sr, ni = ar * hi + ai * hr + si; hr = nr; hi = ni; }
#pragma unroll 8
  for (int s = 0; s < 512; ++s) { const int r = r0 + (d ? 511 - s : s);
    const float sr = S[(size_t)r * 256], si = S[(size_t)r * 256 + 64];
    YA[(size_t)r * 512] = f2bf(hr); YA[(size_t)r * 512 + 64] = f2bf(hi);
    const float nr = ar * hr - ai * hi + sr, ni = ar * hi + ai * hr + si; hr = nr; hi = ni; }
}
__device__ __forceinline__ void phase_s5scan(const Params& p) {
  const int tid_ = opaque_tid(); const int lane = tid_ & 63, wave = tid_ >> 6;
  const int gw = blockIdx.x * NWAVES + wave;
  if (gw < 128) s5_scan_item(p, gw, lane);
}

struct SchedS5Y {
  static constexpr bool GATHER = false;
  int G, c;
  __device__ __forceinline__ bool next(int i, pg::Unit& u) const {
    const int L = i * G + c; if (L >= 128) return false;
    u.aux = L >> 2; u.pm = L & 3; u.pn = 0; u.arow = (u.pm >> 1) * 528 + (u.pm & 1) * 256; return true;
  }
};
struct EpiS5Y {
  static constexpr bool PERM = true;
  bf16_t* GY;
  __device__ __forceinline__ void operator()(const pg::Acc& acc, const pg::Unit& u, int wr, int wc, int fr, int fq) const {
    const int row0 = u.arow + wr * 64 + fr;
#pragma unroll
    for (int ai = 0; ai < 2; ++ai)
#pragma unroll
      for (int m = 0; m < 4; ++m) { const int chunk = row0 + ai * 128 + m * 16;
#pragma unroll
        for (int bj = 0; bj < 2; ++bj) { const int col = bj * 128 + wc * 32 + 8 * fq, ti = col >> 4, c0 = col & 15;
          float o[8];
#pragma unroll
          for (int n = 0; n < 2; ++n)
#pragma unroll
            for (int e = 0; e < 4; ++e) o[n * 4 + e] = gelu_tanh(acc[ai][bj][m][n][e]);
          u32x4 w; w.x = cvt_pk_bf16(o[0], o[1]); w.y = cvt_pk_bf16(o[2], o[3]); w.z = cvt_pk_bf16(o[4], o[5]); w.w = cvt_pk_bf16(o[6], o[7]);
          *(u32x4*)(GY + (size_t)(chunk * 16 + ti) * 512 + u.aux * 16 + c0) = w; } }
  }
};
__device__ __forceinline__ void phase_s5y(const Params& p, LAS unsigned char* lds) {
  pg::Addr AD{(const bf16_t*)((unsigned char*)p.out + DO_YA), 512, (size_t)NCHUNK * 512, (const bf16_t*)(p.ws + WS_S5T), 512, (size_t)256 * 512, false};
  SchedS5Y S{(int)gridDim.x, (int)blockIdx.x};
  EpiS5Y E{(bf16_t*)((unsigned char*)p.out + DO_GY)};
  pg::gemm_phase(lds, AD, S, E);
}
__device__ __forceinline__ void map_static(int L, int nM, int nN, int& pm, int& pn) {
  const int nwg = nM * nN; int wgid = L;
  { const int q = nwg / 8, r = nwg % 8, xcd = wgid % 8, off = wgid / 8; wgid = (xcd < r ? xcd * (q + 1) : r * (q + 1) + (xcd - r) * q) + off; }
  const int nig = 8 * nN, gid = wgid / nig, fm = gid * 8, gsz = (nM - fm) < 8 ? (nM - fm) : 8;
  pm = fm + ((wgid % nig) % gsz); pn = (wgid % nig) / gsz;
}

__device__ __forceinline__ void cvt_item(const float* W, int ldw, bf16_t* dst, int ldd, int k0, int n0, LAS float* scr, int lane) {
#pragma unroll 8
  for (int i = 0; i < 32; ++i) { const int kk = 2 * i + (lane >> 5); scr[kk * 33 + (lane & 31)] = W[(size_t)(k0 + kk) * ldw + n0 + (lane & 31)]; }
  asm volatile("s_waitcnt lgkmcnt(0)" ::: "memory");
  const int c = lane & 7;
#pragma unroll
  for (int j = 0; j < 4; ++j) { const int n = (lane >> 3) + 8 * j; const LAS float* s = scr + (8 * c) * 33 + n;
    u32x4 o; o.x = cvt_pk_bf16(s[0 * 33], s[1 * 33]); o.y = cvt_pk_bf16(s[2 * 33], s[3 * 33]); o.z = cvt_pk_bf16(s[4 * 33], s[5 * 33]); o.w = cvt_pk_bf16(s[6 * 33], s[7 * 33]);
    *(u32x4*)(dst + (size_t)n * ldd + k0 + 8 * c) = o; }
  asm volatile("s_waitcnt lgkmcnt(0)" ::: "memory");
}
__device__ __forceinline__ int ilv_row(int n, int second) { return (n >> 7) * 256 + (n & 127) + second * 128; }

constexpr int CV_WIN = (1024 / 64) * (4096 / 32);
constexpr int CV_GLU = (512 / 64) * (1024 / 32);
constexpr int CV_SQ = (1024 / 64) * (1024 / 32);
constexpr int CV_EGU = (1024 / 64) * (512 / 32);
constexpr int CV_ED = (512 / 64) * (1024 / 32);
constexpr int CV_SMALL = CV_WIN + 2 * CV_GLU + 2 * CV_SQ;
constexpr int CV_TOTAL = CV_SMALL + 32 * (2 * CV_EGU + CV_ED);

__device__ __forceinline__ void cvt_dispatch(const Params& p, int it, LAS float* scr, int lane) {
  unsigned char* ws = p.ws;
  if (it < CV_WIN) { const int nb = 4096 / 32; cvt_item(p.in[I_WIN], 4096, (bf16_t*)(ws + WS_WIN) + (size_t)(32 * (it % nb)) * 1024, 1024, 64 * (it / nb), 32 * (it % nb), scr, lane); return; }
  it -= CV_WIN;
  if (it < 2 * CV_GLU) { const int second = it / CV_GLU; it %= CV_GLU; const int nb = 1024 / 32, n0 = 32 * (it % nb);
    cvt_item(p.in[second ? I_WGB : I_WGA], 1024, (bf16_t*)(ws + WS_WGLU) + (size_t)ilv_row(n0, second) * 512, 512, 64 * (it / nb), n0, scr, lane); return; }
  it -= 2 * CV_GLU;
  if (it < 2 * CV_SQ) { const int second = it / CV_SQ; it %= CV_SQ; const int nb = 1024 / 32, n0 = 32 * (it % nb);
    cvt_item(p.in[second ? I_WOUT : I_WAO], 1024, (bf16_t*)(ws + (second ? WS_WOUT : WS_WAO)) + (size_t)n0 * 1024, 1024, 64 * (it / nb), n0, scr, lane); return; }
  it -= 2 * CV_SQ;
  const int per_e = 2 * CV_EGU + CV_ED, e = it / per_e; it %= per_e;
  if (it < 2 * CV_EGU) { const int second = it / CV_EGU; it %= CV_EGU; const int nb = 512 / 32, n0 = 32 * (it % nb);
    cvt_item(p.in[second ? I_WEU : I_WEG] + (size_t)e * 1024 * 512, 512, (bf16_t*)(ws + WS_WGU) + ((size_t)e * 1024 + ilv_row(n0, second)) * 1024, 1024, 64 * (it / nb), n0, scr, lane); return; }
  it -= 2 * CV_EGU;
  { const int nb = 1024 / 32, n0 = 32 * (it % nb);
    cvt_item(p.in[I_WED] + (size_t)e * 512 * 1024, 1024, (bf16_t*)(ws + WS_WD) + ((size_t)e * 1024 + n0) * 512, 512, 64 * (it / nb), n0, scr, lane); }
}

__device__ __forceinline__ void phase0(const Params& p, LAS unsigned char* lds) {
  const int tid = opaque_tid(), lane = tid & 63, wave = tid >> 6, c = blockIdx.x, G = gridDim.x;
  LAS float* red = (LAS float*)lds;
  for (int cg = c; cg < NMOD / 24; cg += G) {
    const int col = tid % 24, sl = tid / 24;
    float a0 = 0.f, a1 = 0.f, a2 = 0.f;
    if (sl < 21) {
      const float* w = p.in[I_WMOD] + cg * 24 + col;
      for (int k = sl; k < DM; k += 21) { const float wv = w[(size_t)k * NMOD];
        a0 += siluf_(p.in[I_C][k]) * wv; a1 += siluf_(p.in[I_C][DM + k]) * wv; a2 += siluf_(p.in[I_CCTX][k]) * wv; }
      red[(sl * 24 + col) * 3 + 0] = a0; red[(sl * 24 + col) * 3 + 1] = a1; red[(sl * 24 + col) * 3 + 2] = a2;
    }
    __syncthreads();
    if (tid < 72) { const int cc = tid / 3, r = tid % 3; float s = 0.f;
      for (int q = 0; q < 21; ++q) s += red[(q * 24 + cc) * 3 + r];
      ((float*)(p.ws + WS_MOD))[r * NMOD + cg * 24 + cc] = s + p.in[I_BMOD][cg * 24 + cc]; }
    __syncthreads();
  }
  const int nb = (G >= 64) ? 32 : 0;
  for (int g = c; g < 32; g += G) s5_build_tables(p, lds, g);
  if (c >= nb) {
    LAS float* scr = (LAS float*)(lds + 8192) + wave * (64 * 33);
    const int gw = (c - nb) * NWAVES + wave, NGW = (G - nb) * NWAVES;
    for (int it = gw; it < CV_TOTAL; it += NGW) cvt_dispatch(p, it, scr, lane);
  }
}

__device__ __forceinline__ void phase1(const Params& p) {
  const float* mod = (const float*)(p.ws + WS_MOD);
  bf16_t* H = (bf16_t*)(p.ws + WS_RH);
  const int tid_ = opaque_tid(); const int lane = tid_ & 63, wave = tid_ >> 6;
  const int gw = blockIdx.x * NWAVES + wave, NGW = gridDim.x * NWAVES;
  for (int pr = gw; pr < NROW; pr += NGW) {
    const int b = pr / SKV, t = pr % SKV;
    const float* xr; const float* mrow;
    if (t < SEQ) { xr = p.in[I_X] + ((size_t)b * SEQ + t) * DM; mrow = mod + b * NMOD; }
    else { xr = p.in[I_CTX] + ((size_t)b * NCTX + (t - SEQ)) * DM; mrow = mod + 2 * NMOD; }
    f32x4 v[4]; float s = 0;
#pragma unroll
    for (int j = 0; j < 4; ++j) { v[j] = ((const f32x4*)xr)[lane + 64 * j]; s += (v[j].x + v[j].y) + (v[j].z + v[j].w); }
    const float mean = wave_sum(s) * (1.f / DM); float s2 = 0;
#pragma unroll
    for (int j = 0; j < 4; ++j) { v[j] = v[j] - mean; s2 += (v[j].x * v[j].x + v[j].y * v[j].y) + (v[j].z * v[j].z + v[j].w * v[j].w); }
    const float rstd = rsqrtf(wave_sum(s2) * (1.f / DM) + LN_EPS);
#pragma unroll
    for (int j = 0; j < 4; ++j) {
      const int col = (lane + 64 * j) * 4;
      const f32x4 sh = *(const f32x4*)(mrow + col), sc = *(const f32x4*)(mrow + DM + col);
      const f32x4 o = v[j] * rstd * (sc + 1.f) + sh;
      u32x2 w; w.x = cvt_pk_bf16(o.x, o.y); w.y = cvt_pk_bf16(o.z, o.w);
      *(u32x2*)(H + (size_t)pr * DM + col) = w;
    }
  }
}

struct SchedIn {
  static constexpr bool GATHER = false;
  int G, c;
  __device__ __forceinline__ bool next(int i, pg::Unit& u) const {
    const int L = i * G + c; u.aux = 0;
    if (L < 1024) { int lm, pn; map_static(L, 64, 16, lm, pn); u.pm = lm + (lm >> 5); u.pn = pn; u.arow = u.pm * 256; return true; }
    if (L < 1032) { const int j = L - 1024; u.pm = (j < 4) ? 32 : 65; const int q = j & 3; u.pn = (q < 2) ? q : q + 4; u.arow = u.pm * 256; return true; }
    return false;
  }
};
struct EpiIn {
  static constexpr bool PERM = true;
  bf16_t* YA; bf16_t* P;
  __device__ __forceinline__ void operator()(const pg::Acc& acc, const pg::Unit& u, int wr, int wc, int fr, int fq) const {
    const int row0 = u.pm * 256 + wr * 64 + fr;
    if (u.pn < 2) {
#pragma unroll
      for (int ai = 0; ai < 2; ++ai)
#pragma unroll
        for (int m = 0; m < 4; ++m) { const int r = row0 + ai * 128 + m * 16, chunk = r >> 4, ti = r & 15;
#pragma unroll
          for (int bj = 0; bj < 2; ++bj) { const int ch = u.pn * 256 + bj * 128 + wc * 32 + 8 * fq, g = ch >> 4, off = ch & 15;
            const f32x4 v0 = acc[ai][bj][m][0], v1 = acc[ai][bj][m][1];
            u32x4 w; w.x = cvt_pk_bf16(v0[0], v0[1]); w.y = cvt_pk_bf16(v0[2], v0[3]); w.z = cvt_pk_bf16(v1[0], v1[1]); w.w = cvt_pk_bf16(v1[2], v1[3]);
            *(u32x4*)(YA + ((size_t)g * NCHUNK + chunk) * 512 + ti * 16 + off) = w; } }
    } else {
      const int colb = (u.pn - 2) * 256 + wc * 32 + 8 * fq; const bool sig = u.pn >= 8;
#pragma unroll
      for (int ai = 0; ai < 2; ++ai)
#pragma unroll
        for (int m = 0; m < 4; ++m) { bf16_t* rowp = P + (size_t)(row0 + ai * 128 + m * 16) * PLD + colb;
#pragma unroll
          for (int bj = 0; bj < 2; ++bj) { f32x4 v0 = acc[ai][bj][m][0], v1 = acc[ai][bj][m][1];
            if (sig) {
#pragma unroll
              for (int e = 0; e < 4; ++e) { v0[e] = __builtin_amdgcn_rcpf(1.f + __builtin_amdgcn_exp2f(-1.4426950408889634f * v0[e])); v1[e] = __builtin_amdgcn_rcpf(1.f + __builtin_amdgcn_exp2f(-1.4426950408889634f * v1[e])); } }
            u32x4 w; w.x = cvt_pk_bf16(v0[0], v0[1]); w.y = cvt_pk_bf16(v0[2], v0[3]); w.z = cvt_pk_bf16(v1[0], v1[1]); w.w = cvt_pk_bf16(v1[2], v1[3]);
            *(u32x4*)(rowp + bj * 128) = w; } }
    }
  }
};
__device__ __forceinline__ void phase2(const Params& p, LAS unsigned char* lds) {
  pg::Addr AD{(const bf16_t*)(p.ws + WS_RH), DM, 0, (const bf16_t*)(p.ws + WS_WIN), DM, 0, false};
  SchedIn S{(int)gridDim.x, (int)blockIdx.x};
  EpiIn E{(bf16_t*)((unsigned char*)p.out + DO_YA), (bf16_t*)(p.ws + WS_P)};
  pg::gemm_phase(lds, AD, S, E);
}

__device__ __forceinline__ void phase_qknorm(const Params& p) {
  bf16_t* P = (bf16_t*)(p.ws + WS_P);
  const int tid_ = opaque_tid(); const int lane = tid_ & 63, wave = tid_ >> 6;
  const int gw = blockIdx.x * NWAVES + wave, NGW = gridDim.x * NWAVES;
  const int axis = lane >> 5, f = lane & 31, e1 = axis * 64 + f, e2 = e1 + 32;
  const float inv = exp2f(-(float)(2 * f) * (13.287712379549449f / 64.f));
  const float gq1 = p.in[I_QG][e1], gq2 = p.in[I_QG][e2], gk1 = p.in[I_KG][e1], gk2 = p.in[I_KG][e2];
  for (int item = gw; item < NROW * 10; item += NGW) {
    const int pr = item / 10, slot = item % 10, t = pr % SKV;
    const bool isctx = t >= SEQ;
    if (isctx && slot < 8) continue;
    bf16_t* base = P + (size_t)pr * PLD + (slot < 8 ? PC_Q + slot * 128 : PC_K + (slot - 8) * 128);
    float x1 = bf2f(base[e1]), x2 = bf2f(base[e2]);
    const float ss = wave_sum(x1 * x1 + x2 * x2);
    const float r = rsqrtf(ss * (1.f / 128.f) + LN_EPS);
    x1 = x1 * r * (slot < 8 ? gq1 : gk1); x2 = x2 * r * (slot < 8 ? gq2 : gk2);
    float o1 = x1, o2 = x2;
    if (!isctx) {
      const float posf = (axis == 0) ? (float)(t >> 6) : (float)(t & 63);
      float sn, cs; sincosf(posf * inv, &sn, &cs);
      o1 = x1 * cs - x2 * sn; o2 = x1 * sn + x2 * cs;
    }
    base[e1] = f2bf(o1); base[e2] = f2bf(o2);
  }
}
struct SchedLat {
  static constexpr bool GATHER = false;
  int G, c, nN;
  __device__ __forceinline__ bool next(int i, pg::Unit& u) const {
    const int L = i * G + c; u.aux = 0;
    if (L >= 64 * nN) return false;
    int lm, pn; map_static(L, 64, nN, lm, pn); u.pm = lm + (lm >> 5); u.pn = pn; u.arow = u.pm * 256; return true;
  }
};
struct EpiGlu {
  static constexpr bool PERM = true;
  const bf16_t* P; bf16_t* Z;
  __device__ __forceinline__ void operator()(const pg::Acc& acc, const pg::Unit& u, int wr, int wc, int fr, int fq) const {
    const int row0 = u.pm * 256 + wr * 64 + fr, ch = u.pn * 128 + wc * 32 + 8 * fq;
#pragma unroll
    for (int ai = 0; ai < 2; ++ai)
#pragma unroll
      for (int m = 0; m < 4; ++m) { const int r = row0 + ai * 128 + m * 16;
        const u32x4 gw = *(const u32x4*)(P + (size_t)r * PLD + PC_G + ch);
        float gt[8] = {__uint_as_float(gw.x << 16), __uint_as_float(gw.x & 0xffff0000u), __uint_as_float(gw.y << 16), __uint_as_float(gw.y & 0xffff0000u),
                       __uint_as_float(gw.z << 16), __uint_as_float(gw.z & 0xffff0000u), __uint_as_float(gw.w << 16), __uint_as_float(gw.w & 0xffff0000u)};
        float o[8];
#pragma unroll
        for (int n = 0; n < 2; ++n)
#pragma unroll
          for (int e = 0; e < 4; ++e) { const float a = acc[ai][0][m][n][e], b = acc[ai][1][m][n][e];
            o[n * 4 + e] = gt[n * 4 + e] * a * __builtin_amdgcn_rcpf(1.f + __builtin_amdgcn_exp2f(-1.4426950408889634f * b)); }
        u32x4 w; w.x = cvt_pk_bf16(o[0], o[1]); w.y = cvt_pk_bf16(o[2], o[3]); w.z = cvt_pk_bf16(o[4], o[5]); w.w = cvt_pk_bf16(o[6], o[7]);
        *(u32x4*)(Z + (size_t)r * DM + ch) = w; }
  }
};
struct EpiMix {
  static constexpr bool PERM = true;
  const bf16_t* P; bf16_t* Z;
  __device__ __forceinline__ void operator()(const pg::Acc& acc, const pg::Unit& u, int wr, int wc, int fr, int fq) const {
    const int row0 = u.pm * 256 + wr * 64 + fr, col0 = u.pn * 256 + wc * 32 + 8 * fq;
#pragma unroll
    for (int ai = 0; ai < 2; ++ai)
#pragma unroll
      for (int m = 0; m < 4; ++m) { const int r = row0 + ai * 128 + m * 16;
#pragma unroll
        for (int bj = 0; bj < 2; ++bj) { const int c = col0 + bj * 128;
          const u32x4 gw = *(const u32x4*)(P + (size_t)r * PLD + PC_G + 1024 + c);
          const u32x4 zw = *(const u32x4*)(Z + (size_t)r * DM + c);
          const unsigned gq[4] = {gw.x, gw.y, gw.z, gw.w}, zq[4] = {zw.x, zw.y, zw.z, zw.w};
          unsigned ow[4];
#pragma unroll
          for (int q = 0; q < 4; ++q) { const float a0 = acc[ai][bj][m][q >> 1][(q & 1) * 2], a1 = acc[ai][bj][m][q >> 1][(q & 1) * 2 + 1];
            ow[q] = cvt_pk_bf16(__uint_as_float(zq[q] << 16) + __uint_as_float(gq[q] << 16) * a0, __uint_as_float(zq[q] & 0xffff0000u) + __uint_as_float(gq[q] & 0xffff0000u) * a1); }
          *(u32x4*)(Z + (size_t)r * DM + c) = (u32x4){ow[0], ow[1], ow[2], ow[3]}; } }
  }
};
struct EpiOut {
  static constexpr bool PERM = false;
  const float* X; const float* mod; float* R1;
  __device__ __forceinline__ void operator()(const pg::Acc& acc, const pg::Unit& u, int wr, int wc, int fr, int fq) const {
    const int b = u.pm / 33, lrow0 = (u.pm - b) * 256 + wr * 64 + fr, col0 = u.pn * 256 + wc * 32 + 4 * fq;
    const float* g1 = mod + b * NMOD + 2 * DM;
    f32x4 gv[2][2];
#pragma unroll
    for (int bj = 0; bj < 2; ++bj)
#pragma unroll
      for (int n = 0; n < 2; ++n) gv[bj][n] = *(const f32x4*)(g1 + col0 + bj * 128 + n * 16);
#pragma unroll
    for (int ai = 0; ai < 2; ++ai)
#pragma unroll
      for (int m = 0; m < 4; ++m) { const size_t off = (size_t)(lrow0 + ai * 128 + m * 16) * DM + col0;
#pragma unroll
        for (int bj = 0; bj < 2; ++bj)
#pragma unroll
          for (int n = 0; n < 2; ++n) { const f32x4 xv = *(const f32x4*)(X + off + bj * 128 + n * 16);
            *(f32x4*)(R1 + off + bj * 128 + n * 16) = xv * ALPHA + gv[bj][n] * acc[ai][bj][m][n]; } }
  }
};
__device__ __forceinline__ void phase_g1(const Params& p, LAS unsigned char* lds) {
  pg::Addr AD{(const bf16_t*)((unsigned char*)p.out + DO_GY), 512, 0, (const bf16_t*)(p.ws + WS_WGLU), 512, 0, false};
  SchedLat S{(int)gridDim.x, (int)blockIdx.x, 8};
  EpiGlu E{(const bf16_t*)(p.ws + WS_P), (bf16_t*)(p.ws + WS_RH)};
  pg::gemm_phase(lds, AD, S, E);
}
__device__ __forceinline__ void phase_g2(const Params& p, LAS unsigned char* lds) {
  pg::Addr AD{(const bf16_t*)(p.ws + WS_P) + PC_Q, PLD, 0, (const bf16_t*)(p.ws + WS_WAO), DM, 0, false};
  SchedLat S{(int)gridDim.x, (int)blockIdx.x, 4};
  EpiMix E{(const bf16_t*)(p.ws + WS_P), (bf16_t*)(p.ws + WS_RH)};
  pg::gemm_phase(lds, AD, S, E);
}
__device__ __forceinline__ void phase_g3(const Params& p, LAS unsigned char* lds) {
  pg::Addr AD{(const bf16_t*)(p.ws + WS_RH), DM, 0, (const bf16_t*)(p.ws + WS_WOUT), DM, 0, false};
  SchedLat S{(int)gridDim.x, (int)blockIdx.x, 4};
  EpiOut E{p.in[I_X], (const float*)(p.ws + WS_MOD), p.out};
  pg::gemm_phase(lds, AD, S, E);
}

constexpr size_t RT_EW = 0, RT_LIST = 256 * 1024;
constexpr int CTL_CNT = 1024;
constexpr int ACT_TILES_MAX = 160;
constexpr size_t PR_ACT = 66 * MiB;

struct MoeTab { const LAS int* tb; const LAS int* cn; };
__device__ __forceinline__ MoeTab moe_tables(const Params& p, LAS unsigned char* lds) {
  LAS int* tb = (LAS int*)(lds + LDS_STAGE); LAS int* cn = tb + 64;
  const unsigned* cnt = (const unsigned*)(p.ws + WS_CTL) + CTL_CNT;
  if (threadIdx.x == 0) { int acc = 0; for (int e = 0; e < 32; ++e) { const int c = (int)cnt[e]; cn[e] = c; tb[e] = acc; acc += (c + 255) >> 8; } tb[32] = acc; }
  __syncthreads();
  return MoeTab{tb, cn};
}
struct SchedMoe {
  static constexpr bool GATHER_ = true;
  int G, c, nN; MoeTab tab; const int* lists;
  __device__ __forceinline__ bool next_(int i, pg::Unit& u) const {
    const int L = i * G + c, T = L / nN;
    if (T >= tab.tb[32]) return false;
    int e = 0;
#pragma unroll 1
    for (int q = 1; q < 32; ++q) e = (tab.tb[q] <= T) ? q : e;
    u.pm = T; u.pn = L % nN; u.aux = e; u.arow = T * 256; return true;
  }
  __device__ __forceinline__ int arow_(const pg::Unit& u, int r) const {
    const int slot = (u.pm - tab.tb[u.aux]) * 256 + r;
    if (slot >= tab.cn[u.aux]) return 0;
    return lat2pad(lists[u.aux * NLAT + slot] >> 1);
  }
};
struct SchedMoeUp : SchedMoe { static constexpr bool GATHER = true;
  __device__ __forceinline__ bool next(int i, pg::Unit& u) const { return next_(i, u); }
  __device__ __forceinline__ int arow(const pg::Unit& u, int r) const { return arow_(u, r); } };
struct SchedMoeDown : SchedMoe { static constexpr bool GATHER = false;
  __device__ __forceinline__ bool next(int i, pg::Unit& u) const { return next_(i, u); } };
struct EpiGU {
  static constexpr bool PERM = true;
  bf16_t* ACT;
  __device__ __forceinline__ void operator()(const pg::Acc& acc, const pg::Unit& u, int wr, int wc, int fr, int fq) const {
    const int row0 = u.pm * 256 + wr * 64 + fr, ch = u.pn * 128 + wc * 32 + 8 * fq;
#pragma unroll
    for (int ai = 0; ai < 2; ++ai)
#pragma unroll
      for (int m = 0; m < 4; ++m) { const int r = row0 + ai * 128 + m * 16;
        float o[8];
#pragma unroll
        for (int n = 0; n < 2; ++n)
#pragma unroll
          for (int e = 0; e < 4; ++e) { const float a = acc[ai][0][m][n][e], b = acc[ai][1][m][n][e];
            o[n * 4 + e] = a * b * __builtin_amdgcn_rcpf(1.f + __builtin_amdgcn_exp2f(-1.4426950408889634f * a)); }
        u32x4 w; w.x = cvt_pk_bf16(o[0], o[1]); w.y = cvt_pk_bf16(o[2], o[3]); w.z = cvt_pk_bf16(o[4], o[5]); w.w = cvt_pk_bf16(o[6], o[7]);
        *(u32x4*)(ACT + (size_t)r * 512 + ch) = w; }
  }
};
struct EpiDown {
  static constexpr bool PERM = true;
  bf16_t* Y2; const int* lists; const float* ew; MoeTab tab;
  __device__ __forceinline__ void operator()(const pg::Acc& acc, const pg::Unit& u, int wr, int wc, int fr, int fq) const {
    const int slot0 = (u.pm - tab.tb[u.aux]) * 256 + wr * 64 + fr, n_e = tab.cn[u.aux], col0 = u.pn * 256 + wc * 32 + 8 * fq;
#pragma unroll
    for (int ai = 0; ai < 2; ++ai)
#pragma unroll
      for (int m = 0; m < 4; ++m) { const int slot = slot0 + ai * 128 + m * 16;
        if (slot < n_e) { const int id = lists[u.aux * NLAT + slot]; const float w = ew[id];
#pragma unroll
          for (int bj = 0; bj < 2; ++bj) { const f32x4 v0 = acc[ai][bj][m][0] * w, v1 = acc[ai][bj][m][1] * w;
            u32x4 o; o.x = cvt_pk_bf16(v0[0], v0[1]); o.y = cvt_pk_bf16(v0[2], v0[3]); o.z = cvt_pk_bf16(v1[0], v1[1]); o.w = cvt_pk_bf16(v1[2], v1[3]);
            *(u32x4*)(Y2 + (size_t)id * DM + col0 + bj * 128) = o; } } }
  }
};
__device__ __forceinline__ void phase_moe_up(const Params& p, LAS unsigned char* lds) {
  const MoeTab tab = moe_tables(p, lds);
  pg::Addr AD{(const bf16_t*)(p.ws + WS_RH), DM, 0, (const bf16_t*)(p.ws + WS_WGU), DM, (size_t)1024 * 1024, true};
  SchedMoeUp S; S.G = gridDim.x; S.c = blockIdx.x; S.nN = 4; S.tab = tab; S.lists = (const int*)(p.ws + WS_ROUTE + RT_LIST);
  EpiGU E{(bf16_t*)(p.ws + WS_P + PR_ACT)};
  pg::gemm_phase(lds, AD, S, E);
}
__device__ __forceinline__ void phase_moe_down(const Params& p, LAS unsigned char* lds) {
  const MoeTab tab = moe_tables(p, lds);
  pg::Addr AD{(const bf16_t*)(p.ws + WS_P + PR_ACT), 512, 0, (const bf16_t*)(p.ws + WS_WD), 512, (size_t)1024 * 512, false};
  SchedMoeDown S; S.G = gridDim.x; S.c = blockIdx.x; S.nN = 4; S.tab = tab; S.lists = (const int*)(p.ws + WS_ROUTE + RT_LIST);
  EpiDown E{(bf16_t*)(p.ws + WS_P), (const int*)(p.ws + WS_ROUTE + RT_LIST), (const float*)(p.ws + WS_ROUTE + RT_EW), tab};
  pg::gemm_phase(lds, AD, S, E);
}

__device__ __forceinline__ void phase_final(const Params& p) {
  const float* mod = (const float*)(p.ws + WS_MOD);
  const bf16_t* Y2 = (const bf16_t*)(p.ws + WS_P);
  float* X1 = p.out;
  const int tid_ = opaque_tid(); const int lane = tid_ & 63, wave = tid_ >> 6;
  const int gw = blockIdx.x * NWAVES + wave, NGW = gridDim.x * NWAVES;
  for (int row = gw; row < NLAT; row += NGW) {
    const float* mrow = mod + (row / SEQ) * NMOD;
    f32x4 v[4]; float s = 0;
#pragma unroll
    for (int j = 0; j < 4; ++j) {
      const int col = (lane + 64 * j) * 4;
      const f32x4 x1 = ((const f32x4*)(X1 + (size_t)row * DM))[lane + 64 * j];
      const u32x2 ya = *(const u32x2*)(Y2 + (size_t)(2 * row) * DM + col), yb = *(const u32x2*)(Y2 + (size_t)(2 * row + 1) * DM + col);
      f32x4 ym;
      ym.x = __uint_as_float(ya.x << 16) + __uint_as_float(yb.x << 16); ym.y = __uint_as_float(ya.x & 0xffff0000u) + __uint_as_float(yb.x & 0xffff0000u);
      ym.z = __uint_as_float(ya.y << 16) + __uint_as_float(yb.y << 16); ym.w = __uint_as_float(ya.y & 0xffff0000u) + __uint_as_float(yb.y & 0xffff0000u);
      const f32x4 g2 = *(const f32x4*)(mrow + 5 * DM + col);
      v[j] = x1 * ALPHA + g2 * ym;
      s += (v[j].x + v[j].y) + (v[j].z + v[j].w);
    }
    const float mean = wave_sum(s) * (1.f / DM); float s2 = 0;
#pragma unroll
    for (int j = 0; j < 4; ++j) { v[j] = v[j] - mean; s2 += (v[j].x * v[j].x + v[j].y * v[j].y) + (v[j].z * v[j].z + v[j].w * v[j].w); }
    const float rstd = rsqrtf(wave_sum(s2) * (1.f / DM) + LN_EPS);
#pragma unroll
    for (int j = 0; j < 4; ++j) {
      const int col = (lane + 64 * j) * 4;
      const f32x4 g = *(const f32x4*)(p.in[I_LN2G] + col), bb = *(const f32x4*)(p.in[I_LN2B] + col);
      ((f32x4*)(X1 + (size_t)row * DM))[lane + 64 * j] = v[j] * rstd * g + bb;
    }
  }
}
__device__ __forceinline__ void phase_attn(const Params& p, char* lds) {
  bf16_t* P = (bf16_t*)(p.ws + WS_P);
  int seq = SKV; asm volatile("" : "+s"(seq));
  for (int unit = blockIdx.x; unit < NB * 8 * (SEQ / 256); unit += gridDim.x) {
    const int qb = unit % 32, h = (unit / 32) % 8, b = unit / 256;
    bf16_t* Qp = P + ((size_t)b * SKV + qb * 256) * PLD + PC_Q + h * 128;
    const bf16_t* Kp = P + (size_t)b * SKV * PLD + PC_K + (h >> 2) * 128;
    const bf16_t* Vp = P + (size_t)b * SKV * PLD + PC_V + (h >> 2) * 128;
    att::attn_dense_body(Qp, Kp, Vp, Qp, seq, lds);
  }
}

__device__ __forceinline__ void phase_ln1_router(const Params& p) {
  const float* mod = (const float*)(p.ws + WS_MOD);
  float* R1 = p.out;
  bf16_t* H2 = (bf16_t*)(p.ws + WS_RH);
  float* ew = (float*)(p.ws + WS_ROUTE + RT_EW); int* lists = (int*)(p.ws + WS_ROUTE + RT_LIST);
  unsigned* cnt = (unsigned*)(p.ws + WS_CTL) + CTL_CNT;
  const int tid_ = opaque_tid(); const int lane0 = tid_ & 63, wave = tid_ >> 6;
  const int gw = blockIdx.x * NWAVES + wave, NGW = gridDim.x * NWAVES;
  for (int row = gw; row < NLAT; row += NGW) {
    const float* mrow = mod + (row / SEQ) * NMOD;
    const int pr = lat2pad(row);
    int lane = lane0; asm volatile("" : "+v"(lane));
    f32x4 v[4]; float s = 0;
#pragma unroll
    for (int j = 0; j < 4; ++j) { v[j] = ((const f32x4*)(R1 + (size_t)row * DM))[lane + 64 * j]; s += (v[j].x + v[j].y) + (v[j].z + v[j].w); }
    float mean = wave_sum(s) * (1.f / DM); float s2 = 0;
#pragma unroll
    for (int j = 0; j < 4; ++j) { v[j] = v[j] - mean; s2 += (v[j].x * v[j].x + v[j].y * v[j].y) + (v[j].z * v[j].z + v[j].w * v[j].w); }
    float rstd = rsqrtf(wave_sum(s2) * (1.f / DM) + LN_EPS);
    s = 0;
#pragma unroll
    for (int j = 0; j < 4; ++j) {
      const int col = (lane + 64 * j) * 4;
      const f32x4 g = *(const f32x4*)(p.in[I_LN1G] + col), bb = *(const f32x4*)(p.in[I_LN1B] + col);
      v[j] = v[j] * rstd * g + bb;
      ((f32x4*)(R1 + (size_t)row * DM))[lane + 64 * j] = v[j];
      s += (v[j].x + v[j].y) + (v[j].z + v[j].w);
    }
    mean = wave_sum(s) * (1.f / DM); s2 = 0;
#pragma unroll
    for (int j = 0; j < 4; ++j) { v[j] = v[j] - mean; s2 += (v[j].x * v[j].x + v[j].y * v[j].y) + (v[j].z * v[j].z + v[j].w * v[j].w); }
    rstd = rsqrtf(wave_sum(s2) * (1.f / DM) + LN_EPS);
    float lg[36];
#pragma unroll
    for (int i = 0; i < 36; ++i) lg[i] = 0.f;
#pragma unroll
    for (int j = 0; j < 4; ++j) {
      const int col = (lane + 64 * j) * 4;
      const f32x4 sh = *(const f32x4*)(mrow + 3 * DM + col), sc = *(const f32x4*)(mrow + 4 * DM + col);
      const f32x4 hv = v[j] * rstd * (sc + 1.f) + sh;
      u32x2 w; w.x = cvt_pk_bf16(hv.x, hv.y); w.y = cvt_pk_bf16(hv.z, hv.w);
      *(u32x2*)(H2 + (size_t)pr * DM + col) = w;
#pragma unroll
      for (int e = 0; e < 4; ++e) {
        const f32x4 wg = *(const f32x4*)(p.in[I_WRG] + (size_t)(col + e) * 4);
        lg[0] += hv[e] * wg.x; lg[1] += hv[e] * wg.y; lg[2] += hv[e] * wg.z; lg[3] += hv[e] * wg.w;
        const f32x4* we = (const f32x4*)(p.in[I_WRE] + (size_t)(col + e) * 32);
#pragma unroll
        for (int q = 0; q < 8; ++q) { const f32x4 w4 = we[q]; lg[4 + 4 * q] += hv[e] * w4.x; lg[5 + 4 * q] += hv[e] * w4.y; lg[6 + 4 * q] += hv[e] * w4.z; lg[7 + 4 * q] += hv[e] * w4.w; }
      }
    }
#pragma unroll
    for (int i = 0; i < 36; ++i) lg[i] = wave_sum(lg[i]);
    if (lane == 0) {
      float gl[4]; int gi = 0;
#pragma unroll
      for (int i = 0; i < 4; ++i) gl[i] = lg[i] + p.in[I_BRG][i];
      float gm = gl[0];
#pragma unroll
      for (int i = 1; i < 4; ++i) if (gl[i] > gm) { gm = gl[i]; gi = i; }
      float den = 0.f;
#pragma unroll
      for (int i = 0; i < 4; ++i) den += expf(gl[i] - gm);
      const float gw_ = 1.f / den;
      float el[8];
#pragma unroll
      for (int i = 0; i < 8; ++i) {
        float t = 0.f;
#pragma unroll
        for (int gq = 0; gq < 4; ++gq) if (gq == gi) t = lg[4 + gq * 8 + i] + p.in[I_BRE][gq * 8 + i];
        el[i] = t;
      }
      int i1 = 0; float v1 = el[0];
#pragma unroll
      for (int i = 1; i < 8; ++i) if (el[i] > v1) { v1 = el[i]; i1 = i; }
      int i2 = -1; float v2 = -3.0e38f;
#pragma unroll
      for (int i = 0; i < 8; ++i) if (i != i1 && el[i] > v2) { v2 = el[i]; i2 = i; }
      const float e2 = expf(v2 - v1); const float w1 = 1.f / (1.f + e2), w2 = e2 / (1.f + e2);
      const int ea = gi * 8 + i1, eb = gi * 8 + i2;
      const unsigned pa = atomicAdd(cnt + ea, 1u), pb = atomicAdd(cnt + eb, 1u);
      lists[ea * NLAT + pa] = row * 2; lists[eb * NLAT + pb] = row * 2 + 1;
      ew[row * 2] = w1 * gw_; ew[row * 2 + 1] = w2 * gw_;
    }
  }
}

enum { PH_PRO = 0, PH_LN, PH_GIN, PH_QK, PH_ATT, PH_G1, PH_G2, PH_G3, PH_RT, PH_UP, PH_DOWN, PH_FIN, PH_S5S, PH_SCAN, PH_S5Y, PH_COUNT };
template <int PH> __device__ __forceinline__ void run_phase(const Params& p, unsigned char* lds_raw) {
  LAS unsigned char* lds = (LAS unsigned char*)lds_raw;
  if constexpr (PH == PH_PRO) phase0(p, lds);
  if constexpr (PH == PH_LN) phase1(p);
  if constexpr (PH == PH_GIN) phase2(p, lds);
  if constexpr (PH == PH_QK) phase_qknorm(p);
  if constexpr (PH == PH_ATT) phase_attn(p, (char*)lds_raw);
  if constexpr (PH == PH_G1) phase_g1(p, lds);
  if constexpr (PH == PH_G2) phase_g2(p, lds);
  if constexpr (PH == PH_G3) phase_g3(p, lds);
  if constexpr (PH == PH_RT) phase_ln1_router(p);
  if constexpr (PH == PH_UP) phase_moe_up(p, lds);
  if constexpr (PH == PH_DOWN) phase_moe_down(p, lds);
  if constexpr (PH == PH_FIN) phase_final(p);
  if constexpr (PH == PH_S5S) phase_s5s(p, lds);
  if constexpr (PH == PH_SCAN) phase_s5scan(p);
  if constexpr (PH == PH_S5Y) phase_s5y(p, lds);
}
#ifndef MK_FUSED
#define MK_FUSED 1
#endif
#if !MK_FUSED
template <int PH> __global__ __launch_bounds__(512, 2) void k_phase(Params p) {
  extern __shared__ __attribute__((aligned(16))) unsigned char lds_raw[];
  run_phase<PH>(p, lds_raw);
}
template <int PH> static bool set_lds() { return hipFuncSetAttribute((const void*)k_phase<PH>, hipFuncAttributeMaxDynamicSharedMemorySize, LDS_BYTES) == hipSuccess; }
template <int PH> static void launch_ph(int grid, hipStream_t stream, const Params& p) { hipLaunchKernelGGL(k_phase<PH>, dim3(grid), dim3(512), LDS_BYTES, stream, p); }
#else
constexpr int CTL_SCAN = 2048;
#define GRID_BAR() cooperative_groups::this_grid().sync()
typedef const __attribute__((address_space(4))) Params* KParamsPtr;
__device__ __forceinline__ KParamsPtr kparams() { KParamsPtr k = (KParamsPtr)__builtin_amdgcn_kernarg_segment_ptr(); asm volatile("" : "+s"(k)); return k; }
#define KP (*(const Params*)kparams())
#ifndef MK_MASK
#define MK_MASK 0xFFFF
#endif
__global__ __launch_bounds__(512, 2) void k_mega(Params p_unused) {
  extern __shared__ __attribute__((aligned(16))) unsigned char lds_raw[];
  if constexpr ((MK_MASK >> PH_PRO) & 1) run_phase<PH_PRO>(KP, lds_raw);  GRID_BAR();
  if constexpr ((MK_MASK >> PH_LN) & 1) run_phase<PH_LN>(KP, lds_raw);   GRID_BAR();
  if constexpr ((MK_MASK >> PH_GIN) & 1) run_phase<PH_GIN>(KP, lds_raw);  GRID_BAR();
  if constexpr ((MK_MASK >> PH_S5S) & 1) run_phase<PH_S5S>(KP, lds_raw);  if constexpr ((MK_MASK >> PH_QK) & 1) run_phase<PH_QK>(KP, lds_raw);  GRID_BAR();
  {
    unsigned* ctr = (unsigned*)(KP.ws + WS_CTL) + CTL_SCAN;
    if (blockIdx.x * NWAVES < 128) {
      if constexpr ((MK_MASK >> PH_SCAN) & 1) run_phase<PH_SCAN>(KP, lds_raw);
      __threadfence();
      if ((threadIdx.x & 63) == 0 && blockIdx.x * NWAVES + (threadIdx.x >> 6) < 128) __hip_atomic_fetch_add(ctr, 1u, __ATOMIC_RELEASE, __HIP_MEMORY_SCOPE_AGENT);
    }
    if constexpr ((MK_MASK >> PH_ATT) & 1) run_phase<PH_ATT>(KP, lds_raw);
    if (threadIdx.x == 0) { unsigned spins = 0; while (__hip_atomic_load(ctr, __ATOMIC_ACQUIRE, __HIP_MEMORY_SCOPE_AGENT) < 128u && ++spins < (1u << 24)) __builtin_amdgcn_s_sleep(8); }
    __syncthreads();
    __threadfence();
    if constexpr ((MK_MASK >> PH_S5Y) & 1) run_phase<PH_S5Y>(KP, lds_raw);
  }
  GRID_BAR();
  if constexpr ((MK_MASK >> PH_G1) & 1) run_phase<PH_G1>(KP, lds_raw);   GRID_BAR();
  if constexpr ((MK_MASK >> PH_G2) & 1) run_phase<PH_G2>(KP, lds_raw);   GRID_BAR();
  if constexpr ((MK_MASK >> PH_G3) & 1) run_phase<PH_G3>(KP, lds_raw);   GRID_BAR();
  if constexpr ((MK_MASK >> PH_RT) & 1) run_phase<PH_RT>(KP, lds_raw);   GRID_BAR();
  if constexpr ((MK_MASK >> PH_UP) & 1) run_phase<PH_UP>(KP, lds_raw);   GRID_BAR();
  if constexpr ((MK_MASK >> PH_DOWN) & 1) run_phase<PH_DOWN>(KP, lds_raw); GRID_BAR();
  if constexpr ((MK_MASK >> PH_FIN) & 1) run_phase<PH_FIN>(KP, lds_raw);
}
#endif

extern "C" void kernel_launch(void* const* d_in, const int* in_sizes, int n_in, void* d_out, int out_size, void* d_ws, size_t ws_size, hipStream_t stream) {
  static int grid = 0;
  if (grid == 0) {
    if (n_in != 32 || out_size != NLAT * DM || ws_size < WS_END) { fprintf(stderr, "kernel_launch: unexpected shapes n_in %d out %d ws %zu\n", n_in, out_size, ws_size); grid = -1; return; }
    int dev = 0, cus = 0;
    hipGetDevice(&dev); hipDeviceGetAttribute(&cus, hipDeviceAttributeMultiprocessorCount, dev);
#if !MK_FUSED
    bool ok = set_lds<0>() && set_lds<1>() && set_lds<2>() && set_lds<3>() && set_lds<4>() && set_lds<5>() && set_lds<6>() && set_lds<7>() && set_lds<8>() && set_lds<9>() && set_lds<10>() && set_lds<11>() && set_lds<12>() && set_lds<13>() && set_lds<14>();
    if (!ok) { fprintf(stderr, "kernel_launch: hipFuncSetAttribute failed\n"); grid = -1; return; }
    grid = cus > 0 ? cus : 256;
#else
    if (hipFuncSetAttribute((const void*)k_mega, hipFuncAttributeMaxDynamicSharedMemorySize, LDS_BYTES) != hipSuccess) { fprintf(stderr, "kernel_launch: hipFuncSetAttribute failed\n"); grid = -1; return; }
    int per_cu = 0;
    if (hipOccupancyMaxActiveBlocksPerMultiprocessor(&per_cu, (const void*)k_mega, 512, LDS_BYTES) != hipSuccess || per_cu < 1) { fprintf(stderr, "kernel_launch: occupancy query says %d blocks per CU\n", per_cu); grid = -1; return; }
    grid = (cus > 0 ? cus : 256) * 1;
#endif
  }
  if (grid < 0) return;
  Params p{};
  for (int i = 0; i < 32; ++i) p.in[i] = (const float*)d_in[i];
  p.out = (float*)d_out; p.ws = (unsigned char*)d_ws;
  hipMemsetAsync((char*)d_ws + WS_CTL, 0, 64 * 1024, stream);
#if !MK_FUSED
  launch_ph<PH_PRO>(grid, stream, p);
  launch_ph<PH_LN>(grid, stream, p);
  launch_ph<PH_GIN>(grid, stream, p);
  launch_ph<PH_QK>(grid, stream, p);
  launch_ph<PH_S5S>(grid, stream, p);
  launch_ph<PH_SCAN>(grid, stream, p);
  launch_ph<PH_ATT>(grid, stream, p);
  launch_ph<PH_S5Y>(grid, stream, p);
  launch_ph<PH_G1>(grid, stream, p);
  launch_ph<PH_G2>(grid, stream, p);
  launch_ph<PH_G3>(grid, stream, p);
  launch_ph<PH_RT>(grid, stream, p);
  launch_ph<PH_UP>(grid, stream, p);
  launch_ph<PH_DOWN>(grid, stream, p);
  launch_ph<PH_FIN>(grid, stream, p);
#else
  void* args[] = {&p};
  hipError_t e = hipLaunchCooperativeKernel((const void*)k_mega, dim3(grid), dim3(512), args, LDS_BYTES, stream);
  if (e != hipSuccess) fprintf(stderr, "kernel_launch: cooperative launch failed: %s (grid %d)\n", hipGetErrorString(e), grid);
#endif
}
```

```cpp
#include <hip/hip_runtime.h>
#include <hip/hip_bf16.h>
#include <hip/hip_cooperative_groups.h>
#include <cstdint>
#include <cstdio>

typedef unsigned short bf16_t;
#define LAS __attribute__((address_space(3)))
typedef short bf16x8 __attribute__((ext_vector_type(8)));
typedef float f32x4 __attribute__((ext_vector_type(4)));
typedef float f32x2 __attribute__((ext_vector_type(2)));
typedef unsigned u32x4 __attribute__((ext_vector_type(4)));
typedef unsigned u32x2 __attribute__((ext_vector_type(2)));

__device__ __forceinline__ float bf2f(bf16_t v) { return __uint_as_float(((unsigned)v) << 16); }
__device__ __forceinline__ bf16_t f2bf(float f) { unsigned u = __float_as_uint(f); return (bf16_t)((u + 0x7fffu + ((u >> 16) & 1u)) >> 16); }
__device__ __forceinline__ unsigned cvt_pk_bf16(float lo, float hi) { unsigned r; asm volatile("v_cvt_pk_bf16_f32 %0, %1, %2" : "=v"(r) : "v"(lo), "v"(hi)); return r; }

constexpr int DM = 1024, NB = 2, SEQ = 8192, NCTX = 256;
constexpr int NLAT = NB * SEQ;
constexpr int SKV = SEQ + NCTX;
constexpr int NROW = NB * SKV;
constexpr int INW = 4096;
constexpr int NMOD = 6 * DM;
constexpr int PLD = 3584;
constexpr int PC_Q = 0, PC_K = 1024, PC_V = 1280, PC_G = 1536;
constexpr int NCHUNK = NROW / 16;
constexpr float LN_EPS = 1e-6f;
constexpr float ALPHA = 1.189207115002721f;

constexpr size_t MiB = 1u << 20;
constexpr size_t WS_CTL = 0;
constexpr size_t WS_MOD = 1 * MiB;
constexpr size_t WS_ROUTE = 2 * MiB;
constexpr size_t WS_S5AB = 5 * MiB;
constexpr size_t WS_S5T = 6 * MiB;
constexpr size_t WS_S5E = 14 * MiB;
constexpr size_t WS_WIN = 18 * MiB;
constexpr size_t WS_WGLU = 26 * MiB;
constexpr size_t WS_WAO = 28 * MiB;
constexpr size_t WS_WOUT = 30 * MiB;
constexpr size_t WS_WGU = 32 * MiB;
constexpr size_t WS_WD = 96 * MiB;
constexpr size_t WS_RH = 128 * MiB;
constexpr size_t WS_P = 162 * MiB;
constexpr size_t WS_END = 280 * MiB;
constexpr size_t DO_YA = 0, DO_GY = 34 * MiB;

struct Params {
  const float* in[32];
  float* out;
  unsigned char* ws;
};
enum { I_X = 0, I_C, I_CTX, I_CCTX, I_WMOD, I_BMOD, I_WIN, I_SARE, I_SAIM, I_SLDT, I_SBRE, I_SBIM, I_SCRE, I_SCIM, I_SD,
       I_WGA, I_WGB, I_QG, I_KG, I_WAO, I_WOUT, I_LN1G, I_LN1B, I_WRG, I_BRG, I_WRE, I_BRE, I_WEG, I_WEU, I_WED, I_LN2G, I_LN2B };

__device__ __forceinline__ float wave_sum(float v) {
#pragma unroll
  for (int o = 1; o < 64; o <<= 1) v += __shfl_xor(v, o);
  return v;
}
__device__ __forceinline__ float sigmoidf_(float x) { return 1.f / (1.f + __expf(-x)); }
__device__ __forceinline__ float siluf_(float x) { return x / (1.f + __expf(-x)); }
__device__ __forceinline__ float gelu_tanh(float x) {
  const float k0 = 0.7978845608028654f, k1 = 0.044715f;
  const float z = k0 * (x + k1 * x * x * x);
  return x / (1.f + __expf(-2.f * z));
}
__device__ __forceinline__ int lat2pad(int lr) { return lr + (lr / SEQ) * NCTX; }

constexpr int NWAVES = 8;
constexpr int LDS_STAGE = 131072;
constexpr int LDS_BYTES = 147456;


__device__ __forceinline__ int opaque_tid() { int t = threadIdx.x; asm volatile("" : "+v"(t)); return t; }
namespace pg {
constexpr int BM = 256, BK = 64, HALF = 128, HTB = HALF * BK * 2, STAGE_BYTES = 8 * HTB;
__host__ __device__ __forceinline__ int lds_byte(int r, int c) { const int st = (r >> 4) * 2 + (c >> 5), rr = r & 15, cc = c & 31, ob = rr * 64 + cc * 2; return st * 1024 + (ob ^ (((ob >> 9) & 1) << 5)); }
__host__ __device__ __forceinline__ void stage_rc(int b, int& R, int& C) { const int st = b / 1024, sb = b % 1024, swz = sb ^ (((sb >> 9) & 1) << 5); R = (st >> 1) * 16 + swz / 64; C = (st & 1) * 32 + (swz % 64) / 2; }
__host__ __device__ __forceinline__ int perm32(int rho) { const int n = rho >> 4, i = rho & 15; return 8 * (i >> 2) + 4 * n + (i & 3); }

struct Unit { int pm, pn, aux, arow; };
struct Addr {
  const bf16_t* A; int lda; size_t a_gs; const bf16_t* Bt; int K; size_t b_gs;
  bool gather;
  __device__ __forceinline__ const char* a_base(const Unit& u) const { return gather ? (const char*)A : (const char*)(A + (size_t)u.aux * a_gs + (size_t)u.arow * lda); }
  __device__ __forceinline__ const char* b_base(const Unit& u) const { return (const char*)(Bt + (size_t)u.aux * b_gs + (size_t)u.pn * BM * K); }
};
typedef f32x4 Acc[2][2][4][2];

template <class Epi, class Sched>
__device__ __forceinline__ void gemm_phase(LAS unsigned char* lds, const Addr AD, const Sched& S, const Epi& E) {
  const int tid = opaque_tid(), wid = __builtin_amdgcn_readfirstlane(tid >> 6), lane = tid & 63, wr = wid >> 2, wc = wid & 3, fr = lane & 15, fq = lane >> 4;
  int K_ = AD.K; asm volatile("" : "+s"(K_));
  const int K = K_, nt = K / BK, lda = AD.lda;
  int R0, C0; stage_rc(tid * 16, R0, C0);
  const unsigned voffB0 = (unsigned)(((Epi::PERM ? ((R0 & ~31) + perm32(R0 & 31)) : R0)) * K + C0) * 2u;
  const size_t pstepB = (size_t)64 * K * 2, pstepA = (size_t)64 * lda * 2, hstepA = (size_t)HALF * lda * 2;
  unsigned vA[2][2], vAn[2][2];
  const unsigned voffA0 = (unsigned)(R0 * lda + C0) * 2u;
#define PG_SETV(v, u) do { if constexpr (Sched::GATHER) { _Pragma("unroll") for (int _h = 0; _h < 2; ++_h) _Pragma("unroll") for (int _i = 0; _i < 2; ++_i) \
    v[_h][_i] = (unsigned)(S.arow(u, _h * HALF + _i * 64 + R0) * lda + C0) * 2u; } } while (0)
  const size_t kstep = (size_t)(BK * 2);
  const size_t hstepB = (size_t)HALF * K * 2;
  const unsigned ldsw = (unsigned)wid * 1024u;
  const int aoff = lds_byte(wr * 64 + fr, fq * 8), boff = lds_byte(wc * 32 + fr, fq * 8);
#define PG_SA(b, h) (((b) * 2 + (h)) * HTB)
#define PG_SB(b, h) ((4 + (b) * 2 + (h)) * HTB)
#define PG_STAGE_B(bufoff, gbase) do { _Pragma("unroll") for (int _i = 0; _i < 2; ++_i) \
    __builtin_amdgcn_global_load_lds((const unsigned*)((const char*)(gbase) + _i * pstepB + voffB0), (LAS unsigned*)(lds + (bufoff) + ldsw + _i * 8192), 16, 0, 0); } while (0)
#define PG_STAGE_A(b, h, gbase, V) do { _Pragma("unroll") for (int _i = 0; _i < 2; ++_i) { \
    if constexpr (Sched::GATHER) __builtin_amdgcn_global_load_lds((const unsigned*)((const char*)(gbase) + V[h][_i]), (LAS unsigned*)(lds + PG_SA(b, h) + ldsw + _i * 8192), 16, 0, 0); \
    else __builtin_amdgcn_global_load_lds((const unsigned*)((const char*)(gbase) + (h) * hstepA + _i * pstepA + voffA0), (LAS unsigned*)(lds + PG_SA(b, h) + ldsw + _i * 8192), 16, 0, 0); } } while (0)
#define PG_LDA(dst, b, h) do { _Pragma("unroll") for (int m = 0; m < 4; ++m) _Pragma("unroll") for (int k = 0; k < 2; ++k) dst[m][k] = *(const LAS bf16x8*)(lds + PG_SA(b, h) + aoff + m * 2048 + k * 1024); } while (0)
#define PG_LDB(dst, b, h) do { _Pragma("unroll") for (int n = 0; n < 2; ++n) _Pragma("unroll") for (int k = 0; k < 2; ++k) dst[n][k] = *(const LAS bf16x8*)(lds + PG_SB(b, h) + boff + n * 2048 + k * 1024); } while (0)
#define PG_MMA(ai, bj, At, Bt) do { __builtin_amdgcn_s_setprio(1); _Pragma("unroll") for (int m = 0; m < 4; ++m) _Pragma("unroll") for (int n = 0; n < 2; ++n) _Pragma("unroll") for (int k = 0; k < 2; ++k) \
    acc[ai][bj][m][n] = __builtin_amdgcn_mfma_f32_16x16x32_bf16(Bt[n][k], At[m][k], acc[ai][bj][m][n], 0, 0, 0); __builtin_amdgcn_s_setprio(0); } while (0)
#define PG_WAIT_V(n) asm volatile("s_waitcnt vmcnt(" #n ")" ::: "memory")
#define PG_WAIT_L(n) asm volatile("s_waitcnt lgkmcnt(" #n ")" ::: "memory")
#define PG_BAR __builtin_amdgcn_s_barrier()
#define PG_SCHED __builtin_amdgcn_sched_barrier(0)
  Unit cur, nxt; int ui = 0;
  if (!S.next(0, cur)) return;
  Acc acc;
#pragma unroll
  for (int a = 0; a < 2; ++a)
#pragma unroll
    for (int b = 0; b < 2; ++b)
#pragma unroll
      for (int m = 0; m < 4; ++m)
#pragma unroll
        for (int n = 0; n < 2; ++n) acc[a][b][m][n] = (f32x4){0.f, 0.f, 0.f, 0.f};
  bf16x8 At[4][2], B0[2][2], B1[2][2];
  const char* cA = AD.a_base(cur); const char* cB = AD.b_base(cur);
  PG_SETV(vA, cur);
  PG_STAGE_B(PG_SB(0, 0), cB); PG_STAGE_B(PG_SB(0, 1), cB + hstepB); PG_STAGE_A(0, 0, cA, vA); PG_STAGE_A(0, 1, cA, vA);
  if (wr == 1) PG_BAR;
  PG_WAIT_V(2); PG_BAR;
  PG_STAGE_B(PG_SB(1, 0), cB + kstep); PG_STAGE_A(1, 0, cA + kstep, vA); PG_STAGE_B(PG_SB(1, 1), cB + hstepB + kstep);
  PG_WAIT_V(6); PG_BAR;
#define PG_KPAIR(a1, a2, b2, a3, b3, VN) do { \
      PG_LDB(B0, 0, 0); PG_LDB(B1, 0, 1); PG_SCHED; PG_LDA(At, 0, 0); PG_STAGE_A(1, 1, a1, vA); \
      PG_WAIT_V(8); PG_WAIT_L(0); PG_BAR; PG_MMA(0, 0, At, B0); PG_MMA(0, 1, At, B1); PG_BAR; PG_SCHED; \
      PG_LDA(At, 0, 1); PG_STAGE_B(PG_SB(0, 0), b2); PG_STAGE_B(PG_SB(0, 1), (b2) + hstepB); PG_STAGE_A(0, 0, a2, VN); \
      PG_WAIT_V(8); PG_WAIT_L(0); PG_BAR; PG_MMA(1, 0, At, B0); PG_MMA(1, 1, At, B1); PG_BAR; PG_SCHED; \
      PG_LDB(B0, 1, 0); PG_LDB(B1, 1, 1); PG_SCHED; PG_LDA(At, 1, 0); PG_STAGE_A(0, 1, a2, VN); \
      PG_WAIT_V(8); PG_WAIT_L(0); PG_BAR; PG_MMA(0, 0, At, B0); PG_MMA(0, 1, At, B1); PG_BAR; PG_SCHED; \
      PG_LDA(At, 1, 1); PG_STAGE_B(PG_SB(1, 0), b3); PG_STAGE_B(PG_SB(1, 1), (b3) + hstepB); PG_STAGE_A(1, 0, a3, VN); \
      PG_WAIT_V(8); PG_WAIT_L(0); PG_BAR; PG_MMA(1, 0, At, B0); PG_MMA(1, 1, At, B1); PG_BAR; PG_SCHED; } while (0)
  for (;;) {
    const bool has_next = S.next(ui + 1, nxt);
    const char* nA = has_next ? AD.a_base(nxt) : cA; const char* nB = has_next ? AD.b_base(nxt) : cB;
    if constexpr (Sched::GATHER) { if (has_next) PG_SETV(vAn, nxt); else {
#pragma unroll
      for (int _h = 0; _h < 2; ++_h)
#pragma unroll
        for (int _i = 0; _i < 2; ++_i) vAn[_h][_i] = vA[_h][_i]; } }
    if constexpr (Sched::GATHER) {
      for (int t = 0; t < nt - 2; t += 2) {
        const char* a1 = cA + (size_t)(t + 1) * kstep; const char* a2 = cA + (size_t)(t + 2) * kstep; const char* b2 = cB + (size_t)(t + 2) * kstep;
        PG_KPAIR(a1, a2, b2, a2 + kstep, b2 + kstep, vA);
      }
      { const char* a1 = cA + (size_t)(nt - 1) * kstep;
        PG_KPAIR(a1, nA, nB, nA + kstep, nB + kstep, vAn); }
    } else {
      for (int t = 0; t < nt; t += 2) {
        const bool last = (t == nt - 2);
        const char* a1 = cA + (size_t)(t + 1) * kstep;
        const char* a2 = last ? nA : cA + (size_t)(t + 2) * kstep; const char* b2 = last ? nB : cB + (size_t)(t + 2) * kstep;
        PG_KPAIR(a1, a2, b2, a2 + kstep, b2 + kstep, vA);
      }
    }
    if (wr == 0) PG_BAR;
    E(acc, cur, wr, wc, fr, fq);
    if (!has_next) break;
#pragma unroll
    for (int a = 0; a < 2; ++a)
#pragma unroll
      for (int b = 0; b < 2; ++b)
#pragma unroll
        for (int m = 0; m < 4; ++m)
#pragma unroll
          for (int n = 0; n < 2; ++n) acc[a][b][m][n] = (f32x4){0.f, 0.f, 0.f, 0.f};
    cur = nxt; cA = nA; cB = nB; ++ui;
    if constexpr (Sched::GATHER) {
#pragma unroll
      for (int _h = 0; _h < 2; ++_h)
#pragma unroll
        for (int _i = 0; _i < 2; ++_i) vA[_h][_i] = vAn[_h][_i]; }
    if (wr == 1) PG_BAR;
  }
  PG_WAIT_V(0);
  PG_BAR;
#undef PG_SETV
#undef PG_KPAIR
#undef PG_SA
#undef PG_SB
#undef PG_STAGE_A
#undef PG_STAGE_B
#undef PG_LDA
#undef PG_LDB
#undef PG_MMA
#undef PG_WAIT_V
#undef PG_WAIT_L
#undef PG_BAR
#undef PG_SCHED
}
}
namespace att {
using bf16x8 = __attribute__((ext_vector_type(8))) short;
using s16x4 = __attribute__((ext_vector_type(4))) short;
using f32x16 = __attribute__((ext_vector_type(16))) float;
using u32x4 = __attribute__((ext_vector_type(4))) unsigned;
constexpr int D = 128, NW = 8, QBLK = 32, KVBLK = 64;
constexpr float SCALE = 0.088388347648318440f;
constexpr float THR = 8.f;
constexpr int LDQ = PLD, LDK = PLD, LDO = PLD;
constexpr size_t SHM_V = KVBLK * D * 2, SHM_K = KVBLK * D * 2, SHM_ATTN = 2 * SHM_V + 2 * SHM_K + NW * 64 * 4;
#define KSWZ(row, colB) ((row) * 256 + ((colB) ^ (((row) & 7) << 4)))
#define SBAR() __builtin_amdgcn_sched_barrier(0)
__device__ __forceinline__ int crow(int r, int hi) { return (r & 3) + 8 * (r >> 2) + 4 * hi; }
__device__ __forceinline__ unsigned cvtpk(float lo, float hi) { unsigned r; asm volatile("v_cvt_pk_bf16_f32 %0, %1, %2" : "=v"(r) : "v"(lo), "v"(hi)); return r; }
__device__ __forceinline__ void partialSM(f32x16& p0, f32x16& p1, float& m_reg, float& mn, float& alpha) {
  constexpr float C = SCALE * 1.4426950408889634f;
  float pmax = p0[0]; for (int r = 1; r < 16; ++r) pmax = fmaxf(pmax, p0[r]); for (int r = 0; r < 16; ++r) pmax = fmaxf(pmax, p1[r]);
  { auto rr = __builtin_amdgcn_permlane32_swap(__float_as_uint(pmax), __float_as_uint(pmax), false, false);
    pmax = fmaxf(__uint_as_float(rr[0]), __uint_as_float(rr[1])); }
  if (__builtin_expect(__all(pmax - m_reg <= THR / SCALE), 1)) { mn = m_reg; alpha = 1.f; }
  else { mn = fmaxf(m_reg, pmax); alpha = __builtin_amdgcn_exp2f((m_reg - mn) * C); m_reg = mn; }
  float mnC = -mn * C;
  for (int r = 0; r < 16; ++r) p0[r] = fmaf(p0[r], C, mnC); for (int r = 0; r < 16; ++r) p1[r] = fmaf(p1[r], C, mnC);
  for (int r = 0; r < 16; ++r) p0[r] = __builtin_amdgcn_exp2f(p0[r]);
}
__device__ __forceinline__ void finishSM(f32x16& p0, f32x16& p1, float alpha, float& l_reg, bf16x8& pa0, bf16x8& pa1, bf16x8& pa2, bf16x8& pa3) {
  for (int r = 0; r < 16; ++r) p1[r] = __builtin_amdgcn_exp2f(p1[r]);
  float ps = 0; for (int r = 0; r < 16; ++r) ps += p0[r]; for (int r = 0; r < 16; ++r) ps += p1[r];
  { auto rr = __builtin_amdgcn_permlane32_swap(__float_as_uint(ps), __float_as_uint(ps), false, false);
    ps = __uint_as_float(rr[0]) + __uint_as_float(rr[1]); }
  l_reg = l_reg * alpha + ps;
#define PK4(P, BASE, OUT) do { unsigned a0 = cvtpk(P[BASE + 0], P[BASE + 1]), a1 = cvtpk(P[BASE + 2], P[BASE + 3]);   \
    unsigned b0 = cvtpk(P[BASE + 4], P[BASE + 5]), b1 = cvtpk(P[BASE + 6], P[BASE + 7]);                              \
    auto r0 = __builtin_amdgcn_permlane32_swap(a0, b0, false, false); auto r1 = __builtin_amdgcn_permlane32_swap(a1, b1, false, false); \
    u32x4 w = {r0[0], r1[0], r0[1], r1[1]}; OUT = *reinterpret_cast<bf16x8*>(&w); } while (0)
  PK4(p0, 0, pa0); PK4(p0, 8, pa1); PK4(p1, 0, pa2); PK4(p1, 8, pa3);
#undef PK4
}
__device__ __forceinline__ void qkt(f32x16& p0, f32x16& p1, const bf16_t* Ks, const bf16x8* qr, int r32, int hi) {
  p0 = f32x16{}; p1 = f32x16{};
  for (int d0 = 0; d0 < 8; ++d0) { int cb = (d0 * 16 + hi * 8) * 2;
    bf16x8 b0 = *reinterpret_cast<const bf16x8*>((const char*)Ks + KSWZ(r32, cb));
    bf16x8 b1 = *reinterpret_cast<const bf16x8*>((const char*)Ks + KSWZ(32 + r32, cb));
    p0 = __builtin_amdgcn_mfma_f32_32x32x16_bf16(b0, qr[d0], p0, 0, 0, 0);
    p1 = __builtin_amdgcn_mfma_f32_32x32x16_bf16(b1, qr[d0], p1, 0, 0, 0); }
}
__device__ __forceinline__ int v_st(int k, int c) { const int kk = (k & ~0xC) | ((k & 4) << 1) | ((k & 8) >> 1); return ((kk >> 3) * 4 + (c >> 5)) * 512 + ((kk & 7) * 32 + (c & 31)) * 2; }
__device__ __forceinline__ int v_rd_base(int lane) { return ((lane & 3) << 3) | (((lane >> 2) & 3) << 6) | (((lane >> 4) & 1) << 5) | (((lane >> 5) & 1) << 8); }
constexpr int v_rd_off(int d0, int ks, int half) { return d0 * 512 + ks * 4096 + half * 2048; }
template <int OFF> __device__ __forceinline__ s16x4 tr_read(int vb) {
  s16x4 r; asm volatile("ds_read_b64_tr_b16 %0, %1 offset:%2" : "=&v"(r) : "v"(vb), "i"(OFF) : "memory"); return r;
}
template <int D0> __device__ __forceinline__ void pv_one(f32x16& od, int vb, bf16x8 pa0, bf16x8 pa1, bf16x8 pa2, bf16x8 pa3) {
  const s16x4 l0 = tr_read<v_rd_off(D0, 0, 0)>(vb), h0 = tr_read<v_rd_off(D0, 0, 1)>(vb), l1 = tr_read<v_rd_off(D0, 1, 0)>(vb), h1 = tr_read<v_rd_off(D0, 1, 1)>(vb);
  const s16x4 l2 = tr_read<v_rd_off(D0, 2, 0)>(vb), h2 = tr_read<v_rd_off(D0, 2, 1)>(vb), l3 = tr_read<v_rd_off(D0, 3, 0)>(vb), h3 = tr_read<v_rd_off(D0, 3, 1)>(vb);
  asm volatile("s_waitcnt lgkmcnt(0)" ::: "memory"); SBAR();
#define PK(L, H) (bf16x8){L[0], L[1], L[2], L[3], H[0], H[1], H[2], H[3]}
  od = __builtin_amdgcn_mfma_f32_32x32x16_bf16(pa0, PK(l0, h0), od, 0, 0, 0);
  od = __builtin_amdgcn_mfma_f32_32x32x16_bf16(pa1, PK(l1, h1), od, 0, 0, 0);
  od = __builtin_amdgcn_mfma_f32_32x32x16_bf16(pa2, PK(l2, h2), od, 0, 0, 0);
  od = __builtin_amdgcn_mfma_f32_32x32x16_bf16(pa3, PK(l3, h3), od, 0, 0, 0);
#undef PK
}
__device__ __forceinline__ void pv_d0(f32x16* o, int vb, bf16x8 pa0, bf16x8 pa1, bf16x8 pa2, bf16x8 pa3) {
  pv_one<0>(o[0], vb, pa0, pa1, pa2, pa3); pv_one<1>(o[1], vb, pa0, pa1, pa2, pa3); pv_one<2>(o[2], vb, pa0, pa1, pa2, pa3); pv_one<3>(o[3], vb, pa0, pa1, pa2, pa3);
}
__device__ __forceinline__ void attn_dense_body(const bf16_t* __restrict__ Qb, const bf16_t* __restrict__ Kh, const bf16_t* __restrict__ Vh, bf16_t* __restrict__ Ob, int seq, char* lds) {
  const int tid = threadIdx.x, wid = tid >> 6, lane = tid & 63, r32 = lane & 31, hi = lane >> 5;
  bf16_t* V_lds = (bf16_t*)lds; bf16_t* K_lds = (bf16_t*)(lds + 2 * SHM_V);
  float* ws = (float*)(lds + 2 * SHM_V + 2 * SHM_K) + wid * 64; float* li_l = ws; float* al_l = ws + 32;
  float m_reg = -1e30f, l_reg = 0; f32x16 o[4] = {}; bf16x8 qr[8];
  const bf16_t* Qw = Qb + (long)(wid * QBLK + r32) * LDQ + hi * 8;
#pragma unroll
  for (int d0 = 0; d0 < 8; ++d0) qr[d0] = *reinterpret_cast<const bf16x8*>(Qw + d0 * 16);
  const int sr = tid >> 4, sc = (tid & 15) * 8, vst0 = v_st(sr, sc), vst1 = v_st(32 + sr, sc);
  const int vb0 = (int)(uintptr_t)V_lds + v_rd_base(lane);
  struct { bf16x8 vs0, vs1, ks0, ks1; } sr_[2];
#define SLOAD(i, k0) do { sr_[i].vs0 = *(const bf16x8*)(&Vh[(long)((k0) + sr) * LDK + sc]); sr_[i].vs1 = *(const bf16x8*)(&Vh[(long)((k0) + 32 + sr) * LDK + sc]); \
    sr_[i].ks0 = *(const bf16x8*)(&Kh[(long)((k0) + sr) * LDK + sc]); sr_[i].ks1 = *(const bf16x8*)(&Kh[(long)((k0) + 32 + sr) * LDK + sc]); } while (0)
#define SWRITE(b, i) do { *(bf16x8*)((char*)V_lds + (b) * SHM_V + vst0) = sr_[i].vs0;          \
    *(bf16x8*)((char*)V_lds + (b) * SHM_V + vst1) = sr_[i].vs1; int kc = sc * 2;               \
    *(bf16x8*)((char*)K_lds + (b) * SHM_K + KSWZ(sr, kc)) = sr_[i].ks0;                       \
    *(bf16x8*)((char*)K_lds + (b) * SHM_K + KSWZ(32 + sr, kc)) = sr_[i].ks1; } while (0)
#define SWAIT() asm volatile("s_waitcnt vmcnt(4)" ::: "memory")
#define RESC(a) do { if (__any((a) < 1.f)) { if (hi == 0) al_l[r32] = (a); asm volatile("s_waitcnt lgkmcnt(0)" ::: "memory"); \
    for (int d = 0; d < 4; ++d) for (int r = 0; r < 16; ++r) o[d][r] *= al_l[crow(r, hi)]; } } while (0)
  f32x16 pA0, pA1, pB0, pB1; float mnA, mnB, alA, alB; bf16x8 pa0, pa1, pa2, pa3; const int NT = seq / KVBLK;
  constexpr int SE = 0, SO = 1;
  SLOAD(SE, 0); asm volatile("s_waitcnt vmcnt(0)" ::: "memory"); SWRITE(0, SE); __syncthreads();
  qkt(pA0, pA1, K_lds, qr, r32, hi); partialSM(pA0, pA1, m_reg, mnA, alA);
  SLOAD(SO, KVBLK); if (2 < NT) SLOAD(SE, 2 * KVBLK);
  SWAIT(); SWRITE(1, SO); __syncthreads();
  for (int j = 1; j + 1 < NT; j += 2) {
    SBAR(); qkt(pB0, pB1, (bf16_t*)((char*)K_lds + SHM_K), qr, r32, hi);
    finishSM(pA0, pA1, alA, l_reg, pa0, pa1, pa2, pa3); SBAR();
    SLOAD(SO, (j + 2) * KVBLK); SBAR();
    pv_d0(o, vb0, pa0, pa1, pa2, pa3); partialSM(pB0, pB1, m_reg, mnB, alB);
    __syncthreads(); SWAIT(); SWRITE(0, SE);
    RESC(alB); __syncthreads();
    SBAR(); qkt(pA0, pA1, K_lds, qr, r32, hi);
    finishSM(pB0, pB1, alB, l_reg, pa0, pa1, pa2, pa3); SBAR();
    if (j + 3 < NT) SLOAD(SE, (j + 3) * KVBLK); SBAR();
    pv_d0(o, vb0 + (int)SHM_V, pa0, pa1, pa2, pa3); partialSM(pA0, pA1, m_reg, mnA, alA);
    __syncthreads(); SWAIT(); SWRITE(1, SO);
    RESC(alA); __syncthreads();
  }
  SBAR(); qkt(pB0, pB1, (bf16_t*)((char*)K_lds + SHM_K), qr, r32, hi);
  finishSM(pA0, pA1, alA, l_reg, pa0, pa1, pa2, pa3); SBAR();
  pv_d0(o, vb0, pa0, pa1, pa2, pa3); partialSM(pB0, pB1, m_reg, mnB, alB);
  __syncthreads(); RESC(alB);
  finishSM(pB0, pB1, alB, l_reg, pa0, pa1, pa2, pa3); SBAR();
  pv_d0(o, vb0 + (int)SHM_V, pa0, pa1, pa2, pa3);
  if (hi == 0) li_l[r32] = l_reg; asm volatile("s_waitcnt lgkmcnt(0)" ::: "memory");
  float rli[16];
#pragma unroll
  for (int r = 0; r < 16; ++r) rli[r] = __builtin_amdgcn_rcpf(li_l[crow(r, hi)]);
  bf16_t* Ow = Ob + (long)(wid * QBLK) * LDO;
#pragma unroll
  for (int r = 0; r < 16; ++r) { int orow = crow(r, hi);
    for (int d0 = 0; d0 < 4; ++d0) Ow[(long)orow * LDO + d0 * 32 + r32] = f2bf(o[d0][r] * rli[r]); }
  __syncthreads();
#undef SLOAD
#undef SWRITE
#undef SWAIT
#undef RESC
}
}

#define XB_TMO      128
#define XB_XCNT(j)  (256  + 64 * (j))
#define XB_XSUB(j)  (1280 + 64 * (j))
#define XB_XGEN(j)  (2304 + 64 * (j))
#define XB_TOP      3328
#define XB_TOPGEN   3392
#define XCD_BAR_WORDS 3456
#define XB_SPIN_CAP (1u << 18)

__device__ __forceinline__ unsigned xb_ld(unsigned* p)              { return __hip_atomic_load(p, __ATOMIC_RELAXED, __HIP_MEMORY_SCOPE_AGENT); }
__device__ __forceinline__ unsigned xb_add(unsigned* p, unsigned v) { return __hip_atomic_fetch_add(p, v, __ATOMIC_RELAXED, __HIP_MEMORY_SCOPE_AGENT); }
__device__ __forceinline__ unsigned xb_xcc_id() { return (unsigned)__builtin_amdgcn_s_getreg((3 << 11) | 20) & 0xFu; }
#define XB_SPIN(cond, bar) do { unsigned _sp = 0; while (cond) { __builtin_amdgcn_s_sleep(1); \
    if ((++_sp & 255u) == 0u) { if (xb_ld(&(bar)[XB_TMO])) break; if (_sp > XB_SPIN_CAP) { atomicAdd(&(bar)[XB_TMO], 1u); break; } } } } while (0)

struct XcdBarrier {
    unsigned* bar; unsigned x;
    volatile LAS unsigned* st;
};

__device__ __forceinline__ XcdBarrier xcd_barrier_post(unsigned* bar, volatile LAS unsigned* st) {
    XcdBarrier b; b.bar = bar; b.x = xb_xcc_id(); b.st = st;
    if (threadIdx.x == 0) (void)xb_add(&bar[XB_XCNT(b.x)], 1u);
    return b;
}
__device__ __forceinline__ void xcd_barrier_complete(unsigned* bar, unsigned x, unsigned& nloc, unsigned& nx) {
    const unsigned G = gridDim.x * gridDim.y * gridDim.z;
    unsigned sum, cnt, mine, sp = 0u;
    for (;;) {
        sum = 0u; cnt = 0u; mine = 0u;
#pragma unroll
        for (unsigned j = 0; j < 16; ++j) { const unsigned c = xb_ld(&bar[XB_XCNT(j)]); sum += c; cnt += (c > 0u) ? 1u : 0u; mine = (j == x) ? c : mine; }
        if (sum == G) break;
        __builtin_amdgcn_s_sleep(1);
        if ((++sp & 255u) == 0u) { if (xb_ld(&bar[XB_TMO])) break; if (sp > XB_SPIN_CAP) { atomicAdd(&bar[XB_TMO], 1u); break; } }
    }
    nloc = mine > 0u ? mine : 1u; nx = cnt > 0u ? cnt : 1u;
}

__device__ __forceinline__ void xcd_barrier(const XcdBarrier& b) {
    asm volatile("s_waitcnt vmcnt(0)" ::: "memory");
    __syncthreads();
    if (threadIdx.x == 0) {
        unsigned* bar = b.bar;
        __builtin_amdgcn_s_waitcnt(0);
        unsigned nloc = b.st[0], nx = b.st[1];
        if (nloc == 0u) { xcd_barrier_complete(bar, b.x, nloc, nx); b.st[0] = nloc; b.st[1] = nx; }
        const unsigned old = xb_add(&bar[XB_XSUB(b.x)], 1u);
        const unsigned gen = old / nloc;
        if (old + 1u == (gen + 1u) * nloc) {
            __builtin_amdgcn_fence(__ATOMIC_RELEASE, "agent");
            asm volatile("s_waitcnt vmcnt(0)" ::: "memory");
            const unsigned og = xb_add(&bar[XB_TOP], 1u);
            const unsigned tg = og / nx;
            if (og + 1u == (tg + 1u) * nx) xb_add(&bar[XB_TOPGEN], 1u);
            else XB_SPIN(xb_ld(&bar[XB_TOPGEN]) == tg, bar);
            __builtin_amdgcn_fence(__ATOMIC_ACQUIRE, "agent");
            xb_add(&bar[XB_XGEN(b.x)], 1u);
            asm volatile("s_waitcnt vmcnt(0)" ::: "memory");
        } else {
            XB_SPIN(xb_ld(&bar[XB_XGEN(b.x)]) == gen, bar);
            __builtin_amdgcn_fence(__ATOMIC_ACQUIRE, "agent");
            asm volatile("s_waitcnt vmcnt(0)" ::: "memory");
        }
    }
    __syncthreads();
}


__device__ __forceinline__ void s5_build_tables(const Params& p, LAS unsigned char* lds, int g) {
  const int tid = opaque_tid();
  LAS float* Bb = (LAS float*)lds;
  LAS float* Cc = Bb + 4096;
  LAS float* PW = Cc + 4096;
  LAS float* KK = PW + 4352;
  if (tid < 128) {
    const int d = tid >> 6, pi = tid & 63, dg = d * 32 + g, idx = dg * 64 + pi;
    const float are = p.in[I_SARE][idx], aim = p.in[I_SAIM][idx];
    const float dt = expf(p.in[I_SLDT][dg]);
    const float lam = are * dt, om = aim * dt;
    for (int n = 0; n <= 16; ++n) { const float ea = expf(lam * (float)n); float sn, cs; sincosf(om * (float)n, &sn, &cs);
      PW[((d * 17 + n) * 64 + pi) * 2] = ea * cs; PW[((d * 17 + n) * 64 + pi) * 2 + 1] = ea * sn; }
    const float abr = PW[((d * 17 + 1) * 64 + pi) * 2], abi = PW[((d * 17 + 1) * 64 + pi) * 2 + 1];
    const float den = are * are + aim * aim;
    const float nr = abr - 1.f, ni = abi;
    const float rr = (nr * are + ni * aim) / den, ri = (ni * are - nr * aim) / den;
    for (int c = 0; c < 16; ++c) {
      const float bre = p.in[I_SBRE][idx * 16 + c], bim = p.in[I_SBIM][idx * 16 + c];
      Bb[((d * 64 + pi) * 16 + c) * 2] = rr * bre - ri * bim; Bb[((d * 64 + pi) * 16 + c) * 2 + 1] = rr * bim + ri * bre;
      Cc[((d * 16 + c) * 64 + pi) * 2] = p.in[I_SCRE][(dg * 16 + c) * 64 + pi]; Cc[((d * 16 + c) * 64 + pi) * 2 + 1] = p.in[I_SCIM][(dg * 16 + c) * 64 + pi];
    }
  }
  __syncthreads();
  for (int o = tid; o < 8192; o += 512) {
    const int d = o >> 12, tau = (o >> 8) & 15, c = (o >> 4) & 15, c2 = o & 15;
    float s = 0.f;
    for (int pi = 0; pi < 64; ++pi) {
      const float cr = Cc[((d * 16 + c) * 64 + pi) * 2], ci = Cc[((d * 16 + c) * 64 + pi) * 2 + 1];
      const float ar = PW[((d * 17 + tau) * 64 + pi) * 2], ai = PW[((d * 17 + tau) * 64 + pi) * 2 + 1];
      const float br = Bb[((d * 64 + pi) * 16 + c2) * 2], bi = Bb[((d * 64 + pi) * 16 + c2) * 2 + 1];
      const float mr = ar * br - ai * bi, mi = ar * bi + ai * br;
      s += cr * mr - ci * mi;
    }
    KK[o] = s;
  }
  __syncthreads();
  bf16_t* T = (bf16_t*)(p.ws + WS_S5T) + (size_t)g * 256 * 512;
  for (int o = tid; o < 256 * 256; o += 512) {
    const int n = o >> 8, k = (o & 255) * 2, i = n >> 4, c = n & 15;
    float v[2];
#pragma unroll
    for (int q = 0; q < 2; ++q) { const int kk = k + q; float x;
      if (kk < 256) { const int j = kk >> 4, c2 = kk & 15; x = 0.f;
        if (i >= j) x += KK[((0 * 16 + (i - j)) * 16 + c) * 16 + c2];
        if (j >= i) x += KK[((1 * 16 + (j - i)) * 16 + c) * 16 + c2];
        if (i == j && c == c2) x += p.in[I_SD][g * 16 + c];
      } else { const int d = (kk - 256) >> 7, qq = (kk - 256) & 127, part = qq >> 6, pi = qq & 63, n_pw = d ? (16 - i) : (i + 1);
        const float cr = Cc[((d * 16 + c) * 64 + pi) * 2], ci = Cc[((d * 16 + c) * 64 + pi) * 2 + 1];
        const float ar = PW[((d * 17 + n_pw) * 64 + pi) * 2], ai = PW[((d * 17 + n_pw) * 64 + pi) * 2 + 1];
        x = part ? -(cr * ai + ci * ar) : (cr * ar - ci * ai); }
      v[q] = x; }
    *(unsigned*)(T + (size_t)n * 512 + k) = cvt_pk_bf16(v[0], v[1]);
  }
  bf16_t* E = (bf16_t*)(p.ws + WS_S5E) + (size_t)g * 256 * 256;
  for (int o = tid; o < 256 * 128; o += 512) {
    const int n = o >> 7, k = (o & 127) * 2, d = n >> 7, part = (n >> 6) & 1, pi = n & 63;
    float v[2];
#pragma unroll
    for (int q = 0; q < 2; ++q) { const int kk = k + q, j = kk >> 4, c2 = kk & 15, n_pw = d ? j : (15 - j);
      const float ar = PW[((d * 17 + n_pw) * 64 + pi) * 2], ai = PW[((d * 17 + n_pw) * 64 + pi) * 2 + 1];
      const float br = Bb[((d * 64 + pi) * 16 + c2) * 2], bi = Bb[((d * 64 + pi) * 16 + c2) * 2 + 1];
      v[q] = part ? (ar * bi + ai * br) : (ar * br - ai * bi); }
    *(unsigned*)(E + (size_t)n * 256 + k) = cvt_pk_bf16(v[0], v[1]);
  }
  __syncthreads();
}

struct SchedS5S {
  static constexpr bool GATHER = false;
  int G, c;
  __device__ __forceinline__ bool next(int i, pg::Unit& u) const {
    const int L = i * G + c; if (L >= 160) return false;
    u.aux = L / 5; u.pm = L % 5; u.pn = 0; u.arow = u.pm * 256; return true;
  }
};
struct EpiS5S {
  static constexpr bool PERM = false;
  float* S;
  __device__ __forceinline__ void operator()(const pg::Acc& acc, const pg::Unit& u, int wr, int wc, int fr, int fq) const {
    const int row0 = u.arow + wr * 64 + fr, col0 = wc * 32 + 4 * fq;
#pragma unroll
    for (int ai = 0; ai < 2; ++ai)
#pragma unroll
      for (int m = 0; m < 4; ++m) { const int r = row0 + ai * 128 + m * 16;
        if (r < NCHUNK) { float* rowp = S + ((size_t)u.aux * NCHUNK + r) * 256 + col0;
#pragma unroll
          for (int bj = 0; bj < 2; ++bj)
#pragma unroll
            for (int n = 0; n < 2; ++n) *(f32x4*)(rowp + bj * 128 + n * 16) = acc[ai][bj][m][n]; } }
  }
};
__device__ __forceinline__ void phase_s5s(const Params& p, LAS unsigned char* lds) {
  pg::Addr AD{(const bf16_t*)((unsigned char*)p.out + DO_YA), 512, (size_t)NCHUNK * 512, (const bf16_t*)(p.ws + WS_S5E), 256, (size_t)256 * 256, false};
  SchedS5S S{(int)gridDim.x, (int)blockIdx.x};
  EpiS5S E{(float*)(p.ws + WS_RH)};
  pg::gemm_phase(lds, AD, S, E);
}

__device__ __forceinline__ void s5_scan_item(const Params& p, int item, int lane) {
  const int d = item & 1, g = (item >> 1) & 31, b = item >> 6;
  const float* S = (const float*)(p.ws + WS_RH) + (size_t)g * NCHUNK * 256 + d * 128 + lane;
  bf16_t* YA = (bf16_t*)((unsigned char*)p.out + DO_YA) + (size_t)g * NCHUNK * 512 + 256 + d * 128 + lane;
  const int idx = (d * 32 + g) * 64 + lane;
  const float dt = expf(p.in[I_SLDT][d * 32 + g]);
  const float ea = expf(p.in[I_SARE][idx] * dt * 16.f); float sn, cs; sincosf(p.in[I_SAIM][idx] * dt * 16.f, &sn, &cs);
  const float ar = ea * cs, ai = ea * sn;
  float hr = 0.f, hi = 0.f;
  const int r0 = b * 528;
#pragma unroll 4
  for (int s = 0; s < 16; ++s) { const int r = r0 + 512 + (d ? 15 - s : s);
    const float sr = S[(size_t)r * 256], si = S[(size_t)r * 256 + 64];
    const float nr = ar * hr - ai * hi + sr, ni = ar * hi + ai * hr + si; hr = nr; hi = ni; }
#pragma unroll 8
  for (int s = 0; s < 512; ++s) { const int r = r0 + (d ? 511 - s : s);
    const float sr = S[(size_t)r * 256], si = S[(size_t)r * 256 + 64];
    YA[(size_t)r * 512] = f2bf(hr); YA[(size_t)r * 512 + 64] = f2bf(hi);
    const float nr = ar * hr - ai * hi + sr, ni = ar * hi + ai * hr + si; hr = nr; hi = ni; }
}
__device__ __forceinline__ void phase_s5scan(const Params& p) {
  const int tid_ = opaque_tid(); const int lane = tid_ & 63, wave = tid_ >> 6;
  const int gw = blockIdx.x * NWAVES + wave;
  if (gw < 128) s5_scan_item(p, gw, lane);
}

struct SchedS5Y {
  static constexpr bool GATHER = false;
  int G, c;
  __device__ __forceinline__ bool next(int i, pg::Unit& u) const {
    const int L = i * G + c; if (L >= 128) return false;
    u.aux = L >> 2; u.pm = L & 3; u.pn = 0; u.arow = (u.pm >> 1) * 528 + (u.pm & 1) * 256; return true;
  }
};
struct EpiS5Y {
  static constexpr bool PERM = true;
  bf16_t* GY;
  __device__ __forceinline__ void operator()(const pg::Acc& acc, const pg::Unit& u, int wr, int wc, int fr, int fq) const {
    const int row0 = u.arow + wr * 64 + fr;
#pragma unroll
    for (int ai = 0; ai < 2; ++ai)
#pragma unroll
      for (int m = 0; m < 4; ++m) { const int chunk = row0 + ai * 128 + m * 16;
#pragma unroll
        for (int bj = 0; bj < 2; ++bj) { const int col = bj * 128 + wc * 32 + 8 * fq, ti = col >> 4, c0 = col & 15;
          float o[8];
#pragma unroll
          for (int n = 0; n < 2; ++n)
#pragma unroll
            for (int e = 0; e < 4; ++e) o[n * 4 + e] = gelu_tanh(acc[ai][bj][m][n][e]);
          u32x4 w; w.x = cvt_pk_bf16(o[0], o[1]); w.y = cvt_pk_bf16(o[2], o[3]); w.z = cvt_pk_bf16(o[4], o[5]); w.w = cvt_pk_bf16(o[6], o[7]);
          *(u32x4*)(GY + (size_t)(chunk * 16 + ti) * 512 + u.aux * 16 + c0) = w; } }
  }
};
__device__ __forceinline__ void phase_s5y(const Params& p, LAS unsigned char* lds) {
  pg::Addr AD{(const bf16_t*)((unsigned char*)p.out + DO_YA), 512, (size_t)NCHUNK * 512, (const bf16_t*)(p.ws + WS_S5T), 512, (size_t)256 * 512, false};
  SchedS5Y S{(int)gridDim.x, (int)blockIdx.x};
  EpiS5Y E{(bf16_t*)((unsigned char*)p.out + DO_GY)};
  pg::gemm_phase(lds, AD, S, E);
}
__device__ __forceinline__ void map_static(int L, int nM, int nN, int& pm, int& pn) {
  const int nwg = nM * nN; int wgid = L;
  { const int q = nwg / 8, r = nwg % 8, xcd = wgid % 8, off = wgid / 8; wgid = (xcd < r ? xcd * (q + 1) : r * (q + 1) + (xcd - r) * q) + off; }
  const int nig = 8 * nN, gid = wgid / nig, fm = gid * 8, gsz = (nM - fm) < 8 ? (nM - fm) : 8;
  pm = fm + ((wgid % nig) % gsz); pn = (wgid % nig) / gsz;
}

__device__ __forceinline__ void cvt_item(const float* W, int ldw, bf16_t* dst, int ldd, int k0, int n0, LAS float* scr, int lane) {
#pragma unroll 8
  for (int i = 0; i < 32; ++i) { const int kk = 2 * i + (lane >> 5); scr[kk * 33 + (lane & 31)] = W[(size_t)(k0 + kk) * ldw + n0 + (lane & 31)]; }
  asm volatile("s_waitcnt lgkmcnt(0)" ::: "memory");
  const int c = lane & 7;
#pragma unroll
  for (int j = 0; j < 4; ++j) { const int n = (lane >> 3) + 8 * j; const LAS float* s = scr + (8 * c) * 33 + n;
    u32x4 o; o.x = cvt_pk_bf16(s[0 * 33], s[1 * 33]); o.y = cvt_pk_bf16(s[2 * 33], s[3 * 33]); o.z = cvt_pk_bf16(s[4 * 33], s[5 * 33]); o.w = cvt_pk_bf16(s[6 * 33], s[7 * 33]);
    *(u32x4*)(dst + (size_t)n * ldd + k0 + 8 * c) = o; }
  asm volatile("s_waitcnt lgkmcnt(0)" ::: "memory");
}
__device__ __forceinline__ int ilv_row(int n, int second) { return (n >> 7) * 256 + (n & 127) + second * 128; }

constexpr int CV_WIN = (1024 / 64) * (4096 / 32);
constexpr int CV_GLU = (512 / 64) * (1024 / 32);
constexpr int CV_SQ = (1024 / 64) * (1024 / 32);
constexpr int CV_EGU = (1024 / 64) * (512 / 32);
constexpr int CV_ED = (512 / 64) * (1024 / 32);
constexpr int CV_SMALL = CV_WIN + 2 * CV_GLU + 2 * CV_SQ;
constexpr int CV_TOTAL = CV_SMALL + 32 * (2 * CV_EGU + CV_ED);

__device__ __forceinline__ void cvt_dispatch(const Params& p, int it, LAS float* scr, int lane) {
  unsigned char* ws = p.ws;
  if (it < CV_WIN) { const int nb = 4096 / 32; cvt_item(p.in[I_WIN], 4096, (bf16_t*)(ws + WS_WIN) + (size_t)(32 * (it % nb)) * 1024, 1024, 64 * (it / nb), 32 * (it % nb), scr, lane); return; }
  it -= CV_WIN;
  if (it < 2 * CV_GLU) { const int second = it / CV_GLU; it %= CV_GLU; const int nb = 1024 / 32, n0 = 32 * (it % nb);
    cvt_item(p.in[second ? I_WGB : I_WGA], 1024, (bf16_t*)(ws + WS_WGLU) + (size_t)ilv_row(n0, second) * 512, 512, 64 * (it / nb), n0, scr, lane); return; }
  it -= 2 * CV_GLU;
  if (it < 2 * CV_SQ) { const int second = it / CV_SQ; it %= CV_SQ; const int nb = 1024 / 32, n0 = 32 * (it % nb);
    cvt_item(p.in[second ? I_WOUT : I_WAO], 1024, (bf16_t*)(ws + (second ? WS_WOUT : WS_WAO)) + (size_t)n0 * 1024, 1024, 64 * (it / nb), n0, scr, lane); return; }
  it -= 2 * CV_SQ;
  const int per_e = 2 * CV_EGU + CV_ED, e = it / per_e; it %= per_e;
  if (it < 2 * CV_EGU) { const int second = it / CV_EGU; it %= CV_EGU; const int nb = 512 / 32, n0 = 32 * (it % nb);
    cvt_item(p.in[second ? I_WEU : I_WEG] + (size_t)e * 1024 * 512, 512, (bf16_t*)(ws + WS_WGU) + ((size_t)e * 1024 + ilv_row(n0, second)) * 1024, 1024, 64 * (it / nb), n0, scr, lane); return; }
  it -= 2 * CV_EGU;
  { const int nb = 1024 / 32, n0 = 32 * (it % nb);
    cvt_item(p.in[I_WED] + (size_t)e * 512 * 1024, 1024, (bf16_t*)(ws + WS_WD) + ((size_t)e * 1024 + n0) * 512, 512, 64 * (it / nb), n0, scr, lane); }
}

__device__ __forceinline__ void phase0(const Params& p, LAS unsigned char* lds) {
  const int tid = opaque_tid(), lane = tid & 63, wave = tid >> 6, c = blockIdx.x, G = gridDim.x;
  LAS float* red = (LAS float*)lds;
  for (int cg = c; cg < NMOD / 24; cg += G) {
    const int col = tid % 24, sl = tid / 24;
    float a0 = 0.f, a1 = 0.f, a2 = 0.f;
    if (sl < 21) {
      const float* w = p.in[I_WMOD] + cg * 24 + col;
      for (int k = sl; k < DM; k += 21) { const float wv = w[(size_t)k * NMOD];
        a0 += siluf_(p.in[I_C][k]) * wv; a1 += siluf_(p.in[I_C][DM + k]) * wv; a2 += siluf_(p.in[I_CCTX][k]) * wv; }
      red[(sl * 24 + col) * 3 + 0] = a0; red[(sl * 24 + col) * 3 + 1] = a1; red[(sl * 24 + col) * 3 + 2] = a2;
    }
    __syncthreads();
    if (tid < 72) { const int cc = tid / 3, r = tid % 3; float s = 0.f;
      for (int q = 0; q < 21; ++q) s += red[(q * 24 + cc) * 3 + r];
      ((float*)(p.ws + WS_MOD))[r * NMOD + cg * 24 + cc] = s + p.in[I_BMOD][cg * 24 + cc]; }
    __syncthreads();
  }
  const int nb = (G >= 64) ? 32 : 0;
  for (int g = c; g < 32; g += G) s5_build_tables(p, lds, g);
  if (c >= nb) {
    LAS float* scr = (LAS float*)(lds + 8192) + wave * (64 * 33);
    const int gw = (c - nb) * NWAVES + wave, NGW = (G - nb) * NWAVES;
    for (int it = gw; it < CV_TOTAL; it += NGW) cvt_dispatch(p, it, scr, lane);
  }
}

__device__ __forceinline__ void phase1(const Params& p) {
  const float* mod = (const float*)(p.ws + WS_MOD);
  bf16_t* H = (bf16_t*)(p.ws + WS_RH);
  const int tid_ = opaque_tid(); const int lane = tid_ & 63, wave = tid_ >> 6;
  const int gw = blockIdx.x * NWAVES + wave, NGW = gridDim.x * NWAVES;
  for (int pr = gw; pr < NROW; pr += NGW) {
    const int b = pr / SKV, t = pr % SKV;
    const float* xr; const float* mrow;
    if (t < SEQ) { xr = p.in[I_X] + ((size_t)b * SEQ + t) * DM; mrow = mod + b * NMOD; }
    else { xr = p.in[I_CTX] + ((size_t)b * NCTX + (t - SEQ)) * DM; mrow = mod + 2 * NMOD; }
    f32x4 v[4]; float s = 0;
#pragma unroll
    for (int j = 0; j < 4; ++j) { v[j] = ((const f32x4*)xr)[lane + 64 * j]; s += (v[j].x + v[j].y) + (v[j].z + v[j].w); }
    const float mean = wave_sum(s) * (1.f / DM); float s2 = 0;
#pragma unroll
    for (int j = 0; j < 4; ++j) { v[j] = v[j] - mean; s2 += (v[j].x * v[j].x + v[j].y * v[j].y) + (v[j].z * v[j].z + v[j].w * v[j].w); }
    const float rstd = rsqrtf(wave_sum(s2) * (1.f / DM) + LN_EPS);
#pragma unroll
    for (int j = 0; j < 4; ++j) {
      const int col = (lane + 64 * j) * 4;
      const f32x4 sh = *(const f32x4*)(mrow + col), sc = *(const f32x4*)(mrow + DM + col);
      const f32x4 o = v[j] * rstd * (sc + 1.f) + sh;
      u32x2 w; w.x = cvt_pk_bf16(o.x, o.y); w.y = cvt_pk_bf16(o.z, o.w);
      *(u32x2*)(H + (size_t)pr * DM + col) = w;
    }
  }
}

struct SchedIn {
  static constexpr bool GATHER = false;
  int G, c;
  __device__ __forceinline__ bool next(int i, pg::Unit& u) const {
    const int L = i * G + c; u.aux = 0;
    if (L < 1024) { int lm, pn; map_static(L, 64, 16, lm, pn); u.pm = lm + (lm >> 5); u.pn = pn; u.arow = u.pm * 256; return true; }
    if (L < 1032) { const int j = L - 1024; u.pm = (j < 4) ? 32 : 65; const int q = j & 3; u.pn = (q < 2) ? q : q + 4; u.arow = u.pm * 256; return true; }
    return false;
  }
};
struct EpiIn {
  static constexpr bool PERM = true;
  bf16_t* YA; bf16_t* P;
  __device__ __forceinline__ void operator()(const pg::Acc& acc, const pg::Unit& u, int wr, int wc, int fr, int fq) const {
    const int row0 = u.pm * 256 + wr * 64 + fr;
    if (u.pn < 2) {
#pragma unroll
      for (int ai = 0; ai < 2; ++ai)
#pragma unroll
        for (int m = 0; m < 4; ++m) { const int r = row0 + ai * 128 + m * 16, chunk = r >> 4, ti = r & 15;
#pragma unroll
          for (int bj = 0; bj < 2; ++bj) { const int ch = u.pn * 256 + bj * 128 + wc * 32 + 8 * fq, g = ch >> 4, off = ch & 15;
            const f32x4 v0 = acc[ai][bj][m][0], v1 = acc[ai][bj][m][1];
            u32x4 w; w.x = cvt_pk_bf16(v0[0], v0[1]); w.y = cvt_pk_bf16(v0[2], v0[3]); w.z = cvt_pk_bf16(v1[0], v1[1]); w.w = cvt_pk_bf16(v1[2], v1[3]);
            *(u32x4*)(YA + ((size_t)g * NCHUNK + chunk) * 512 + ti * 16 + off) = w; } }
    } else {
      const int colb = (u.pn - 2) * 256 + wc * 32 + 8 * fq; const bool sig = u.pn >= 8;
#pragma unroll
      for (int ai = 0; ai < 2; ++ai)
#pragma unroll
        for (int m = 0; m < 4; ++m) { bf16_t* rowp = P + (size_t)(row0 + ai * 128 + m * 16) * PLD + colb;
#pragma unroll
          for (int bj = 0; bj < 2; ++bj) { f32x4 v0 = acc[ai][bj][m][0], v1 = acc[ai][bj][m][1];
            if (sig) {
#pragma unroll
              for (int e = 0; e < 4; ++e) { v0[e] = __builtin_amdgcn_rcpf(1.f + __builtin_amdgcn_exp2f(-1.4426950408889634f * v0[e])); v1[e] = __builtin_amdgcn_rcpf(1.f + __builtin_amdgcn_exp2f(-1.4426950408889634f * v1[e])); } }
            u32x4 w; w.x = cvt_pk_bf16(v0[0], v0[1]); w.y = cvt_pk_bf16(v0[2], v0[3]); w.z = cvt_pk_bf16(v1[0], v1[1]); w.w = cvt_pk_bf16(v1[2], v1[3]);
            *(u32x4*)(rowp + bj * 128) = w; } }
    }
  }
};
__device__ __forceinline__ void phase2(const Params& p, LAS unsigned char* lds) {
  pg::Addr AD{(const bf16_t*)(p.ws + WS_RH), DM, 0, (const bf16_t*)(p.ws + WS_WIN), DM, 0, false};
  SchedIn S{(int)gridDim.x, (int)blockIdx.x};
  EpiIn E{(bf16_t*)((unsigned char*)p.out + DO_YA), (bf16_t*)(p.ws + WS_P)};
  pg::gemm_phase(lds, AD, S, E);
}

__device__ __forceinline__ void phase_qknorm(const Params& p) {
  bf16_t* P = (bf16_t*)(p.ws + WS_P);
  const int tid_ = opaque_tid(); const int lane = tid_ & 63, wave = tid_ >> 6;
  const int gw = blockIdx.x * NWAVES + wave, NGW = gridDim.x * NWAVES;
  const int axis = lane >> 5, f = lane & 31, e1 = axis * 64 + f, e2 = e1 + 32;
  const float inv = exp2f(-(float)(2 * f) * (13.287712379549449f / 64.f));
  const float gq1 = p.in[I_QG][e1], gq2 = p.in[I_QG][e2], gk1 = p.in[I_KG][e1], gk2 = p.in[I_KG][e2];
  for (int item = gw; item < NROW * 10; item += NGW) {
    const int pr = item / 10, slot = item % 10, t = pr % SKV;
    const bool isctx = t >= SEQ;
    if (isctx && slot < 8) continue;
    bf16_t* base = P + (size_t)pr * PLD + (slot < 8 ? PC_Q + slot * 128 : PC_K + (slot - 8) * 128);
    float x1 = bf2f(base[e1]), x2 = bf2f(base[e2]);
    const float ss = wave_sum(x1 * x1 + x2 * x2);
    const float r = rsqrtf(ss * (1.f / 128.f) + LN_EPS);
    x1 = x1 * r * (slot < 8 ? gq1 : gk1); x2 = x2 * r * (slot < 8 ? gq2 : gk2);
    float o1 = x1, o2 = x2;
    if (!isctx) {
      const float posf = (axis == 0) ? (float)(t >> 6) : (float)(t & 63);
      float sn, cs; sincosf(posf * inv, &sn, &cs);
      o1 = x1 * cs - x2 * sn; o2 = x1 * sn + x2 * cs;
    }
    base[e1] = f2bf(o1); base[e2] = f2bf(o2);
  }
}
struct SchedLat {
  static constexpr bool GATHER = false;
  int G, c, nN;
  __device__ __forceinline__ bool next(int i, pg::Unit& u) const {
    const int L = i * G + c; u.aux = 0;
    if (L >= 64 * nN) return false;
    int lm, pn; map_static(L, 64, nN, lm, pn); u.pm = lm + (lm >> 5); u.pn = pn; u.arow = u.pm * 256; return true;
  }
};
struct EpiGlu {
  static constexpr bool PERM = true;
  const bf16_t* P; bf16_t* Z;
  __device__ __forceinline__ void operator()(const pg::Acc& acc, const pg::Unit& u, int wr, int wc, int fr, int fq) const {
    const int row0 = u.pm * 256 + wr * 64 + fr, ch = u.pn * 128 + wc * 32 + 8 * fq;
#pragma unroll
    for (int ai = 0; ai < 2; ++ai)
#pragma unroll
      for (int m = 0; m < 4; ++m) { const int r = row0 + ai * 128 + m * 16;
        const u32x4 gw = *(const u32x4*)(P + (size_t)r * PLD + PC_G + ch);
        float gt[8] = {__uint_as_float(gw.x << 16), __uint_as_float(gw.x & 0xffff0000u), __uint_as_float(gw.y << 16), __uint_as_float(gw.y & 0xffff0000u),
                       __uint_as_float(gw.z << 16), __uint_as_float(gw.z & 0xffff0000u), __uint_as_float(gw.w << 16), __uint_as_float(gw.w & 0xffff0000u)};
        float o[8];
#pragma unroll
        for (int n = 0; n < 2; ++n)
#pragma unroll
          for (int e = 0; e < 4; ++e) { const float a = acc[ai][0][m][n][e], b = acc[ai][1][m][n][e];
            o[n * 4 + e] = gt[n * 4 + e] * a * __builtin_amdgcn_rcpf(1.f + __builtin_amdgcn_exp2f(-1.4426950408889634f * b)); }
        u32x4 w; w.x = cvt_pk_bf16(o[0], o[1]); w.y = cvt_pk_bf16(o[2], o[3]); w.z = cvt_pk_bf16(o[4], o[5]); w.w = cvt_pk_bf16(o[6], o[7]);
        *(u32x4*)(Z + (size_t)r * DM + ch) = w; }
  }
};
struct EpiMix {
  static constexpr bool PERM = true;
  const bf16_t* P; bf16_t* Z;
  __device__ __forceinline__ void operator()(const pg::Acc& acc, const pg::Unit& u, int wr, int wc, int fr, int fq) const {
    const int row0 = u.pm * 256 + wr * 64 + fr, col0 = u.pn * 256 + wc * 32 + 8 * fq;
#pragma unroll
    for (int ai = 0; ai < 2; ++ai)
#pragma unroll
      for (int m = 0; m < 4; ++m) { const int r = row0 + ai * 128 + m * 16;
#pragma unroll
        for (int bj = 0; bj < 2; ++bj) { const int c = col0 + bj * 128;
          const u32x4 gw = *(const u32x4*)(P + (size_t)r * PLD + PC_G + 1024 + c);
          const u32x4 zw = *(const u32x4*)(Z + (size_t)r * DM + c);
          const unsigned gq[4] = {gw.x, gw.y, gw.z, gw.w}, zq[4] = {zw.x, zw.y, zw.z, zw.w};
          unsigned ow[4];
#pragma unroll
          for (int q = 0; q < 4; ++q) { const float a0 = acc[ai][bj][m][q >> 1][(q & 1) * 2], a1 = acc[ai][bj][m][q >> 1][(q & 1) * 2 + 1];
            ow[q] = cvt_pk_bf16(__uint_as_float(zq[q] << 16) + __uint_as_float(gq[q] << 16) * a0, __uint_as_float(zq[q] & 0xffff0000u) + __uint_as_float(gq[q] & 0xffff0000u) * a1); }
          *(u32x4*)(Z + (size_t)r * DM + c) = (u32x4){ow[0], ow[1], ow[2], ow[3]}; } }
  }
};
struct EpiOut {
  static constexpr bool PERM = false;
  const float* X; const float* mod; float* R1;
  __device__ __forceinline__ void operator()(const pg::Acc& acc, const pg::Unit& u, int wr, int wc, int fr, int fq) const {
    const int b = u.pm / 33, lrow0 = (u.pm - b) * 256 + wr * 64 + fr, col0 = u.pn * 256 + wc * 32 + 4 * fq;
    const float* g1 = mod + b * NMOD + 2 * DM;
    f32x4 gv[2][2];
#pragma unroll
    for (int bj = 0; bj < 2; ++bj)
#pragma unroll
      for (int n = 0; n < 2; ++n) gv[bj][n] = *(const f32x4*)(g1 + col0 + bj * 128 + n * 16);
#pragma unroll
    for (int ai = 0; ai < 2; ++ai)
#pragma unroll
      for (int m = 0; m < 4; ++m) { const size_t off = (size_t)(lrow0 + ai * 128 + m * 16) * DM + col0;
#pragma unroll
        for (int bj = 0; bj < 2; ++bj)
#pragma unroll
          for (int n = 0; n < 2; ++n) { const f32x4 xv = *(const f32x4*)(X + off + bj * 128 + n * 16);
            *(f32x4*)(R1 + off + bj * 128 + n * 16) = xv * ALPHA + gv[bj][n] * acc[ai][bj][m][n]; } }
  }
};
__device__ __forceinline__ void phase_g1(const Params& p, LAS unsigned char* lds) {
  pg::Addr AD{(const bf16_t*)((unsigned char*)p.out + DO_GY), 512, 0, (const bf16_t*)(p.ws + WS_WGLU), 512, 0, false};
  SchedLat S{(int)gridDim.x, (int)blockIdx.x, 8};
  EpiGlu E{(const bf16_t*)(p.ws + WS_P), (bf16_t*)(p.ws + WS_RH)};
  pg::gemm_phase(lds, AD, S, E);
}
__device__ __forceinline__ void phase_g2(const Params& p, LAS unsigned char* lds) {
  pg::Addr AD{(const bf16_t*)(p.ws + WS_P) + PC_Q, PLD, 0, (const bf16_t*)(p.ws + WS_WAO), DM, 0, false};
  SchedLat S{(int)gridDim.x, (int)blockIdx.x, 4};
  EpiMix E{(const bf16_t*)(p.ws + WS_P), (bf16_t*)(p.ws + WS_RH)};
  pg::gemm_phase(lds, AD, S, E);
}
__device__ __forceinline__ void phase_g3(const Params& p, LAS unsigned char* lds) {
  pg::Addr AD{(const bf16_t*)(p.ws + WS_RH), DM, 0, (const bf16_t*)(p.ws + WS_WOUT), DM, 0, false};
  SchedLat S{(int)gridDim.x, (int)blockIdx.x, 4};
  EpiOut E{p.in[I_X], (const float*)(p.ws + WS_MOD), p.out};
  pg::gemm_phase(lds, AD, S, E);
}

constexpr size_t RT_EW = 0, RT_LIST = 256 * 1024;
constexpr int CTL_CNT = 1024;
constexpr int ACT_TILES_MAX = 160;
constexpr size_t PR_ACT = 66 * MiB;

struct MoeTab { const LAS int* tb; const LAS int* cn; };
__device__ __forceinline__ MoeTab moe_tables(const Params& p, LAS unsigned char* lds) {
  LAS int* tb = (LAS int*)(lds + LDS_STAGE); LAS int* cn = tb + 64;
  const unsigned* cnt = (const unsigned*)(p.ws + WS_CTL) + CTL_CNT;
  if (threadIdx.x == 0) { int acc = 0; for (int e = 0; e < 32; ++e) { const int c = (int)cnt[e]; cn[e] = c; tb[e] = acc; acc += (c + 255) >> 8; } tb[32] = acc; }
  __syncthreads();
  return MoeTab{tb, cn};
}
struct SchedMoe {
  static constexpr bool GATHER_ = true;
  int G, c, nN; MoeTab tab; const int* lists;
  __device__ __forceinline__ bool next_(int i, pg::Unit& u) const {
    const int L = i * G + c, T = L / nN;
    if (T >= tab.tb[32]) return false;
    int e = 0;
#pragma unroll 1
    for (int q = 1; q < 32; ++q) e = (tab.tb[q] <= T) ? q : e;
    u.pm = T; u.pn = L % nN; u.aux = e; u.arow = T * 256; return true;
  }
  __device__ __forceinline__ int arow_(const pg::Unit& u, int r) const {
    const int slot = (u.pm - tab.tb[u.aux]) * 256 + r;
    if (slot >= tab.cn[u.aux]) return 0;
    return lat2pad(lists[u.aux * NLAT + slot] >> 1);
  }
};
struct SchedMoeUp : SchedMoe { static constexpr bool GATHER = true;
  __device__ __forceinline__ bool next(int i, pg::Unit& u) const { return next_(i, u); }
  __device__ __forceinline__ int arow(const pg::Unit& u, int r) const { return arow_(u, r); } };
struct SchedMoeDown : SchedMoe { static constexpr bool GATHER = false;
  __device__ __forceinline__ bool next(int i, pg::Unit& u) const { return next_(i, u); } };
struct EpiGU {
  static constexpr bool PERM = true;
  bf16_t* ACT;
  __device__ __forceinline__ void operator()(const pg::Acc& acc, const pg::Unit& u, int wr, int wc, int fr, int fq) const {
    const int row0 = u.pm * 256 + wr * 64 + fr, ch = u.pn * 128 + wc * 32 + 8 * fq;
#pragma unroll
    for (int ai = 0; ai < 2; ++ai)
#pragma unroll
      for (int m = 0; m < 4; ++m) { const int r = row0 + ai * 128 + m * 16;
        float o[8];
#pragma unroll
        for (int n = 0; n < 2; ++n)
#pragma unroll
          for (int e = 0; e < 4; ++e) { const float a = acc[ai][0][m][n][e], b = acc[ai][1][m][n][e];
            o[n * 4 + e] = a * b * __builtin_amdgcn_rcpf(1.f + __builtin_amdgcn_exp2f(-1.4426950408889634f * a)); }
        u32x4 w; w.x = cvt_pk_bf16(o[0], o[1]); w.y = cvt_pk_bf16(o[2], o[3]); w.z = cvt_pk_bf16(o[4], o[5]); w.w = cvt_pk_bf16(o[6], o[7]);
        *(u32x4*)(ACT + (size_t)r * 512 + ch) = w; }
  }
};
struct EpiDown {
  static constexpr bool PERM = true;
  bf16_t* Y2; const int* lists; const float* ew; MoeTab tab;
  __device__ __forceinline__ void operator()(const pg::Acc& acc, const pg::Unit& u, int wr, int wc, int fr, int fq) const {
    const int slot0 = (u.pm - tab.tb[u.aux]) * 256 + wr * 64 + fr, n_e = tab.cn[u.aux], col0 = u.pn * 256 + wc * 32 + 8 * fq;
#pragma unroll
    for (int ai = 0; ai < 2; ++ai)
#pragma unroll
      for (int m = 0; m < 4; ++m) { const int slot = slot0 + ai * 128 + m * 16;
        if (slot < n_e) { const int id = lists[u.aux * NLAT + slot]; const float w = ew[id];
#pragma unroll
          for (int bj = 0; bj < 2; ++bj) { const f32x4 v0 = acc[ai][bj][m][0] * w, v1 = acc[ai][bj][m][1] * w;
            u32x4 o; o.x = cvt_pk_bf16(v0[0], v0[1]); o.y = cvt_pk_bf16(v0[2], v0[3]); o.z = cvt_pk_bf16(v1[0], v1[1]); o.w = cvt_pk_bf16(v1[2], v1[3]);
            *(u32x4*)(Y2 + (size_t)id * DM + col0 + bj * 128) = o; } } }
  }
};
__device__ __forceinline__ void phase_moe_up(const Params& p, LAS unsigned char* lds) {
  const MoeTab tab = moe_tables(p, lds);
  pg::Addr AD{(const bf16_t*)(p.ws + WS_RH), DM, 0, (const bf16_t*)(p.ws + WS_WGU), DM, (size_t)1024 * 1024, true};
  SchedMoeUp S; S.G = gridDim.x; S.c = blockIdx.x; S.nN = 4; S.tab = tab; S.lists = (const int*)(p.ws + WS_ROUTE + RT_LIST);
  EpiGU E{(bf16_t*)(p.ws + WS_P + PR_ACT)};
  pg::gemm_phase(lds, AD, S, E);
}
__device__ __forceinline__ void phase_moe_down(const Params& p, LAS unsigned char* lds) {
  const MoeTab tab = moe_tables(p, lds);
  pg::Addr AD{(const bf16_t*)(p.ws + WS_P + PR_ACT), 512, 0, (const bf16_t*)(p.ws + WS_WD), 512, (size_t)1024 * 512, false};
  SchedMoeDown S; S.G = gridDim.x; S.c = blockIdx.x; S.nN = 4; S.tab = tab; S.lists = (const int*)(p.ws + WS_ROUTE + RT_LIST);
  EpiDown E{(bf16_t*)(p.ws + WS_P), (const int*)(p.ws + WS_ROUTE + RT_LIST), (const float*)(p.ws + WS_ROUTE + RT_EW), tab};
  pg::gemm_phase(lds, AD, S, E);
}

__device__ __forceinline__ void phase_final(const Params& p) {
  const float* mod = (const float*)(p.ws + WS_MOD);
  const bf16_t* Y2 = (const bf16_t*)(p.ws + WS_P);
  float* X1 = p.out;
  const int tid_ = opaque_tid(); const int lane = tid_ & 63, wave = tid_ >> 6;
  const int gw = blockIdx.x * NWAVES + wave, NGW = gridDim.x * NWAVES;
  for (int row = gw; row < NLAT; row += NGW) {
    const float* mrow = mod + (row / SEQ) * NMOD;
    f32x4 v[4]; float s = 0;
#pragma unroll
    for (int j = 0; j < 4; ++j) {
      const int col = (lane + 64 * j) * 4;
      const f32x4 x1 = ((const f32x4*)(X1 + (size_t)row * DM))[lane + 64 * j];
      const u32x2 ya = *(const u32x2*)(Y2 + (size_t)(2 * row) * DM + col), yb = *(const u32x2*)(Y2 + (size_t)(2 * row + 1) * DM + col);
      f32x4 ym;
      ym.x = __uint_as_float(ya.x << 16) + __uint_as_float(yb.x << 16); ym.y = __uint_as_float(ya.x & 0xffff0000u) + __uint_as_float(yb.x & 0xffff0000u);
      ym.z = __uint_as_float(ya.y << 16) + __uint_as_float(yb.y << 16); ym.w = __uint_as_float(ya.y & 0xffff0000u) + __uint_as_float(yb.y & 0xffff0000u);
      const f32x4 g2 = *(const f32x4*)(mrow + 5 * DM + col);
      v[j] = x1 * ALPHA + g2 * ym;
      s += (v[j].x + v[j].y) + (v[j].z + v[j].w);
    }
    const float mean = wave_sum(s) * (1.f / DM); float s2 = 0;
#pragma unroll
    for (int j = 0; j < 4; ++j) { v[j] = v[j] - mean; s2 += (v[j].x * v[j].x + v[j].y * v[j].y) + (v[j].z * v[j].z + v[j].w * v[j].w); }
    const float rstd = rsqrtf(wave_sum(s2) * (1.f / DM) + LN_EPS);
#pragma unroll
    for (int j = 0; j < 4; ++j) {
      const int col = (lane + 64 * j) * 4;
      const f32x4 g = *(const f32x4*)(p.in[I_LN2G] + col), bb = *(const f32x4*)(p.in[I_LN2B] + col);
      ((f32x4*)(X1 + (size_t)row * DM))[lane + 64 * j] = v[j] * rstd * g + bb;
    }
  }
}
__device__ __forceinline__ void phase_attn(const Params& p, char* lds) {
  bf16_t* P = (bf16_t*)(p.ws + WS_P);
  int seq = SKV; asm volatile("" : "+s"(seq));
  for (int unit = blockIdx.x; unit < NB * 8 * (SEQ / 256); unit += gridDim.x) {
    const int qb = unit % 32, h = (unit / 32) % 8, b = unit / 256;
    bf16_t* Qp = P + ((size_t)b * SKV + qb * 256) * PLD + PC_Q + h * 128;
    const bf16_t* Kp = P + (size_t)b * SKV * PLD + PC_K + (h >> 2) * 128;
    const bf16_t* Vp = P + (size_t)b * SKV * PLD + PC_V + (h >> 2) * 128;
    att::attn_dense_body(Qp, Kp, Vp, Qp, seq, lds);
  }
}

__device__ __forceinline__ void phase_ln1_router(const Params& p) {
  const float* mod = (const float*)(p.ws + WS_MOD);
  float* R1 = p.out;
  bf16_t* H2 = (bf16_t*)(p.ws + WS_RH);
  float* ew = (float*)(p.ws + WS_ROUTE + RT_EW); int* lists = (int*)(p.ws + WS_ROUTE + RT_LIST);
  unsigned* cnt = (unsigned*)(p.ws + WS_CTL) + CTL_CNT;
  const int tid_ = opaque_tid(); const int lane0 = tid_ & 63, wave = tid_ >> 6;
  const int gw = blockIdx.x * NWAVES + wave, NGW = gridDim.x * NWAVES;
  for (int row = gw; row < NLAT; row += NGW) {
    const float* mrow = mod + (row / SEQ) * NMOD;
    const int pr = lat2pad(row);
    int lane = lane0; asm volatile("" : "+v"(lane));
    f32x4 v[4]; float s = 0;
#pragma unroll
    for (int j = 0; j < 4; ++j) { v[j] = ((const f32x4*)(R1 + (size_t)row * DM))[lane + 64 * j]; s += (v[j].x + v[j].y) + (v[j].z + v[j].w); }
    float mean = wave_sum(s) * (1.f / DM); float s2 = 0;
#pragma unroll
    for (int j = 0; j < 4; ++j) { v[j] = v[j] - mean; s2 += (v[j].x * v[j].x + v[j].y * v[j].y) + (v[j].z * v[j].z + v[j].w * v[j].w); }
    float rstd = rsqrtf(wave_sum(s2) * (1.f / DM) + LN_EPS);
    s = 0;
#pragma unroll
    for (int j = 0; j < 4; ++j) {
      const int col = (lane + 64 * j) * 4;
      const f32x4 g = *(const f32x4*)(p.in[I_LN1G] + col), bb = *(const f32x4*)(p.in[I_LN1B] + col);
      v[j] = v[j] * rstd * g + bb;
      ((f32x4*)(R1 + (size_t)row * DM))[lane + 64 * j] = v[j];
      s += (v[j].x + v[j].y) + (v[j].z + v[j].w);
    }
    mean = wave_sum(s) * (1.f / DM); s2 = 0;
#pragma unroll
    for (int j = 0; j < 4; ++j) { v[j] = v[j] - mean; s2 += (v[j].x * v[j].x + v[j].y * v[j].y) + (v[j].z * v[j].z + v[j].w * v[j].w); }
    rstd = rsqrtf(wave_sum(s2) * (1.f / DM) + LN_EPS);
    float lg[36];
#pragma unroll
    for (int i = 0; i < 36; ++i) lg[i] = 0.f;
#pragma unroll
    for (int j = 0; j < 4; ++j) {
      const int col = (lane + 64 * j) * 4;
      const f32x4 sh = *(const f32x4*)(mrow + 3 * DM + col), sc = *(const f32x4*)(mrow + 4 * DM + col);
      const f32x4 hv = v[j] * rstd * (sc + 1.f) + sh;
      u32x2 w; w.x = cvt_pk_bf16(hv.x, hv.y); w.y = cvt_pk_bf16(hv.z, hv.w);
      *(u32x2*)(H2 + (size_t)pr * DM + col) = w;
#pragma unroll
      for (int e = 0; e < 4; ++e) {
        const f32x4 wg = *(const f32x4*)(p.in[I_WRG] + (size_t)(col + e) * 4);
        lg[0] += hv[e] * wg.x; lg[1] += hv[e] * wg.y; lg[2] += hv[e] * wg.z; lg[3] += hv[e] * wg.w;
        const f32x4* we = (const f32x4*)(p.in[I_WRE] + (size_t)(col + e) * 32);
#pragma unroll
        for (int q = 0; q < 8; ++q) { const f32x4 w4 = we[q]; lg[4 + 4 * q] += hv[e] * w4.x; lg[5 + 4 * q] += hv[e] * w4.y; lg[6 + 4 * q] += hv[e] * w4.z; lg[7 + 4 * q] += hv[e] * w4.w; }
      }
    }
#pragma unroll
    for (int i = 0; i < 36; ++i) lg[i] = wave_sum(lg[i]);
    if (lane == 0) {
      float gl[4]; int gi = 0;
#pragma unroll
      for (int i = 0; i < 4; ++i) gl[i] = lg[i] + p.in[I_BRG][i];
      float gm = gl[0];
#pragma unroll
      for (int i = 1; i < 4; ++i) if (gl[i] > gm) { gm = gl[i]; gi = i; }
      float den = 0.f;
#pragma unroll
      for (int i = 0; i < 4; ++i) den += expf(gl[i] - gm);
      const float gw_ = 1.f / den;
      float el[8];
#pragma unroll
      for (int i = 0; i < 8; ++i) {
        float t = 0.f;
#pragma unroll
        for (int gq = 0; gq < 4; ++gq) if (gq == gi) t = lg[4 + gq * 8 + i] + p.in[I_BRE][gq * 8 + i];
        el[i] = t;
      }
      int i1 = 0; float v1 = el[0];
#pragma unroll
      for (int i = 1; i < 8; ++i) if (el[i] > v1) { v1 = el[i]; i1 = i; }
      int i2 = -1; float v2 = -3.0e38f;
#pragma unroll
      for (int i = 0; i < 8; ++i) if (i != i1 && el[i] > v2) { v2 = el[i]; i2 = i; }
      const float e2 = expf(v2 - v1); const float w1 = 1.f / (1.f + e2), w2 = e2 / (1.f + e2);
      const int ea = gi * 8 + i1, eb = gi * 8 + i2;
      const unsigned pa = atomicAdd(cnt + ea, 1u), pb = atomicAdd(cnt + eb, 1u);
      lists[ea * NLAT + pa] = row * 2; lists[eb * NLAT + pb] = row * 2 + 1;
      ew[row * 2] = w1 * gw_; ew[row * 2 + 1] = w2 * gw_;
    }
  }
}

enum { PH_PRO = 0, PH_LN, PH_GIN, PH_QK, PH_ATT, PH_G1, PH_G2, PH_G3, PH_RT, PH_UP, PH_DOWN, PH_FIN, PH_S5S, PH_SCAN, PH_S5Y, PH_COUNT };
template <int PH> __device__ __forceinline__ void run_phase(const Params& p, unsigned char* lds_raw) {
  LAS unsigned char* lds = (LAS unsigned char*)lds_raw;
  if constexpr (PH == PH_PRO) phase0(p, lds);
  if constexpr (PH == PH_LN) phase1(p);
  if constexpr (PH == PH_GIN) phase2(p, lds);
  if constexpr (PH == PH_QK) phase_qknorm(p);
  if constexpr (PH == PH_ATT) phase_attn(p, (char*)lds_raw);
  if constexpr (PH == PH_G1) phase_g1(p, lds);
  if constexpr (PH == PH_G2) phase_g2(p, lds);
  if constexpr (PH == PH_G3) phase_g3(p, lds);
  if constexpr (PH == PH_RT) phase_ln1_router(p);
  if constexpr (PH == PH_UP) phase_moe_up(p, lds);
  if constexpr (PH == PH_DOWN) phase_moe_down(p, lds);
  if constexpr (PH == PH_FIN) phase_final(p);
  if constexpr (PH == PH_S5S) phase_s5s(p, lds);
  if constexpr (PH == PH_SCAN) phase_s5scan(p);
  if constexpr (PH == PH_S5Y) phase_s5y(p, lds);
}
#ifndef MK_FUSED
#define MK_FUSED 1
#endif
#if !MK_FUSED
template <int PH> __global__ __launch_bounds__(512, 2) void k_phase(Params p) {
  extern __shared__ __attribute__((aligned(16))) unsigned char lds_raw[];
  run_phase<PH>(p, lds_raw);
}
template <int PH> static bool set_lds() { return hipFuncSetAttribute((const void*)k_phase<PH>, hipFuncAttributeMaxDynamicSharedMemorySize, LDS_BYTES) == hipSuccess; }
template <int PH> static void launch_ph(int grid, hipStream_t stream, const Params& p) { hipLaunchKernelGGL(k_phase<PH>, dim3(grid), dim3(512), LDS_BYTES, stream, p); }
#else
constexpr int CTL_SCAN = 2048;
#ifndef MK_CG_SYNC
#define MK_CG_SYNC 0
#endif
constexpr int CTL_BAR = 4096;
constexpr int LDS_BARST = LDS_STAGE + 1024;
#if MK_CG_SYNC
#define GRID_BAR() cooperative_groups::this_grid().sync()
#else
#define GRID_BAR() xcd_barrier(xbar)
#endif
typedef const __attribute__((address_space(4))) Params* KParamsPtr;
__device__ __forceinline__ KParamsPtr kparams() { KParamsPtr k = (KParamsPtr)__builtin_amdgcn_kernarg_segment_ptr(); asm volatile("" : "+s"(k)); return k; }
#define KP (*(const Params*)kparams())
#ifndef MK_MASK
#define MK_MASK 0xFFFF
#endif
__global__ __launch_bounds__(512, 2) void k_mega(Params p_unused) {
  extern __shared__ __attribute__((aligned(16))) unsigned char lds_raw[];
#if !MK_CG_SYNC
  volatile LAS unsigned* bst = (volatile LAS unsigned*)((LAS unsigned char*)lds_raw + LDS_BARST);
  if (threadIdx.x < 2) bst[threadIdx.x] = 0u;
  __syncthreads();
  const XcdBarrier xbar = xcd_barrier_post((unsigned*)(KP.ws + WS_CTL) + CTL_BAR, bst);
#endif
  if constexpr ((MK_MASK >> PH_PRO) & 1) run_phase<PH_PRO>(KP, lds_raw);  GRID_BAR();
  if constexpr ((MK_MASK >> PH_LN) & 1) run_phase<PH_LN>(KP, lds_raw);   GRID_BAR();
  if constexpr ((MK_MASK >> PH_GIN) & 1) run_phase<PH_GIN>(KP, lds_raw);  GRID_BAR();
  if constexpr ((MK_MASK >> PH_S5S) & 1) run_phase<PH_S5S>(KP, lds_raw);  if constexpr ((MK_MASK >> PH_QK) & 1) run_phase<PH_QK>(KP, lds_raw);  GRID_BAR();
  {
    unsigned* ctr = (unsigned*)(KP.ws + WS_CTL) + CTL_SCAN;
    if (blockIdx.x * NWAVES < 128) {
      if constexpr ((MK_MASK >> PH_SCAN) & 1) run_phase<PH_SCAN>(KP, lds_raw);
      __threadfence();
      if ((threadIdx.x & 63) == 0 && blockIdx.x * NWAVES + (threadIdx.x >> 6) < 128) __hip_atomic_fetch_add(ctr, 1u, __ATOMIC_RELEASE, __HIP_MEMORY_SCOPE_AGENT);
    }
    if constexpr ((MK_MASK >> PH_ATT) & 1) run_phase<PH_ATT>(KP, lds_raw);
    if (threadIdx.x == 0) { unsigned spins = 0; while (__hip_atomic_load(ctr, __ATOMIC_ACQUIRE, __HIP_MEMORY_SCOPE_AGENT) < 128u && ++spins < (1u << 24)) __builtin_amdgcn_s_sleep(8); }
    __syncthreads();
    __threadfence();
    if constexpr ((MK_MASK >> PH_S5Y) & 1) run_phase<PH_S5Y>(KP, lds_raw);
  }
  GRID_BAR();
  if constexpr ((MK_MASK >> PH_G1) & 1) run_phase<PH_G1>(KP, lds_raw);   GRID_BAR();
  if constexpr ((MK_MASK >> PH_G2) & 1) run_phase<PH_G2>(KP, lds_raw);   GRID_BAR();
  if constexpr ((MK_MASK >> PH_G3) & 1) run_phase<PH_G3>(KP, lds_raw);   GRID_BAR();
  if constexpr ((MK_MASK >> PH_RT) & 1) run_phase<PH_RT>(KP, lds_raw);   GRID_BAR();
  if constexpr ((MK_MASK >> PH_UP) & 1) run_phase<PH_UP>(KP, lds_raw);   GRID_BAR();
  if constexpr ((MK_MASK >> PH_DOWN) & 1) run_phase<PH_DOWN>(KP, lds_raw); GRID_BAR();
  if constexpr ((MK_MASK >> PH_FIN) & 1) run_phase<PH_FIN>(KP, lds_raw);
}
#endif

extern "C" void kernel_launch(void* const* d_in, const int* in_sizes, int n_in, void* d_out, int out_size, void* d_ws, size_t ws_size, hipStream_t stream) {
  static int grid = 0;
  if (grid == 0) {
    if (n_in != 32 || out_size != NLAT * DM || ws_size < WS_END) { fprintf(stderr, "kernel_launch: unexpected shapes n_in %d out %d ws %zu\n", n_in, out_size, ws_size); grid = -1; return; }
    int dev = 0, cus = 0;
    hipGetDevice(&dev); hipDeviceGetAttribute(&cus, hipDeviceAttributeMultiprocessorCount, dev);
#if !MK_FUSED
    bool ok = set_lds<0>() && set_lds<1>() && set_lds<2>() && set_lds<3>() && set_lds<4>() && set_lds<5>() && set_lds<6>() && set_lds<7>() && set_lds<8>() && set_lds<9>() && set_lds<10>() && set_lds<11>() && set_lds<12>() && set_lds<13>() && set_lds<14>();
    if (!ok) { fprintf(stderr, "kernel_launch: hipFuncSetAttribute failed\n"); grid = -1; return; }
    grid = cus > 0 ? cus : 256;
#else
    if (hipFuncSetAttribute((const void*)k_mega, hipFuncAttributeMaxDynamicSharedMemorySize, LDS_BYTES) != hipSuccess) { fprintf(stderr, "kernel_launch: hipFuncSetAttribute failed\n"); grid = -1; return; }
    int per_cu = 0;
    if (hipOccupancyMaxActiveBlocksPerMultiprocessor(&per_cu, (const void*)k_mega, 512, LDS_BYTES) != hipSuccess || per_cu < 1) { fprintf(stderr, "kernel_launch: occupancy query says %d blocks per CU\n", per_cu); grid = -1; return; }
    grid = (cus > 0 ? cus : 256) * 1;
#endif
  }
  if (grid < 0) return;
  Params p{};
  for (int i = 0; i < 32; ++i) p.in[i] = (const float*)d_in[i];
  p.out = (float*)d_out; p.ws = (unsigned char*)d_ws;
  hipMemsetAsync((char*)d_ws + WS_CTL, 0, 64 * 1024, stream);
#if !MK_FUSED
  launch_ph<PH_PRO>(grid, stream, p);
  launch_ph<PH_LN>(grid, stream, p);
  launch_ph<PH_GIN>(grid, stream, p);
  launch_ph<PH_QK>(grid, stream, p);
  launch_ph<PH_S5S>(grid, stream, p);
  launch_ph<PH_SCAN>(grid, stream, p);
  launch_ph<PH_ATT>(grid, stream, p);
  launch_ph<PH_S5Y>(grid, stream, p);
  launch_ph<PH_G1>(grid, stream, p);
  launch_ph<PH_G2>(grid, stream, p);
  launch_ph<PH_G3>(grid, stream, p);
  launch_ph<PH_RT>(grid, stream, p);
  launch_ph<PH_UP>(grid, stream, p);
  launch_ph<PH_DOWN>(grid, stream, p);
  launch_ph<PH_FIN>(grid, stream, p);
#else
  void* args[] = {&p};
  hipError_t e = hipLaunchCooperativeKernel((const void*)k_mega, dim3(grid), dim3(512), args, LDS_BYTES, stream);
  if (e != hipSuccess) fprintf(stderr, "kernel_launch: cooperative launch failed: %s (grid %d)\n", hipGetErrorString(e), grid);
#endif
}
```

```cpp
#include <hip/hip_runtime.h>
#include <hip/hip_bf16.h>
#include <hip/hip_cooperative_groups.h>
#include <cstdint>
#include <cstdio>

typedef unsigned short bf16_t;
#define LAS __attribute__((address_space(3)))
typedef short bf16x8 __attribute__((ext_vector_type(8)));
typedef float f32x4 __attribute__((ext_vector_type(4)));
typedef float f32x2 __attribute__((ext_vector_type(2)));
typedef unsigned u32x4 __attribute__((ext_vector_type(4)));
typedef unsigned u32x2 __attribute__((ext_vector_type(2)));

__device__ __forceinline__ float bf2f(bf16_t v) { return __uint_as_float(((unsigned)v) << 16); }
__device__ __forceinline__ bf16_t f2bf(float f) { unsigned u = __float_as_uint(f); return (bf16_t)((u + 0x7fffu + ((u >> 16) & 1u)) >> 16); }
__device__ __forceinline__ unsigned cvt_pk_bf16(float lo, float hi) { unsigned r; asm volatile("v_cvt_pk_bf16_f32 %0, %1, %2" : "=v"(r) : "v"(lo), "v"(hi)); return r; }

constexpr int DM = 1024, NB = 2, SEQ = 8192, NCTX = 256;
constexpr int NLAT = NB * SEQ;
constexpr int SKV = SEQ + NCTX;
constexpr int NROW = NB * SKV;
constexpr int INW = 4096;
constexpr int NMOD = 6 * DM;
constexpr int PLD = 3584;
constexpr int PC_Q = 0, PC_K = 1024, PC_V = 1280, PC_G = 1536;
constexpr int NCHUNK = NROW / 16;
constexpr float LN_EPS = 1e-6f;
constexpr float ALPHA = 1.189207115002721f;

constexpr size_t MiB = 1u << 20;
constexpr size_t WS_CTL = 0;
constexpr size_t WS_MOD = 1 * MiB;
constexpr size_t WS_ROUTE = 2 * MiB;
constexpr size_t WS_S5AB = 5 * MiB;
constexpr size_t WS_S5T = 6 * MiB;
constexpr size_t WS_S5E = 14 * MiB;
constexpr size_t WS_WIN = 18 * MiB;
constexpr size_t WS_WGLU = 26 * MiB;
constexpr size_t WS_WAO = 28 * MiB;
constexpr size_t WS_WOUT = 30 * MiB;
constexpr size_t WS_WGU = 32 * MiB;
constexpr size_t WS_WD = 96 * MiB;
constexpr size_t WS_RH = 128 * MiB;
constexpr size_t WS_P = 162 * MiB;
constexpr size_t WS_KC = 280 * MiB;
constexpr size_t WS_VC = WS_KC + (size_t)NB * 2 * SKV * 128 * 2;
constexpr size_t WS_X1B = 268 * MiB;
constexpr size_t WS_END = 300 * MiB;
constexpr size_t DO_YA = 0, DO_GY = 34 * MiB;

struct Params {
  const float* in[32];
  float* out;
  unsigned char* ws;
};
enum { I_X = 0, I_C, I_CTX, I_CCTX, I_WMOD, I_BMOD, I_WIN, I_SARE, I_SAIM, I_SLDT, I_SBRE, I_SBIM, I_SCRE, I_SCIM, I_SD,
       I_WGA, I_WGB, I_QG, I_KG, I_WAO, I_WOUT, I_LN1G, I_LN1B, I_WRG, I_BRG, I_WRE, I_BRE, I_WEG, I_WEU, I_WED, I_LN2G, I_LN2B };

template <int CTRL> __device__ __forceinline__ float dpp_add(float v) { return v + __builtin_bit_cast(float, __builtin_amdgcn_update_dpp(0, __builtin_bit_cast(int, v), CTRL, 0xF, 0xF, false)); }
__device__ __forceinline__ float row16_sum(float v) {
  v = dpp_add<0xB1>(v); v = dpp_add<0x4E>(v); v = dpp_add<0x141>(v); v = dpp_add<0x140>(v); return v; }
__device__ __forceinline__ float wave_sum(float v) {
  v = row16_sum(v);
  { auto rr = __builtin_amdgcn_permlane16_swap(__float_as_uint(v), __float_as_uint(v), false, false); v = __uint_as_float(rr[0]) + __uint_as_float(rr[1]); }
  { auto rr = __builtin_amdgcn_permlane32_swap(__float_as_uint(v), __float_as_uint(v), false, false); v = __uint_as_float(rr[0]) + __uint_as_float(rr[1]); }
  return v;
}
__device__ __forceinline__ float lane_xor4(float x) {
  int t = __builtin_amdgcn_update_dpp(0, __builtin_bit_cast(int, x), 0x104, 0xF, 0x5, false);
  t = __builtin_amdgcn_update_dpp(t, __builtin_bit_cast(int, x), 0x114, 0xF, 0xA, false);
  return __builtin_bit_cast(float, t);
}
__device__ __forceinline__ float sigmoidf_(float x) { return 1.f / (1.f + __expf(-x)); }
__device__ __forceinline__ float siluf_(float x) { return x / (1.f + __expf(-x)); }
__device__ __forceinline__ float gelu_tanh(float x) {
  const float k0 = 0.7978845608028654f, k1 = 0.044715f;
  const float z = k0 * (x + k1 * x * x * x);
  return x / (1.f + __expf(-2.f * z));
}
__device__ __forceinline__ int lat2pad(int lr) { return lr + (lr / SEQ) * NCTX; }

constexpr int NWAVES = 8;
constexpr int LDS_STAGE = 131072;
constexpr int LDS_BYTES = 147456;


constexpr int LDS_WIDTAB = LDS_STAGE + 15872;
__device__ __forceinline__ unsigned hw_wave_slot() { return (unsigned)__builtin_amdgcn_s_getreg(((6 - 1) << 11) | 4) & 63u; }
__device__ __forceinline__ int opaque_tid() {
  extern __shared__ __attribute__((aligned(16))) unsigned char lds_dyn_[];
  const int wv = __builtin_amdgcn_readfirstlane(((const volatile LAS int*)((LAS unsigned char*)lds_dyn_ + LDS_WIDTAB))[hw_wave_slot()]);
  unsigned m = ~0u; asm volatile("" : "+s"(m));
  int t = (wv << 6) | (int)__builtin_amdgcn_mbcnt_hi(m, __builtin_amdgcn_mbcnt_lo(m, 0u));
  asm volatile("" : "+v"(t)); return t;
}
__device__ __forceinline__ void tid_table_init() {
  extern __shared__ __attribute__((aligned(16))) unsigned char lds_dyn_[];
  if ((threadIdx.x & 63) == 0) ((volatile LAS int*)((LAS unsigned char*)lds_dyn_ + LDS_WIDTAB))[hw_wave_slot()] = (int)(threadIdx.x >> 6);
}

#ifndef MK_TS_PHASE
#define MK_TS_PHASE -1
#endif
#ifndef MK_TS_SCALE
#define MK_TS_SCALE 5.0e-8f
#endif
constexpr int CTL_TS = 3072;
#ifndef MK_CTX_IN_P1
#define MK_CTX_IN_P1 0
#endif
#ifndef MK_N1_NUM
#define MK_N1_NUM 4
#define MK_N1_DEN 5
#endif
#ifndef MK_LN_IN_PRO
#define MK_LN_IN_PRO 0
#endif
#ifndef MK_CTX_IN_PRO
#define MK_CTX_IN_PRO 0
#endif
constexpr int NCTXB = 8;
constexpr int CTL_CTXCNT = 2176;
constexpr int CTL_MODCNT = 2304, CTL_WINCNT = 2368;
#ifndef MK_MMA_PRIO
#define MK_MMA_PRIO 1
#endif
#ifndef MK_EARLY_DOWN
#define MK_EARLY_DOWN 0
#endif
#ifndef MK_WARM_G2
#define MK_WARM_G2 0
#endif
#ifndef MK_S5_IN_P3
#define MK_S5_IN_P3 0
#endif
#ifndef MK_MOE_HALF
#define MK_MOE_HALF 1
#endif
namespace pg {
constexpr int BM = 256, BK = 64, HALF = 128, HTB = HALF * BK * 2, STAGE_BYTES = 8 * HTB;
__host__ __device__ __forceinline__ int lds_byte(int r, int c) { const int st = (r >> 4) * 2 + (c >> 5), rr = r & 15, cc = c & 31, ob = rr * 64 + cc * 2; return st * 1024 + (ob ^ (((ob >> 9) & 1) << 5)); }
__host__ __device__ __forceinline__ void stage_rc(int b, int& R, int& C) { const int st = b / 1024, sb = b % 1024, swz = sb ^ (((sb >> 9) & 1) << 5); R = (st >> 1) * 16 + swz / 64; C = (st & 1) * 32 + (swz % 64) / 2; }
__host__ __device__ __forceinline__ int perm32(int rho) { const int n = rho >> 4, i = rho & 15; return 8 * (i >> 2) + 4 * n + (i & 3); }

struct Unit { int pm, pn, aux, arow, half; };
struct Addr {
  const bf16_t* A; int lda; size_t a_gs; const bf16_t* Bt; int K; size_t b_gs;
  bool gather;
  __device__ __forceinline__ const char* a_base(const Unit& u) const { return gather ? (const char*)A : (const char*)(A + (size_t)u.aux * a_gs + (size_t)u.arow * lda); }
  __device__ __forceinline__ const char* b_base(const Unit& u) const { return (const char*)(Bt + (size_t)u.aux * b_gs + (size_t)u.pn * BM * K); }
};
typedef f32x4 Acc[2][2][4][2];

template <class Epi, class Sched>
__device__ __forceinline__ void gemm_phase(LAS unsigned char* lds, const Addr AD, const Sched& S, const Epi& E) {
  const int tid = opaque_tid(), wid = __builtin_amdgcn_readfirstlane(tid >> 6), lane = tid & 63, wr = wid >> 2, wc = wid & 3, fr = lane & 15, fq = lane >> 4;
  int K_ = AD.K; asm volatile("" : "+s"(K_));
  const int K = K_, nt = K / BK, lda = AD.lda;
  int R0, C0; stage_rc(tid * 16, R0, C0);
  const unsigned voffB0 = (unsigned)(((Epi::PERM ? ((R0 & ~31) + perm32(R0 & 31)) : R0)) * K + C0) * 2u;
  const size_t pstepB = (size_t)64 * K * 2, pstepA = (size_t)64 * lda * 2, hstepA = (size_t)HALF * lda * 2;
  unsigned vA[2][2];
  const unsigned voffA0 = (unsigned)(R0 * lda + C0) * 2u;
#define PG_SETV(v, u) do { if constexpr (Sched::GATHER) { _Pragma("unroll") for (int _h = 0; _h < 2; ++_h) _Pragma("unroll") for (int _i = 0; _i < 2; ++_i) \
    v[_h][_i] = (unsigned)(S.arow(u, _h * HALF + _i * 64 + R0) * lda + C0) * 2u; } } while (0)
  const size_t kstep = (size_t)(BK * 2);
  const size_t hstepB = (size_t)HALF * K * 2;
  const unsigned ldsw = (unsigned)wid * 1024u;
  const int aoff = lds_byte(wr * 64 + fr, fq * 8), boff = lds_byte(wc * 32 + fr, fq * 8);
#define PG_SA(b, h) (((b) * 2 + (h)) * HTB)
#define PG_SB(b, h) ((4 + (b) * 2 + (h)) * HTB)
#define PG_STAGE_B(bufoff, gbase) do { _Pragma("unroll") for (int _i = 0; _i < 2; ++_i) { unsigned _vo = voffB0; asm volatile("" : "+v"(_vo)); \
    __builtin_amdgcn_global_load_lds((const unsigned*)((const char*)(gbase) + _i * pstepB + _vo), (LAS unsigned*)(lds + (bufoff) + ldsw + _i * 8192), 16, 0, 0); } } while (0)
#define PG_STAGE_A(b, h, gbase, V) do { _Pragma("unroll") for (int _i = 0; _i < 2; ++_i) { \
    if constexpr (Sched::GATHER) { unsigned _vo = V[h][_i]; asm volatile("" : "+v"(_vo)); __builtin_amdgcn_global_load_lds((const unsigned*)((const char*)(gbase) + _vo), (LAS unsigned*)(lds + PG_SA(b, h) + ldsw + _i * 8192), 16, 0, 0); } \
    else { unsigned _vo = voffA0; asm volatile("" : "+v"(_vo)); __builtin_amdgcn_global_load_lds((const unsigned*)((const char*)(gbase) + (h) * hstepA + _i * pstepA + _vo), (LAS unsigned*)(lds + PG_SA(b, h) + ldsw + _i * 8192), 16, 0, 0); } } } while (0)
#define PG_LDA(dst, b, h) do { _Pragma("unroll") for (int m = 0; m < 4; ++m) _Pragma("unroll") for (int k = 0; k < 2; ++k) dst[m][k] = *(const LAS bf16x8*)(lds + PG_SA(b, h) + aoff + m * 2048 + k * 1024); } while (0)
#define PG_LDB(dst, b, h) do { _Pragma("unroll") for (int n = 0; n < 2; ++n) _Pragma("unroll") for (int k = 0; k < 2; ++k) dst[n][k] = *(const LAS bf16x8*)(lds + PG_SB(b, h) + boff + n * 2048 + k * 1024); } while (0)
#define PG_MMA(ai, bj, At, Bt) do { __builtin_amdgcn_s_setprio(1); _Pragma("unroll") for (int m = 0; m < 4; ++m) _Pragma("unroll") for (int n = 0; n < 2; ++n) _Pragma("unroll") for (int k = 0; k < 2; ++k) \
    acc[ai][bj][m][n] = __builtin_amdgcn_mfma_f32_16x16x32_bf16(Bt[n][k], At[m][k], acc[ai][bj][m][n], 0, 0, 0); __builtin_amdgcn_s_setprio(0); } while (0)
#define PG_WAIT_V(n) asm volatile("s_waitcnt vmcnt(" #n ")" ::: "memory")
#define PG_WAIT_L(n) asm volatile("s_waitcnt lgkmcnt(" #n ")" ::: "memory")
#define PG_BAR __builtin_amdgcn_s_barrier()
#define PG_SCHED __builtin_amdgcn_sched_barrier(0)
  Unit cur, nxt; int ui = 0;
  if (!S.next(0, cur)) return;
  Acc acc;
#pragma unroll
  for (int a = 0; a < 2; ++a)
#pragma unroll
    for (int b = 0; b < 2; ++b)
#pragma unroll
      for (int m = 0; m < 4; ++m)
#pragma unroll
        for (int n = 0; n < 2; ++n) acc[a][b][m][n] = (f32x4){0.f, 0.f, 0.f, 0.f};
  bf16x8 At[4][2], B0[2][2], B1[2][2];
  const char* cA = AD.a_base(cur); const char* cB = AD.b_base(cur);
  PG_SETV(vA, cur);
  PG_STAGE_B(PG_SB(0, 0), cB); PG_STAGE_B(PG_SB(0, 1), cB + hstepB); PG_STAGE_A(0, 0, cA, vA); PG_STAGE_A(0, 1, cA, vA);
  if (wr == 1) PG_BAR;
  PG_WAIT_V(2); PG_BAR;
  PG_STAGE_B(PG_SB(1, 0), cB + kstep); PG_STAGE_A(1, 0, cA + kstep, vA); PG_STAGE_B(PG_SB(1, 1), cB + hstepB + kstep);
  PG_WAIT_V(6); PG_BAR;
#define PG_MMA1() do { if constexpr (Sched::HALF) { if (!cur.half) { PG_MMA(1, 0, At, B0); PG_MMA(1, 1, At, B1); } } else { PG_MMA(1, 0, At, B0); PG_MMA(1, 1, At, B1); } } while (0)
#define PG_KPAIR(a1, a2, b2, a3, b3, VN) do { \
      PG_LDB(B0, 0, 0); PG_LDB(B1, 0, 1); PG_SCHED; PG_LDA(At, 0, 0); PG_STAGE_A(1, 1, a1, vA); \
      PG_WAIT_V(8); PG_WAIT_L(0); PG_BAR; PG_MMA(0, 0, At, B0); PG_MMA(0, 1, At, B1); PG_BAR; PG_SCHED; \
      PG_LDA(At, 0, 1); PG_STAGE_B(PG_SB(0, 0), b2); PG_STAGE_B(PG_SB(0, 1), (b2) + hstepB); PG_STAGE_A(0, 0, a2, VN); \
      PG_WAIT_V(8); PG_WAIT_L(0); PG_BAR; PG_MMA1(); PG_BAR; PG_SCHED; \
      PG_LDB(B0, 1, 0); PG_LDB(B1, 1, 1); PG_SCHED; PG_LDA(At, 1, 0); PG_STAGE_A(0, 1, a2, VN); \
      PG_WAIT_V(8); PG_WAIT_L(0); PG_BAR; PG_MMA(0, 0, At, B0); PG_MMA(0, 1, At, B1); PG_BAR; PG_SCHED; \
      PG_LDA(At, 1, 1); PG_STAGE_B(PG_SB(1, 0), b3); PG_STAGE_B(PG_SB(1, 1), (b3) + hstepB); PG_STAGE_A(1, 0, a3, VN); \
      PG_WAIT_V(8); PG_WAIT_L(0); PG_BAR; PG_MMA1(); PG_BAR; PG_SCHED; } while (0)
  for (;;) {
    const bool has_next = S.next(ui + 1, nxt);
    const char* nA = has_next ? AD.a_base(nxt) : cA; const char* nB = has_next ? AD.b_base(nxt) : cB;
    if constexpr (Sched::GATHER) {
      unsigned vT[2][2];
      if (has_next) PG_SETV(vT, nxt); else {
#pragma unroll
        for (int _h = 0; _h < 2; ++_h)
#pragma unroll
          for (int _i = 0; _i < 2; ++_i) vT[_h][_i] = vA[_h][_i]; }
      *(LAS u32x4*)(lds + STAGE_BYTES + 2048 + tid * 16) = (u32x4){vT[0][0], vT[0][1], vT[1][0], vT[1][1]};
    }
    if constexpr (Sched::GATHER) {
      for (int t = 0; t < nt - 2; t += 2) {
        const char* a1 = cA + (size_t)(t + 1) * kstep; const char* a2 = cA + (size_t)(t + 2) * kstep; const char* b2 = cB + (size_t)(t + 2) * kstep;
        PG_KPAIR(a1, a2, b2, a2 + kstep, b2 + kstep, vA);
      }
      { const char* a1 = cA + (size_t)(nt - 1) * kstep;
        const u32x4 q = *(const LAS u32x4*)(lds + STAGE_BYTES + 2048 + tid * 16);
        unsigned vAn[2][2] = {{q.x, q.y}, {q.z, q.w}};
        PG_KPAIR(a1, nA, nB, nA + kstep, nB + kstep, vAn);
#pragma unroll
        for (int _h = 0; _h < 2; ++_h)
#pragma unroll
          for (int _i = 0; _i < 2; ++_i) vA[_h][_i] = vAn[_h][_i]; }
    } else {
      for (int t = 0; t < nt; t += 2) {
        const bool last = (t == nt - 2);
        const char* a1 = cA + (size_t)(t + 1) * kstep;
        const char* a2 = last ? nA : cA + (size_t)(t + 2) * kstep; const char* b2 = last ? nB : cB + (size_t)(t + 2) * kstep;
        PG_KPAIR(a1, a2, b2, a2 + kstep, b2 + kstep, vA);
      }
    }
    if (wr == 0) PG_BAR;
    E(acc, cur, wr, wc, fr, fq);
    if constexpr (Sched::HAS_DONE) S.done(cur, lane);
    if (!has_next) break;
#pragma unroll
    for (int a = 0; a < 2; ++a)
#pragma unroll
      for (int b = 0; b < 2; ++b)
#pragma unroll
        for (int m = 0; m < 4; ++m)
#pragma unroll
          for (int n = 0; n < 2; ++n) acc[a][b][m][n] = (f32x4){0.f, 0.f, 0.f, 0.f};
    cur = nxt; cA = nA; cB = nB; ++ui;
    if (wr == 1) PG_BAR;
  }
  PG_WAIT_V(0);
  PG_BAR;
#undef PG_MMA1
#undef PG_SETV
#undef PG_KPAIR
#undef PG_SA
#undef PG_SB
#undef PG_STAGE_A
#undef PG_STAGE_B
#undef PG_LDA
#undef PG_LDB
#undef PG_MMA
#undef PG_WAIT_V
#undef PG_WAIT_L
#undef PG_BAR
#undef PG_SCHED
}
}
namespace att {
using bf16x8 = __attribute__((ext_vector_type(8))) short;
using s16x4 = __attribute__((ext_vector_type(4))) short;
using f32x16 = __attribute__((ext_vector_type(16))) float;
using u32x4 = __attribute__((ext_vector_type(4))) unsigned;
constexpr int D = 128, NW = 8, QBLK = 32, KVBLK = 64;
constexpr float SCALE = 0.088388347648318440f;
constexpr float THR = 8.f;
constexpr int LDQ = PLD, LDK = 128, LDO = PLD;
constexpr int NRING = 3;
constexpr size_t SHM_V = KVBLK * D * 2, SHM_K = KVBLK * D * 2, SHM_ATTN = NRING * SHM_V + NRING * SHM_K + NW * 64 * 4;
constexpr float ROPE_C8[8] = {1.0f, 0.74989421f, 0.56234133f, 0.42169650f, 0.31622777f, 0.23713737f, 0.17782794f, 0.13335214f};
#define KSWZ(row, colB) ((row) * 256 + ((colB) ^ (((row) & 7) << 4)))
#define SBAR() __builtin_amdgcn_sched_barrier(0)
__device__ __forceinline__ int crow(int r, int hi) { return (r & 3) + 8 * (r >> 2) + 4 * hi; }
__device__ __forceinline__ unsigned cvtpk(float lo, float hi) { unsigned r; asm volatile("v_cvt_pk_bf16_f32 %0, %1, %2" : "=v"(r) : "v"(lo), "v"(hi)); return r; }
__device__ __forceinline__ void partialSM(f32x16& p0, f32x16& p1, float& m_reg, float& mn, float& alpha) {
  constexpr float C = SCALE * 1.4426950408889634f;
  float pmax = m_reg; asm volatile("" : "+v"(pmax));
  if (__builtin_expect(__all(pmax - m_reg <= THR / SCALE), 1)) { mn = m_reg; }
  else { mn = fmaxf(m_reg, pmax); m_reg = mn; }
  float mnC = -mn * C;
  for (int r = 0; r < 16; ++r) p0[r] = fmaf(p0[r], C, mnC); for (int r = 0; r < 16; ++r) p1[r] = fmaf(p1[r], C, mnC);
  for (int r = 0; r < 16; ++r) p0[r] = __builtin_amdgcn_exp2f(p0[r]);
}
__device__ __forceinline__ void finishSM(f32x16& p0, f32x16& p1, float alpha, float& l_reg, bf16x8& pa0, bf16x8& pa1, bf16x8& pa2, bf16x8& pa3) {
  for (int r = 0; r < 16; ++r) p1[r] = __builtin_amdgcn_exp2f(p1[r]);
  float ps = 0; for (int r = 0; r < 16; ++r) ps += p0[r]; for (int r = 0; r < 16; ++r) ps += p1[r];
  { auto rr = __builtin_amdgcn_permlane32_swap(__float_as_uint(ps), __float_as_uint(ps), false, false);
    ps = __uint_as_float(rr[0]) + __uint_as_float(rr[1]); }
  l_reg += ps;
#define PK4(P, BASE, OUT) do { unsigned a0 = cvtpk(P[BASE + 0], P[BASE + 1]), a1 = cvtpk(P[BASE + 2], P[BASE + 3]);   \
    unsigned b0 = cvtpk(P[BASE + 4], P[BASE + 5]), b1 = cvtpk(P[BASE + 6], P[BASE + 7]);                              \
    auto r0 = __builtin_amdgcn_permlane32_swap(a0, b0, false, false); auto r1 = __builtin_amdgcn_permlane32_swap(a1, b1, false, false); \
    u32x4 w = {r0[0], r1[0], r0[1], r1[1]}; OUT = *reinterpret_cast<bf16x8*>(&w); } while (0)
  PK4(p0, 0, pa0); PK4(p0, 8, pa1); PK4(p1, 0, pa2); PK4(p1, 8, pa3);
#undef PK4
}
__device__ __forceinline__ void qkt(f32x16& p0, f32x16& p1, const bf16_t* Ks, const bf16x8* qr, int r32, int hi) {
  p0 = f32x16{}; p1 = f32x16{};
  for (int d0 = 0; d0 < 8; ++d0) { int cb = (d0 * 16 + hi * 8) * 2;
    bf16x8 b0 = *reinterpret_cast<const bf16x8*>((const char*)Ks + KSWZ(r32, cb));
    bf16x8 b1 = *reinterpret_cast<const bf16x8*>((const char*)Ks + KSWZ(32 + r32, cb));
    p0 = __builtin_amdgcn_mfma_f32_32x32x16_bf16(b0, qr[d0], p0, 0, 0, 0);
    p1 = __builtin_amdgcn_mfma_f32_32x32x16_bf16(b1, qr[d0], p1, 0, 0, 0); }
}
__device__ __forceinline__ int v_st(int k, int c) { const int kk = (k & ~0xC) | ((k & 4) << 1) | ((k & 8) >> 1); return ((kk >> 3) * 4 + (c >> 5)) * 512 + ((kk & 7) * 32 + (c & 31)) * 2; }
__device__ __forceinline__ int v_rd_base(int lane) { return ((lane & 3) << 3) | (((lane >> 2) & 3) << 6) | (((lane >> 4) & 1) << 5) | (((lane >> 5) & 1) << 8); }
constexpr int v_rd_off(int d0, int ks, int half) { return d0 * 512 + ks * 4096 + half * 2048; }
template <int OFF> __device__ __forceinline__ s16x4 tr_read(int vb) {
  s16x4 r; asm volatile("ds_read_b64_tr_b16 %0, %1 offset:%2" : "=&v"(r) : "v"(vb), "i"(OFF) : "memory"); return r;
}
template <int D0> __device__ __forceinline__ void pv_one(f32x16& od, int vb, bf16x8 pa0, bf16x8 pa1, bf16x8 pa2, bf16x8 pa3) {
  const s16x4 l0 = tr_read<v_rd_off(D0, 0, 0)>(vb), h0 = tr_read<v_rd_off(D0, 0, 1)>(vb), l1 = tr_read<v_rd_off(D0, 1, 0)>(vb), h1 = tr_read<v_rd_off(D0, 1, 1)>(vb);
  const s16x4 l2 = tr_read<v_rd_off(D0, 2, 0)>(vb), h2 = tr_read<v_rd_off(D0, 2, 1)>(vb), l3 = tr_read<v_rd_off(D0, 3, 0)>(vb), h3 = tr_read<v_rd_off(D0, 3, 1)>(vb);
  asm volatile("s_waitcnt lgkmcnt(0)" ::: "memory"); SBAR();
#define PK(L, H) (bf16x8){L[0], L[1], L[2], L[3], H[0], H[1], H[2], H[3]}
  od = __builtin_amdgcn_mfma_f32_32x32x16_bf16(pa0, PK(l0, h0), od, 0, 0, 0);
  od = __builtin_amdgcn_mfma_f32_32x32x16_bf16(pa1, PK(l1, h1), od, 0, 0, 0);
  od = __builtin_amdgcn_mfma_f32_32x32x16_bf16(pa2, PK(l2, h2), od, 0, 0, 0);
  od = __builtin_amdgcn_mfma_f32_32x32x16_bf16(pa3, PK(l3, h3), od, 0, 0, 0);
#undef PK
}
__device__ __forceinline__ void pv_d0(f32x16* o, int vb, bf16x8 pa0, bf16x8 pa1, bf16x8 pa2, bf16x8 pa3) {
  pv_one<0>(o[0], vb, pa0, pa1, pa2, pa3); pv_one<1>(o[1], vb, pa0, pa1, pa2, pa3); pv_one<2>(o[2], vb, pa0, pa1, pa2, pa3); pv_one<3>(o[3], vb, pa0, pa1, pa2, pa3);
}
__device__ __forceinline__ void attn_dense_body(const bf16_t* __restrict__ Qb, const bf16_t* __restrict__ Kh, const bf16_t* __restrict__ Vh, bf16_t* __restrict__ Ob, int seq, float mbound, const float* __restrict__ qgain, int t0, char* lds) {
  const int tid = opaque_tid(), wid = tid >> 6, lane = tid & 63, r32 = lane & 31, hi = lane >> 5;
  bf16_t* V_lds = (bf16_t*)lds; bf16_t* K_lds = (bf16_t*)(lds + NRING * SHM_V);
  float* ws = (float*)(lds + NRING * SHM_V + NRING * SHM_K) + wid * 64; float* li_l = ws; float* al_l = ws + 32;
  float m_reg = mbound, l_reg = 0; f32x16 o[4]; bf16x8 qr[8];
  const bf16_t* Qw = Qb + (long)(wid * QBLK + r32) * LDQ + hi * 8;
#pragma unroll
  for (int d0 = 0; d0 < 8; ++d0) qr[d0] = *reinterpret_cast<const bf16x8*>(Qw + d0 * 16);
  {
#define UNPK8(W, X) do { X[0] = __uint_as_float(W.x << 16); X[1] = __uint_as_float(W.x & 0xffff0000u); X[2] = __uint_as_float(W.y << 16); X[3] = __uint_as_float(W.y & 0xffff0000u); \
                         X[4] = __uint_as_float(W.z << 16); X[5] = __uint_as_float(W.z & 0xffff0000u); X[6] = __uint_as_float(W.w << 16); X[7] = __uint_as_float(W.w & 0xffff0000u); } while (0)
    char* qs = lds + wid * 8192 + lane * 16;
    float ss = 0.f;
#pragma unroll
    for (int d0 = 0; d0 < 8; ++d0) { const u32x4 w = *reinterpret_cast<const u32x4*>(&qr[d0]); float x[8]; UNPK8(w, x);
#pragma unroll
      for (int j = 0; j < 8; ++j) ss += x[j] * x[j];
      *(u32x4*)(qs + d0 * 1024) = w; }
    { auto rr = __builtin_amdgcn_permlane32_swap(__float_as_uint(ss), __float_as_uint(ss), false, false); ss = __uint_as_float(rr[0]) + __uint_as_float(rr[1]); }
    const float rn = rsqrtf(ss * (1.f / 128.f) + 1e-6f);
    const int tq = t0 + wid * QBLK + r32;
#pragma unroll 1
    for (int it = 0; it < 4; ++it) { const int ax = it >> 1, d = it & 1, da = 4 * ax + d, db = da + 2;
      const float ph = (ax == 0 ? (float)(tq >> 6) : (float)(tq & 63)) * (hi ? 0.1f : 1.f) * (d ? 0.01f : 1.f);
      const u32x4 wa = *(const u32x4*)(qs + da * 1024), wb = *(const u32x4*)(qs + db * 1024);
      float xa[8], xb[8]; UNPK8(wa, xa); UNPK8(wb, xb);
      const f32x4 ga0 = *(const f32x4*)(qgain + 16 * da + 8 * hi), ga1 = *(const f32x4*)(qgain + 16 * da + 8 * hi + 4), gb0 = *(const f32x4*)(qgain + 16 * db + 8 * hi), gb1 = *(const f32x4*)(qgain + 16 * db + 8 * hi + 4);
      const float ga[8] = {ga0.x, ga0.y, ga0.z, ga0.w, ga1.x, ga1.y, ga1.z, ga1.w}, gb[8] = {gb0.x, gb0.y, gb0.z, gb0.w, gb1.x, gb1.y, gb1.z, gb1.w};
#pragma unroll
      for (int j = 0; j < 8; ++j) { const float ang = ph * ROPE_C8[j];
        const float sn = __sinf(ang), cs = __cosf(ang);
        const float x1 = xa[j] * rn * ga[j], x2 = xb[j] * rn * gb[j];
        xa[j] = x1 * cs - x2 * sn; xb[j] = x1 * sn + x2 * cs; }
      *(u32x4*)(qs + da * 1024) = (u32x4){cvtpk(xa[0], xa[1]), cvtpk(xa[2], xa[3]), cvtpk(xa[4], xa[5]), cvtpk(xa[6], xa[7])};
      *(u32x4*)(qs + db * 1024) = (u32x4){cvtpk(xb[0], xb[1]), cvtpk(xb[2], xb[3]), cvtpk(xb[4], xb[5]), cvtpk(xb[6], xb[7])}; }
#pragma unroll
    for (int d0 = 0; d0 < 8; ++d0) qr[d0] = *reinterpret_cast<const bf16x8*>(qs + d0 * 1024);
    asm volatile("s_waitcnt lgkmcnt(0)" ::: "memory");
    __syncthreads();
#undef UNPK8
  }
  SBAR();
#pragma unroll
  for (int d = 0; d < 4; ++d) o[d] = f32x16{};
  SBAR();
  const int sr = tid >> 4, sc = (tid & 15) * 8, vst0 = v_st(sr, sc), vst1 = v_st(32 + sr, sc);
  const int vb0 = (int)(uintptr_t)V_lds + v_rd_base(lane);
  struct { bf16x8 vs0, vs1, ks0, ks1; } sr_[2];
#define SLOAD(i, k0) do { sr_[i].vs0 = *(const bf16x8*)(&Vh[(long)((k0) + sr) * LDK + sc]); sr_[i].vs1 = *(const bf16x8*)(&Vh[(long)((k0) + 32 + sr) * LDK + sc]); \
    sr_[i].ks0 = *(const bf16x8*)(&Kh[(long)((k0) + sr) * LDK + sc]); sr_[i].ks1 = *(const bf16x8*)(&Kh[(long)((k0) + 32 + sr) * LDK + sc]); } while (0)
#define SWRITE(b, i) do { *(bf16x8*)((char*)V_lds + (b) * SHM_V + vst0) = sr_[i].vs0;          \
    *(bf16x8*)((char*)V_lds + (b) * SHM_V + vst1) = sr_[i].vs1; int kc = sc * 2;               \
    *(bf16x8*)((char*)K_lds + (b) * SHM_K + KSWZ(sr, kc)) = sr_[i].ks0;                       \
    *(bf16x8*)((char*)K_lds + (b) * SHM_K + KSWZ(32 + sr, kc)) = sr_[i].ks1; } while (0)
#define SWAIT() asm volatile("s_waitcnt vmcnt(4)" ::: "memory")
#define RESC(a) do { if (__any((a) < 1.f)) { if (hi == 0) al_l[r32] = (a); asm volatile("s_waitcnt lgkmcnt(0)" ::: "memory"); \
    for (int d = 0; d < 4; ++d) for (int r = 0; r < 16; ++r) o[d][r] *= al_l[crow(r, hi)]; } } while (0)
  f32x16 pA0, pA1, pB0, pB1; float mnA, mnB, alA, alB; bf16x8 pa0, pa1, pa2, pa3; const int NT = seq / KVBLK;
#define KRING(b) ((bf16_t*)((char*)K_lds + (b) * SHM_K))
#define ATT_STEP(PC0, PC1, MNC, ALC, PP0, PP1, ALP, KB, VBP, WB, SLW, SLL, TLOAD, DO_LOAD, DO_WRITE, WAIT0) do { \
    SBAR(); qkt(PC0, PC1, KRING(KB), qr, r32, hi); \
    finishSM(PP0, PP1, ALP, l_reg, pa0, pa1, pa2, pa3); SBAR(); \
    if (DO_LOAD) SLOAD(SLL, (TLOAD) * KVBLK); SBAR(); \
    pv_d0(o, vb0 + (VBP) * (int)SHM_V, pa0, pa1, pa2, pa3); partialSM(PC0, PC1, m_reg, MNC, ALC); \
    if (DO_WRITE) { if (WAIT0) asm volatile("s_waitcnt vmcnt(0)" ::: "memory"); else SWAIT(); SWRITE(WB, SLW); } \
    __syncthreads(); } while (0)
#define STEP_B(t, KB, VBP, WB, DL, DW, W0) ATT_STEP(pB0, pB1, mnB, alB, pA0, pA1, alA, KB, VBP, WB, 0, 1, (t) + 2, DL, DW, W0)
#define STEP_A(t, KB, VBP, WB, DL, DW, W0) ATT_STEP(pA0, pA1, mnA, alA, pB0, pB1, alB, KB, VBP, WB, 1, 0, (t) + 2, DL, DW, W0)
  SLOAD(0, 0); SLOAD(1, KVBLK); SWAIT(); SWRITE(0, 0); __syncthreads();
  SLOAD(0, 2 * KVBLK);
  qkt(pA0, pA1, KRING(0), qr, r32, hi); partialSM(pA0, pA1, m_reg, mnA, alA);
  SWAIT(); SWRITE(1, 1); __syncthreads();
  int t = 1, r0 = 0, r1 = 1, r2 = 2;
#define ATT_STEPR(PC0, PC1, MNC, ALC, PP0, PP1, ALP, SLW, SLL, DO_LOAD, DO_WRITE, WAIT0) do { \
    SBAR(); qkt(PC0, PC1, (bf16_t*)((char*)K_lds + r1 * (int)SHM_K), qr, r32, hi); \
    finishSM(PP0, PP1, ALP, l_reg, pa0, pa1, pa2, pa3); SBAR(); \
    if (DO_LOAD) SLOAD(SLL, (t + 2) * KVBLK); SBAR(); \
    pv_d0(o, vb0 + r0 * (int)SHM_V, pa0, pa1, pa2, pa3); partialSM(PC0, PC1, m_reg, MNC, ALC); \
    if (DO_WRITE) { if (WAIT0) asm volatile("s_waitcnt vmcnt(0)" ::: "memory"); else SWAIT(); SWRITE(r2, SLW); } \
    __syncthreads(); { const int _r = r0; r0 = r1; r1 = r2; r2 = _r; } ++t; } while (0)
#define STEPR_B(DL, DW, W0) ATT_STEPR(pB0, pB1, mnB, alB, pA0, pA1, alA, 0, 1, DL, DW, W0)
#define STEPR_A(DL, DW, W0) ATT_STEPR(pA0, pA1, mnA, alA, pB0, pB1, alB, 1, 0, DL, DW, W0)
  while (t + 3 < NT) { STEPR_B(true, true, false); STEPR_A(true, true, false); }
  STEPR_B(true, true, false);
  STEPR_A(false, true, true);
  STEPR_B(false, false, false);
  finishSM(pB0, pB1, alB, l_reg, pa0, pa1, pa2, pa3); SBAR();
  pv_d0(o, vb0 + r0 * (int)SHM_V, pa0, pa1, pa2, pa3);
#undef ATT_STEPR
#undef STEPR_A
#undef STEPR_B
#undef KRING
#undef ATT_STEP
#undef STEP_A
#undef STEP_B
  if (hi == 0) li_l[r32] = l_reg; asm volatile("s_waitcnt lgkmcnt(0)" ::: "memory");
  float rli[16];
#pragma unroll
  for (int r = 0; r < 16; ++r) rli[r] = __builtin_amdgcn_rcpf(li_l[crow(r, hi)]);
  int lane_e = lane; asm volatile("" : "+v"(lane_e));
  const int r32e = lane_e & 31, hie = lane_e >> 5;
  bf16_t* Ow = Ob + (long)(wid * QBLK) * LDO;
#pragma unroll
  for (int r = 0; r < 16; ++r) { int orow = crow(r, hie);
    for (int d0 = 0; d0 < 4; ++d0) Ow[(long)orow * LDO + d0 * 32 + r32e] = f2bf(o[d0][r] * rli[r]); }
  __syncthreads();
#undef SLOAD
#undef SWRITE
#undef SWAIT
#undef RESC
}
}

#define XB_TMO      128
#define XB_XCNT(j)  (256  + 64 * (j))
#define XB_XSUB(j)  (1280 + 64 * (j))
#define XB_XGEN(j)  (2304 + 64 * (j))
#define XB_TOP      3328
#define XB_TOPGEN   3392
#define XCD_BAR_WORDS 3456
#define XB_SPIN_CAP (1u << 18)

__device__ __forceinline__ unsigned xb_ld(unsigned* p)              { return __hip_atomic_load(p, __ATOMIC_RELAXED, __HIP_MEMORY_SCOPE_AGENT); }
__device__ __forceinline__ unsigned xb_add(unsigned* p, unsigned v) { return __hip_atomic_fetch_add(p, v, __ATOMIC_RELAXED, __HIP_MEMORY_SCOPE_AGENT); }
__device__ __forceinline__ unsigned xb_xcc_id() { return (unsigned)__builtin_amdgcn_s_getreg((3 << 11) | 20) & 0xFu; }
#define XB_SPIN(cond, bar) do { unsigned _sp = 0; while (cond) { __builtin_amdgcn_s_sleep(1); \
    if ((++_sp & 255u) == 0u) { if (xb_ld(&(bar)[XB_TMO])) break; if (_sp > XB_SPIN_CAP) { atomicAdd(&(bar)[XB_TMO], 1u); break; } } } } while (0)

struct XcdBarrier {
    unsigned* bar; unsigned x;
    volatile LAS unsigned* st;
};

__device__ __forceinline__ XcdBarrier xcd_barrier_post(unsigned* bar, volatile LAS unsigned* st) {
    XcdBarrier b; b.bar = bar; b.x = (unsigned)__builtin_amdgcn_readfirstlane((int)xb_xcc_id()); b.st = st;
    if (opaque_tid() == 0) (void)xb_add(&bar[XB_XCNT(b.x)], 1u);
    return b;
}
__device__ __forceinline__ void xcd_barrier_complete(unsigned* bar, unsigned x, unsigned& nloc, unsigned& nx) {
    const unsigned G = gridDim.x * gridDim.y * gridDim.z;
    unsigned sum, cnt, mine, sp = 0u;
    for (;;) {
        sum = 0u; cnt = 0u; mine = 0u;
#pragma unroll 1
        for (unsigned j = 0; j < 16; ++j) { const unsigned c = xb_ld(&bar[XB_XCNT(j)]); sum += c; cnt += (c > 0u) ? 1u : 0u; mine = (j == x) ? c : mine; }
        if (sum == G) break;
        __builtin_amdgcn_s_sleep(1);
        if ((++sp & 255u) == 0u) { if (xb_ld(&bar[XB_TMO])) break; if (sp > XB_SPIN_CAP) { atomicAdd(&bar[XB_TMO], 1u); break; } }
    }
    nloc = mine > 0u ? mine : 1u; nx = cnt > 0u ? cnt : 1u;
}

__device__ __forceinline__ void xcd_barrier(const XcdBarrier& b) {
    asm volatile("s_waitcnt vmcnt(0)" ::: "memory");
    __syncthreads();
    if (opaque_tid() == 0) {
        unsigned* bar = b.bar; unsigned bx = b.x; asm volatile("" : "+s"(bx));
        __builtin_amdgcn_s_waitcnt(0);
        unsigned nloc = b.st[0], nx = b.st[1];
        if (nloc == 0u) { xcd_barrier_complete(bar, bx, nloc, nx); b.st[0] = nloc; b.st[1] = nx; }
        const unsigned old = xb_add(&bar[XB_XSUB(bx)], 1u);
        const unsigned gen = old / nloc;
        if (old + 1u == (gen + 1u) * nloc) {
            __builtin_amdgcn_fence(__ATOMIC_RELEASE, "agent");
            asm volatile("s_waitcnt vmcnt(0)" ::: "memory");
            const unsigned og = xb_add(&bar[XB_TOP], 1u);
            const unsigned tg = og / nx;
            if (og + 1u == (tg + 1u) * nx) xb_add(&bar[XB_TOPGEN], 1u);
            else XB_SPIN(xb_ld(&bar[XB_TOPGEN]) == tg, bar);
            __builtin_amdgcn_fence(__ATOMIC_ACQUIRE, "agent");
            xb_add(&bar[XB_XGEN(bx)], 1u);
            asm volatile("s_waitcnt vmcnt(0)" ::: "memory");
        } else {
            XB_SPIN(xb_ld(&bar[XB_XGEN(bx)]) == gen, bar);
            __builtin_amdgcn_fence(__ATOMIC_ACQUIRE, "agent");
            asm volatile("s_waitcnt vmcnt(0)" ::: "memory");
        }
    }
    __syncthreads();
}


#if MK_TS_PHASE >= 16
#define BLD_TS(k) do { if (blockIdx.x == 0 && tid == 0) ((unsigned long long*)((unsigned*)(p.ws + WS_CTL) + CTL_TS))[k] = __builtin_amdgcn_s_memrealtime(); } while (0)
#else
#define BLD_TS(k) do { } while (0)
#endif
__device__ __forceinline__ void s5_build_tables(const Params& p, LAS unsigned char* lds, int g) {
  const int tid = opaque_tid();
  BLD_TS(16);
  LAS float* Bb = (LAS float*)lds;
  LAS float* Cc = Bb + 4096;
  LAS float* PW = Cc + 4096;
  LAS float* KK = PW + 4352;
  if (tid < 128) {
    const int d = tid >> 6, pi = tid & 63, dg = d * 32 + g, idx = dg * 64 + pi;
    const float are = p.in[I_SARE][idx], aim = p.in[I_SAIM][idx];
    const float dt = expf(p.in[I_SLDT][dg]);
    const float lam = are * dt, om = aim * dt;
    for (int n = 0; n <= 16; ++n) { const float ea = expf(lam * (float)n); float sn, cs; sincosf(om * (float)n, &sn, &cs);
      PW[((d * 17 + n) * 64 + pi) * 2] = ea * cs; PW[((d * 17 + n) * 64 + pi) * 2 + 1] = ea * sn; }
    const float abr = PW[((d * 17 + 1) * 64 + pi) * 2], abi = PW[((d * 17 + 1) * 64 + pi) * 2 + 1];
    const float den = are * are + aim * aim;
    const float nr = abr - 1.f, ni = abi;
    const float rr = (nr * are + ni * aim) / den, ri = (ni * are - nr * aim) / den;
    for (int c = 0; c < 16; ++c) {
      const float bre = p.in[I_SBRE][idx * 16 + c], bim = p.in[I_SBIM][idx * 16 + c];
      Bb[((d * 64 + pi) * 16 + c) * 2] = rr * bre - ri * bim; Bb[((d * 64 + pi) * 16 + c) * 2 + 1] = rr * bim + ri * bre;
      Cc[((d * 16 + c) * 64 + pi) * 2] = p.in[I_SCRE][(dg * 16 + c) * 64 + pi]; Cc[((d * 16 + c) * 64 + pi) * 2 + 1] = p.in[I_SCIM][(dg * 16 + c) * 64 + pi];
    }
  }
  __syncthreads();
  BLD_TS(17);
  {
    const int d = tid >> 8, tau = (tid >> 4) & 15, c = tid & 15;
    float s[16];
#pragma unroll
    for (int c2 = 0; c2 < 16; ++c2) s[c2] = 0.f;
    for (int pi = 0; pi < 64; ++pi) {
      const f32x2 cv = *(const LAS f32x2*)(Cc + ((d * 16 + c) * 64 + pi) * 2), av = *(const LAS f32x2*)(PW + ((d * 17 + tau) * 64 + pi) * 2);
      const float mr = cv.x * av.x - cv.y * av.y, mi = cv.x * av.y + cv.y * av.x;
      const LAS f32x4* bp = (const LAS f32x4*)(Bb + ((d * 64 + pi) * 16) * 2);
#pragma unroll
      for (int q = 0; q < 8; ++q) { const f32x4 b = bp[q]; s[2 * q] += mr * b.x - mi * b.y; s[2 * q + 1] += mr * b.z - mi * b.w; }
    }
#pragma unroll
    for (int c2 = 0; c2 < 16; ++c2) KK[((d * 16 + tau) * 16 + c) * 16 + c2] = s[c2];
  }
  __syncthreads();
  BLD_TS(18);
  bf16_t* T = (bf16_t*)(p.ws + WS_S5T) + (size_t)g * 256 * 512;
  for (int o = tid; o < 256 * 256; o += 512) {
    const int n = o >> 8, k = (o & 255) * 2, i = n >> 4, c = n & 15;
    float v[2];
#pragma unroll
    for (int q = 0; q < 2; ++q) { const int kk = k + q; float x;
      if (kk < 256) { const int j = kk >> 4, c2 = kk & 15; x = 0.f;
        if (i >= j) x += KK[((0 * 16 + (i - j)) * 16 + c) * 16 + c2];
        if (j >= i) x += KK[((1 * 16 + (j - i)) * 16 + c) * 16 + c2];
        if (i == j && c == c2) x += p.in[I_SD][g * 16 + c];
      } else { const int d = (kk - 256) >> 7, qq = (kk - 256) & 127, part = qq >> 6, pi = qq & 63, n_pw = d ? (16 - i) : (i + 1);
        const float cr = Cc[((d * 16 + c) * 64 + pi) * 2], ci = Cc[((d * 16 + c) * 64 + pi) * 2 + 1];
        const float ar = PW[((d * 17 + n_pw) * 64 + pi) * 2], ai = PW[((d * 17 + n_pw) * 64 + pi) * 2 + 1];
        x = part ? -(cr * ai + ci * ar) : (cr * ar - ci * ai); }
      v[q] = x; }
    *(unsigned*)(T + (size_t)n * 512 + k) = cvt_pk_bf16(v[0], v[1]);
  }
  BLD_TS(19);
  bf16_t* E = (bf16_t*)(p.ws + WS_S5E) + (size_t)g * 256 * 256;
  for (int o = tid; o < 256 * 128; o += 512) {
    const int n = o >> 7, k = (o & 127) * 2, d = n >> 7, part = (n >> 6) & 1, pi = n & 63;
    float v[2];
#pragma unroll
    for (int q = 0; q < 2; ++q) { const int kk = k + q, j = kk >> 4, c2 = kk & 15, n_pw = d ? j : (15 - j);
      const float ar = PW[((d * 17 + n_pw) * 64 + pi) * 2], ai = PW[((d * 17 + n_pw) * 64 + pi) * 2 + 1];
      const float br = Bb[((d * 64 + pi) * 16 + c2) * 2], bi = Bb[((d * 64 + pi) * 16 + c2) * 2 + 1];
      v[q] = part ? (ar * bi + ai * br) : (ar * br - ai * bi); }
    *(unsigned*)(E + (size_t)n * 256 + k) = cvt_pk_bf16(v[0], v[1]);
  }
  BLD_TS(20);
  __syncthreads();
}

struct SchedS5S {
  static constexpr bool GATHER = false, HAS_DONE = false, HALF = false;
  int G, c;
  __device__ __forceinline__ bool next(int i, pg::Unit& u) const {
    const int L = i * G + c; if (L >= 160) return false;
    u.aux = L / 5; u.pm = L % 5; u.pn = 0; u.arow = u.pm * 256; return true;
  }
};
struct EpiS5S {
  static constexpr bool PERM = false;
  float* S;
  __device__ __forceinline__ void operator()(const pg::Acc& acc, const pg::Unit& u, int wr, int wc, int fr, int fq) const {
    const int row0 = u.arow + wr * 64 + fr, col0 = wc * 32 + 4 * fq;
#pragma unroll
    for (int ai = 0; ai < 2; ++ai)
#pragma unroll
      for (int m = 0; m < 4; ++m) { const int r = row0 + ai * 128 + m * 16;
        if (r < NCHUNK) { float* rowp = S + ((size_t)u.aux * NCHUNK + r) * 256 + col0;
#pragma unroll
          for (int bj = 0; bj < 2; ++bj)
#pragma unroll
            for (int n = 0; n < 2; ++n) *(f32x4*)(rowp + bj * 128 + n * 16) = acc[ai][bj][m][n]; } }
  }
};
__device__ __forceinline__ void phase_s5s(const Params& p, LAS unsigned char* lds) {
  pg::Addr AD{(const bf16_t*)((unsigned char*)p.out + DO_YA), 512, (size_t)NCHUNK * 512, (const bf16_t*)(p.ws + WS_S5E), 256, (size_t)256 * 256, false};
  SchedS5S S{(int)gridDim.x, (int)blockIdx.x};
  EpiS5S E{(float*)(p.ws + WS_RH)};
  pg::gemm_phase(lds, AD, S, E);
}

__device__ __forceinline__ void s5_scan_item(const Params& p, int item, int lane) {
  const int d = item & 1, g = (item >> 1) & 31, b = item >> 6;
  const float* S = (const float*)(p.ws + WS_RH) + (size_t)g * NCHUNK * 256 + d * 128 + lane;
  bf16_t* YA = (bf16_t*)((unsigned char*)p.out + DO_YA) + (size_t)g * NCHUNK * 512 + 256 + d * 128 + lane;
  const int idx = (d * 32 + g) * 64 + lane;
  const float dt = expf(p.in[I_SLDT][d * 32 + g]);
  const float ea = expf(p.in[I_SARE][idx] * dt * 16.f); float sn, cs; sincosf(p.in[I_SAIM][idx] * dt * 16.f, &sn, &cs);
  const float ar = ea * cs, ai = ea * sn;
  float hr = 0.f, hi = 0.f;
  const int r0 = b * 528;
#pragma unroll 4
  for (int s = 0; s < 16; ++s) { const int r = r0 + 512 + (d ? 15 - s : s);
    const float sr = S[(size_t)r * 256], si = S[(size_t)r * 256 + 64];
    const float nr = ar * hr - ai * hi + sr, ni = ar * hi + ai * hr + si; hr = nr; hi = ni; }
  float sa[16], sb[16];
#define SCAN_LOAD(buf, s0) do { _Pragma("unroll") for (int q = 0; q < 8; ++q) { const int r = r0 + (d ? 511 - ((s0) + q) : (s0) + q); buf[2 * q] = S[(size_t)r * 256]; buf[2 * q + 1] = S[(size_t)r * 256 + 64]; } } while (0)
#define SCAN_STEP(buf, s0) do { _Pragma("unroll") for (int q = 0; q < 8; ++q) { const int r = r0 + (d ? 511 - ((s0) + q) : (s0) + q); \
    YA[(size_t)r * 512] = f2bf(hr); YA[(size_t)r * 512 + 64] = f2bf(hi); \
    const float nr = ar * hr - ai * hi + buf[2 * q], ni = ar * hi + ai * hr + buf[2 * q + 1]; hr = nr; hi = ni; } } while (0)
  SCAN_LOAD(sa, 0);
  for (int s = 0; s < 512; s += 16) {
    SCAN_LOAD(sb, s + 8);
    SCAN_STEP(sa, s);
    if (s + 16 < 512) SCAN_LOAD(sa, s + 16);
    SCAN_STEP(sb, s + 8);
  }
#undef SCAN_LOAD
#undef SCAN_STEP
}
__device__ __forceinline__ void phase_s5scan(const Params& p) {
  const int tid_ = opaque_tid(); const int lane = tid_ & 63, wave = tid_ >> 6;
  const int gw = blockIdx.x * NWAVES + wave;
  if (gw < 128) s5_scan_item(p, gw, lane);
}

struct SchedS5Y {
  static constexpr bool GATHER = false, HAS_DONE = false, HALF = false;
  int G, c;
  __device__ __forceinline__ bool next(int i, pg::Unit& u) const {
    const int L = i * G + (MK_S5_IN_P3 ? c : ((c + G / 2) % G)); if (L >= 128) return false;
    u.aux = L >> 2; u.pm = L & 3; u.pn = 0; u.arow = (u.pm >> 1) * 528 + (u.pm & 1) * 256; return true;
  }
};
struct EpiS5Y {
  static constexpr bool PERM = true;
  bf16_t* GY;
  __device__ __forceinline__ void operator()(const pg::Acc& acc, const pg::Unit& u, int wr, int wc, int fr, int fq) const {
    const int row0 = u.arow + wr * 64 + fr;
#pragma unroll
    for (int ai = 0; ai < 2; ++ai)
#pragma unroll
      for (int m = 0; m < 4; ++m) { const int chunk = row0 + ai * 128 + m * 16;
#pragma unroll
        for (int bj = 0; bj < 2; ++bj) { const int col = bj * 128 + wc * 32 + 8 * fq, ti = col >> 4, c0 = col & 15;
          float o[8];
#pragma unroll
          for (int n = 0; n < 2; ++n)
#pragma unroll
            for (int e = 0; e < 4; ++e) o[n * 4 + e] = gelu_tanh(acc[ai][bj][m][n][e]);
          u32x4 w; w.x = cvt_pk_bf16(o[0], o[1]); w.y = cvt_pk_bf16(o[2], o[3]); w.z = cvt_pk_bf16(o[4], o[5]); w.w = cvt_pk_bf16(o[6], o[7]);
          *(u32x4*)(GY + (size_t)(chunk * 16 + ti) * 512 + u.aux * 16 + c0) = w; } }
  }
};
__device__ __forceinline__ void phase_s5y(const Params& p, LAS unsigned char* lds) {
  pg::Addr AD{(const bf16_t*)((unsigned char*)p.out + DO_YA), 512, (size_t)NCHUNK * 512, (const bf16_t*)(p.ws + WS_S5T), 512, (size_t)256 * 512, false};
  SchedS5Y S{(int)gridDim.x, (int)blockIdx.x};
  EpiS5Y E{(bf16_t*)((unsigned char*)p.out + DO_GY)};
  pg::gemm_phase(lds, AD, S, E);
}
__device__ __forceinline__ void map_static(int L, int nM, int nN, int& pm, int& pn) {
  const int nwg = nM * nN; int wgid = L;
  { const int q = nwg / 8, r = nwg % 8, xcd = wgid % 8, off = wgid / 8; wgid = (xcd < r ? xcd * (q + 1) : r * (q + 1) + (xcd - r) * q) + off; }
  const int nig = 8 * nN, gid = wgid / nig, fm = gid * 8, gsz = (nM - fm) < 8 ? (nM - fm) : 8;
  pm = fm + ((wgid % nig) % gsz); pn = (wgid % nig) / gsz;
}

struct CvtItem { const float* src; bf16_t* dst; int ldw, ldd; };
__device__ __forceinline__ void cvt_load(const CvtItem& d, f32x4 (&r)[8], int lane) {
  const float* s = d.src + (size_t)(lane >> 3) * d.ldw + 4 * (lane & 7);
#pragma unroll
  for (int i = 0; i < 8; ++i) r[i] = __builtin_nontemporal_load((const f32x4*)(s + (size_t)(8 * i) * d.ldw));
}
__device__ __forceinline__ void cvt_store(const CvtItem& d, const f32x4 (&r)[8], LAS float* scr, int lane) {
  LAS float* w = scr + (lane >> 3) * 33 + 4 * (lane & 7);
#pragma unroll
  for (int i = 0; i < 8; ++i) { w[(8 * i) * 33 + 0] = r[i].x; w[(8 * i) * 33 + 1] = r[i].y; w[(8 * i) * 33 + 2] = r[i].z; w[(8 * i) * 33 + 3] = r[i].w; }
  asm volatile("s_waitcnt lgkmcnt(0)" ::: "memory");
  const int c = lane & 7;
#pragma unroll
  for (int j = 0; j < 4; ++j) { const int n = (lane >> 3) + 8 * j; const LAS float* s = scr + (8 * c) * 33 + n;
    u32x4 o; o.x = cvt_pk_bf16(s[0 * 33], s[1 * 33]); o.y = cvt_pk_bf16(s[2 * 33], s[3 * 33]); o.z = cvt_pk_bf16(s[4 * 33], s[5 * 33]); o.w = cvt_pk_bf16(s[6 * 33], s[7 * 33]);
    *(u32x4*)(d.dst + (size_t)n * d.ldd + 8 * c) = o; }
  asm volatile("s_waitcnt lgkmcnt(0)" ::: "memory");
}
__device__ __forceinline__ int ilv_row(int n, int second) { return (n >> 7) * 256 + (n & 127) + second * 128; }

constexpr int CV_WIN = (1024 / 64) * (4096 / 32);
constexpr int CV_GLU = (512 / 64) * (1024 / 32);
constexpr int CV_SQ = (1024 / 64) * (1024 / 32);
constexpr int CV_EGU = (1024 / 64) * (512 / 32);
constexpr int CV_ED = (512 / 64) * (1024 / 32);
constexpr int CV_SMALL = CV_WIN + 2 * CV_GLU + 2 * CV_SQ;
constexpr int CV_TOTAL = CV_SMALL + 32 * (2 * CV_EGU + CV_ED);

__device__ __forceinline__ void cvt_kn(int it, int nb, int& kb_, int& nb_) { const int grp = it >> 3, w = it & 7, gpr = nb >> 2; kb_ = 2 * (grp / gpr) + (w >> 2); nb_ = 4 * (grp % gpr) + (w & 3); }
__device__ __forceinline__ CvtItem cvt_desc(const Params& p, int it) {
  unsigned char* ws = p.ws;
  if (it < CV_WIN) { const int nb = 4096 / 32; int kb_, nb_; cvt_kn(it, nb, kb_, nb_); const int n0 = 32 * nb_, k0 = 64 * kb_;
    return CvtItem{p.in[I_WIN] + (size_t)k0 * 4096 + n0, (bf16_t*)(ws + WS_WIN) + (size_t)n0 * 1024 + k0, 4096, 1024}; }
  it -= CV_WIN;
  if (it < 2 * CV_GLU) { const int second = it / CV_GLU; it %= CV_GLU; const int nb = 1024 / 32; int kb_, nb_; cvt_kn(it, nb, kb_, nb_); const int n0 = 32 * nb_, k0 = 64 * kb_;
    return CvtItem{p.in[second ? I_WGB : I_WGA] + (size_t)k0 * 1024 + n0, (bf16_t*)(ws + WS_WGLU) + (size_t)ilv_row(n0, second) * 512 + k0, 1024, 512}; }
  it -= 2 * CV_GLU;
  if (it < 2 * CV_SQ) { const int second = it / CV_SQ; it %= CV_SQ; const int nb = 1024 / 32; int kb_, nb_; cvt_kn(it, nb, kb_, nb_); const int n0 = 32 * nb_, k0 = 64 * kb_;
    return CvtItem{p.in[second ? I_WOUT : I_WAO] + (size_t)k0 * 1024 + n0, (bf16_t*)(ws + (second ? WS_WOUT : WS_WAO)) + (size_t)n0 * 1024 + k0, 1024, 1024}; }
  it -= 2 * CV_SQ;
  const int per_e = 2 * CV_EGU + CV_ED, e = it / per_e; it %= per_e;
  if (it < 2 * CV_EGU) { const int second = it / CV_EGU; it %= CV_EGU; const int nb = 512 / 32; int kb_, nb_; cvt_kn(it, nb, kb_, nb_); const int n0 = 32 * nb_, k0 = 64 * kb_;
    return CvtItem{p.in[second ? I_WEU : I_WEG] + (size_t)e * 1024 * 512 + (size_t)k0 * 512 + n0, (bf16_t*)(ws + WS_WGU) + ((size_t)e * 1024 + ilv_row(n0, second)) * 1024 + k0, 512, 1024}; }
  it -= 2 * CV_EGU;
  { const int nb = 1024 / 32; int kb_, nb_; cvt_kn(it, nb, kb_, nb_); const int n0 = 32 * nb_, k0 = 64 * kb_;
    return CvtItem{p.in[I_WED] + (size_t)e * 512 * 1024 + (size_t)k0 * 1024 + n0, (bf16_t*)(ws + WS_WD) + ((size_t)e * 1024 + n0) * 512 + k0, 1024, 512}; }
}
template <bool SIGNAL_WIN> __device__ __forceinline__ void cvt_run(const Params& p, int lo, int CV_END, int gw, int NGW, LAS float* scr, int lane) {
  int it = lo + gw; if (it >= CV_END) return;
  CvtItem d = cvt_desc(p, it); f32x4 ra[8], rb[8];
  cvt_load(d, ra, lane);
  for (;;) {
    const int nit = it + NGW; const bool more = nit < CV_END; CvtItem dn = d;
    if (more) { dn = cvt_desc(p, nit); cvt_load(dn, rb, lane); }
    cvt_store(d, ra, scr, lane);
#if MK_CTX_IN_PRO
    if (SIGNAL_WIN && it < CV_WIN && nit >= CV_WIN) {
      asm volatile("s_waitcnt vmcnt(0)" ::: "memory"); __builtin_amdgcn_fence(__ATOMIC_RELEASE, "agent");
      if (lane == 0) __hip_atomic_fetch_add((unsigned*)(p.ws + WS_CTL) + CTL_WINCNT, 1u, __ATOMIC_RELAXED, __HIP_MEMORY_SCOPE_AGENT); }
#endif
    if (!more) break;
#pragma unroll
    for (int i = 0; i < 8; ++i) ra[i] = rb[i];
    d = dn; it = nit;
  }
}

__device__ __forceinline__ const float* ln_src_row(const Params& p, int pr) {
  const int b = pr / SKV, t = pr % SKV;
  return (t < SEQ) ? p.in[I_X] + ((size_t)b * SEQ + t) * DM : p.in[I_CTX] + ((size_t)b * NCTX + (t - SEQ)) * DM;
}
template <bool LAT> __device__ __forceinline__ void ln_batch_load_t(const Params& p, int r0, int NGW, f32x4 (&v)[4][4], int lane) {
#pragma unroll
  for (int r = 0; r < 4; ++r) { const int ri = r0 + r * NGW;
    if (ri < (LAT ? NLAT : NROW)) { const float* xr = LAT ? p.in[I_X] + (size_t)ri * DM : ln_src_row(p, ri);
#pragma unroll
      for (int j = 0; j < 4; ++j) v[r][j] = ((const f32x4*)xr)[lane + 64 * j]; } }
}
__device__ __forceinline__ void ln_batch_load(const Params& p, int pr0, int NGW, f32x4 (&v)[4][4], int lane) { ln_batch_load_t<false>(p, pr0, NGW, v, lane); }
__device__ __forceinline__ void ln_batch_load_lat(const Params& p, int lr0, int NGW, f32x4 (&v)[4][4], int lane) { ln_batch_load_t<true>(p, lr0, NGW, v, lane); }
template <bool LAT> __device__ __forceinline__ void ln_batch_run_t(const Params& p, int r0, int NGW, f32x4 (&v)[4][4], int lane) {
  const float* mod = (const float*)(p.ws + WS_MOD);
  bf16_t* H = (bf16_t*)(p.ws + WS_RH);
#pragma unroll
  for (int r = 0; r < 4; ++r) { const int ri = r0 + r * NGW; const int pr = LAT ? lat2pad(ri) : ri;
    if (ri < (LAT ? NLAT : NROW)) {
      const int b = pr / SKV, t = pr % SKV;
      const float* mrow = mod + ((t < SEQ) ? b : 2) * NMOD;
      f32x4 sh[4], sc[4];
#pragma unroll
      for (int j = 0; j < 4; ++j) { const int col = (lane + 64 * j) * 4; sh[j] = *(const f32x4*)(mrow + col); sc[j] = *(const f32x4*)(mrow + DM + col); }
      float s = 0;
#pragma unroll
      for (int j = 0; j < 4; ++j) s += (v[r][j].x + v[r][j].y) + (v[r][j].z + v[r][j].w);
      const float mean = wave_sum(s) * (1.f / DM); float s2 = 0;
#pragma unroll
      for (int j = 0; j < 4; ++j) { v[r][j] = v[r][j] - mean; s2 += (v[r][j].x * v[r][j].x + v[r][j].y * v[r][j].y) + (v[r][j].z * v[r][j].z + v[r][j].w * v[r][j].w); }
      const float rstd = rsqrtf(wave_sum(s2) * (1.f / DM) + LN_EPS);
#pragma unroll
      for (int j = 0; j < 4; ++j) {
        const int col = (lane + 64 * j) * 4;
        const f32x4 o = v[r][j] * rstd * (sc[j] + 1.f) + sh[j];
        u32x2 w; w.x = cvt_pk_bf16(o.x, o.y); w.y = cvt_pk_bf16(o.z, o.w);
        *(u32x2*)(H + (size_t)pr * DM + col) = w;
      }
    } }
}
__device__ __forceinline__ void ln_batch_run(const Params& p, int pr0, int NGW, f32x4 (&v)[4][4], int lane) { ln_batch_run_t<false>(p, pr0, NGW, v, lane); }
__device__ __forceinline__ void ln_batch_run_lat(const Params& p, int lr0, int NGW, f32x4 (&v)[4][4], int lane) { ln_batch_run_t<true>(p, lr0, NGW, v, lane); }
struct SchedIn {
  static constexpr bool GATHER = false, HAS_DONE = false, HALF = false;
  int G, c;
  __device__ __forceinline__ bool next(int i, pg::Unit& u) const {
    const int L = i * G + c; u.aux = 0;
    if (L < 1024) { int lm, pn; map_static(L, 64, 16, lm, pn); u.pm = lm + (lm >> 5); u.pn = pn; u.arow = u.pm * 256; return true; }
    if (((!MK_CTX_IN_P1 && !MK_CTX_IN_PRO) || G < 64) && L < 1032) { const int j = L - 1024; u.pm = (j < 4) ? 32 : 65; const int q = j & 3; u.pn = (q < 2) ? q : q + 4; u.arow = u.pm * 256; return true; }
    return false;
  }
};
struct EpiIn {
  static constexpr bool PERM = true;
  bf16_t* YA; bf16_t* P;
  __device__ __forceinline__ void operator()(const pg::Acc& acc, const pg::Unit& u, int wr, int wc, int fr, int fq) const {
    const int row0 = u.pm * 256 + wr * 64 + fr;
    if (u.pn < 2) {
#pragma unroll
      for (int ai = 0; ai < 2; ++ai)
#pragma unroll
        for (int m = 0; m < 4; ++m) { const int r = row0 + ai * 128 + m * 16, chunk = r >> 4, ti = r & 15;
#pragma unroll
          for (int bj = 0; bj < 2; ++bj) { const int ch = u.pn * 256 + bj * 128 + wc * 32 + 8 * fq, g = ch >> 4, off = ch & 15;
            const f32x4 v0 = acc[ai][bj][m][0], v1 = acc[ai][bj][m][1];
            u32x4 w; w.x = cvt_pk_bf16(v0[0], v0[1]); w.y = cvt_pk_bf16(v0[2], v0[3]); w.z = cvt_pk_bf16(v1[0], v1[1]); w.w = cvt_pk_bf16(v1[2], v1[3]);
            *(u32x4*)(YA + ((size_t)g * NCHUNK + chunk) * 512 + ti * 16 + off) = w; } }
    } else {
      const int colb = (u.pn - 2) * 256 + wc * 32 + 8 * fq; const bool sig = u.pn >= 8;
#pragma unroll
      for (int ai = 0; ai < 2; ++ai)
#pragma unroll
        for (int m = 0; m < 4; ++m) { bf16_t* rowp = P + (size_t)(row0 + ai * 128 + m * 16) * PLD + colb;
#pragma unroll
          for (int bj = 0; bj < 2; ++bj) { f32x4 v0 = acc[ai][bj][m][0], v1 = acc[ai][bj][m][1];
            if (sig) {
#pragma unroll
              for (int e = 0; e < 4; ++e) { v0[e] = __builtin_amdgcn_rcpf(1.f + __builtin_amdgcn_exp2f(-1.4426950408889634f * v0[e])); v1[e] = __builtin_amdgcn_rcpf(1.f + __builtin_amdgcn_exp2f(-1.4426950408889634f * v1[e])); } }
            u32x4 w; w.x = cvt_pk_bf16(v0[0], v0[1]); w.y = cvt_pk_bf16(v0[2], v0[3]); w.z = cvt_pk_bf16(v1[0], v1[1]); w.w = cvt_pk_bf16(v1[2], v1[3]);
            *(u32x4*)(rowp + bj * 128) = w; } }
    }
  }
};
__device__ __forceinline__ void phase2(const Params& p, LAS unsigned char* lds) {
  pg::Addr AD{(const bf16_t*)(p.ws + WS_RH), DM, 0, (const bf16_t*)(p.ws + WS_WIN), DM, 0, false};
  SchedIn S{(int)gridDim.x, (int)blockIdx.x};
  EpiIn E{(bf16_t*)((unsigned char*)p.out + DO_YA), (bf16_t*)(p.ws + WS_P)};
  pg::gemm_phase(lds, AD, S, E);
}

struct SchedOne {
  static constexpr bool GATHER = false, HAS_DONE = false, HALF = false;
  int pm, pn;
  __device__ __forceinline__ bool next(int i, pg::Unit& u) const { if (i > 0) return false; u.pm = pm; u.pn = pn; u.aux = 0; u.arow = pm * 256; return true; }
};
__device__ __forceinline__ void ctx_ln_and_unit(const Params& p, LAS unsigned char* lds, int c, int tid_) {
  const int lane = tid_ & 63, wave = tid_ >> 6;
  const int tile = c >> 2, pm = tile ? 65 : 32, quarter = c & 3;
  f32x4 va[4][4];
#pragma unroll 1
  for (int h = 0; h < 2; ++h) { const int pr0 = pm * 256 + quarter * 64 + wave * 8 + h * 4;
    ln_batch_load(p, pr0, 1, va, lane); ln_batch_run(p, pr0, 1, va, lane); }
  unsigned* ctr = (unsigned*)(p.ws + WS_CTL) + CTL_CTXCNT + tile * 64;
  asm volatile("s_waitcnt vmcnt(0)" ::: "memory");
  __syncthreads();
  if (tid_ == 0) { __threadfence(); __hip_atomic_fetch_add(ctr, 1u, __ATOMIC_RELEASE, __HIP_MEMORY_SCOPE_AGENT);
    unsigned spins = 0; while (__hip_atomic_load(ctr, __ATOMIC_ACQUIRE, __HIP_MEMORY_SCOPE_AGENT) < 4u && ++spins < (1u << 22)) __builtin_amdgcn_s_sleep(4);
    __threadfence(); }
  __syncthreads();
  __builtin_amdgcn_fence(__ATOMIC_ACQUIRE, "agent");
  pg::Addr AD{(const bf16_t*)(p.ws + WS_RH), DM, 0, (const bf16_t*)(p.ws + WS_WIN), DM, 0, false};
  SchedOne S{pm, (quarter < 2) ? quarter : quarter + 4};
  EpiIn E{(bf16_t*)((unsigned char*)p.out + DO_YA), (bf16_t*)(p.ws + WS_P)};
  pg::gemm_phase(lds, AD, S, E);
}
__device__ __forceinline__ void phase0(const Params& p, LAS unsigned char* lds) {
  const int tid = opaque_tid(), lane = tid & 63, wave = tid >> 6, c = blockIdx.x, G = gridDim.x;
  {
    LAS float* sv = (LAS float*)lds;
    LAS float* red = sv + 3 * DM;
    for (int i = tid; i < DM; i += 512) { sv[i] = siluf_(p.in[I_C][i]); sv[DM + i] = siluf_(p.in[I_C][DM + i]); sv[2 * DM + i] = siluf_(p.in[I_CCTX][i]); }
    __syncthreads();
    for (int cg = c; cg < NMOD / 24; cg += G) {
      const int c4 = tid % 6, rs = tid / 6;
      if (rs < 85) {
        const float* w = p.in[I_WMOD] + cg * 24 + 4 * c4;
        f32x4 wv[13];
#pragma unroll
        for (int q = 0; q < 13; ++q) { const int k = rs + 85 * q; wv[q] = (k < DM) ? *(const f32x4*)(w + (size_t)k * NMOD) : (f32x4){0.f, 0.f, 0.f, 0.f}; }
        f32x4 a0 = {0.f, 0.f, 0.f, 0.f}, a1 = a0, a2 = a0;
#pragma unroll
        for (int q = 0; q < 13; ++q) { const int k = rs + 85 * q; if (k < DM) { a0 += wv[q] * sv[k]; a1 += wv[q] * sv[DM + k]; a2 += wv[q] * sv[2 * DM + k]; } }
#pragma unroll
        for (int e = 0; e < 4; ++e) { red[(rs * 24 + 4 * c4 + e) * 3 + 0] = a0[e]; red[(rs * 24 + 4 * c4 + e) * 3 + 1] = a1[e]; red[(rs * 24 + 4 * c4 + e) * 3 + 2] = a2[e]; }
      }
      __syncthreads();
      if (tid < 72) { const int cc = tid / 3, r = tid % 3; float s = 0.f;
        for (int q = 0; q < 85; ++q) s += red[(q * 24 + cc) * 3 + r];
        ((float*)(p.ws + WS_MOD))[r * NMOD + cg * 24 + cc] = s + p.in[I_BMOD][cg * 24 + cc]; }
      __syncthreads();
    }
#if MK_CTX_IN_PRO || MK_LN_IN_PRO
    asm volatile("s_waitcnt vmcnt(0)" ::: "memory"); __syncthreads();
    if (tid == 0) { __threadfence(); __hip_atomic_fetch_add((unsigned*)(p.ws + WS_CTL) + CTL_MODCNT, 1u, __ATOMIC_RELEASE, __HIP_MEMORY_SCOPE_AGENT); }
#endif
  }
  const int nb = (G >= 64) ? 32 : 0;
  for (int g = c; g < 32; g += G) s5_build_tables(p, lds, g);
#if MK_CTX_IN_PRO
  if (G >= 64 && c < NCTXB) {
    if (tid == 0) { unsigned spins = 0;
      while (__hip_atomic_load((unsigned*)(p.ws + WS_CTL) + CTL_MODCNT, __ATOMIC_ACQUIRE, __HIP_MEMORY_SCOPE_AGENT) < (unsigned)G && ++spins < (1u << 22)) __builtin_amdgcn_s_sleep(4);
      while (__hip_atomic_load((unsigned*)(p.ws + WS_CTL) + CTL_WINCNT, __ATOMIC_ACQUIRE, __HIP_MEMORY_SCOPE_AGENT) < (unsigned)((G - nb) * NWAVES) && ++spins < (1u << 22)) __builtin_amdgcn_s_sleep(4);
      __threadfence(); }
    __syncthreads();
    __builtin_amdgcn_fence(__ATOMIC_ACQUIRE, "agent");
    ctx_ln_and_unit(p, lds, c, tid);
    return;
  }
#endif
  {
    LAS float* scr = (LAS float*)(lds + 8192) + wave * (64 * 33);
    const int N1 = (nb > 0) ? ((CV_TOTAL * MK_N1_NUM) / MK_N1_DEN) & ~7 : 0;
    if (c >= nb) cvt_run<true>(p, 0, N1, (c - nb) * NWAVES + wave, (G - nb) * NWAVES, scr, lane);
    { const int skip = (MK_CTX_IN_PRO && G >= 64) ? NCTXB : 0;
      cvt_run<false>(p, N1, CV_TOTAL, (c - skip) * NWAVES + wave, (G - skip) * NWAVES, scr, lane); }
  }
}

__device__ __forceinline__ void phase1(const Params& p, LAS unsigned char* lds) {
  const int tid_ = opaque_tid(); const int lane = tid_ & 63, wave = tid_ >> 6;
  const int c = blockIdx.x, G = gridDim.x;
  if (MK_CTX_IN_P1 && G > 2 * NCTXB && c < NCTXB) { ctx_ln_and_unit(p, lds, c, tid_); return; }
  if (!MK_CTX_IN_P1 && !MK_CTX_IN_PRO) {
    const int gwa = c * NWAVES + wave, NGWa = G * NWAVES;
    f32x4 va[4][4], vb[4][4];
    ln_batch_load(p, gwa, NGWa, va, lane);
    for (int pr0 = gwa; pr0 < NROW; pr0 += 8 * NGWa) {
      ln_batch_load(p, pr0 + 4 * NGWa, NGWa, vb, lane);
      ln_batch_run(p, pr0, NGWa, va, lane);
      ln_batch_load(p, pr0 + 8 * NGWa, NGWa, va, lane);
      ln_batch_run(p, pr0 + 4 * NGWa, NGWa, vb, lane);
    }
    return;
  }
  const int nb = (MK_CTX_IN_P1 && G > 2 * NCTXB) ? NCTXB : 0;
  const int gw = (c - nb) * NWAVES + wave, NGW = (G - nb) * NWAVES;
  f32x4 va[4][4], vb[4][4];
  ln_batch_load_lat(p, gw, NGW, va, lane);
  for (int lr0 = gw; lr0 < NLAT; lr0 += 8 * NGW) {
    ln_batch_load_lat(p, lr0 + 4 * NGW, NGW, vb, lane);
    ln_batch_run_lat(p, lr0, NGW, va, lane);
    ln_batch_load_lat(p, lr0 + 8 * NGW, NGW, va, lane);
    ln_batch_run_lat(p, lr0 + 4 * NGW, NGW, vb, lane);
  }
  if (nb == 0) {
    for (int pr0 = gw; pr0 < NROW; pr0 += 4 * NGW) {   }
  }
}

__device__ __forceinline__ void phase_qknorm(const Params& p) {
  const bf16_t* P = (const bf16_t*)(p.ws + WS_P); bf16_t* KC = (bf16_t*)(p.ws + WS_KC); bf16_t* VC = (bf16_t*)(p.ws + WS_VC);
  const int tid_ = opaque_tid(); const int lane = tid_ & 63, wave = tid_ >> 6;
  const int gw = blockIdx.x * NWAVES + wave, NGW = gridDim.x * NWAVES;
  const int sub = lane & 15, grp = lane >> 4, e0 = sub * 8, axis = sub >> 3; const bool hi_half = (sub & 4) != 0;
  float inv[8], gk[8];
#pragma unroll
  for (int j = 0; j < 8; ++j) { const int f = (e0 + j) & 31; inv[j] = exp2f(-(float)(2 * f) * (13.287712379549449f / 64.f)); gk[j] = p.in[I_KG][e0 + j]; }
  for (int pr = gw; pr < NROW; pr += NGW) {
    const int b = pr / SKV, t = pr % SKV; const bool isctx = t >= SEQ;
    const u32x4 w = *(const u32x4*)(P + (size_t)pr * PLD + PC_K + lane * 8);
    bf16_t* dst = (grp < 2 ? KC : VC) + ((size_t)(b * 2 + (grp & 1)) * SKV + t) * 128 + e0;
    if (grp >= 2) { *(u32x4*)dst = w; }
    float x[8] = {__uint_as_float(w.x << 16), __uint_as_float(w.x & 0xffff0000u), __uint_as_float(w.y << 16), __uint_as_float(w.y & 0xffff0000u),
                  __uint_as_float(w.z << 16), __uint_as_float(w.z & 0xffff0000u), __uint_as_float(w.w << 16), __uint_as_float(w.w & 0xffff0000u)};
    float ss = 0.f;
#pragma unroll
    for (int j = 0; j < 8; ++j) ss += x[j] * x[j];
    ss = row16_sum(ss);
    const float r = rsqrtf(ss * (1.f / 128.f) + LN_EPS);
    const float posf = (axis == 0) ? (float)(t >> 6) : (float)(t & 63);
    float o[8];
#pragma unroll
    for (int j = 0; j < 8; ++j) { x[j] = x[j] * r * gk[j];
      const float y = lane_xor4(x[j]);
      float sn = 0.f, cs = 1.f; if (!isctx) sincosf(posf * inv[j], &sn, &cs);
      o[j] = hi_half ? (y * sn + x[j] * cs) : (x[j] * cs - y * sn); }
    if (grp < 2) { u32x4 ow; ow.x = cvt_pk_bf16(o[0], o[1]); ow.y = cvt_pk_bf16(o[2], o[3]); ow.z = cvt_pk_bf16(o[4], o[5]); ow.w = cvt_pk_bf16(o[6], o[7]); *(u32x4*)dst = ow; }
  }
}
struct SchedLat {
  static constexpr bool GATHER = false, HAS_DONE = false, HALF = false;
  int G, c, nN;
  __device__ __forceinline__ bool next(int i, pg::Unit& u) const {
    const int L = i * G + c; u.aux = 0;
    if (L >= 64 * nN) return false;
    int lm, pn; map_static(L, 64, nN, lm, pn); u.pm = lm + (lm >> 5); u.pn = pn; u.arow = u.pm * 256; return true;
  }
};
struct EpiGlu {
  static constexpr bool PERM = true;
  const bf16_t* P; bf16_t* Z;
  __device__ __forceinline__ void operator()(const pg::Acc& acc, const pg::Unit& u, int wr, int wc, int fr, int fq) const {
    const int row0 = u.pm * 256 + wr * 64 + fr, ch = u.pn * 128 + wc * 32 + 8 * fq;
    u32x4 gwv[2][4];
#pragma unroll
    for (int ai = 0; ai < 2; ++ai)
#pragma unroll
      for (int m = 0; m < 4; ++m) gwv[ai][m] = *(const u32x4*)(P + (size_t)(row0 + ai * 128 + m * 16) * PLD + PC_G + ch);
#pragma unroll
    for (int ai = 0; ai < 2; ++ai)
#pragma unroll
      for (int m = 0; m < 4; ++m) { const int r = row0 + ai * 128 + m * 16;
        const u32x4 gw = gwv[ai][m];
        float gt[8] = {__uint_as_float(gw.x << 16), __uint_as_float(gw.x & 0xffff0000u), __uint_as_float(gw.y << 16), __uint_as_float(gw.y & 0xffff0000u),
                       __uint_as_float(gw.z << 16), __uint_as_float(gw.z & 0xffff0000u), __uint_as_float(gw.w << 16), __uint_as_float(gw.w & 0xffff0000u)};
        float o[8];
#pragma unroll
        for (int n = 0; n < 2; ++n)
#pragma unroll
          for (int e = 0; e < 4; ++e) { const float a_ = acc[ai][0][m][n][e], b_ = acc[ai][1][m][n][e];
            o[n * 4 + e] = gt[n * 4 + e] * a_ * __builtin_amdgcn_rcpf(1.f + __builtin_amdgcn_exp2f(-1.4426950408889634f * b_)); }
        u32x4 w; w.x = cvt_pk_bf16(o[0], o[1]); w.y = cvt_pk_bf16(o[2], o[3]); w.z = cvt_pk_bf16(o[4], o[5]); w.w = cvt_pk_bf16(o[6], o[7]);
        *(u32x4*)(Z + (size_t)r * DM + ch) = w; }
  }
};
struct EpiMix {
  static constexpr bool PERM = true;
  const bf16_t* P; bf16_t* Z;
  __device__ __forceinline__ void operator()(const pg::Acc& acc, const pg::Unit& u, int wr, int wc, int fr, int fq) const {
    const int row0 = u.pm * 256 + wr * 64 + fr, col0 = u.pn * 256 + wc * 32 + 8 * fq;
#pragma unroll
    for (int ai = 0; ai < 2; ++ai) {
      u32x4 gwv[4][2], zwv[4][2];
#pragma unroll
      for (int m = 0; m < 4; ++m)
#pragma unroll
        for (int bj = 0; bj < 2; ++bj) { const int r = row0 + ai * 128 + m * 16, cc = col0 + bj * 128;
          gwv[m][bj] = *(const u32x4*)(P + (size_t)r * PLD + PC_G + 1024 + cc); zwv[m][bj] = *(const u32x4*)(Z + (size_t)r * DM + cc); }
#pragma unroll
      for (int m = 0; m < 4; ++m)
#pragma unroll
        for (int bj = 0; bj < 2; ++bj) { const int r = row0 + ai * 128 + m * 16, cc = col0 + bj * 128;
          const u32x4 gw = gwv[m][bj], zw = zwv[m][bj];
          const unsigned gq[4] = {gw.x, gw.y, gw.z, gw.w}, zq[4] = {zw.x, zw.y, zw.z, zw.w};
          unsigned ow[4];
#pragma unroll
          for (int q = 0; q < 4; ++q) { const float a0 = acc[ai][bj][m][q >> 1][(q & 1) * 2], a1 = acc[ai][bj][m][q >> 1][(q & 1) * 2 + 1];
            ow[q] = cvt_pk_bf16(__uint_as_float(zq[q] << 16) + __uint_as_float(gq[q] << 16) * a0, __uint_as_float(zq[q] & 0xffff0000u) + __uint_as_float(gq[q] & 0xffff0000u) * a1); }
          *(u32x4*)(Z + (size_t)r * DM + cc) = (u32x4){ow[0], ow[1], ow[2], ow[3]}; }
    }
  }
};
struct EpiOut {
  static constexpr bool PERM = false;
  const float* X; const float* mod; float* R1;
  __device__ __forceinline__ void operator()(const pg::Acc& acc, const pg::Unit& u, int wr, int wc, int fr, int fq) const {
    const int b = u.pm / 33, lrow0 = (u.pm - b) * 256 + wr * 64 + fr, col0 = u.pn * 256 + wc * 32 + 4 * fq;
    const float* g1 = mod + b * NMOD + 2 * DM;
    f32x4 gv[2][2];
#pragma unroll
    for (int bj = 0; bj < 2; ++bj)
#pragma unroll
      for (int n = 0; n < 2; ++n) gv[bj][n] = *(const f32x4*)(g1 + col0 + bj * 128 + n * 16);
#pragma unroll
    for (int ai = 0; ai < 2; ++ai) {
      f32x4 xv[4][2][2];
#pragma unroll
      for (int m = 0; m < 4; ++m) { const size_t off = (size_t)(lrow0 + ai * 128 + m * 16) * DM + col0;
#pragma unroll
        for (int bj = 0; bj < 2; ++bj)
#pragma unroll
          for (int n = 0; n < 2; ++n) xv[m][bj][n] = *(const f32x4*)(X + off + bj * 128 + n * 16); }
#pragma unroll
      for (int m = 0; m < 4; ++m) { const size_t off = (size_t)(lrow0 + ai * 128 + m * 16) * DM + col0;
#pragma unroll
        for (int bj = 0; bj < 2; ++bj)
#pragma unroll
          for (int n = 0; n < 2; ++n) *(f32x4*)(R1 + off + bj * 128 + n * 16) = xv[m][bj][n] * ALPHA + gv[bj][n] * acc[ai][bj][m][n]; }
    }
  }
};
__device__ __forceinline__ void phase_g1(const Params& p, LAS unsigned char* lds) {
  pg::Addr AD{(const bf16_t*)((unsigned char*)p.out + DO_GY), 512, 0, (const bf16_t*)(p.ws + WS_WGLU), 512, 0, false};
  SchedLat S{(int)gridDim.x, (int)blockIdx.x, 8};
  EpiGlu E{(const bf16_t*)(p.ws + WS_P), (bf16_t*)(p.ws + WS_RH)};
  pg::gemm_phase(lds, AD, S, E);
}
__device__ __forceinline__ void phase_g2(const Params& p, LAS unsigned char* lds) {
  pg::Addr AD{(const bf16_t*)(p.ws + WS_P) + PC_Q, PLD, 0, (const bf16_t*)(p.ws + WS_WAO), DM, 0, false};
  SchedLat S{(int)gridDim.x, (int)blockIdx.x, 4};
  EpiMix E{(const bf16_t*)(p.ws + WS_P), (bf16_t*)(p.ws + WS_RH)};
  pg::gemm_phase(lds, AD, S, E);
}
__device__ __forceinline__ void phase_g3(const Params& p, LAS unsigned char* lds) {
  pg::Addr AD{(const bf16_t*)(p.ws + WS_RH), DM, 0, (const bf16_t*)(p.ws + WS_WOUT), DM, 0, false};
  SchedLat S{(int)gridDim.x, (int)blockIdx.x, 4};
  EpiOut E{p.in[I_X], (const float*)(p.ws + WS_MOD), p.out};
  pg::gemm_phase(lds, AD, S, E);
}

constexpr size_t RT_EW = 0, RT_LIST = 256 * 1024;
constexpr int CTL_CNT = 8192, CNT_STRIDE = 64;
constexpr int ACT_TILES_MAX = 160;
constexpr size_t PR_ACT = 66 * MiB;

struct MoeTab { const LAS int* tb; const LAS int* cn; };
__device__ __forceinline__ MoeTab moe_tables(const Params& p, LAS unsigned char* lds) {
  LAS int* tb = (LAS int*)(lds + LDS_STAGE); LAS int* cn = tb + 64;
  const unsigned* cnt = (const unsigned*)(p.ws + WS_CTL) + CTL_CNT;
  if (opaque_tid() == 0) { int acc = 0; for (int e = 0; e < 32; ++e) { const int c = (int)cnt[e * CNT_STRIDE]; cn[e] = c; tb[e] = acc; acc += (c + 255) >> 8; } tb[32] = acc; }
  __syncthreads();
  return MoeTab{tb, cn};
}
struct SchedMoe {
  static constexpr bool GATHER_ = true;
  int G, c, nN; MoeTab tab; const int* lists;
  __device__ __forceinline__ bool next_(int i, pg::Unit& u) const {
    if ((G & 7) != 0) {
      const int L = i * G + c, T = L / nN;
      if (T >= tab.tb[32]) return false;
      int e = 0;
#pragma unroll 1
      for (int q = 1; q < 32; ++q) e = (tab.tb[q] <= T) ? q : e;
      u.pm = T; u.pn = L % nN; u.aux = e; u.arow = T * 256; return true;
    }
    const int x = c & 7, j = c >> 3, nper = G >> 3;
    int idx = j + nper * i;
#pragma unroll 1
    for (int k = 0; k < 4; ++k) { const int e = x + 8 * k, n_e = (tab.tb[e + 1] - tab.tb[e]) * nN;
      if (idx < n_e) { const int T = tab.tb[e] + idx / nN; u.pm = T; u.pn = idx % nN; u.aux = e; u.arow = T * 256; return true; }
      idx -= n_e; }
    return false;
  }
  __device__ __forceinline__ int arow_(const pg::Unit& u, int r) const {
    const int slot = (u.pm - tab.tb[u.aux]) * 256 + r;
    if (slot >= tab.cn[u.aux]) return 0;
    return lat2pad(lists[u.aux * NLAT + slot] >> 1);
  }
};
constexpr int NEARLY = 48;
constexpr int CTL_TILECNT = 10496;
struct SchedMoeUp : SchedMoe { static constexpr bool GATHER = true, HAS_DONE = true, HALF = false;
  unsigned* tilecnt; bool early;
  __device__ __forceinline__ bool next(int i, pg::Unit& u) const { return next_(i, u); }
  __device__ __forceinline__ int arow(const pg::Unit& u, int r) const { return arow_(u, r); }
  __device__ __forceinline__ void done(const pg::Unit& u, int lane) const {
    if (early && u.pm < NEARLY) { asm volatile("s_waitcnt vmcnt(0)" ::: "memory"); __builtin_amdgcn_fence(__ATOMIC_RELEASE, "agent"); asm volatile("s_waitcnt vmcnt(0)" ::: "memory");
      if (lane == 0) __hip_atomic_fetch_add(tilecnt + 64 * u.pm, 1u, __ATOMIC_RELAXED, __HIP_MEMORY_SCOPE_AGENT); } } };
struct SchedMoeDown : SchedMoe { static constexpr bool GATHER = false, HAS_DONE = false, HALF = false;
  int t_first;
  __device__ __forceinline__ bool next(int i, pg::Unit& u) const {
    if (t_first == 0) return next_(i, u);
    const int L = i * G + c, T = t_first + L / nN;
    if (T >= tab.tb[32]) return false;
    int e = 0;
#pragma unroll 1
    for (int q = 1; q < 32; ++q) e = (tab.tb[q] <= T) ? q : e;
    u.pm = T; u.pn = L % nN; u.aux = e; u.arow = T * 256; return true; } };
struct SchedMoeDownOne : SchedMoe { static constexpr bool GATHER = false, HAS_DONE = false, HALF = false;
  int T, pn;
  __device__ __forceinline__ bool next(int i, pg::Unit& u) const {
    if (i > 0) return false;
    int e = 0;
#pragma unroll 1
    for (int q = 1; q < 32; ++q) e = (tab.tb[q] <= T) ? q : e;
    u.pm = T; u.pn = pn; u.aux = e; u.arow = T * 256; return true; } };
struct EpiGU {
  static constexpr bool PERM = true;
  bf16_t* ACT;
  __device__ __forceinline__ void operator()(const pg::Acc& acc, const pg::Unit& u, int wr, int wc, int fr, int fq) const {
    const int row0 = u.pm * 256 + wr * 64 + fr, ch = u.pn * 128 + wc * 32 + 8 * fq;
#pragma unroll
    for (int ai = 0; ai < 2; ++ai)
#pragma unroll
      for (int m = 0; m < 4; ++m) { const int r = row0 + ai * 128 + m * 16;
        float o[8];
#pragma unroll
        for (int n = 0; n < 2; ++n)
#pragma unroll
          for (int e = 0; e < 4; ++e) { const float a = acc[ai][0][m][n][e], b = acc[ai][1][m][n][e];
            o[n * 4 + e] = a * b * __builtin_amdgcn_rcpf(1.f + __builtin_amdgcn_exp2f(-1.4426950408889634f * a)); }
        u32x4 w; w.x = cvt_pk_bf16(o[0], o[1]); w.y = cvt_pk_bf16(o[2], o[3]); w.z = cvt_pk_bf16(o[4], o[5]); w.w = cvt_pk_bf16(o[6], o[7]);
        *(u32x4*)(ACT + (size_t)r * 512 + ch) = w; }
  }
};
struct EpiDown {
  static constexpr bool PERM = true;
  bf16_t* Y2; const int* lists; const float* ew; MoeTab tab;
  __device__ __forceinline__ void operator()(const pg::Acc& acc, const pg::Unit& u, int wr, int wc, int fr, int fq) const {
    const int slot0 = (u.pm - tab.tb[u.aux]) * 256 + wr * 64 + fr, n_e = tab.cn[u.aux], col0 = u.pn * 256 + wc * 32 + 8 * fq;
    int ids[2][4]; float wts[2][4];
#pragma unroll
    for (int ai = 0; ai < 2; ++ai)
#pragma unroll
      for (int m = 0; m < 4; ++m) { const int slot = slot0 + ai * 128 + m * 16; ids[ai][m] = (slot < n_e) ? lists[u.aux * NLAT + slot] : -1; }
#pragma unroll
    for (int ai = 0; ai < 2; ++ai)
#pragma unroll
      for (int m = 0; m < 4; ++m) wts[ai][m] = (ids[ai][m] >= 0) ? ew[ids[ai][m]] : 0.f;
#pragma unroll
    for (int ai = 0; ai < 2; ++ai)
#pragma unroll
      for (int m = 0; m < 4; ++m) {
        if (ids[ai][m] >= 0) { const int id = ids[ai][m]; const float w = wts[ai][m];
#pragma unroll
          for (int bj = 0; bj < 2; ++bj) { const f32x4 v0 = acc[ai][bj][m][0] * w, v1 = acc[ai][bj][m][1] * w;
            u32x4 o; o.x = cvt_pk_bf16(v0[0], v0[1]); o.y = cvt_pk_bf16(v0[2], v0[3]); o.z = cvt_pk_bf16(v1[0], v1[1]); o.w = cvt_pk_bf16(v1[2], v1[3]);
            *(u32x4*)(Y2 + (size_t)id * DM + col0 + bj * 128) = o; } } }
  }
};
__device__ __forceinline__ void phase_moe_up(const Params& p, LAS unsigned char* lds) {
  const MoeTab tab = moe_tables(p, lds);
  const bool early = (MK_EARLY_DOWN != 0) && gridDim.x == 256;
  unsigned* tilecnt = (unsigned*)(p.ws + WS_CTL) + CTL_TILECNT;
  {
    pg::Addr AD{(const bf16_t*)(p.ws + WS_RH), DM, 0, (const bf16_t*)(p.ws + WS_WGU), DM, (size_t)1024 * 1024, true};
    SchedMoeUp S; S.G = gridDim.x; S.c = blockIdx.x; S.nN = 4; S.tab = tab; S.lists = (const int*)(p.ws + WS_ROUTE + RT_LIST); S.tilecnt = tilecnt; S.early = early;
    EpiGU E{(bf16_t*)(p.ws + WS_P + PR_ACT)};
    pg::gemm_phase(lds, AD, S, E);
  }
  if (early && blockIdx.x >= 64) {
    const int Le = blockIdx.x - 64, T = Le >> 2, pn = Le & 3;
    if (opaque_tid() == 0) { unsigned spins = 0;
      while (__hip_atomic_load(tilecnt + 64 * T, __ATOMIC_RELAXED, __HIP_MEMORY_SCOPE_AGENT) < 32u && ++spins < (1u << 22)) __builtin_amdgcn_s_sleep(4); }
    __syncthreads();
    __builtin_amdgcn_fence(__ATOMIC_ACQUIRE, "agent");
    asm volatile("s_waitcnt vmcnt(0)" ::: "memory");
    pg::Addr AD{(const bf16_t*)(p.ws + WS_P + PR_ACT), 512, 0, (const bf16_t*)(p.ws + WS_WD), 512, (size_t)1024 * 512, false};
    SchedMoeDownOne S; S.G = gridDim.x; S.c = blockIdx.x; S.nN = 4; S.tab = tab; S.lists = (const int*)(p.ws + WS_ROUTE + RT_LIST); S.T = T; S.pn = pn;
    EpiDown E{(bf16_t*)(p.ws + WS_P), (const int*)(p.ws + WS_ROUTE + RT_LIST), (const float*)(p.ws + WS_ROUTE + RT_EW), tab};
    pg::gemm_phase(lds, AD, S, E);
  }
}
__device__ __forceinline__ void phase_moe_down(const Params& p, LAS unsigned char* lds) {
  const MoeTab tab = moe_tables(p, lds);
  const bool early = (MK_EARLY_DOWN != 0) && gridDim.x == 256;
  pg::Addr AD{(const bf16_t*)(p.ws + WS_P + PR_ACT), 512, 0, (const bf16_t*)(p.ws + WS_WD), 512, (size_t)1024 * 512, false};
  SchedMoeDown S; S.G = gridDim.x; S.c = blockIdx.x; S.nN = 4; S.tab = tab; S.lists = (const int*)(p.ws + WS_ROUTE + RT_LIST); S.t_first = early ? NEARLY : 0;
  EpiDown E{(bf16_t*)(p.ws + WS_P), (const int*)(p.ws + WS_ROUTE + RT_LIST), (const float*)(p.ws + WS_ROUTE + RT_EW), tab};
  pg::gemm_phase(lds, AD, S, E);
}

__device__ __forceinline__ void phase_final(const Params& p) {
  const float* mod = (const float*)(p.ws + WS_MOD);
  const bf16_t* Y2 = (const bf16_t*)(p.ws + WS_P);
  const bf16_t* X1b = (const bf16_t*)(p.ws + WS_X1B); float* OUT = p.out;
  const int tid_ = opaque_tid(); const int lane = tid_ & 63, wave = tid_ >> 6;
  const int gw = blockIdx.x * NWAVES + wave, NGW = gridDim.x * NWAVES;
  u32x2 x1[4], x1n[4]; u32x2 ya[4], yb[4], yan[4], ybn[4];
#define FIN_LOAD(row, X, A, B) do { _Pragma("unroll") for (int j = 0; j < 4; ++j) { const int col = (lane + 64 * j) * 4; \
    X[j] = *(const u32x2*)(X1b + (size_t)(row) * DM + col); A[j] = *(const u32x2*)(Y2 + (size_t)(2 * (row)) * DM + col); B[j] = *(const u32x2*)(Y2 + (size_t)(2 * (row) + 1) * DM + col); } } while (0)
  if (gw < NLAT) FIN_LOAD(gw, x1, ya, yb);
  for (int row = gw; row < NLAT; row += NGW) {
    const int rown = row + NGW;
    if (rown < NLAT) FIN_LOAD(rown, x1n, yan, ybn);
    const float* mrow = mod + (row / SEQ) * NMOD;
    float probe_scale = 1.f;
#if MK_TS_PHASE >= 0
    if (row < 164) { const unsigned long long* ts = (const unsigned long long*)((const unsigned*)(p.ws + WS_CTL) + CTL_TS); probe_scale = 1.f + sqrtf((float)(ts[MK_TS_PHASE + 1] - ts[MK_TS_PHASE]) * MK_TS_SCALE); }
#endif
    f32x4 g2[4], gg[4], bb[4];
#pragma unroll
    for (int j = 0; j < 4; ++j) { const int col = (lane + 64 * j) * 4; g2[j] = *(const f32x4*)(mrow + 5 * DM + col); gg[j] = *(const f32x4*)(p.in[I_LN2G] + col); bb[j] = *(const f32x4*)(p.in[I_LN2B] + col); }
    f32x4 v[4]; float s = 0;
#pragma unroll
    for (int j = 0; j < 4; ++j) {
      f32x4 ym;
      ym.x = __uint_as_float(ya[j].x << 16) + __uint_as_float(yb[j].x << 16); ym.y = __uint_as_float(ya[j].x & 0xffff0000u) + __uint_as_float(yb[j].x & 0xffff0000u);
      ym.z = __uint_as_float(ya[j].y << 16) + __uint_as_float(yb[j].y << 16); ym.w = __uint_as_float(ya[j].y & 0xffff0000u) + __uint_as_float(yb[j].y & 0xffff0000u);
      const f32x4 xf = {__uint_as_float(x1[j].x << 16), __uint_as_float(x1[j].x & 0xffff0000u), __uint_as_float(x1[j].y << 16), __uint_as_float(x1[j].y & 0xffff0000u)};
      v[j] = xf * ALPHA + g2[j] * ym;
      s += (v[j].x + v[j].y) + (v[j].z + v[j].w);
    }
    const float mean = wave_sum(s) * (1.f / DM); float s2 = 0;
#pragma unroll
    for (int j = 0; j < 4; ++j) { v[j] = v[j] - mean; s2 += (v[j].x * v[j].x + v[j].y * v[j].y) + (v[j].z * v[j].z + v[j].w * v[j].w); }
    const float rstd = rsqrtf(wave_sum(s2) * (1.f / DM) + LN_EPS);
#pragma unroll
    for (int j = 0; j < 4; ++j) ((f32x4*)(OUT + (size_t)row * DM))[lane + 64 * j] = (v[j] * rstd * gg[j] + bb[j]) * probe_scale;
#pragma unroll
    for (int j = 0; j < 4; ++j) { x1[j] = x1n[j]; ya[j] = yan[j]; yb[j] = ybn[j]; }
  }
#undef FIN_LOAD
}
__device__ __forceinline__ void phase_attn(const Params& p, char* lds) {
  bf16_t* P = (bf16_t*)(p.ws + WS_P);
  int seq = SKV; asm volatile("" : "+s"(seq));
  float negMC;
  { const int l_ = opaque_tid() & 63; float gq = fmaxf(fabsf(p.in[I_QG][l_]), fabsf(p.in[I_QG][64 + l_])), gk = fmaxf(fabsf(p.in[I_KG][l_]), fabsf(p.in[I_KG][64 + l_]));
#pragma unroll
    for (int o = 1; o < 64; o <<= 1) { gq = fmaxf(gq, __shfl_xor(gq, o)); gk = fmaxf(gk, __shfl_xor(gk, o)); }
    negMC = 128.f * 1.01f * gq * gk; }
  for (int unit = blockIdx.x; unit < NB * 8 * (SEQ / 256); unit += gridDim.x) {
    const int h = unit % 8, qb = (unit / 8) % 32, b = unit / 256;
    bf16_t* Qp = P + ((size_t)b * SKV + qb * 256) * PLD + PC_Q + h * 128;
    const bf16_t* Kp = (const bf16_t*)(p.ws + WS_KC) + (size_t)(b * 2 + (h >> 2)) * SKV * 128;
    const bf16_t* Vp = (const bf16_t*)(p.ws + WS_VC) + (size_t)(b * 2 + (h >> 2)) * SKV * 128;
    att::attn_dense_body(Qp, Kp, Vp, Qp, seq, negMC, p.in[I_QG], qb * 256, lds);
  }
}

#if MK_TS_PHASE >= 16
#define RT_TS(k) do { if (gw == 0 && row0 == 0 && lane == 0) ((unsigned long long*)((unsigned*)(p.ws + WS_CTL) + CTL_TS))[k] = __builtin_amdgcn_s_memrealtime(); } while (0)
#else
#define RT_TS(k) do { } while (0)
#endif
constexpr int LDS_RTLOG = LDS_STAGE + 10240;
__device__ __forceinline__ void phase_ln1_router(const Params& p, LAS unsigned char* lds) {
  const float* mod = (const float*)(p.ws + WS_MOD);
  const float* R1 = p.out; bf16_t* X1b = (bf16_t*)(p.ws + WS_X1B);
  bf16_t* H2 = (bf16_t*)(p.ws + WS_RH);
  float* ew = (float*)(p.ws + WS_ROUTE + RT_EW); int* lists = (int*)(p.ws + WS_ROUTE + RT_LIST);
  unsigned* cnt = (unsigned*)(p.ws + WS_CTL) + CTL_CNT;
  const int tid_ = opaque_tid(); const int lane = tid_ & 63, wave = tid_ >> 6;
  const int gw = blockIdx.x * NWAVES + wave, NGW = gridDim.x * NWAVES;
  LAS float* hb = (LAS float*)lds + wave * 4096;
  LAS float* lg = (LAS float*)(lds + LDS_RTLOG) + wave * 160;
  const float* Wre = p.in[I_WRE]; const float* Wrg = p.in[I_WRG];
  f32x4 vv[4][4];
#define RT_LOAD(row0_) do { const int _r0 = ((row0_) < NLAT) ? (row0_) : (NLAT - 4); _Pragma("unroll") for (int r = 0; r < 4; ++r) _Pragma("unroll") for (int j = 0; j < 4; ++j) \
    vv[r][j] = ((const f32x4*)(R1 + (size_t)(_r0 + r) * DM))[lane + 64 * j]; } while (0)
  RT_LOAD(gw * 4);
  for (int row0 = gw * 4; row0 < NLAT; row0 += NGW * 4) {
    const float* mrow = mod + (row0 / SEQ) * NMOD;
    RT_TS(16);
#pragma unroll
    for (int r = 0; r < 4; ++r) {
      const int row = row0 + r, pr = lat2pad(row);
      f32x4 v[4]; float s = 0;
#pragma unroll
      for (int j = 0; j < 4; ++j) { v[j] = vv[r][j]; s += (v[j].x + v[j].y) + (v[j].z + v[j].w); }
      float mean = wave_sum(s) * (1.f / DM); float s2 = 0;
#pragma unroll
      for (int j = 0; j < 4; ++j) { v[j] = v[j] - mean; s2 += (v[j].x * v[j].x + v[j].y * v[j].y) + (v[j].z * v[j].z + v[j].w * v[j].w); }
      float rstd = rsqrtf(wave_sum(s2) * (1.f / DM) + LN_EPS);
      s = 0;
#pragma unroll
      for (int j = 0; j < 4; ++j) {
        const int col = (lane + 64 * j) * 4;
        const f32x4 g = *(const f32x4*)(p.in[I_LN1G] + col), bb = *(const f32x4*)(p.in[I_LN1B] + col);
        v[j] = v[j] * rstd * g + bb;
        { u32x2 xw; xw.x = cvt_pk_bf16(v[j].x, v[j].y); xw.y = cvt_pk_bf16(v[j].z, v[j].w); *(u32x2*)(X1b + (size_t)row * DM + col) = xw; }
        s += (v[j].x + v[j].y) + (v[j].z + v[j].w);
      }
      mean = wave_sum(s) * (1.f / DM); s2 = 0;
#pragma unroll
      for (int j = 0; j < 4; ++j) { v[j] = v[j] - mean; s2 += (v[j].x * v[j].x + v[j].y * v[j].y) + (v[j].z * v[j].z + v[j].w * v[j].w); }
      rstd = rsqrtf(wave_sum(s2) * (1.f / DM) + LN_EPS);
#pragma unroll
      for (int j = 0; j < 4; ++j) {
        const int col = (lane + 64 * j) * 4;
        const f32x4 sh = *(const f32x4*)(mrow + 3 * DM + col), sc = *(const f32x4*)(mrow + 4 * DM + col);
        const f32x4 hv = v[j] * rstd * (sc + 1.f) + sh;
        u32x2 w; w.x = cvt_pk_bf16(hv.x, hv.y); w.y = cvt_pk_bf16(hv.z, hv.w);
        *(u32x2*)(H2 + (size_t)pr * DM + col) = w;
        *(LAS f32x4*)(hb + r * 1024 + (col ^ (16 * r))) = hv;
      }
    }
    RT_LOAD(row0 + NGW * 4);
    asm volatile("s_waitcnt lgkmcnt(0)" ::: "memory");
    RT_TS(17);
    int gsel[4];
    {
      f32x4 acc[4];
#pragma unroll
      for (int r = 0; r < 4; ++r) acc[r] = (f32x4){0.f, 0.f, 0.f, 0.f};
#pragma unroll
      for (int i = 0; i < 16; ++i) { const int k = lane + 64 * i; const float* wrow = Wrg + (size_t)i * 256; const f32x4 w = *(const f32x4*)(wrow + (unsigned)(lane * 4));
#pragma unroll
        for (int r = 0; r < 4; ++r) acc[r] += w * hb[r * 1024 + (k ^ (16 * r))]; }
#pragma unroll
      for (int r = 0; r < 4; ++r)
#pragma unroll
        for (int e = 0; e < 4; ++e) acc[r][e] = wave_sum(acc[r][e]);
      if (lane == 0) {
#pragma unroll
        for (int r = 0; r < 4; ++r) *(LAS f32x4*)(lg + r * 40) = acc[r]; }
#pragma unroll
      for (int r = 0; r < 4; ++r) {
        int gi = 0; float gm = acc[r][0] + p.in[I_BRG][0];
#pragma unroll
        for (int i = 1; i < 4; ++i) { const float g = acc[r][i] + p.in[I_BRG][i]; if (g > gm) { gm = g; gi = i; } }
        gsel[r] = gi; }
    }
    RT_TS(18);
    {
      const int r_ = lane & 3, hf = (lane >> 2) & 1, kk = lane >> 3;
      const int gmine = (r_ == 0) ? gsel[0] : (r_ == 1) ? gsel[1] : (r_ == 2) ? gsel[2] : gsel[3];
      f32x4 acc = (f32x4){0.f, 0.f, 0.f, 0.f};
      const unsigned loff = (unsigned)(kk * 32 + gmine * 8 + 4 * hf);
      const LAS float* hrow = hb + r_ * 1024;
      const int kx = 16 * r_;
#pragma unroll 16
      for (int i = 0; i < 128; ++i) { const float* wrow = Wre + (size_t)i * 256; const f32x4 w = *(const f32x4*)(wrow + loff);
        acc += w * hrow[(8 * i + kk) ^ kx]; }
#pragma unroll
      for (int e = 0; e < 4; ++e) { float t = acc[e];
        t += __builtin_bit_cast(float, __builtin_amdgcn_update_dpp(0, __builtin_bit_cast(int, t), 0x128, 0xF, 0xF, false));
        { auto rr = __builtin_amdgcn_permlane16_swap(__float_as_uint(t), __float_as_uint(t), false, false); t = __uint_as_float(rr[0]) + __uint_as_float(rr[1]); }
        { auto rr = __builtin_amdgcn_permlane32_swap(__float_as_uint(t), __float_as_uint(t), false, false); t = __uint_as_float(rr[0]) + __uint_as_float(rr[1]); }
        acc[e] = t; }
      if (kk == 0) *(LAS f32x4*)(lg + r_ * 40 + 4 + gmine * 8 + 4 * hf) = acc;
    }
    asm volatile("s_waitcnt lgkmcnt(0)" ::: "memory");
    RT_TS(19);
    if (lane < 4) {
      const int row = row0 + lane; const LAS float* L = lg + lane * 40;
      float gl[4]; int gi = 0;
#pragma unroll
      for (int i = 0; i < 4; ++i) gl[i] = L[i] + p.in[I_BRG][i];
      float gm = gl[0];
#pragma unroll
      for (int i = 1; i < 4; ++i) if (gl[i] > gm) { gm = gl[i]; gi = i; }
      float den = 0.f;
#pragma unroll
      for (int i = 0; i < 4; ++i) den += expf(gl[i] - gm);
      const float gw_ = 1.f / den;
      float el[8];
#pragma unroll
      for (int i = 0; i < 8; ++i) el[i] = L[4 + gi * 8 + i] + p.in[I_BRE][gi * 8 + i];
      int i1 = 0; float v1 = el[0];
#pragma unroll
      for (int i = 1; i < 8; ++i) if (el[i] > v1) { v1 = el[i]; i1 = i; }
      int i2 = -1; float v2 = -3.0e38f;
#pragma unroll
      for (int i = 0; i < 8; ++i) if (i != i1 && el[i] > v2) { v2 = el[i]; i2 = i; }
      const float e2 = expf(v2 - v1); const float w1 = 1.f / (1.f + e2), w2 = e2 / (1.f + e2);
      const int ea = gi * 8 + i1, eb = gi * 8 + i2;
      const unsigned pa = atomicAdd(cnt + ea * CNT_STRIDE, 1u), pb = atomicAdd(cnt + eb * CNT_STRIDE, 1u);
      lists[ea * NLAT + pa] = row * 2; lists[eb * NLAT + pb] = row * 2 + 1;
      ew[row * 2] = w1 * gw_; ew[row * 2 + 1] = w2 * gw_;
    }
    asm volatile("s_waitcnt vmcnt(0) lgkmcnt(0)" ::: "memory");
    RT_TS(20);
  }
}

enum { PH_PRO = 0, PH_LN, PH_GIN, PH_QK, PH_ATT, PH_G1, PH_G2, PH_G3, PH_RT, PH_UP, PH_DOWN, PH_FIN, PH_S5S, PH_SCAN, PH_S5Y, PH_COUNT };
template <int PH> __device__ __forceinline__ void run_phase(const Params& p, unsigned char* lds_raw) {
  LAS unsigned char* lds = (LAS unsigned char*)lds_raw;
  if constexpr (PH == PH_PRO) phase0(p, lds);
  if constexpr (PH == PH_LN) phase1(p, lds);
  if constexpr (PH == PH_GIN) phase2(p, lds);
  if constexpr (PH == PH_QK) phase_qknorm(p);
  if constexpr (PH == PH_ATT) phase_attn(p, (char*)lds_raw);
  if constexpr (PH == PH_G1) phase_g1(p, lds);
  if constexpr (PH == PH_G2) phase_g2(p, lds);
  if constexpr (PH == PH_G3) phase_g3(p, lds);
  if constexpr (PH == PH_RT) phase_ln1_router(p, lds);
  if constexpr (PH == PH_UP) phase_moe_up(p, lds);
  if constexpr (PH == PH_DOWN) phase_moe_down(p, lds);
  if constexpr (PH == PH_FIN) phase_final(p);
  if constexpr (PH == PH_S5S) phase_s5s(p, lds);
  if constexpr (PH == PH_SCAN) phase_s5scan(p);
  if constexpr (PH == PH_S5Y) phase_s5y(p, lds);
}
#ifndef MK_FUSED
#define MK_FUSED 1
#endif
#if !MK_FUSED
template <int PH> __global__ __launch_bounds__(512, 2) void k_phase(Params p) {
  extern __shared__ __attribute__((aligned(16))) unsigned char lds_raw[];
  run_phase<PH>(p, lds_raw);
}
template <int PH> static bool set_lds() { return hipFuncSetAttribute((const void*)k_phase<PH>, hipFuncAttributeMaxDynamicSharedMemorySize, LDS_BYTES) == hipSuccess; }
template <int PH> static void launch_ph(int grid, hipStream_t stream, const Params& p) { hipLaunchKernelGGL(k_phase<PH>, dim3(grid), dim3(512), LDS_BYTES, stream, p); }
#else
constexpr int CTL_SCAN = 2048;
constexpr int CTL_S5SCNT = 2432;
#ifndef MK_CG_SYNC
#define MK_CG_SYNC 0
#endif
constexpr int CTL_BAR = 4096;
constexpr int LDS_BARST = LDS_STAGE + 1024;
#if MK_CG_SYNC
#define GRID_BAR() cooperative_groups::this_grid().sync()
#else
#ifdef MK_DOUBLE_BAR
#define GRID_BAR() do { xcd_barrier(xbar); xcd_barrier(xbar); } while (0)
#else
#define GRID_BAR() xcd_barrier(xbar)
#endif
#endif
typedef const __attribute__((address_space(4))) Params* KParamsPtr;
__device__ __forceinline__ KParamsPtr kparams() { KParamsPtr k = (KParamsPtr)__builtin_amdgcn_kernarg_segment_ptr(); asm volatile("" : "+s"(k)); return k; }
#define KP (*(const Params*)kparams())
#ifndef MK_MASK
#define MK_MASK 0xFFFF
#endif
#ifndef MK_REP_MASK
#define MK_REP_MASK 0
#endif
#ifndef MK_REP
#define MK_REP 1
#endif
#define REP_PHASE(PH) do { if constexpr ((MK_REP_MASK >> PH) & 1) { for (int _r = 0; _r < MK_REP; ++_r) { run_phase<PH>(KP, lds_raw); GRID_BAR(); } } } while (0)
#ifndef MK_TS_PHASE
#define MK_TS_PHASE -1
#endif
#ifndef MK_TS_SCALE
#define MK_TS_SCALE 5.0e-8f
#endif
#if MK_TS_PHASE >= 0
#ifdef MK_TS_CLOCK
#define TS_MARK() do { if (blockIdx.x == 0 && opaque_tid() == 0) { ((unsigned long long*)((unsigned*)(KP.ws + WS_CTL) + CTL_TS))[ts_n] = __builtin_readcyclecounter(); } ++ts_n; } while (0)
#else
#define TS_MARK() do { if (blockIdx.x == 0 && opaque_tid() == 0) { ((unsigned long long*)((unsigned*)(KP.ws + WS_CTL) + CTL_TS))[ts_n] = __builtin_amdgcn_s_memrealtime(); } ++ts_n; } while (0)
#endif
#else
#define TS_MARK() do { } while (0)
#endif
__global__ __launch_bounds__(512, 2) void k_mega(Params p_unused) {
  extern __shared__ __attribute__((aligned(16))) unsigned char lds_raw[];
  int ts_n = 0; (void)ts_n;
#if !MK_CG_SYNC
  volatile LAS unsigned* bst = (volatile LAS unsigned*)((LAS unsigned char*)lds_raw + LDS_BARST);
  if (threadIdx.x < 2) bst[threadIdx.x] = 0u;
  tid_table_init();
  __syncthreads();
  const XcdBarrier xbar = xcd_barrier_post((unsigned*)(KP.ws + WS_CTL) + CTL_BAR, bst);
#endif
  TS_MARK();
  REP_PHASE(PH_PRO);
#if MK_LN_IN_PRO
  if constexpr ((MK_MASK >> PH_PRO) & 1) run_phase<PH_PRO>(KP, lds_raw);
  { if (opaque_tid() == 0) { unsigned spins = 0;
      while (__hip_atomic_load((unsigned*)(KP.ws + WS_CTL) + CTL_MODCNT, __ATOMIC_ACQUIRE, __HIP_MEMORY_SCOPE_AGENT) < gridDim.x && ++spins < (1u << 22)) __builtin_amdgcn_s_sleep(4); }
    __syncthreads();
    __builtin_amdgcn_fence(__ATOMIC_ACQUIRE, "agent"); }
  TS_MARK();
#else
  if constexpr ((MK_MASK >> PH_PRO) & 1) run_phase<PH_PRO>(KP, lds_raw);  GRID_BAR(); TS_MARK();
#endif
  REP_PHASE(PH_LN);
  if constexpr ((MK_MASK >> PH_LN) & 1) run_phase<PH_LN>(KP, lds_raw);   GRID_BAR(); TS_MARK();
  REP_PHASE(PH_GIN);
  if constexpr ((MK_MASK >> PH_GIN) & 1) run_phase<PH_GIN>(KP, lds_raw);  GRID_BAR(); TS_MARK();
  REP_PHASE(PH_S5S);
#if MK_S5_IN_P3
  {
    unsigned* c_s5s = (unsigned*)(KP.ws + WS_CTL) + CTL_S5SCNT; unsigned* c_scan = (unsigned*)(KP.ws + WS_CTL) + CTL_SCAN;
    const int cB = blockIdx.x;
    if (cB < 160) {
      run_phase<PH_S5S>(KP, lds_raw);
      if (opaque_tid() == 0) { __threadfence(); __hip_atomic_fetch_add(c_s5s, 1u, __ATOMIC_RELEASE, __HIP_MEMORY_SCOPE_AGENT); }
    } else if (cB < 176) {
      if (opaque_tid() == 0) { unsigned spins = 0; while (__hip_atomic_load(c_s5s, __ATOMIC_ACQUIRE, __HIP_MEMORY_SCOPE_AGENT) < 160u && ++spins < (1u << 22)) __builtin_amdgcn_s_sleep(4); }
      __syncthreads();
      __builtin_amdgcn_fence(__ATOMIC_ACQUIRE, "agent");
      { const int t_ = opaque_tid(); s5_scan_item(KP, (cB - 160) * NWAVES + (t_ >> 6), t_ & 63); }
      asm volatile("s_waitcnt vmcnt(0)" ::: "memory");
      __syncthreads();
      if (opaque_tid() == 0) { __threadfence(); __hip_atomic_fetch_add(c_scan, 1u, __ATOMIC_RELEASE, __HIP_MEMORY_SCOPE_AGENT); }
    }
    run_phase<PH_QK>(KP, lds_raw);
    if (cB < 128) {
      if (opaque_tid() == 0) { unsigned spins = 0; while (__hip_atomic_load(c_scan, __ATOMIC_ACQUIRE, __HIP_MEMORY_SCOPE_AGENT) < 16u && ++spins < (1u << 22)) __builtin_amdgcn_s_sleep(4); }
      __syncthreads();
      __builtin_amdgcn_fence(__ATOMIC_ACQUIRE, "agent");
      run_phase<PH_S5Y>(KP, lds_raw);
    }
  }
  GRID_BAR(); TS_MARK();
  run_phase<PH_ATT>(KP, lds_raw);
#else
#if MK_TS_PHASE >= 16
  if (blockIdx.x == 0 && opaque_tid() == 0) ((unsigned long long*)((unsigned*)(KP.ws + WS_CTL) + CTL_TS))[21] = __builtin_amdgcn_s_memrealtime();
#endif
  if constexpr ((MK_MASK >> PH_S5S) & 1) run_phase<PH_S5S>(KP, lds_raw);
#if MK_TS_PHASE >= 16
  if (blockIdx.x == 0 && opaque_tid() == 0) ((unsigned long long*)((unsigned*)(KP.ws + WS_CTL) + CTL_TS))[22] = __builtin_amdgcn_s_memrealtime();
#endif
  if constexpr ((MK_MASK >> PH_QK) & 1) run_phase<PH_QK>(KP, lds_raw);
#if MK_TS_PHASE >= 16
  asm volatile("s_waitcnt vmcnt(0)" ::: "memory");
  if (blockIdx.x == 0 && opaque_tid() == 0) ((unsigned long long*)((unsigned*)(KP.ws + WS_CTL) + CTL_TS))[23] = __builtin_amdgcn_s_memrealtime();
#endif
  GRID_BAR(); TS_MARK();
  {
    unsigned* ctr = (unsigned*)(KP.ws + WS_CTL) + CTL_SCAN;
    if (blockIdx.x * NWAVES < 128) {
#if MK_TS_PHASE >= 16
      if (blockIdx.x == 0 && opaque_tid() == 0) ((unsigned long long*)((unsigned*)(KP.ws + WS_CTL) + CTL_TS))[16] = __builtin_amdgcn_s_memrealtime();
#endif
      if constexpr ((MK_MASK >> PH_SCAN) & 1) run_phase<PH_SCAN>(KP, lds_raw);
#if MK_TS_PHASE >= 16
      asm volatile("s_waitcnt vmcnt(0)" ::: "memory");
      if (blockIdx.x == 0 && opaque_tid() == 0) ((unsigned long long*)((unsigned*)(KP.ws + WS_CTL) + CTL_TS))[17] = __builtin_amdgcn_s_memrealtime();
#endif
      __threadfence();
      if ((opaque_tid() & 63) == 0 && blockIdx.x * NWAVES + (opaque_tid() >> 6) < 128) __hip_atomic_fetch_add(ctr, 1u, __ATOMIC_RELEASE, __HIP_MEMORY_SCOPE_AGENT);
    }
    if constexpr ((MK_MASK >> PH_ATT) & 1) run_phase<PH_ATT>(KP, lds_raw);
    if (opaque_tid() == 0) { unsigned spins = 0; while (__hip_atomic_load(ctr, __ATOMIC_ACQUIRE, __HIP_MEMORY_SCOPE_AGENT) < 128u && ++spins < (1u << 24)) __builtin_amdgcn_s_sleep(8); }
    __syncthreads();
    __threadfence();
    if constexpr ((MK_MASK >> PH_S5Y) & 1) run_phase<PH_S5Y>(KP, lds_raw);
  }
#endif
  GRID_BAR(); TS_MARK();
  REP_PHASE(PH_S5Y);
  REP_PHASE(PH_G1);
  if constexpr ((MK_MASK >> PH_G1) & 1) run_phase<PH_G1>(KP, lds_raw);   GRID_BAR(); TS_MARK();
  if constexpr ((MK_MASK >> PH_G2) & 1) run_phase<PH_G2>(KP, lds_raw);   GRID_BAR(); TS_MARK();
  REP_PHASE(PH_G3);
  if constexpr ((MK_MASK >> PH_G3) & 1) run_phase<PH_G3>(KP, lds_raw);   GRID_BAR(); TS_MARK();
  if constexpr ((MK_MASK >> PH_RT) & 1) run_phase<PH_RT>(KP, lds_raw);   GRID_BAR(); TS_MARK();
  REP_PHASE(PH_UP);
  if constexpr ((MK_MASK >> PH_UP) & 1) run_phase<PH_UP>(KP, lds_raw);   GRID_BAR(); TS_MARK();
  REP_PHASE(PH_DOWN);
  if constexpr ((MK_MASK >> PH_DOWN) & 1) run_phase<PH_DOWN>(KP, lds_raw); GRID_BAR(); TS_MARK();
#if MK_TS_PHASE >= 0
  GRID_BAR();
#endif
  if constexpr ((MK_MASK >> PH_FIN) & 1) run_phase<PH_FIN>(KP, lds_raw);
}
#endif

extern "C" void kernel_launch(void* const* d_in, const int* in_sizes, int n_in, void* d_out, int out_size, void* d_ws, size_t ws_size, hipStream_t stream) {
  static int grid = 0;
  if (grid == 0) {
    if (n_in != 32 || out_size != NLAT * DM || ws_size < WS_END) { fprintf(stderr, "kernel_launch: unexpected shapes n_in %d out %d ws %zu\n", n_in, out_size, ws_size); grid = -1; return; }
    int dev = 0, cus = 0;
    hipGetDevice(&dev); hipDeviceGetAttribute(&cus, hipDeviceAttributeMultiprocessorCount, dev);
#if !MK_FUSED
    bool ok = set_lds<0>() && set_lds<1>() && set_lds<2>() && set_lds<3>() && set_lds<4>() && set_lds<5>() && set_lds<6>() && set_lds<7>() && set_lds<8>() && set_lds<9>() && set_lds<10>() && set_lds<11>() && set_lds<12>() && set_lds<13>() && set_lds<14>();
    if (!ok) { fprintf(stderr, "kernel_launch: hipFuncSetAttribute failed\n"); grid = -1; return; }
    grid = cus > 0 ? cus : 256;
#else
    if (hipFuncSetAttribute((const void*)k_mega, hipFuncAttributeMaxDynamicSharedMemorySize, LDS_BYTES) != hipSuccess) { fprintf(stderr, "kernel_launch: hipFuncSetAttribute failed\n"); grid = -1; return; }
    int per_cu = 0;
    if (hipOccupancyMaxActiveBlocksPerMultiprocessor(&per_cu, (const void*)k_mega, 512, LDS_BYTES) != hipSuccess || per_cu < 1) { fprintf(stderr, "kernel_launch: occupancy query says %d blocks per CU\n", per_cu); grid = -1; return; }
    grid = (cus > 0 ? cus : 256) * 1;
#endif
  }
  if (grid < 0) return;
  Params p{};
  for (int i = 0; i < 32; ++i) p.in[i] = (const float*)d_in[i];
  p.out = (float*)d_out; p.ws = (unsigned char*)d_ws;
  hipMemsetAsync((char*)d_ws + WS_CTL, 0, 64 * 1024, stream);
#if !MK_FUSED
  launch_ph<PH_PRO>(grid, stream, p);
  launch_ph<PH_LN>(grid, stream, p);
  launch_ph<PH_GIN>(grid, stream, p);
  launch_ph<PH_QK>(grid, stream, p);
  launch_ph<PH_S5S>(grid, stream, p);
  launch_ph<PH_SCAN>(grid, stream, p);
  launch_ph<PH_ATT>(grid, stream, p);
  launch_ph<PH_S5Y>(grid, stream, p);
  launch_ph<PH_G1>(grid, stream, p);
  launch_ph<PH_G2>(grid, stream, p);
  launch_ph<PH_G3>(grid, stream, p);
  launch_ph<PH_RT>(grid, stream, p);
  launch_ph<PH_UP>(grid, stream, p);
  launch_ph<PH_DOWN>(grid, stream, p);
  launch_ph<PH_FIN>(grid, stream, p);
#else
  void* args[] = {&p};
  hipError_t e = hipLaunchCooperativeKernel((const void*)k_mega, dim3(grid), dim3(512), args, LDS_BYTES, stream);
  if (e != hipSuccess) fprintf(stderr, "kernel_launch: cooperative launch failed: %s (grid %d)\n", hipGetErrorString(e), grid);
#endif
}
```

```cpp
#include <hip/hip_runtime.h>
#include <hip/hip_bf16.h>
#include <hip/hip_cooperative_groups.h>
#include <cstdint>
#include <cstdio>

typedef unsigned short bf16_t;
#define LAS __attribute__((address_space(3)))
typedef short bf16x8 __attribute__((ext_vector_type(8)));
typedef float f32x4 __attribute__((ext_vector_type(4)));
typedef float f32x2 __attribute__((ext_vector_type(2)));
typedef unsigned u32x4 __attribute__((ext_vector_type(4)));
typedef unsigned u32x2 __attribute__((ext_vector_type(2)));

__device__ __forceinline__ float bf2f(bf16_t v) { return __uint_as_float(((unsigned)v) << 16); }
__device__ __forceinline__ bf16_t f2bf(float f) { unsigned u = __float_as_uint(f); return (bf16_t)((u + 0x7fffu + ((u >> 16) & 1u)) >> 16); }
__device__ __forceinline__ unsigned cvt_pk_bf16(float lo, float hi) { unsigned r; asm volatile("v_cvt_pk_bf16_f32 %0, %1, %2" : "=v"(r) : "v"(lo), "v"(hi)); return r; }

constexpr int DM = 1024, NB = 2, SEQ = 8192, NCTX = 256;
constexpr int NLAT = NB * SEQ;
constexpr int SKV = SEQ + NCTX;
constexpr int NROW = NB * SKV;
constexpr int INW = 4096;
constexpr int NMOD = 6 * DM;
constexpr int PLD = 3584;
constexpr int PC_Q = 0, PC_K = 1024, PC_V = 1280, PC_G = 1536;
constexpr int NCHUNK = NROW / 16;
constexpr float LN_EPS = 1e-6f;
constexpr float ALPHA = 1.189207115002721f;

constexpr size_t MiB = 1u << 20;
constexpr size_t WS_CTL = 0;
constexpr size_t WS_MOD = 1 * MiB;
constexpr size_t WS_ROUTE = 2 * MiB;
constexpr size_t WS_S5AB = 5 * MiB;
constexpr size_t WS_S5T = 6 * MiB;
constexpr size_t WS_S5E = 14 * MiB;
constexpr size_t WS_WIN = 18 * MiB;
constexpr size_t WS_WGLU = 26 * MiB;
constexpr size_t WS_WAO = 28 * MiB;
constexpr size_t WS_WOUT = 30 * MiB;
constexpr size_t WS_WGU = 32 * MiB;
constexpr size_t WS_WD = 96 * MiB;
constexpr size_t WS_RH = 128 * MiB;
constexpr size_t WS_P = 162 * MiB;
constexpr size_t WS_KC = 280 * MiB;
constexpr size_t WS_VC = WS_KC + (size_t)NB * 2 * SKV * 128 * 2;
constexpr size_t WS_X1B = 268 * MiB;
constexpr size_t WS_END = 300 * MiB;
constexpr size_t DO_YA = 0, DO_GY = 34 * MiB;

struct Params {
  const float* in[32];
  float* out;
  unsigned char* ws;
};
enum { I_X = 0, I_C, I_CTX, I_CCTX, I_WMOD, I_BMOD, I_WIN, I_SARE, I_SAIM, I_SLDT, I_SBRE, I_SBIM, I_SCRE, I_SCIM, I_SD,
       I_WGA, I_WGB, I_QG, I_KG, I_WAO, I_WOUT, I_LN1G, I_LN1B, I_WRG, I_BRG, I_WRE, I_BRE, I_WEG, I_WEU, I_WED, I_LN2G, I_LN2B };

template <int CTRL> __device__ __forceinline__ float dpp_add(float v) { return v + __builtin_bit_cast(float, __builtin_amdgcn_update_dpp(0, __builtin_bit_cast(int, v), CTRL, 0xF, 0xF, false)); }
__device__ __forceinline__ float row16_sum(float v) {
  v = dpp_add<0xB1>(v); v = dpp_add<0x4E>(v); v = dpp_add<0x141>(v); v = dpp_add<0x140>(v); return v; }
__device__ __forceinline__ float wave_sum(float v) {
  v = row16_sum(v);
  { auto rr = __builtin_amdgcn_permlane16_swap(__float_as_uint(v), __float_as_uint(v), false, false); v = __uint_as_float(rr[0]) + __uint_as_float(rr[1]); }
  { auto rr = __builtin_amdgcn_permlane32_swap(__float_as_uint(v), __float_as_uint(v), false, false); v = __uint_as_float(rr[0]) + __uint_as_float(rr[1]); }
  return v;
}
__device__ __forceinline__ float lane_xor4(float x) {
  int t = __builtin_amdgcn_update_dpp(0, __builtin_bit_cast(int, x), 0x104, 0xF, 0x5, false);
  t = __builtin_amdgcn_update_dpp(t, __builtin_bit_cast(int, x), 0x114, 0xF, 0xA, false);
  return __builtin_bit_cast(float, t);
}
__device__ __forceinline__ float sigmoidf_(float x) { return 1.f / (1.f + __expf(-x)); }
__device__ __forceinline__ float siluf_(float x) { return x / (1.f + __expf(-x)); }
__device__ __forceinline__ float gelu_tanh(float x) {
  const float k0 = 0.7978845608028654f, k1 = 0.044715f;
  const float z = k0 * (x + k1 * x * x * x);
  return x / (1.f + __expf(-2.f * z));
}
__device__ __forceinline__ int lat2pad(int lr) { return lr + (lr / SEQ) * NCTX; }

constexpr int NWAVES = 8;
constexpr int LDS_STAGE = 131072;
constexpr int LDS_BYTES = 147456;


constexpr int LDS_WIDTAB = LDS_STAGE + 15872;
__device__ __forceinline__ unsigned hw_wave_slot() { return (unsigned)__builtin_amdgcn_s_getreg(((6 - 1) << 11) | 4) & 63u; }
__device__ __forceinline__ int opaque_tid() {
  extern __shared__ __attribute__((aligned(16))) unsigned char lds_dyn_[];
  const int wv = __builtin_amdgcn_readfirstlane(((const volatile LAS int*)((LAS unsigned char*)lds_dyn_ + LDS_WIDTAB))[hw_wave_slot()]);
  unsigned m = ~0u; asm volatile("" : "+s"(m));
  int t = (wv << 6) | (int)__builtin_amdgcn_mbcnt_hi(m, __builtin_amdgcn_mbcnt_lo(m, 0u));
  asm volatile("" : "+v"(t)); return t;
}
__device__ __forceinline__ void tid_table_init() {
  extern __shared__ __attribute__((aligned(16))) unsigned char lds_dyn_[];
  if ((threadIdx.x & 63) == 0) ((volatile LAS int*)((LAS unsigned char*)lds_dyn_ + LDS_WIDTAB))[hw_wave_slot()] = (int)(threadIdx.x >> 6);
}

#ifndef MK_TS_PHASE
#define MK_TS_PHASE -1
#endif
#ifndef MK_TS_SCALE
#define MK_TS_SCALE 5.0e-8f
#endif
constexpr int CTL_TS = 3072;
#ifndef MK_CTX_IN_P1
#define MK_CTX_IN_P1 0
#endif
#ifndef MK_N1_NUM
#define MK_N1_NUM 4
#define MK_N1_DEN 5
#endif
#ifndef MK_LN_IN_PRO
#define MK_LN_IN_PRO 0
#endif
#ifndef MK_CTX_IN_PRO
#define MK_CTX_IN_PRO 0
#endif
constexpr int NCTXB = 8;
constexpr int CTL_CTXCNT = 2176;
constexpr int CTL_MODCNT = 2304, CTL_WINCNT = 2368;
#ifndef MK_MMA_PRIO
#define MK_MMA_PRIO 1
#endif
#ifndef MK_EARLY_DOWN
#define MK_EARLY_DOWN 0
#endif
#ifndef MK_WARM_G2
#define MK_WARM_G2 0
#endif
#ifndef MK_S5_IN_P3
#define MK_S5_IN_P3 0
#endif
#ifndef MK_MOE_HALF
#define MK_MOE_HALF 1
#endif
namespace pg {
constexpr int BM = 256, BK = 64, HALF = 128, HTB = HALF * BK * 2, STAGE_BYTES = 8 * HTB;
__host__ __device__ __forceinline__ int lds_byte(int r, int c) { const int st = (r >> 4) * 2 + (c >> 5), rr = r & 15, cc = c & 31, ob = rr * 64 + cc * 2; return st * 1024 + (ob ^ (((ob >> 9) & 1) << 5)); }
__host__ __device__ __forceinline__ void stage_rc(int b, int& R, int& C) { const int st = b / 1024, sb = b % 1024, swz = sb ^ (((sb >> 9) & 1) << 5); R = (st >> 1) * 16 + swz / 64; C = (st & 1) * 32 + (swz % 64) / 2; }
__host__ __device__ __forceinline__ int perm32(int rho) { const int n = rho >> 4, i = rho & 15; return 8 * (i >> 2) + 4 * n + (i & 3); }

struct Unit { int pm, pn, aux, arow, half; };
struct Addr {
  const bf16_t* A; int lda; size_t a_gs; const bf16_t* Bt; int K; size_t b_gs;
  bool gather;
  __device__ __forceinline__ const char* a_base(const Unit& u) const { return gather ? (const char*)A : (const char*)(A + (size_t)u.aux * a_gs + (size_t)u.arow * lda); }
  __device__ __forceinline__ const char* b_base(const Unit& u) const { return (const char*)(Bt + (size_t)u.aux * b_gs + (size_t)u.pn * BM * K); }
};
typedef f32x4 Acc[2][2][4][2];

template <class Epi, class Sched>
__device__ __forceinline__ void gemm_phase(LAS unsigned char* lds, const Addr AD, const Sched& S, const Epi& E) {
  const int tid = opaque_tid(), wid = __builtin_amdgcn_readfirstlane(tid >> 6), lane = tid & 63, wr = wid >> 2, wc = wid & 3, fr = lane & 15, fq = lane >> 4;
  int K_ = AD.K; asm volatile("" : "+s"(K_));
  const int K = K_, nt = K / BK, lda = AD.lda;
  int R0, C0; stage_rc(tid * 16, R0, C0);
  const unsigned voffB0 = (unsigned)(((Epi::PERM ? ((R0 & ~31) + perm32(R0 & 31)) : R0)) * K + C0) * 2u;
  const size_t pstepB = (size_t)64 * K * 2, pstepA = (size_t)64 * lda * 2, hstepA = (size_t)HALF * lda * 2;
  unsigned vA[2][2];
  const unsigned voffA0 = (unsigned)(R0 * lda + C0) * 2u;
#define PG_SETV(v, u) do { if constexpr (Sched::GATHER) { _Pragma("unroll") for (int _h = 0; _h < 2; ++_h) _Pragma("unroll") for (int _i = 0; _i < 2; ++_i) \
    v[_h][_i] = (unsigned)(S.arow(u, _h * HALF + _i * 64 + R0) * lda + C0) * 2u; } } while (0)
  const size_t kstep = (size_t)(BK * 2);
  const size_t hstepB = (size_t)HALF * K * 2;
  const unsigned ldsw = (unsigned)wid * 1024u;
  const int aoff = lds_byte(wr * 64 + fr, fq * 8), boff = lds_byte(wc * 32 + fr, fq * 8);
#define PG_SA(b, h) (((b) * 2 + (h)) * HTB)
#define PG_SB(b, h) ((4 + (b) * 2 + (h)) * HTB)
#define PG_STAGE_B(bufoff, gbase) do { _Pragma("unroll") for (int _i = 0; _i < 2; ++_i) { unsigned _vo = voffB0; asm volatile("" : "+v"(_vo)); \
    __builtin_amdgcn_global_load_lds((const unsigned*)((const char*)(gbase) + _i * pstepB + _vo), (LAS unsigned*)(lds + (bufoff) + ldsw + _i * 8192), 16, 0, 0); } } while (0)
#define PG_STAGE_A(b, h, gbase, V) do { _Pragma("unroll") for (int _i = 0; _i < 2; ++_i) { \
    if constexpr (Sched::GATHER) { unsigned _vo = V[h][_i]; asm volatile("" : "+v"(_vo)); __builtin_amdgcn_global_load_lds((const unsigned*)((const char*)(gbase) + _vo), (LAS unsigned*)(lds + PG_SA(b, h) + ldsw + _i * 8192), 16, 0, 0); } \
    else { unsigned _vo = voffA0; asm volatile("" : "+v"(_vo)); __builtin_amdgcn_global_load_lds((const unsigned*)((const char*)(gbase) + (h) * hstepA + _i * pstepA + _vo), (LAS unsigned*)(lds + PG_SA(b, h) + ldsw + _i * 8192), 16, 0, 0); } } } while (0)
#define PG_LDA(dst, b, h) do { _Pragma("unroll") for (int m = 0; m < 4; ++m) _Pragma("unroll") for (int k = 0; k < 2; ++k) dst[m][k] = *(const LAS bf16x8*)(lds + PG_SA(b, h) + aoff + m * 2048 + k * 1024); } while (0)
#define PG_LDB(dst, b, h) do { _Pragma("unroll") for (int n = 0; n < 2; ++n) _Pragma("unroll") for (int k = 0; k < 2; ++k) dst[n][k] = *(const LAS bf16x8*)(lds + PG_SB(b, h) + boff + n * 2048 + k * 1024); } while (0)
#define PG_MMA(ai, bj, At, Bt) do { __builtin_amdgcn_s_setprio(1); _Pragma("unroll") for (int m = 0; m < 4; ++m) _Pragma("unroll") for (int n = 0; n < 2; ++n) _Pragma("unroll") for (int k = 0; k < 2; ++k) \
    acc[ai][bj][m][n] = __builtin_amdgcn_mfma_f32_16x16x32_bf16(Bt[n][k], At[m][k], acc[ai][bj][m][n], 0, 0, 0); __builtin_amdgcn_s_setprio(0); } while (0)
#define PG_WAIT_V(n) asm volatile("s_waitcnt vmcnt(" #n ")" ::: "memory")
#define PG_WAIT_L(n) asm volatile("s_waitcnt lgkmcnt(" #n ")" ::: "memory")
#define PG_BAR __builtin_amdgcn_s_barrier()
#define PG_SCHED __builtin_amdgcn_sched_barrier(0)
  Unit cur, nxt; int ui = 0;
  if (!S.next(0, cur)) return;
  Acc acc;
#pragma unroll
  for (int a = 0; a < 2; ++a)
#pragma unroll
    for (int b = 0; b < 2; ++b)
#pragma unroll
      for (int m = 0; m < 4; ++m)
#pragma unroll
        for (int n = 0; n < 2; ++n) acc[a][b][m][n] = (f32x4){0.f, 0.f, 0.f, 0.f};
  bf16x8 At[4][2], B0[2][2], B1[2][2];
  const char* cA = AD.a_base(cur); const char* cB = AD.b_base(cur);
  PG_SETV(vA, cur);
  PG_STAGE_B(PG_SB(0, 0), cB); PG_STAGE_B(PG_SB(0, 1), cB + hstepB); PG_STAGE_A(0, 0, cA, vA); PG_STAGE_A(0, 1, cA, vA);
  if (wr == 1) PG_BAR;
  PG_WAIT_V(2); PG_BAR;
  PG_STAGE_B(PG_SB(1, 0), cB + kstep); PG_STAGE_A(1, 0, cA + kstep, vA); PG_STAGE_B(PG_SB(1, 1), cB + hstepB + kstep);
  PG_WAIT_V(6); PG_BAR;
#define PG_MMA1() do { if constexpr (Sched::HALF) { if (!cur.half) { PG_MMA(1, 0, At, B0); PG_MMA(1, 1, At, B1); } } else { PG_MMA(1, 0, At, B0); PG_MMA(1, 1, At, B1); } } while (0)
#define PG_KPAIR(a1, a2, b2, a3, b3, VN) do { \
      PG_LDB(B0, 0, 0); PG_LDB(B1, 0, 1); PG_SCHED; PG_LDA(At, 0, 0); PG_STAGE_A(1, 1, a1, vA); \
      PG_WAIT_V(8); PG_WAIT_L(0); PG_BAR; PG_MMA(0, 0, At, B0); PG_MMA(0, 1, At, B1); PG_BAR; PG_SCHED; \
      PG_LDA(At, 0, 1); PG_STAGE_B(PG_SB(0, 0), b2); PG_STAGE_B(PG_SB(0, 1), (b2) + hstepB); PG_STAGE_A(0, 0, a2, VN); \
      PG_WAIT_V(8); PG_WAIT_L(0); PG_BAR; PG_MMA1(); PG_BAR; PG_SCHED; \
      PG_LDB(B0, 1, 0); PG_LDB(B1, 1, 1); PG_SCHED; PG_LDA(At, 1, 0); PG_STAGE_A(0, 1, a2, VN); \
      PG_WAIT_V(8); PG_WAIT_L(0); PG_BAR; PG_MMA(0, 0, At, B0); PG_MMA(0, 1, At, B1); PG_BAR; PG_SCHED; \
      PG_LDA(At, 1, 1); PG_STAGE_B(PG_SB(1, 0), b3); PG_STAGE_B(PG_SB(1, 1), (b3) + hstepB); PG_STAGE_A(1, 0, a3, VN); \
      PG_WAIT_V(8); PG_WAIT_L(0); PG_BAR; PG_MMA1(); PG_BAR; PG_SCHED; } while (0)
  for (;;) {
    const bool has_next = S.next(ui + 1, nxt);
    const char* nA = has_next ? AD.a_base(nxt) : cA; const char* nB = has_next ? AD.b_base(nxt) : cB;
    if constexpr (Sched::GATHER) {
      unsigned vT[2][2];
      if (has_next) PG_SETV(vT, nxt); else {
#pragma unroll
        for (int _h = 0; _h < 2; ++_h)
#pragma unroll
          for (int _i = 0; _i < 2; ++_i) vT[_h][_i] = vA[_h][_i]; }
      *(LAS u32x4*)(lds + STAGE_BYTES + 2048 + tid * 16) = (u32x4){vT[0][0], vT[0][1], vT[1][0], vT[1][1]};
    }
    if constexpr (Sched::GATHER) {
      for (int t = 0; t < nt - 2; t += 2) {
        const char* a1 = cA + (size_t)(t + 1) * kstep; const char* a2 = cA + (size_t)(t + 2) * kstep; const char* b2 = cB + (size_t)(t + 2) * kstep;
        PG_KPAIR(a1, a2, b2, a2 + kstep, b2 + kstep, vA);
      }
      { const char* a1 = cA + (size_t)(nt - 1) * kstep;
        const u32x4 q = *(const LAS u32x4*)(lds + STAGE_BYTES + 2048 + tid * 16);
        unsigned vAn[2][2] = {{q.x, q.y}, {q.z, q.w}};
        PG_KPAIR(a1, nA, nB, nA + kstep, nB + kstep, vAn);
#pragma unroll
        for (int _h = 0; _h < 2; ++_h)
#pragma unroll
          for (int _i = 0; _i < 2; ++_i) vA[_h][_i] = vAn[_h][_i]; }
    } else {
      for (int t = 0; t < nt; t += 2) {
        const bool last = (t == nt - 2);
        const char* a1 = cA + (size_t)(t + 1) * kstep;
        const char* a2 = last ? nA : cA + (size_t)(t + 2) * kstep; const char* b2 = last ? nB : cB + (size_t)(t + 2) * kstep;
        PG_KPAIR(a1, a2, b2, a2 + kstep, b2 + kstep, vA);
      }
    }
    if (wr == 0) PG_BAR;
    E(acc, cur, wr, wc, fr, fq);
    if constexpr (Sched::HAS_DONE) S.done(cur, lane);
    if (!has_next) break;
#pragma unroll
    for (int a = 0; a < 2; ++a)
#pragma unroll
      for (int b = 0; b < 2; ++b)
#pragma unroll
        for (int m = 0; m < 4; ++m)
#pragma unroll
          for (int n = 0; n < 2; ++n) acc[a][b][m][n] = (f32x4){0.f, 0.f, 0.f, 0.f};
    cur = nxt; cA = nA; cB = nB; ++ui;
    if (wr == 1) PG_BAR;
  }
  PG_WAIT_V(0);
  PG_BAR;
#undef PG_MMA1
#undef PG_SETV
#undef PG_KPAIR
#undef PG_SA
#undef PG_SB
#undef PG_STAGE_A
#undef PG_STAGE_B
#undef PG_LDA
#undef PG_LDB
#undef PG_MMA
#undef PG_WAIT_V
#undef PG_WAIT_L
#undef PG_BAR
#undef PG_SCHED
}
}
namespace att {
using bf16x8 = __attribute__((ext_vector_type(8))) short;
using s16x4 = __attribute__((ext_vector_type(4))) short;
using f32x16 = __attribute__((ext_vector_type(16))) float;
using u32x4 = __attribute__((ext_vector_type(4))) unsigned;
constexpr int D = 128, NW = 8, QBLK = 32, KVBLK = 64;
constexpr float SCALE = 0.088388347648318440f;
constexpr float THR = 8.f;
constexpr int LDQ = PLD, LDK = 128, LDO = PLD;
constexpr int NRING = 3;
constexpr size_t SHM_V = KVBLK * D * 2, SHM_K = KVBLK * D * 2, SHM_ATTN = NRING * SHM_V + NRING * SHM_K + NW * 64 * 4;
constexpr float ROPE_C8[8] = {1.0f, 0.74989421f, 0.56234133f, 0.42169650f, 0.31622777f, 0.23713737f, 0.17782794f, 0.13335214f};
#define KSWZ(row, colB) ((row) * 256 + ((colB) ^ (((row) & 7) << 4)))
#define SBAR() __builtin_amdgcn_sched_barrier(0)
__device__ __forceinline__ int crow(int r, int hi) { return (r & 3) + 8 * (r >> 2) + 4 * hi; }
__device__ __forceinline__ unsigned cvtpk(float lo, float hi) { unsigned r; asm volatile("v_cvt_pk_bf16_f32 %0, %1, %2" : "=v"(r) : "v"(lo), "v"(hi)); return r; }
__device__ __forceinline__ void partialSM(f32x16& p0, f32x16& p1, float& m_reg, float& mn, float& alpha) {
  constexpr float C = SCALE * 1.4426950408889634f;
  float pmax = m_reg; asm volatile("" : "+v"(pmax));
  if (__builtin_expect(__all(pmax - m_reg <= THR / SCALE), 1)) { mn = m_reg; }
  else { mn = fmaxf(m_reg, pmax); m_reg = mn; }
  float mnC = -mn * C;
  for (int r = 0; r < 16; ++r) p0[r] = fmaf(p0[r], C, mnC); for (int r = 0; r < 16; ++r) p1[r] = fmaf(p1[r], C, mnC);
  for (int r = 0; r < 16; ++r) p0[r] = __builtin_amdgcn_exp2f(p0[r]);
}
__device__ __forceinline__ void finishSM(f32x16& p0, f32x16& p1, float alpha, float& l_reg, bf16x8& pa0, bf16x8& pa1, bf16x8& pa2, bf16x8& pa3) {
  for (int r = 0; r < 16; ++r) p1[r] = __builtin_amdgcn_exp2f(p1[r]);
  float ps = 0; for (int r = 0; r < 16; ++r) ps += p0[r]; for (int r = 0; r < 16; ++r) ps += p1[r];
  { auto rr = __builtin_amdgcn_permlane32_swap(__float_as_uint(ps), __float_as_uint(ps), false, false);
    ps = __uint_as_float(rr[0]) + __uint_as_float(rr[1]); }
  l_reg += ps;
#define PK4(P, BASE, OUT) do { unsigned a0 = cvtpk(P[BASE + 0], P[BASE + 1]), a1 = cvtpk(P[BASE + 2], P[BASE + 3]);   \
    unsigned b0 = cvtpk(P[BASE + 4], P[BASE + 5]), b1 = cvtpk(P[BASE + 6], P[BASE + 7]);                              \
    auto r0 = __builtin_amdgcn_permlane32_swap(a0, b0, false, false); auto r1 = __builtin_amdgcn_permlane32_swap(a1, b1, false, false); \
    u32x4 w = {r0[0], r1[0], r0[1], r1[1]}; OUT = *reinterpret_cast<bf16x8*>(&w); } while (0)
  PK4(p0, 0, pa0); PK4(p0, 8, pa1); PK4(p1, 0, pa2); PK4(p1, 8, pa3);
#undef PK4
}
__device__ __forceinline__ void qkt(f32x16& p0, f32x16& p1, const bf16_t* Ks, const bf16x8* qr, int r32, int hi) {
  p0 = f32x16{}; p1 = f32x16{};
  for (int d0 = 0; d0 < 8; ++d0) { int cb = (d0 * 16 + hi * 8) * 2;
    bf16x8 b0 = *reinterpret_cast<const bf16x8*>((const char*)Ks + KSWZ(r32, cb));
    bf16x8 b1 = *reinterpret_cast<const bf16x8*>((const char*)Ks + KSWZ(32 + r32, cb));
    p0 = __builtin_amdgcn_mfma_f32_32x32x16_bf16(b0, qr[d0], p0, 0, 0, 0);
    p1 = __builtin_amdgcn_mfma_f32_32x32x16_bf16(b1, qr[d0], p1, 0, 0, 0); }
}
__device__ __forceinline__ int v_st(int k, int c) { const int kk = (k & ~0xC) | ((k & 4) << 1) | ((k & 8) >> 1); return ((kk >> 3) * 4 + (c >> 5)) * 512 + ((kk & 7) * 32 + (c & 31)) * 2; }
__device__ __forceinline__ int v_rd_base(int lane) { return ((lane & 3) << 3) | (((lane >> 2) & 3) << 6) | (((lane >> 4) & 1) << 5) | (((lane >> 5) & 1) << 8); }
constexpr int v_rd_off(int d0, int ks, int half) { return d0 * 512 + ks * 4096 + half * 2048; }
template <int OFF> __device__ __forceinline__ s16x4 tr_read(int vb) {
  s16x4 r; asm volatile("ds_read_b64_tr_b16 %0, %1 offset:%2" : "=&v"(r) : "v"(vb), "i"(OFF) : "memory"); return r;
}
template <int D0> __device__ __forceinline__ void pv_one(f32x16& od, int vb, bf16x8 pa0, bf16x8 pa1, bf16x8 pa2, bf16x8 pa3) {
  const s16x4 l0 = tr_read<v_rd_off(D0, 0, 0)>(vb), h0 = tr_read<v_rd_off(D0, 0, 1)>(vb), l1 = tr_read<v_rd_off(D0, 1, 0)>(vb), h1 = tr_read<v_rd_off(D0, 1, 1)>(vb);
  const s16x4 l2 = tr_read<v_rd_off(D0, 2, 0)>(vb), h2 = tr_read<v_rd_off(D0, 2, 1)>(vb), l3 = tr_read<v_rd_off(D0, 3, 0)>(vb), h3 = tr_read<v_rd_off(D0, 3, 1)>(vb);
  asm volatile("s_waitcnt lgkmcnt(0)" ::: "memory"); SBAR();
#define PK(L, H) (bf16x8){L[0], L[1], L[2], L[3], H[0], H[1], H[2], H[3]}
  od = __builtin_amdgcn_mfma_f32_32x32x16_bf16(pa0, PK(l0, h0), od, 0, 0, 0);
  od = __builtin_amdgcn_mfma_f32_32x32x16_bf16(pa1, PK(l1, h1), od, 0, 0, 0);
  od = __builtin_amdgcn_mfma_f32_32x32x16_bf16(pa2, PK(l2, h2), od, 0, 0, 0);
  od = __builtin_amdgcn_mfma_f32_32x32x16_bf16(pa3, PK(l3, h3), od, 0, 0, 0);
#undef PK
}
__device__ __forceinline__ void pv_d0(f32x16* o, int vb, bf16x8 pa0, bf16x8 pa1, bf16x8 pa2, bf16x8 pa3) {
  pv_one<0>(o[0], vb, pa0, pa1, pa2, pa3); pv_one<1>(o[1], vb, pa0, pa1, pa2, pa3); pv_one<2>(o[2], vb, pa0, pa1, pa2, pa3); pv_one<3>(o[3], vb, pa0, pa1, pa2, pa3);
}
__device__ __forceinline__ void attn_dense_body(const bf16_t* __restrict__ Qb, const bf16_t* __restrict__ Kh, const bf16_t* __restrict__ Vh, bf16_t* __restrict__ Ob, int seq, float mbound, const float* __restrict__ qgain, int t0, char* lds) {
  const int tid = opaque_tid(), wid = tid >> 6, lane = tid & 63, r32 = lane & 31, hi = lane >> 5;
  bf16_t* V_lds = (bf16_t*)lds; bf16_t* K_lds = (bf16_t*)(lds + NRING * SHM_V);
  float* ws = (float*)(lds + NRING * SHM_V + NRING * SHM_K) + wid * 64; float* li_l = ws; float* al_l = ws + 32;
  float m_reg = mbound, l_reg = 0; f32x16 o[4]; bf16x8 qr[8];
  const bf16_t* Qw = Qb + (long)(wid * QBLK + r32) * LDQ + hi * 8;
#pragma unroll
  for (int d0 = 0; d0 < 8; ++d0) qr[d0] = *reinterpret_cast<const bf16x8*>(Qw + d0 * 16);
  {
#define UNPK8(W, X) do { X[0] = __uint_as_float(W.x << 16); X[1] = __uint_as_float(W.x & 0xffff0000u); X[2] = __uint_as_float(W.y << 16); X[3] = __uint_as_float(W.y & 0xffff0000u); \
                         X[4] = __uint_as_float(W.z << 16); X[5] = __uint_as_float(W.z & 0xffff0000u); X[6] = __uint_as_float(W.w << 16); X[7] = __uint_as_float(W.w & 0xffff0000u); } while (0)
    char* qs = lds + wid * 8192 + lane * 16;
    float ss = 0.f;
#pragma unroll
    for (int d0 = 0; d0 < 8; ++d0) { const u32x4 w = *reinterpret_cast<const u32x4*>(&qr[d0]); float x[8]; UNPK8(w, x);
#pragma unroll
      for (int j = 0; j < 8; ++j) ss += x[j] * x[j];
      *(u32x4*)(qs + d0 * 1024) = w; }
    { auto rr = __builtin_amdgcn_permlane32_swap(__float_as_uint(ss), __float_as_uint(ss), false, false); ss = __uint_as_float(rr[0]) + __uint_as_float(rr[1]); }
    const float rn = rsqrtf(ss * (1.f / 128.f) + 1e-6f);
    const int tq = t0 + wid * QBLK + r32;
#pragma unroll 1
    for (int it = 0; it < 4; ++it) { const int ax = it >> 1, d = it & 1, da = 4 * ax + d, db = da + 2;
      const float ph = (ax == 0 ? (float)(tq >> 6) : (float)(tq & 63)) * (hi ? 0.1f : 1.f) * (d ? 0.01f : 1.f);
      const u32x4 wa = *(const u32x4*)(qs + da * 1024), wb = *(const u32x4*)(qs + db * 1024);
      float xa[8], xb[8]; UNPK8(wa, xa); UNPK8(wb, xb);
      const f32x4 ga0 = *(const f32x4*)(qgain + 16 * da + 8 * hi), ga1 = *(const f32x4*)(qgain + 16 * da + 8 * hi + 4), gb0 = *(const f32x4*)(qgain + 16 * db + 8 * hi), gb1 = *(const f32x4*)(qgain + 16 * db + 8 * hi + 4);
      const float ga[8] = {ga0.x, ga0.y, ga0.z, ga0.w, ga1.x, ga1.y, ga1.z, ga1.w}, gb[8] = {gb0.x, gb0.y, gb0.z, gb0.w, gb1.x, gb1.y, gb1.z, gb1.w};
#pragma unroll
      for (int j = 0; j < 8; ++j) { const float ang = ph * ROPE_C8[j];
        const float sn = __sinf(ang), cs = __cosf(ang);
        const float x1 = xa[j] * rn * ga[j], x2 = xb[j] * rn * gb[j];
        xa[j] = x1 * cs - x2 * sn; xb[j] = x1 * sn + x2 * cs; }
      *(u32x4*)(qs + da * 1024) = (u32x4){cvtpk(xa[0], xa[1]), cvtpk(xa[2], xa[3]), cvtpk(xa[4], xa[5]), cvtpk(xa[6], xa[7])};
      *(u32x4*)(qs + db * 1024) = (u32x4){cvtpk(xb[0], xb[1]), cvtpk(xb[2], xb[3]), cvtpk(xb[4], xb[5]), cvtpk(xb[6], xb[7])}; }
#pragma unroll
    for (int d0 = 0; d0 < 8; ++d0) qr[d0] = *reinterpret_cast<const bf16x8*>(qs + d0 * 1024);
    asm volatile("s_waitcnt lgkmcnt(0)" ::: "memory");
    __syncthreads();
#undef UNPK8
  }
  SBAR();
#pragma unroll
  for (int d = 0; d < 4; ++d) o[d] = f32x16{};
  SBAR();
  const int sr = tid >> 4, sc = (tid & 15) * 8, vst0 = v_st(sr, sc), vst1 = v_st(32 + sr, sc);
  const int vb0 = (int)(uintptr_t)V_lds + v_rd_base(lane);
  struct { bf16x8 vs0, vs1, ks0, ks1; } sr_[2];
#define SLOAD(i, k0) do { sr_[i].vs0 = *(const bf16x8*)(&Vh[(long)((k0) + sr) * LDK + sc]); sr_[i].vs1 = *(const bf16x8*)(&Vh[(long)((k0) + 32 + sr) * LDK + sc]); \
    sr_[i].ks0 = *(const bf16x8*)(&Kh[(long)((k0) + sr) * LDK + sc]); sr_[i].ks1 = *(const bf16x8*)(&Kh[(long)((k0) + 32 + sr) * LDK + sc]); } while (0)
#define SWRITE(b, i) do { *(bf16x8*)((char*)V_lds + (b) * SHM_V + vst0) = sr_[i].vs0;          \
    *(bf16x8*)((char*)V_lds + (b) * SHM_V + vst1) = sr_[i].vs1; int kc = sc * 2;               \
    *(bf16x8*)((char*)K_lds + (b) * SHM_K + KSWZ(sr, kc)) = sr_[i].ks0;                       \
    *(bf16x8*)((char*)K_lds + (b) * SHM_K + KSWZ(32 + sr, kc)) = sr_[i].ks1; } while (0)
#define SWAIT() asm volatile("s_waitcnt vmcnt(4)" ::: "memory")
#define RESC(a) do { if (__any((a) < 1.f)) { if (hi == 0) al_l[r32] = (a); asm volatile("s_waitcnt lgkmcnt(0)" ::: "memory"); \
    for (int d = 0; d < 4; ++d) for (int r = 0; r < 16; ++r) o[d][r] *= al_l[crow(r, hi)]; } } while (0)
  f32x16 pA0, pA1, pB0, pB1; float mnA, mnB, alA, alB; bf16x8 pa0, pa1, pa2, pa3; const int NT = seq / KVBLK;
#define KRING(b) ((bf16_t*)((char*)K_lds + (b) * SHM_K))
#define ATT_STEP(PC0, PC1, MNC, ALC, PP0, PP1, ALP, KB, VBP, WB, SLW, SLL, TLOAD, DO_LOAD, DO_WRITE, WAIT0) do { \
    SBAR(); qkt(PC0, PC1, KRING(KB), qr, r32, hi); \
    finishSM(PP0, PP1, ALP, l_reg, pa0, pa1, pa2, pa3); SBAR(); \
    if (DO_LOAD) SLOAD(SLL, (TLOAD) * KVBLK); SBAR(); \
    pv_d0(o, vb0 + (VBP) * (int)SHM_V, pa0, pa1, pa2, pa3); partialSM(PC0, PC1, m_reg, MNC, ALC); \
    if (DO_WRITE) { if (WAIT0) asm volatile("s_waitcnt vmcnt(0)" ::: "memory"); else SWAIT(); SWRITE(WB, SLW); } \
    __syncthreads(); } while (0)
#define STEP_B(t, KB, VBP, WB, DL, DW, W0) ATT_STEP(pB0, pB1, mnB, alB, pA0, pA1, alA, KB, VBP, WB, 0, 1, (t) + 2, DL, DW, W0)
#define STEP_A(t, KB, VBP, WB, DL, DW, W0) ATT_STEP(pA0, pA1, mnA, alA, pB0, pB1, alB, KB, VBP, WB, 1, 0, (t) + 2, DL, DW, W0)
  SLOAD(0, 0); SLOAD(1, KVBLK); SWAIT(); SWRITE(0, 0); __syncthreads();
  SLOAD(0, 2 * KVBLK);
  qkt(pA0, pA1, KRING(0), qr, r32, hi); partialSM(pA0, pA1, m_reg, mnA, alA);
  SWAIT(); SWRITE(1, 1); __syncthreads();
  int t = 1, r0 = 0, r1 = 1, r2 = 2;
#define ATT_STEPR(PC0, PC1, MNC, ALC, PP0, PP1, ALP, SLW, SLL, DO_LOAD, DO_WRITE, WAIT0) do { \
    SBAR(); qkt(PC0, PC1, (bf16_t*)((char*)K_lds + r1 * (int)SHM_K), qr, r32, hi); \
    finishSM(PP0, PP1, ALP, l_reg, pa0, pa1, pa2, pa3); SBAR(); \
    if (DO_LOAD) SLOAD(SLL, (t + 2) * KVBLK); SBAR(); \
    pv_d0(o, vb0 + r0 * (int)SHM_V, pa0, pa1, pa2, pa3); partialSM(PC0, PC1, m_reg, MNC, ALC); \
    if (DO_WRITE) { if (WAIT0) asm volatile("s_waitcnt vmcnt(0)" ::: "memory"); else SWAIT(); SWRITE(r2, SLW); } \
    __syncthreads(); { const int _r = r0; r0 = r1; r1 = r2; r2 = _r; } ++t; } while (0)
#define STEPR_B(DL, DW, W0) ATT_STEPR(pB0, pB1, mnB, alB, pA0, pA1, alA, 0, 1, DL, DW, W0)
#define STEPR_A(DL, DW, W0) ATT_STEPR(pA0, pA1, mnA, alA, pB0, pB1, alB, 1, 0, DL, DW, W0)
  while (t + 3 < NT) { STEPR_B(true, true, false); STEPR_A(true, true, false); }
  STEPR_B(true, true, false);
  STEPR_A(false, true, true);
  STEPR_B(false, false, false);
  finishSM(pB0, pB1, alB, l_reg, pa0, pa1, pa2, pa3); SBAR();
  pv_d0(o, vb0 + r0 * (int)SHM_V, pa0, pa1, pa2, pa3);
#undef ATT_STEPR
#undef STEPR_A
#undef STEPR_B
#undef KRING
#undef ATT_STEP
#undef STEP_A
#undef STEP_B
  if (hi == 0) li_l[r32] = l_reg; asm volatile("s_waitcnt lgkmcnt(0)" ::: "memory");
  float rli[16];
#pragma unroll
  for (int r = 0; r < 16; ++r) rli[r] = __builtin_amdgcn_rcpf(li_l[crow(r, hi)]);
  int lane_e = lane; asm volatile("" : "+v"(lane_e));
  const int r32e = lane_e & 31, hie = lane_e >> 5;
  bf16_t* Ow = Ob + (long)(wid * QBLK) * LDO;
#pragma unroll
  for (int r = 0; r < 16; ++r) { int orow = crow(r, hie);
    for (int d0 = 0; d0 < 4; ++d0) Ow[(long)orow * LDO + d0 * 32 + r32e] = f2bf(o[d0][r] * rli[r]); }
  __syncthreads();
#undef SLOAD
#undef SWRITE
#undef SWAIT
#undef RESC
}
}

#define XB_TMO      128
#define XB_XCNT(j)  (256  + 64 * (j))
#define XB_XSUB(j)  (1280 + 64 * (j))
#define XB_XGEN(j)  (2304 + 64 * (j))
#define XB_TOP      3328
#define XB_TOPGEN   3392
#define XCD_BAR_WORDS 3456
#define XB_SPIN_CAP (1u << 18)

__device__ __forceinline__ unsigned xb_ld(unsigned* p)              { return __hip_atomic_load(p, __ATOMIC_RELAXED, __HIP_MEMORY_SCOPE_AGENT); }
__device__ __forceinline__ unsigned xb_add(unsigned* p, unsigned v) { return __hip_atomic_fetch_add(p, v, __ATOMIC_RELAXED, __HIP_MEMORY_SCOPE_AGENT); }
__device__ __forceinline__ unsigned xb_xcc_id() { return (unsigned)__builtin_amdgcn_s_getreg((3 << 11) | 20) & 0xFu; }
#define XB_SPIN(cond, bar) do { unsigned _sp = 0; while (cond) { __builtin_amdgcn_s_sleep(1); \
    if ((++_sp & 255u) == 0u) { if (xb_ld(&(bar)[XB_TMO])) break; if (_sp > XB_SPIN_CAP) { atomicAdd(&(bar)[XB_TMO], 1u); break; } } } } while (0)

struct XcdBarrier {
    unsigned* bar; unsigned x;
    volatile LAS unsigned* st;
};

__device__ __forceinline__ XcdBarrier xcd_barrier_post(unsigned* bar, volatile LAS unsigned* st) {
    XcdBarrier b; b.bar = bar; b.x = (unsigned)__builtin_amdgcn_readfirstlane((int)xb_xcc_id()); b.st = st;
    if (opaque_tid() == 0) (void)xb_add(&bar[XB_XCNT(b.x)], 1u);
    return b;
}
__device__ __forceinline__ void xcd_barrier_complete(unsigned* bar, unsigned x, unsigned& nloc, unsigned& nx) {
    const unsigned G = gridDim.x * gridDim.y * gridDim.z;
    unsigned sum, cnt, mine, sp = 0u;
    for (;;) {
        sum = 0u; cnt = 0u; mine = 0u;
#pragma unroll 1
        for (unsigned j = 0; j < 16; ++j) { const unsigned c = xb_ld(&bar[XB_XCNT(j)]); sum += c; cnt += (c > 0u) ? 1u : 0u; mine = (j == x) ? c : mine; }
        if (sum == G) break;
        __builtin_amdgcn_s_sleep(1);
        if ((++sp & 255u) == 0u) { if (xb_ld(&bar[XB_TMO])) break; if (sp > XB_SPIN_CAP) { atomicAdd(&bar[XB_TMO], 1u); break; } }
    }
    nloc = mine > 0u ? mine : 1u; nx = cnt > 0u ? cnt : 1u;
}

__device__ __forceinline__ void xcd_barrier(const XcdBarrier& b) {
    asm volatile("s_waitcnt vmcnt(0)" ::: "memory");
    __syncthreads();
    if (opaque_tid() == 0) {
        unsigned* bar = b.bar; unsigned bx = b.x; asm volatile("" : "+s"(bx));
        __builtin_amdgcn_s_waitcnt(0);
        unsigned nloc = b.st[0], nx = b.st[1];
        if (nloc == 0u) { xcd_barrier_complete(bar, bx, nloc, nx); b.st[0] = nloc; b.st[1] = nx; }
        const unsigned old = xb_add(&bar[XB_XSUB(bx)], 1u);
        const unsigned gen = old / nloc;
        if (old + 1u == (gen + 1u) * nloc) {
            __builtin_amdgcn_fence(__ATOMIC_RELEASE, "agent");
            asm volatile("s_waitcnt vmcnt(0)" ::: "memory");
            const unsigned og = xb_add(&bar[XB_TOP], 1u);
            const unsigned tg = og / nx;
            if (og + 1u == (tg + 1u) * nx) xb_add(&bar[XB_TOPGEN], 1u);
            else XB_SPIN(xb_ld(&bar[XB_TOPGEN]) == tg, bar);
            __builtin_amdgcn_fence(__ATOMIC_ACQUIRE, "agent");
            xb_add(&bar[XB_XGEN(bx)], 1u);
            asm volatile("s_waitcnt vmcnt(0)" ::: "memory");
        } else {
            XB_SPIN(xb_ld(&bar[XB_XGEN(bx)]) == gen, bar);
            __builtin_amdgcn_fence(__ATOMIC_ACQUIRE, "agent");
            asm volatile("s_waitcnt vmcnt(0)" ::: "memory");
        }
    }
    __syncthreads();
}


#if MK_TS_PHASE >= 16
#define BLD_TS(k) do { if (blockIdx.x == 0 && tid == 0) ((unsigned long long*)((unsigned*)(p.ws + WS_CTL) + CTL_TS))[k] = __builtin_amdgcn_s_memrealtime(); } while (0)
#else
#define BLD_TS(k) do { } while (0)
#endif
__device__ __forceinline__ void s5_build_tables(const Params& p, LAS unsigned char* lds, int g) {
  const int tid = opaque_tid();
  BLD_TS(16);
  LAS float* Bb = (LAS float*)lds;
  LAS float* Cc = Bb + 4096;
  LAS float* PW = Cc + 4096;
  LAS float* KK = PW + 4352;
  if (tid < 128) {
    const int d = tid >> 6, pi = tid & 63, dg = d * 32 + g, idx = dg * 64 + pi;
    const float are = p.in[I_SARE][idx], aim = p.in[I_SAIM][idx];
    const float dt = expf(p.in[I_SLDT][dg]);
    const float lam = are * dt, om = aim * dt;
    for (int n = 0; n <= 16; ++n) { const float ea = expf(lam * (float)n); float sn, cs; sincosf(om * (float)n, &sn, &cs);
      PW[((d * 17 + n) * 64 + pi) * 2] = ea * cs; PW[((d * 17 + n) * 64 + pi) * 2 + 1] = ea * sn; }
    const float abr = PW[((d * 17 + 1) * 64 + pi) * 2], abi = PW[((d * 17 + 1) * 64 + pi) * 2 + 1];
    const float den = are * are + aim * aim;
    const float nr = abr - 1.f, ni = abi;
    const float rr = (nr * are + ni * aim) / den, ri = (ni * are - nr * aim) / den;
    for (int c = 0; c < 16; ++c) {
      const float bre = p.in[I_SBRE][idx * 16 + c], bim = p.in[I_SBIM][idx * 16 + c];
      Bb[((d * 64 + pi) * 16 + c) * 2] = rr * bre - ri * bim; Bb[((d * 64 + pi) * 16 + c) * 2 + 1] = rr * bim + ri * bre;
      Cc[((d * 16 + c) * 64 + pi) * 2] = p.in[I_SCRE][(dg * 16 + c) * 64 + pi]; Cc[((d * 16 + c) * 64 + pi) * 2 + 1] = p.in[I_SCIM][(dg * 16 + c) * 64 + pi];
    }
  }
  __syncthreads();
  BLD_TS(17);
  {
    const int d = tid >> 8, tau = (tid >> 4) & 15, c = tid & 15;
    float s[16];
#pragma unroll
    for (int c2 = 0; c2 < 16; ++c2) s[c2] = 0.f;
    for (int pi = 0; pi < 64; ++pi) {
      const f32x2 cv = *(const LAS f32x2*)(Cc + ((d * 16 + c) * 64 + pi) * 2), av = *(const LAS f32x2*)(PW + ((d * 17 + tau) * 64 + pi) * 2);
      const float mr = cv.x * av.x - cv.y * av.y, mi = cv.x * av.y + cv.y * av.x;
      const LAS f32x4* bp = (const LAS f32x4*)(Bb + ((d * 64 + pi) * 16) * 2);
#pragma unroll
      for (int q = 0; q < 8; ++q) { const f32x4 b = bp[q]; s[2 * q] += mr * b.x - mi * b.y; s[2 * q + 1] += mr * b.z - mi * b.w; }
    }
#pragma unroll
    for (int c2 = 0; c2 < 16; ++c2) KK[((d * 16 + tau) * 16 + c) * 16 + c2] = s[c2];
  }
  __syncthreads();
  BLD_TS(18);
  bf16_t* T = (bf16_t*)(p.ws + WS_S5T) + (size_t)g * 256 * 512;
  for (int o = tid; o < 256 * 256; o += 512) {
    const int n = o >> 8, k = (o & 255) * 2, i = n >> 4, c = n & 15;
    float v[2];
#pragma unroll
    for (int q = 0; q < 2; ++q) { const int kk = k + q; float x;
      if (kk < 256) { const int j = kk >> 4, c2 = kk & 15; x = 0.f;
        if (i >= j) x += KK[((0 * 16 + (i - j)) * 16 + c) * 16 + c2];
        if (j >= i) x += KK[((1 * 16 + (j - i)) * 16 + c) * 16 + c2];
        if (i == j && c == c2) x += p.in[I_SD][g * 16 + c];
      } else { const int d = (kk - 256) >> 7, qq = (kk - 256) & 127, part = qq >> 6, pi = qq & 63, n_pw = d ? (16 - i) : (i + 1);
        const float cr = Cc[((d * 16 + c) * 64 + pi) * 2], ci = Cc[((d * 16 + c) * 64 + pi) * 2 + 1];
        const float ar = PW[((d * 17 + n_pw) * 64 + pi) * 2], ai = PW[((d * 17 + n_pw) * 64 + pi) * 2 + 1];
        x = part ? -(cr * ai + ci * ar) : (cr * ar - ci * ai); }
      v[q] = x; }
    *(unsigned*)(T + (size_t)n * 512 + k) = cvt_pk_bf16(v[0], v[1]);
  }
  BLD_TS(19);
  bf16_t* E = (bf16_t*)(p.ws + WS_S5E) + (size_t)g * 256 * 256;
  for (int o = tid; o < 256 * 128; o += 512) {
    const int n = o >> 7, k = (o & 127) * 2, d = n >> 7, part = (n >> 6) & 1, pi = n & 63;
    float v[2];
#pragma unroll
    for (int q = 0; q < 2; ++q) { const int kk = k + q, j = kk >> 4, c2 = kk & 15, n_pw = d ? j : (15 - j);
      const float ar = PW[((d * 17 + n_pw) * 64 + pi) * 2], ai = PW[((d * 17 + n_pw) * 64 + pi) * 2 + 1];
      const float br = Bb[((d * 64 + pi) * 16 + c2) * 2], bi = Bb[((d * 64 + pi) * 16 + c2) * 2 + 1];
      v[q] = part ? (ar * bi + ai * br) : (ar * br - ai * bi); }
    *(unsigned*)(E + (size_t)n * 256 + k) = cvt_pk_bf16(v[0], v[1]);
  }
  BLD_TS(20);
  __syncthreads();
}

struct SchedS5S {
  static constexpr bool GATHER = false, HAS_DONE = false, HALF = false;
  int G, c;
  __device__ __forceinline__ bool next(int i, pg::Unit& u) const {
    const int L = i * G + c; if (L >= 160) return false;
    u.aux = L / 5; u.pm = L % 5; u.pn = 0; u.arow = u.pm * 256; return true;
  }
};
struct EpiS5S {
  static constexpr bool PERM = false;
  float* S;
  __device__ __forceinline__ void operator()(const pg::Acc& acc, const pg::Unit& u, int wr, int wc, int fr, int fq) const {
    const int row0 = u.arow + wr * 64 + fr, col0 = wc * 32 + 4 * fq;
#pragma unroll
    for (int ai = 0; ai < 2; ++ai)
#pragma unroll
      for (int m = 0; m < 4; ++m) { const int r = row0 + ai * 128 + m * 16;
        if (r < NCHUNK) { float* rowp = S + ((size_t)u.aux * NCHUNK + r) * 256 + col0;
#pragma unroll
          for (int bj = 0; bj < 2; ++bj)
#pragma unroll
            for (int n = 0; n < 2; ++n) *(f32x4*)(rowp + bj * 128 + n * 16) = acc[ai][bj][m][n]; } }
  }
};
__device__ __forceinline__ void phase_s5s(const Params& p, LAS unsigned char* lds) {
  pg::Addr AD{(const bf16_t*)((unsigned char*)p.out + DO_YA), 512, (size_t)NCHUNK * 512, (const bf16_t*)(p.ws + WS_S5E), 256, (size_t)256 * 256, false};
  SchedS5S S{(int)gridDim.x, (int)blockIdx.x};
  EpiS5S E{(float*)(p.ws + WS_RH)};
  pg::gemm_phase(lds, AD, S, E);
}

__device__ __forceinline__ void s5_scan_item(const Params& p, int item, int lane) {
  const int d = item & 1, g = (item >> 1) & 31, b = item >> 6;
  const float* S = (const float*)(p.ws + WS_RH) + (size_t)g * NCHUNK * 256 + d * 128 + lane;
  bf16_t* YA = (bf16_t*)((unsigned char*)p.out + DO_YA) + (size_t)g * NCHUNK * 512 + 256 + d * 128 + lane;
  const int idx = (d * 32 + g) * 64 + lane;
  const float dt = expf(p.in[I_SLDT][d * 32 + g]);
  const float ea = expf(p.in[I_SARE][idx] * dt * 16.f); float sn, cs; sincosf(p.in[I_SAIM][idx] * dt * 16.f, &sn, &cs);
  const float ar = ea * cs, ai = ea * sn;
  float hr = 0.f, hi = 0.f;
  const int r0 = b * 528;
#pragma unroll 4
  for (int s = 0; s < 16; ++s) { const int r = r0 + 512 + (d ? 15 - s : s);
    const float sr = S[(size_t)r * 256], si = S[(size_t)r * 256 + 64];
    const float nr = ar * hr - ai * hi + sr, ni = ar * hi + ai * hr + si; hr = nr; hi = ni; }
  float sa[16], sb[16];
#define SCAN_LOAD(buf, s0) do { _Pragma("unroll") for (int q = 0; q < 8; ++q) { const int r = r0 + (d ? 511 - ((s0) + q) : (s0) + q); buf[2 * q] = S[(size_t)r * 256]; buf[2 * q + 1] = S[(size_t)r * 256 + 64]; } } while (0)
#define SCAN_STEP(buf, s0) do { _Pragma("unroll") for (int q = 0; q < 8; ++q) { const int r = r0 + (d ? 511 - ((s0) + q) : (s0) + q); \
    YA[(size_t)r * 512] = f2bf(hr); YA[(size_t)r * 512 + 64] = f2bf(hi); \
    const float nr = ar * hr - ai * hi + buf[2 * q], ni = ar * hi + ai * hr + buf[2 * q + 1]; hr = nr; hi = ni; } } while (0)
  SCAN_LOAD(sa, 0);
  for (int s = 0; s < 512; s += 16) {
    SCAN_LOAD(sb, s + 8);
    SCAN_STEP(sa, s);
    if (s + 16 < 512) SCAN_LOAD(sa, s + 16);
    SCAN_STEP(sb, s + 8);
  }
#undef SCAN_LOAD
#undef SCAN_STEP
}
__device__ __forceinline__ void phase_s5scan(const Params& p) {
  const int tid_ = opaque_tid(); const int lane = tid_ & 63, wave = tid_ >> 6;
  const int gw = blockIdx.x * NWAVES + wave;
  if (gw < 128) s5_scan_item(p, gw, lane);
}

struct SchedS5Y {
  static constexpr bool GATHER = false, HAS_DONE = false, HALF = false;
  int G, c;
  __device__ __forceinline__ bool next(int i, pg::Unit& u) const {
    const int L = i * G + (MK_S5_IN_P3 ? c : ((c + G / 2) % G)); if (L >= 128) return false;
    u.aux = L >> 2; u.pm = L & 3; u.pn = 0; u.arow = (u.pm >> 1) * 528 + (u.pm & 1) * 256; return true;
  }
};
struct EpiS5Y {
  static constexpr bool PERM = true;
  bf16_t* GY;
  __device__ __forceinline__ void operator()(const pg::Acc& acc, const pg::Unit& u, int wr, int wc, int fr, int fq) const {
    const int row0 = u.arow + wr * 64 + fr;
#pragma unroll
    for (int ai = 0; ai < 2; ++ai)
#pragma unroll
      for (int m = 0; m < 4; ++m) { const int chunk = row0 + ai * 128 + m * 16;
#pragma unroll
        for (int bj = 0; bj < 2; ++bj) { const int col = bj * 128 + wc * 32 + 8 * fq, ti = col >> 4, c0 = col & 15;
          float o[8];
#pragma unroll
          for (int n = 0; n < 2; ++n)
#pragma unroll
            for (int e = 0; e < 4; ++e) o[n * 4 + e] = gelu_tanh(acc[ai][bj][m][n][e]);
          u32x4 w; w.x = cvt_pk_bf16(o[0], o[1]); w.y = cvt_pk_bf16(o[2], o[3]); w.z = cvt_pk_bf16(o[4], o[5]); w.w = cvt_pk_bf16(o[6], o[7]);
          *(u32x4*)(GY + (size_t)(chunk * 16 + ti) * 512 + u.aux * 16 + c0) = w; } }
  }
};
__device__ __forceinline__ void phase_s5y(const Params& p, LAS unsigned char* lds) {
  pg::Addr AD{(const bf16_t*)((unsigned char*)p.out + DO_YA), 512, (size_t)NCHUNK * 512, (const bf16_t*)(p.ws + WS_S5T), 512, (size_t)256 * 512, false};
  SchedS5Y S{(int)gridDim.x, (int)blockIdx.x};
  EpiS5Y E{(bf16_t*)((unsigned char*)p.out + DO_GY)};
  pg::gemm_phase(lds, AD, S, E);
}
__device__ __forceinline__ void map_static(int L, int nM, int nN, int& pm, int& pn) {
  const int nwg = nM * nN; int wgid = L;
  { const int q = nwg / 8, r = nwg % 8, xcd = wgid % 8, off = wgid / 8; wgid = (xcd < r ? xcd * (q + 1) : r * (q + 1) + (xcd - r) * q) + off; }
  const int nig = 8 * nN, gid = wgid / nig, fm = gid * 8, gsz = (nM - fm) < 8 ? (nM - fm) : 8;
  pm = fm + ((wgid % nig) % gsz); pn = (wgid % nig) / gsz;
}

struct CvtItem { const float* src; bf16_t* dst; int ldw, ldd; };
__device__ __forceinline__ void cvt_load(const CvtItem& d, f32x4 (&r)[8], int lane) {
  const float* s = d.src + (size_t)(lane >> 3) * d.ldw + 4 * (lane & 7);
#pragma unroll
  for (int i = 0; i < 8; ++i) r[i] = __builtin_nontemporal_load((const f32x4*)(s + (size_t)(8 * i) * d.ldw));
}
__device__ __forceinline__ void cvt_store(const CvtItem& d, const f32x4 (&r)[8], LAS float* scr, int lane) {
  LAS float* w = scr + (lane >> 3) * 33 + 4 * (lane & 7);
#pragma unroll
  for (int i = 0; i < 8; ++i) { w[(8 * i) * 33 + 0] = r[i].x; w[(8 * i) * 33 + 1] = r[i].y; w[(8 * i) * 33 + 2] = r[i].z; w[(8 * i) * 33 + 3] = r[i].w; }
  asm volatile("s_waitcnt lgkmcnt(0)" ::: "memory");
  const int c = lane & 7;
#pragma unroll
  for (int j = 0; j < 4; ++j) { const int n = (lane >> 3) + 8 * j; const LAS float* s = scr + (8 * c) * 33 + n;
    u32x4 o; o.x = cvt_pk_bf16(s[0 * 33], s[1 * 33]); o.y = cvt_pk_bf16(s[2 * 33], s[3 * 33]); o.z = cvt_pk_bf16(s[4 * 33], s[5 * 33]); o.w = cvt_pk_bf16(s[6 * 33], s[7 * 33]);
    *(u32x4*)(d.dst + (size_t)n * d.ldd + 8 * c) = o; }
  asm volatile("s_waitcnt lgkmcnt(0)" ::: "memory");
}
__device__ __forceinline__ int ilv_row(int n, int second) { return (n >> 7) * 256 + (n & 127) + second * 128; }

constexpr int CV_WIN = (1024 / 64) * (4096 / 32);
constexpr int CV_GLU = (512 / 64) * (1024 / 32);
constexpr int CV_SQ = (1024 / 64) * (1024 / 32);
constexpr int CV_EGU = (1024 / 64) * (512 / 32);
constexpr int CV_ED = (512 / 64) * (1024 / 32);
constexpr int CV_SMALL = CV_WIN + 2 * CV_GLU + 2 * CV_SQ;
constexpr int CV_TOTAL = CV_SMALL + 32 * (2 * CV_EGU + CV_ED);

__device__ __forceinline__ void cvt_kn(int it, int nb, int& kb_, int& nb_) { const int grp = it >> 3, w = it & 7, gpr = nb >> 2; kb_ = 2 * (grp / gpr) + (w >> 2); nb_ = 4 * (grp % gpr) + (w & 3); }
__device__ __forceinline__ CvtItem cvt_desc(const Params& p, int it) {
  unsigned char* ws = p.ws;
  if (it < CV_WIN) { const int nb = 4096 / 32; int kb_, nb_; cvt_kn(it, nb, kb_, nb_); const int n0 = 32 * nb_, k0 = 64 * kb_;
    return CvtItem{p.in[I_WIN] + (size_t)k0 * 4096 + n0, (bf16_t*)(ws + WS_WIN) + (size_t)n0 * 1024 + k0, 4096, 1024}; }
  it -= CV_WIN;
  if (it < 2 * CV_GLU) { const int second = it / CV_GLU; it %= CV_GLU; const int nb = 1024 / 32; int kb_, nb_; cvt_kn(it, nb, kb_, nb_); const int n0 = 32 * nb_, k0 = 64 * kb_;
    return CvtItem{p.in[second ? I_WGB : I_WGA] + (size_t)k0 * 1024 + n0, (bf16_t*)(ws + WS_WGLU) + (size_t)ilv_row(n0, second) * 512 + k0, 1024, 512}; }
  it -= 2 * CV_GLU;
  if (it < 2 * CV_SQ) { const int second = it / CV_SQ; it %= CV_SQ; const int nb = 1024 / 32; int kb_, nb_; cvt_kn(it, nb, kb_, nb_); const int n0 = 32 * nb_, k0 = 64 * kb_;
    return CvtItem{p.in[second ? I_WOUT : I_WAO] + (size_t)k0 * 1024 + n0, (bf16_t*)(ws + (second ? WS_WOUT : WS_WAO)) + (size_t)n0 * 1024 + k0, 1024, 1024}; }
  it -= 2 * CV_SQ;
  const int per_e = 2 * CV_EGU + CV_ED, e = it / per_e; it %= per_e;
  if (it < 2 * CV_EGU) { const int second = it / CV_EGU; it %= CV_EGU; const int nb = 512 / 32; int kb_, nb_; cvt_kn(it, nb, kb_, nb_); const int n0 = 32 * nb_, k0 = 64 * kb_;
    return CvtItem{p.in[second ? I_WEU : I_WEG] + (size_t)e * 1024 * 512 + (size_t)k0 * 512 + n0, (bf16_t*)(ws + WS_WGU) + ((size_t)e * 1024 + ilv_row(n0, second)) * 1024 + k0, 512, 1024}; }
  it -= 2 * CV_EGU;
  { const int nb = 1024 / 32; int kb_, nb_; cvt_kn(it, nb, kb_, nb_); const int n0 = 32 * nb_, k0 = 64 * kb_;
    return CvtItem{p.in[I_WED] + (size_t)e * 512 * 1024 + (size_t)k0 * 1024 + n0, (bf16_t*)(ws + WS_WD) + ((size_t)e * 1024 + n0) * 512 + k0, 1024, 512}; }
}
template <bool SIGNAL_WIN> __device__ __forceinline__ void cvt_run(const Params& p, int lo, int CV_END, int gw, int NGW, LAS float* scr, int lane) {
  int it = lo + gw; if (it >= CV_END) return;
  CvtItem d = cvt_desc(p, it); f32x4 ra[8], rb[8];
  cvt_load(d, ra, lane);
  for (;;) {
    const int nit = it + NGW; const bool more = nit < CV_END; CvtItem dn = d;
    if (more) { dn = cvt_desc(p, nit); cvt_load(dn, rb, lane); }
    cvt_store(d, ra, scr, lane);
#if MK_CTX_IN_PRO
    if (SIGNAL_WIN && it < CV_WIN && nit >= CV_WIN) {
      asm volatile("s_waitcnt vmcnt(0)" ::: "memory"); __builtin_amdgcn_fence(__ATOMIC_RELEASE, "agent");
      if (lane == 0) __hip_atomic_fetch_add((unsigned*)(p.ws + WS_CTL) + CTL_WINCNT, 1u, __ATOMIC_RELAXED, __HIP_MEMORY_SCOPE_AGENT); }
#endif
    if (!more) break;
#pragma unroll
    for (int i = 0; i < 8; ++i) ra[i] = rb[i];
    d = dn; it = nit;
  }
}

__device__ __forceinline__ const float* ln_src_row(const Params& p, int pr) {
  const int b = pr / SKV, t = pr % SKV;
  return (t < SEQ) ? p.in[I_X] + ((size_t)b * SEQ + t) * DM : p.in[I_CTX] + ((size_t)b * NCTX + (t - SEQ)) * DM;
}
template <bool LAT> __device__ __forceinline__ void ln_batch_load_t(const Params& p, int r0, int NGW, f32x4 (&v)[4][4], int lane) {
#pragma unroll
  for (int r = 0; r < 4; ++r) { const int ri = r0 + r * NGW;
    if (ri < (LAT ? NLAT : NROW)) { const float* xr = LAT ? p.in[I_X] + (size_t)ri * DM : ln_src_row(p, ri);
#pragma unroll
      for (int j = 0; j < 4; ++j) v[r][j] = ((const f32x4*)xr)[lane + 64 * j]; } }
}
__device__ __forceinline__ void ln_batch_load(const Params& p, int pr0, int NGW, f32x4 (&v)[4][4], int lane) { ln_batch_load_t<false>(p, pr0, NGW, v, lane); }
__device__ __forceinline__ void ln_batch_load_lat(const Params& p, int lr0, int NGW, f32x4 (&v)[4][4], int lane) { ln_batch_load_t<true>(p, lr0, NGW, v, lane); }
template <bool LAT> __device__ __forceinline__ void ln_batch_run_t(const Params& p, int r0, int NGW, f32x4 (&v)[4][4], int lane) {
  const float* mod = (const float*)(p.ws + WS_MOD);
  bf16_t* H = (bf16_t*)(p.ws + WS_RH);
#pragma unroll
  for (int r = 0; r < 4; ++r) { const int ri = r0 + r * NGW; const int pr = LAT ? lat2pad(ri) : ri;
    if (ri < (LAT ? NLAT : NROW)) {
      const int b = pr / SKV, t = pr % SKV;
      const float* mrow = mod + ((t < SEQ) ? b : 2) * NMOD;
      f32x4 sh[4], sc[4];
#pragma unroll
      for (int j = 0; j < 4; ++j) { const int col = (lane + 64 * j) * 4; sh[j] = *(const f32x4*)(mrow + col); sc[j] = *(const f32x4*)(mrow + DM + col); }
      float s = 0;
#pragma unroll
      for (int j = 0; j < 4; ++j) s += (v[r][j].x + v[r][j].y) + (v[r][j].z + v[r][j].w);
      const float mean = wave_sum(s) * (1.f / DM); float s2 = 0;
#pragma unroll
      for (int j = 0; j < 4; ++j) { v[r][j] = v[r][j] - mean; s2 += (v[r][j].x * v[r][j].x + v[r][j].y * v[r][j].y) + (v[r][j].z * v[r][j].z + v[r][j].w * v[r][j].w); }
      const float rstd = rsqrtf(wave_sum(s2) * (1.f / DM) + LN_EPS);
#pragma unroll
      for (int j = 0; j < 4; ++j) {
        const int col = (lane + 64 * j) * 4;
        const f32x4 o = v[r][j] * rstd * (sc[j] + 1.f) + sh[j];
        u32x2 w; w.x = cvt_pk_bf16(o.x, o.y); w.y = cvt_pk_bf16(o.z, o.w);
        *(u32x2*)(H + (size_t)pr * DM + col) = w;
      }
    } }
}
__device__ __forceinline__ void ln_batch_run(const Params& p, int pr0, int NGW, f32x4 (&v)[4][4], int lane) { ln_batch_run_t<false>(p, pr0, NGW, v, lane); }
__device__ __forceinline__ void ln_batch_run_lat(const Params& p, int lr0, int NGW, f32x4 (&v)[4][4], int lane) { ln_batch_run_t<true>(p, lr0, NGW, v, lane); }
struct SchedIn {
  static constexpr bool GATHER = false, HAS_DONE = false, HALF = false;
  int G, c;
  __device__ __forceinline__ bool next(int i, pg::Unit& u) const {
    const int L = i * G + c; u.aux = 0;
    if (L < 1024) { int lm, pn; map_static(L, 64, 16, lm, pn); u.pm = lm + (lm >> 5); u.pn = pn; u.arow = u.pm * 256; return true; }
    if (((!MK_CTX_IN_P1 && !MK_CTX_IN_PRO) || G < 64) && L < 1032) { const int j = L - 1024; u.pm = (j < 4) ? 32 : 65; const int q = j & 3; u.pn = (q < 2) ? q : q + 4; u.arow = u.pm * 256; return true; }
    return false;
  }
};
struct EpiIn {
  static constexpr bool PERM = true;
  bf16_t* YA; bf16_t* P;
  __device__ __forceinline__ void operator()(const pg::Acc& acc, const pg::Unit& u, int wr, int wc, int fr, int fq) const {
    const int row0 = u.pm * 256 + wr * 64 + fr;
    if (u.pn < 2) {
#pragma unroll
      for (int ai = 0; ai < 2; ++ai)
#pragma unroll
        for (int m = 0; m < 4; ++m) { const int r = row0 + ai * 128 + m * 16, chunk = r >> 4, ti = r & 15;
#pragma unroll
          for (int bj = 0; bj < 2; ++bj) { const int ch = u.pn * 256 + bj * 128 + wc * 32 + 8 * fq, g = ch >> 4, off = ch & 15;
            const f32x4 v0 = acc[ai][bj][m][0], v1 = acc[ai][bj][m][1];
            u32x4 w; w.x = cvt_pk_bf16(v0[0], v0[1]); w.y = cvt_pk_bf16(v0[2], v0[3]); w.z = cvt_pk_bf16(v1[0], v1[1]); w.w = cvt_pk_bf16(v1[2], v1[3]);
            *(u32x4*)(YA + ((size_t)g * NCHUNK + chunk) * 512 + ti * 16 + off) = w; } }
    } else {
      const int colb = (u.pn - 2) * 256 + wc * 32 + 8 * fq; const bool sig = u.pn >= 8;
#pragma unroll
      for (int ai = 0; ai < 2; ++ai)
#pragma unroll
        for (int m = 0; m < 4; ++m) { bf16_t* rowp = P + (size_t)(row0 + ai * 128 + m * 16) * PLD + colb;
#pragma unroll
          for (int bj = 0; bj < 2; ++bj) { f32x4 v0 = acc[ai][bj][m][0], v1 = acc[ai][bj][m][1];
            if (sig) {
#pragma unroll
              for (int e = 0; e < 4; ++e) { v0[e] = __builtin_amdgcn_rcpf(1.f + __builtin_amdgcn_exp2f(-1.4426950408889634f * v0[e])); v1[e] = __builtin_amdgcn_rcpf(1.f + __builtin_amdgcn_exp2f(-1.4426950408889634f * v1[e])); } }
            u32x4 w; w.x = cvt_pk_bf16(v0[0], v0[1]); w.y = cvt_pk_bf16(v0[2], v0[3]); w.z = cvt_pk_bf16(v1[0], v1[1]); w.w = cvt_pk_bf16(v1[2], v1[3]);
            *(u32x4*)(rowp + bj * 128) = w; } }
    }
  }
};
__device__ __forceinline__ void phase2(const Params& p, LAS unsigned char* lds) {
  pg::Addr AD{(const bf16_t*)(p.ws + WS_RH), DM, 0, (const bf16_t*)(p.ws + WS_WIN), DM, 0, false};
  SchedIn S{(int)gridDim.x, (int)blockIdx.x};
  EpiIn E{(bf16_t*)((unsigned char*)p.out + DO_YA), (bf16_t*)(p.ws + WS_P)};
  pg::gemm_phase(lds, AD, S, E);
}

struct SchedOne {
  static constexpr bool GATHER = false, HAS_DONE = false, HALF = false;
  int pm, pn;
  __device__ __forceinline__ bool next(int i, pg::Unit& u) const { if (i > 0) return false; u.pm = pm; u.pn = pn; u.aux = 0; u.arow = pm * 256; return true; }
};
__device__ __forceinline__ void ctx_ln_and_unit(const Params& p, LAS unsigned char* lds, int c, int tid_) {
  const int lane = tid_ & 63, wave = tid_ >> 6;
  const int tile = c >> 2, pm = tile ? 65 : 32, quarter = c & 3;
  f32x4 va[4][4];
#pragma unroll 1
  for (int h = 0; h < 2; ++h) { const int pr0 = pm * 256 + quarter * 64 + wave * 8 + h * 4;
    ln_batch_load(p, pr0, 1, va, lane); ln_batch_run(p, pr0, 1, va, lane); }
  unsigned* ctr = (unsigned*)(p.ws + WS_CTL) + CTL_CTXCNT + tile * 64;
  asm volatile("s_waitcnt vmcnt(0)" ::: "memory");
  __syncthreads();
  if (tid_ == 0) { __threadfence(); __hip_atomic_fetch_add(ctr, 1u, __ATOMIC_RELEASE, __HIP_MEMORY_SCOPE_AGENT);
    unsigned spins = 0; while (__hip_atomic_load(ctr, __ATOMIC_ACQUIRE, __HIP_MEMORY_SCOPE_AGENT) < 4u && ++spins < (1u << 22)) __builtin_amdgcn_s_sleep(4);
    __threadfence(); }
  __syncthreads();
  __builtin_amdgcn_fence(__ATOMIC_ACQUIRE, "agent");
  pg::Addr AD{(const bf16_t*)(p.ws + WS_RH), DM, 0, (const bf16_t*)(p.ws + WS_WIN), DM, 0, false};
  SchedOne S{pm, (quarter < 2) ? quarter : quarter + 4};
  EpiIn E{(bf16_t*)((unsigned char*)p.out + DO_YA), (bf16_t*)(p.ws + WS_P)};
  pg::gemm_phase(lds, AD, S, E);
}
__device__ __forceinline__ void phase0(const Params& p, LAS unsigned char* lds) {
  const int tid = opaque_tid(), lane = tid & 63, wave = tid >> 6, c = blockIdx.x, G = gridDim.x;
  {
    LAS float* sv = (LAS float*)lds;
    LAS float* red = sv + 3 * DM;
    for (int i = tid; i < DM; i += 512) { sv[i] = siluf_(p.in[I_C][i]); sv[DM + i] = siluf_(p.in[I_C][DM + i]); sv[2 * DM + i] = siluf_(p.in[I_CCTX][i]); }
    __syncthreads();
    for (int cg = c; cg < NMOD / 24; cg += G) {
      const int c4 = tid % 6, rs = tid / 6;
      if (rs < 85) {
        const float* w = p.in[I_WMOD] + cg * 24 + 4 * c4;
        f32x4 wv[13];
#pragma unroll
        for (int q = 0; q < 13; ++q) { const int k = rs + 85 * q; wv[q] = (k < DM) ? *(const f32x4*)(w + (size_t)k * NMOD) : (f32x4){0.f, 0.f, 0.f, 0.f}; }
        f32x4 a0 = {0.f, 0.f, 0.f, 0.f}, a1 = a0, a2 = a0;
#pragma unroll
        for (int q = 0; q < 13; ++q) { const int k = rs + 85 * q; if (k < DM) { a0 += wv[q] * sv[k]; a1 += wv[q] * sv[DM + k]; a2 += wv[q] * sv[2 * DM + k]; } }
#pragma unroll
        for (int e = 0; e < 4; ++e) { red[(rs * 24 + 4 * c4 + e) * 3 + 0] = a0[e]; red[(rs * 24 + 4 * c4 + e) * 3 + 1] = a1[e]; red[(rs * 24 + 4 * c4 + e) * 3 + 2] = a2[e]; }
      }
      __syncthreads();
      if (tid < 72) { const int cc = tid / 3, r = tid % 3; float s = 0.f;
        for (int q = 0; q < 85; ++q) s += red[(q * 24 + cc) * 3 + r];
        ((float*)(p.ws + WS_MOD))[r * NMOD + cg * 24 + cc] = s + p.in[I_BMOD][cg * 24 + cc]; }
      __syncthreads();
    }
#if MK_CTX_IN_PRO || MK_LN_IN_PRO
    asm volatile("s_waitcnt vmcnt(0)" ::: "memory"); __syncthreads();
    if (tid == 0) { __threadfence(); __hip_atomic_fetch_add((unsigned*)(p.ws + WS_CTL) + CTL_MODCNT, 1u, __ATOMIC_RELEASE, __HIP_MEMORY_SCOPE_AGENT); }
#endif
  }
  const int nb = (G >= 64) ? 32 : 0;
  for (int g = c; g < 32; g += G) s5_build_tables(p, lds, g);
#if MK_CTX_IN_PRO
  if (G >= 64 && c < NCTXB) {
    if (tid == 0) { unsigned spins = 0;
      while (__hip_atomic_load((unsigned*)(p.ws + WS_CTL) + CTL_MODCNT, __ATOMIC_ACQUIRE, __HIP_MEMORY_SCOPE_AGENT) < (unsigned)G && ++spins < (1u << 22)) __builtin_amdgcn_s_sleep(4);
      while (__hip_atomic_load((unsigned*)(p.ws + WS_CTL) + CTL_WINCNT, __ATOMIC_ACQUIRE, __HIP_MEMORY_SCOPE_AGENT) < (unsigned)((G - nb) * NWAVES) && ++spins < (1u << 22)) __builtin_amdgcn_s_sleep(4);
      __threadfence(); }
    __syncthreads();
    __builtin_amdgcn_fence(__ATOMIC_ACQUIRE, "agent");
    ctx_ln_and_unit(p, lds, c, tid);
    return;
  }
#endif
  {
    LAS float* scr = (LAS float*)(lds + 8192) + wave * (64 * 33);
    const int N1 = (nb > 0) ? ((CV_TOTAL * MK_N1_NUM) / MK_N1_DEN) & ~7 : 0;
    if (c >= nb) cvt_run<true>(p, 0, N1, (c - nb) * NWAVES + wave, (G - nb) * NWAVES, scr, lane);
    { const int skip = (MK_CTX_IN_PRO && G >= 64) ? NCTXB : 0;
      cvt_run<false>(p, N1, CV_TOTAL, (c - skip) * NWAVES + wave, (G - skip) * NWAVES, scr, lane); }
  }
}

__device__ __forceinline__ void phase1(const Params& p, LAS unsigned char* lds) {
  const int tid_ = opaque_tid(); const int lane = tid_ & 63, wave = tid_ >> 6;
  const int c = blockIdx.x, G = gridDim.x;
  if (MK_CTX_IN_P1 && G > 2 * NCTXB && c < NCTXB) { ctx_ln_and_unit(p, lds, c, tid_); return; }
  if (!MK_CTX_IN_P1 && !MK_CTX_IN_PRO) {
    const int gwa = c * NWAVES + wave, NGWa = G * NWAVES;
    f32x4 va[4][4], vb[4][4];
    ln_batch_load(p, gwa, NGWa, va, lane);
    for (int pr0 = gwa; pr0 < NROW; pr0 += 8 * NGWa) {
      ln_batch_load(p, pr0 + 4 * NGWa, NGWa, vb, lane);
      ln_batch_run(p, pr0, NGWa, va, lane);
      ln_batch_load(p, pr0 + 8 * NGWa, NGWa, va, lane);
      ln_batch_run(p, pr0 + 4 * NGWa, NGWa, vb, lane);
    }
    return;
  }
  const int nb = (MK_CTX_IN_P1 && G > 2 * NCTXB) ? NCTXB : 0;
  const int gw = (c - nb) * NWAVES + wave, NGW = (G - nb) * NWAVES;
  f32x4 va[4][4], vb[4][4];
  ln_batch_load_lat(p, gw, NGW, va, lane);
  for (int lr0 = gw; lr0 < NLAT; lr0 += 8 * NGW) {
    ln_batch_load_lat(p, lr0 + 4 * NGW, NGW, vb, lane);
    ln_batch_run_lat(p, lr0, NGW, va, lane);
    ln_batch_load_lat(p, lr0 + 8 * NGW, NGW, va, lane);
    ln_batch_run_lat(p, lr0 + 4 * NGW, NGW, vb, lane);
  }
  if (nb == 0) {
    for (int pr0 = gw; pr0 < NROW; pr0 += 4 * NGW) {   }
  }
}

__device__ __forceinline__ void phase_qknorm(const Params& p) {
  const bf16_t* P = (const bf16_t*)(p.ws + WS_P); bf16_t* KC = (bf16_t*)(p.ws + WS_KC); bf16_t* VC = (bf16_t*)(p.ws + WS_VC);
  const int tid_ = opaque_tid(); const int lane = tid_ & 63, wave = tid_ >> 6;
  const int gw = blockIdx.x * NWAVES + wave, NGW = gridDim.x * NWAVES;
  const int sub = lane & 15, grp = lane >> 4, e0 = sub * 8, axis = sub >> 3; const bool hi_half = (sub & 4) != 0;
  float inv[8], gk[8];
#pragma unroll
  for (int j = 0; j < 8; ++j) { const int f = (e0 + j) & 31; inv[j] = exp2f(-(float)(2 * f) * (13.287712379549449f / 64.f)); gk[j] = p.in[I_KG][e0 + j]; }
  for (int pr = gw; pr < NROW; pr += NGW) {
    const int b = pr / SKV, t = pr % SKV; const bool isctx = t >= SEQ;
    const u32x4 w = *(const u32x4*)(P + (size_t)pr * PLD + PC_K + lane * 8);
    bf16_t* dst = (grp < 2 ? KC : VC) + ((size_t)(b * 2 + (grp & 1)) * SKV + t) * 128 + e0;
    if (grp >= 2) { *(u32x4*)dst = w; }
    float x[8] = {__uint_as_float(w.x << 16), __uint_as_float(w.x & 0xffff0000u), __uint_as_float(w.y << 16), __uint_as_float(w.y & 0xffff0000u),
                  __uint_as_float(w.z << 16), __uint_as_float(w.z & 0xffff0000u), __uint_as_float(w.w << 16), __uint_as_float(w.w & 0xffff0000u)};
    float ss = 0.f;
#pragma unroll
    for (int j = 0; j < 8; ++j) ss += x[j] * x[j];
    ss = row16_sum(ss);
    const float r = rsqrtf(ss * (1.f / 128.f) + LN_EPS);
    const float posf = (axis == 0) ? (float)(t >> 6) : (float)(t & 63);
    float o[8];
#pragma unroll
    for (int j = 0; j < 8; ++j) { x[j] = x[j] * r * gk[j];
      const float y = lane_xor4(x[j]);
      float sn = 0.f, cs = 1.f; if (!isctx) sincosf(posf * inv[j], &sn, &cs);
      o[j] = hi_half ? (y * sn + x[j] * cs) : (x[j] * cs - y * sn); }
    if (grp < 2) { u32x4 ow; ow.x = cvt_pk_bf16(o[0], o[1]); ow.y = cvt_pk_bf16(o[2], o[3]); ow.z = cvt_pk_bf16(o[4], o[5]); ow.w = cvt_pk_bf16(o[6], o[7]); *(u32x4*)dst = ow; }
  }
}
struct SchedLat {
  static constexpr bool GATHER = false, HAS_DONE = false, HALF = false;
  int G, c, nN;
  __device__ __forceinline__ bool next(int i, pg::Unit& u) const {
    const int L = i * G + c; u.aux = 0;
    if (L >= 64 * nN) return false;
    int lm, pn; map_static(L, 64, nN, lm, pn); u.pm = lm + (lm >> 5); u.pn = pn; u.arow = u.pm * 256; return true;
  }
};
struct EpiGlu {
  static constexpr bool PERM = true;
  const bf16_t* P; bf16_t* Z;
  __device__ __forceinline__ void operator()(const pg::Acc& acc, const pg::Unit& u, int wr, int wc, int fr, int fq) const {
    const int row0 = u.pm * 256 + wr * 64 + fr, ch = u.pn * 128 + wc * 32 + 8 * fq;
    u32x4 gwv[2][4];
#pragma unroll
    for (int ai = 0; ai < 2; ++ai)
#pragma unroll
      for (int m = 0; m < 4; ++m) gwv[ai][m] = *(const u32x4*)(P + (size_t)(row0 + ai * 128 + m * 16) * PLD + PC_G + ch);
#pragma unroll
    for (int ai = 0; ai < 2; ++ai)
#pragma unroll
      for (int m = 0; m < 4; ++m) { const int r = row0 + ai * 128 + m * 16;
        const u32x4 gw = gwv[ai][m];
        float gt[8] = {__uint_as_float(gw.x << 16), __uint_as_float(gw.x & 0xffff0000u), __uint_as_float(gw.y << 16), __uint_as_float(gw.y & 0xffff0000u),
                       __uint_as_float(gw.z << 16), __uint_as_float(gw.z & 0xffff0000u), __uint_as_float(gw.w << 16), __uint_as_float(gw.w & 0xffff0000u)};
        float o[8];
#pragma unroll
        for (int n = 0; n < 2; ++n)
#pragma unroll
          for (int e = 0; e < 4; ++e) { const float a_ = acc[ai][0][m][n][e], b_ = acc[ai][1][m][n][e];
            o[n * 4 + e] = gt[n * 4 + e] * a_ * __builtin_amdgcn_rcpf(1.f + __builtin_amdgcn_exp2f(-1.4426950408889634f * b_)); }
        u32x4 w; w.x = cvt_pk_bf16(o[0], o[1]); w.y = cvt_pk_bf16(o[2], o[3]); w.z = cvt_pk_bf16(o[4], o[5]); w.w = cvt_pk_bf16(o[6], o[7]);
        *(u32x4*)(Z + (size_t)r * DM + ch) = w; }
  }
};
struct EpiMix {
  static constexpr bool PERM = true;
  const bf16_t* P; bf16_t* Z;
  __device__ __forceinline__ void operator()(const pg::Acc& acc, const pg::Unit& u, int wr, int wc, int fr, int fq) const {
    const int row0 = u.pm * 256 + wr * 64 + fr, col0 = u.pn * 256 + wc * 32 + 8 * fq;
#pragma unroll
    for (int ai = 0; ai < 2; ++ai) {
      u32x4 gwv[4][2], zwv[4][2];
#pragma unroll
      for (int m = 0; m < 4; ++m)
#pragma unroll
        for (int bj = 0; bj < 2; ++bj) { const int r = row0 + ai * 128 + m * 16, cc = col0 + bj * 128;
          gwv[m][bj] = *(const u32x4*)(P + (size_t)r * PLD + PC_G + 1024 + cc); zwv[m][bj] = *(const u32x4*)(Z + (size_t)r * DM + cc); }
#pragma unroll
      for (int m = 0; m < 4; ++m)
#pragma unroll
        for (int bj = 0; bj < 2; ++bj) { const int r = row0 + ai * 128 + m * 16, cc = col0 + bj * 128;
          const u32x4 gw = gwv[m][bj], zw = zwv[m][bj];
          const unsigned gq[4] = {gw.x, gw.y, gw.z, gw.w}, zq[4] = {zw.x, zw.y, zw.z, zw.w};
          unsigned ow[4];
#pragma unroll
          for (int q = 0; q < 4; ++q) { const float a0 = acc[ai][bj][m][q >> 1][(q & 1) * 2], a1 = acc[ai][bj][m][q >> 1][(q & 1) * 2 + 1];
            ow[q] = cvt_pk_bf16(__uint_as_float(zq[q] << 16) + __uint_as_float(gq[q] << 16) * a0, __uint_as_float(zq[q] & 0xffff0000u) + __uint_as_float(gq[q] & 0xffff0000u) * a1); }
          *(u32x4*)(Z + (size_t)r * DM + cc) = (u32x4){ow[0], ow[1], ow[2], ow[3]}; }
    }
  }
};
struct EpiOut {
  static constexpr bool PERM = false;
  const float* X; const float* mod; float* R1;
  __device__ __forceinline__ void operator()(const pg::Acc& acc, const pg::Unit& u, int wr, int wc, int fr, int fq) const {
    const int b = u.pm / 33, lrow0 = (u.pm - b) * 256 + wr * 64 + fr, col0 = u.pn * 256 + wc * 32 + 4 * fq;
    const float* g1 = mod + b * NMOD + 2 * DM;
    f32x4 gv[2][2];
#pragma unroll
    for (int bj = 0; bj < 2; ++bj)
#pragma unroll
      for (int n = 0; n < 2; ++n) gv[bj][n] = *(const f32x4*)(g1 + col0 + bj * 128 + n * 16);
#pragma unroll
    for (int ai = 0; ai < 2; ++ai) {
      f32x4 xv[4][2][2];
#pragma unroll
      for (int m = 0; m < 4; ++m) { const size_t off = (size_t)(lrow0 + ai * 128 + m * 16) * DM + col0;
#pragma unroll
        for (int bj = 0; bj < 2; ++bj)
#pragma unroll
          for (int n = 0; n < 2; ++n) xv[m][bj][n] = *(const f32x4*)(X + off + bj * 128 + n * 16); }
#pragma unroll
      for (int m = 0; m < 4; ++m) { const size_t off = (size_t)(lrow0 + ai * 128 + m * 16) * DM + col0;
#pragma unroll
        for (int bj = 0; bj < 2; ++bj)
#pragma unroll
          for (int n = 0; n < 2; ++n) *(f32x4*)(R1 + off + bj * 128 + n * 16) = xv[m][bj][n] * ALPHA + gv[bj][n] * acc[ai][bj][m][n]; }
    }
  }
};
__device__ __forceinline__ void phase_g1(const Params& p, LAS unsigned char* lds) {
  pg::Addr AD{(const bf16_t*)((unsigned char*)p.out + DO_GY), 512, 0, (const bf16_t*)(p.ws + WS_WGLU), 512, 0, false};
  SchedLat S{(int)gridDim.x, (int)blockIdx.x, 8};
  EpiGlu E{(const bf16_t*)(p.ws + WS_P), (bf16_t*)(p.ws + WS_RH)};
  pg::gemm_phase(lds, AD, S, E);
}
__device__ __forceinline__ void phase_g2(const Params& p, LAS unsigned char* lds) {
  pg::Addr AD{(const bf16_t*)(p.ws + WS_P) + PC_Q, PLD, 0, (const bf16_t*)(p.ws + WS_WAO), DM, 0, false};
  SchedLat S{(int)gridDim.x, (int)blockIdx.x, 4};
  EpiMix E{(const bf16_t*)(p.ws + WS_P), (bf16_t*)(p.ws + WS_RH)};
  pg::gemm_phase(lds, AD, S, E);
}
__device__ __forceinline__ void phase_g3(const Params& p, LAS unsigned char* lds) {
  pg::Addr AD{(const bf16_t*)(p.ws + WS_RH), DM, 0, (const bf16_t*)(p.ws + WS_WOUT), DM, 0, false};
  SchedLat S{(int)gridDim.x, (int)blockIdx.x, 4};
  EpiOut E{p.in[I_X], (const float*)(p.ws + WS_MOD), p.out};
  pg::gemm_phase(lds, AD, S, E);
}

constexpr size_t RT_EW = 0, RT_LIST = 256 * 1024;
constexpr int CTL_CNT = 8192, CNT_STRIDE = 64;
constexpr int ACT_TILES_MAX = 160;
constexpr size_t PR_ACT = 66 * MiB;

struct MoeTab { const LAS int* tb; const LAS int* cn; };
__device__ __forceinline__ MoeTab moe_tables(const Params& p, LAS unsigned char* lds) {
  LAS int* tb = (LAS int*)(lds + LDS_STAGE); LAS int* cn = tb + 64;
  const unsigned* cnt = (const unsigned*)(p.ws + WS_CTL) + CTL_CNT;
  if (opaque_tid() == 0) { int acc = 0; for (int e = 0; e < 32; ++e) { const int c = (int)cnt[e * CNT_STRIDE]; cn[e] = c; tb[e] = acc; acc += (c + 255) >> 8; } tb[32] = acc; }
  __syncthreads();
  return MoeTab{tb, cn};
}
struct SchedMoe {
  static constexpr bool GATHER_ = true;
  int G, c, nN; MoeTab tab; const int* lists;
  __device__ __forceinline__ bool next_(int i, pg::Unit& u) const {
    if ((G & 7) != 0) {
      const int L = i * G + c, T = L / nN;
      if (T >= tab.tb[32]) return false;
      int e = 0;
#pragma unroll 1
      for (int q = 1; q < 32; ++q) e = (tab.tb[q] <= T) ? q : e;
      u.pm = T; u.pn = L % nN; u.aux = e; u.arow = T * 256; return true;
    }
    const int x = c & 7, j = c >> 3, nper = G >> 3;
    int idx = j + nper * i;
#pragma unroll 1
    for (int k = 0; k < 4; ++k) { const int e = x + 8 * k, n_e = (tab.tb[e + 1] - tab.tb[e]) * nN;
      if (idx < n_e) { const int T = tab.tb[e] + idx / nN; u.pm = T; u.pn = idx % nN; u.aux = e; u.arow = T * 256; return true; }
      idx -= n_e; }
    return false;
  }
  __device__ __forceinline__ int arow_(const pg::Unit& u, int r) const {
    const int slot = (u.pm - tab.tb[u.aux]) * 256 + r;
    if (slot >= tab.cn[u.aux]) return 0;
    return lat2pad(lists[u.aux * NLAT + slot] >> 1);
  }
};
constexpr int NEARLY = 48;
constexpr int CTL_TILECNT = 10496;
struct SchedMoeUp : SchedMoe { static constexpr bool GATHER = true, HAS_DONE = true, HALF = false;
  unsigned* tilecnt; bool early;
  __device__ __forceinline__ bool next(int i, pg::Unit& u) const { return next_(i, u); }
  __device__ __forceinline__ int arow(const pg::Unit& u, int r) const { return arow_(u, r); }
  __device__ __forceinline__ void done(const pg::Unit& u, int lane) const {
    if (early && u.pm < NEARLY) { asm volatile("s_waitcnt vmcnt(0)" ::: "memory"); __builtin_amdgcn_fence(__ATOMIC_RELEASE, "agent"); asm volatile("s_waitcnt vmcnt(0)" ::: "memory");
      if (lane == 0) __hip_atomic_fetch_add(tilecnt + 64 * u.pm, 1u, __ATOMIC_RELAXED, __HIP_MEMORY_SCOPE_AGENT); } } };
struct SchedMoeDown : SchedMoe { static constexpr bool GATHER = false, HAS_DONE = false, HALF = false;
  int t_first;
  __device__ __forceinline__ bool next(int i, pg::Unit& u) const {
    if (t_first == 0) return next_(i, u);
    const int L = i * G + c, T = t_first + L / nN;
    if (T >= tab.tb[32]) return false;
    int e = 0;
#pragma unroll 1
    for (int q = 1; q < 32; ++q) e = (tab.tb[q] <= T) ? q : e;
    u.pm = T; u.pn = L % nN; u.aux = e; u.arow = T * 256; return true; } };
struct SchedMoeDownOne : SchedMoe { static constexpr bool GATHER = false, HAS_DONE = false, HALF = false;
  int T, pn;
  __device__ __forceinline__ bool next(int i, pg::Unit& u) const {
    if (i > 0) return false;
    int e = 0;
#pragma unroll 1
    for (int q = 1; q < 32; ++q) e = (tab.tb[q] <= T) ? q : e;
    u.pm = T; u.pn = pn; u.aux = e; u.arow = T * 256; return true; } };
struct EpiGU {
  static constexpr bool PERM = true;
  bf16_t* ACT;
  __device__ __forceinline__ void operator()(const pg::Acc& acc, const pg::Unit& u, int wr, int wc, int fr, int fq) const {
    const int row0 = u.pm * 256 + wr * 64 + fr, ch = u.pn * 128 + wc * 32 + 8 * fq;
#pragma unroll
    for (int ai = 0; ai < 2; ++ai)
#pragma unroll
      for (int m = 0; m < 4; ++m) { const int r = row0 + ai * 128 + m * 16;
        float o[8];
#pragma unroll
        for (int n = 0; n < 2; ++n)
#pragma unroll
          for (int e = 0; e < 4; ++e) { const float a = acc[ai][0][m][n][e], b = acc[ai][1][m][n][e];
            o[n * 4 + e] = a * b * __builtin_amdgcn_rcpf(1.f + __builtin_amdgcn_exp2f(-1.4426950408889634f * a)); }
        u32x4 w; w.x = cvt_pk_bf16(o[0], o[1]); w.y = cvt_pk_bf16(o[2], o[3]); w.z = cvt_pk_bf16(o[4], o[5]); w.w = cvt_pk_bf16(o[6], o[7]);
        *(u32x4*)(ACT + (size_t)r * 512 + ch) = w; }
  }
};
struct EpiDown {
  static constexpr bool PERM = true;
  bf16_t* Y2; const int* lists; const float* ew; MoeTab tab;
  __device__ __forceinline__ void operator()(const pg::Acc& acc, const pg::Unit& u, int wr, int wc, int fr, int fq) const {
    const int slot0 = (u.pm - tab.tb[u.aux]) * 256 + wr * 64 + fr, n_e = tab.cn[u.aux], col0 = u.pn * 256 + wc * 32 + 8 * fq;
    int ids[2][4]; float wts[2][4];
#pragma unroll
    for (int ai = 0; ai < 2; ++ai)
#pragma unroll
      for (int m = 0; m < 4; ++m) { const int slot = slot0 + ai * 128 + m * 16; ids[ai][m] = (slot < n_e) ? lists[u.aux * NLAT + slot] : -1; }
#pragma unroll
    for (int ai = 0; ai < 2; ++ai)
#pragma unroll
      for (int m = 0; m < 4; ++m) wts[ai][m] = (ids[ai][m] >= 0) ? ew[ids[ai][m]] : 0.f;
#pragma unroll
    for (int ai = 0; ai < 2; ++ai)
#pragma unroll
      for (int m = 0; m < 4; ++m) {
        if (ids[ai][m] >= 0) { const int id = ids[ai][m]; const float w = wts[ai][m];
#pragma unroll
          for (int bj = 0; bj < 2; ++bj) { const f32x4 v0 = acc[ai][bj][m][0] * w, v1 = acc[ai][bj][m][1] * w;
            u32x4 o; o.x = cvt_pk_bf16(v0[0], v0[1]); o.y = cvt_pk_bf16(v0[2], v0[3]); o.z = cvt_pk_bf16(v1[0], v1[1]); o.w = cvt_pk_bf16(v1[2], v1[3]);
            *(u32x4*)(Y2 + (size_t)id * DM + col0 + bj * 128) = o; } } }
  }
};
__device__ __forceinline__ void phase_moe_up(const Params& p, LAS unsigned char* lds) {
  const MoeTab tab = moe_tables(p, lds);
  const bool early = (MK_EARLY_DOWN != 0) && gridDim.x == 256;
  unsigned* tilecnt = (unsigned*)(p.ws + WS_CTL) + CTL_TILECNT;
  {
    pg::Addr AD{(const bf16_t*)(p.ws + WS_RH), DM, 0, (const bf16_t*)(p.ws + WS_WGU), DM, (size_t)1024 * 1024, true};
    SchedMoeUp S; S.G = gridDim.x; S.c = blockIdx.x; S.nN = 4; S.tab = tab; S.lists = (const int*)(p.ws + WS_ROUTE + RT_LIST); S.tilecnt = tilecnt; S.early = early;
    EpiGU E{(bf16_t*)(p.ws + WS_P + PR_ACT)};
    pg::gemm_phase(lds, AD, S, E);
  }
  if (early && blockIdx.x >= 64) {
    const int Le = blockIdx.x - 64, T = Le >> 2, pn = Le & 3;
    if (opaque_tid() == 0) { unsigned spins = 0;
      while (__hip_atomic_load(tilecnt + 64 * T, __ATOMIC_RELAXED, __HIP_MEMORY_SCOPE_AGENT) < 32u && ++spins < (1u << 22)) __builtin_amdgcn_s_sleep(4); }
    __syncthreads();
    __builtin_amdgcn_fence(__ATOMIC_ACQUIRE, "agent");
    asm volatile("s_waitcnt vmcnt(0)" ::: "memory");
    pg::Addr AD{(const bf16_t*)(p.ws + WS_P + PR_ACT), 512, 0, (const bf16_t*)(p.ws + WS_WD), 512, (size_t)1024 * 512, false};
    SchedMoeDownOne S; S.G = gridDim.x; S.c = blockIdx.x; S.nN = 4; S.tab = tab; S.lists = (const int*)(p.ws + WS_ROUTE + RT_LIST); S.T = T; S.pn = pn;
    EpiDown E{(bf16_t*)(p.ws + WS_P), (const int*)(p.ws + WS_ROUTE + RT_LIST), (const float*)(p.ws + WS_ROUTE + RT_EW), tab};
    pg::gemm_phase(lds, AD, S, E);
  }
}
__device__ __forceinline__ void phase_moe_down(const Params& p, LAS unsigned char* lds) {
  const MoeTab tab = moe_tables(p, lds);
  const bool early = (MK_EARLY_DOWN != 0) && gridDim.x == 256;
  pg::Addr AD{(const bf16_t*)(p.ws + WS_P + PR_ACT), 512, 0, (const bf16_t*)(p.ws + WS_WD), 512, (size_t)1024 * 512, false};
  SchedMoeDown S; S.G = gridDim.x; S.c = blockIdx.x; S.nN = 4; S.tab = tab; S.lists = (const int*)(p.ws + WS_ROUTE + RT_LIST); S.t_first = early ? NEARLY : 0;
  EpiDown E{(bf16_t*)(p.ws + WS_P), (const int*)(p.ws + WS_ROUTE + RT_LIST), (const float*)(p.ws + WS_ROUTE + RT_EW), tab};
  pg::gemm_phase(lds, AD, S, E);
}

__device__ __forceinline__ void phase_final(const Params& p) {
  const float* mod = (const float*)(p.ws + WS_MOD);
  const bf16_t* Y2 = (const bf16_t*)(p.ws + WS_P);
  const bf16_t* X1b = (const bf16_t*)(p.ws + WS_X1B); float* OUT = p.out;
  const int tid_ = opaque_tid(); const int lane = tid_ & 63, wave = tid_ >> 6;
  const int gw = blockIdx.x * NWAVES + wave, NGW = gridDim.x * NWAVES;
  u32x2 x1[4], x1n[4]; u32x2 ya[4], yb[4], yan[4], ybn[4];
#define FIN_LOAD(row, X, A, B) do { _Pragma("unroll") for (int j = 0; j < 4; ++j) { const int col = (lane + 64 * j) * 4; \
    X[j] = *(const u32x2*)(X1b + (size_t)(row) * DM + col); A[j] = *(const u32x2*)(Y2 + (size_t)(2 * (row)) * DM + col); B[j] = *(const u32x2*)(Y2 + (size_t)(2 * (row) + 1) * DM + col); } } while (0)
  if (gw < NLAT) FIN_LOAD(gw, x1, ya, yb);
  for (int row = gw; row < NLAT; row += NGW) {
    const int rown = row + NGW;
    if (rown < NLAT) FIN_LOAD(rown, x1n, yan, ybn);
    const float* mrow = mod + (row / SEQ) * NMOD;
    float probe_scale = 1.f;
#if MK_TS_PHASE >= 0
    if (row < 164) { const unsigned long long* ts = (const unsigned long long*)((const unsigned*)(p.ws + WS_CTL) + CTL_TS); probe_scale = 1.f + sqrtf((float)(ts[MK_TS_PHASE + 1] - ts[MK_TS_PHASE]) * MK_TS_SCALE); }
#endif
    f32x4 g2[4], gg[4], bb[4];
#pragma unroll
    for (int j = 0; j < 4; ++j) { const int col = (lane + 64 * j) * 4; g2[j] = *(const f32x4*)(mrow + 5 * DM + col); gg[j] = *(const f32x4*)(p.in[I_LN2G] + col); bb[j] = *(const f32x4*)(p.in[I_LN2B] + col); }
    f32x4 v[4]; float s = 0;
#pragma unroll
    for (int j = 0; j < 4; ++j) {
      f32x4 ym;
      ym.x = __uint_as_float(ya[j].x << 16) + __uint_as_float(yb[j].x << 16); ym.y = __uint_as_float(ya[j].x & 0xffff0000u) + __uint_as_float(yb[j].x & 0xffff0000u);
      ym.z = __uint_as_float(ya[j].y << 16) + __uint_as_float(yb[j].y << 16); ym.w = __uint_as_float(ya[j].y & 0xffff0000u) + __uint_as_float(yb[j].y & 0xffff0000u);
      const f32x4 xf = {__uint_as_float(x1[j].x << 16), __uint_as_float(x1[j].x & 0xffff0000u), __uint_as_float(x1[j].y << 16), __uint_as_float(x1[j].y & 0xffff0000u)};
      v[j] = xf * ALPHA + g2[j] * ym;
      s += (v[j].x + v[j].y) + (v[j].z + v[j].w);
    }
    const float mean = wave_sum(s) * (1.f / DM); float s2 = 0;
#pragma unroll
    for (int j = 0; j < 4; ++j) { v[j] = v[j] - mean; s2 += (v[j].x * v[j].x + v[j].y * v[j].y) + (v[j].z * v[j].z + v[j].w * v[j].w); }
    const float rstd = rsqrtf(wave_sum(s2) * (1.f / DM) + LN_EPS);
#pragma unroll
    for (int j = 0; j < 4; ++j) ((f32x4*)(OUT + (size_t)row * DM))[lane + 64 * j] = (v[j] * rstd * gg[j] + bb[j]) * probe_scale;
#pragma unroll
    for (int j = 0; j < 4; ++j) { x1[j] = x1n[j]; ya[j] = yan[j]; yb[j] = ybn[j]; }
  }
#undef FIN_LOAD
}
__device__ __forceinline__ void phase_attn(const Params& p, char* lds) {
  bf16_t* P = (bf16_t*)(p.ws + WS_P);
  int seq = SKV; asm volatile("" : "+s"(seq));
  float negMC;
  { const int l_ = opaque_tid() & 63; float gq = fmaxf(fabsf(p.in[I_QG][l_]), fabsf(p.in[I_QG][64 + l_])), gk = fmaxf(fabsf(p.in[I_KG][l_]), fabsf(p.in[I_KG][64 + l_]));
#pragma unroll
    for (int o = 1; o < 64; o <<= 1) { gq = fmaxf(gq, __shfl_xor(gq, o)); gk = fmaxf(gk, __shfl_xor(gk, o)); }
    negMC = 128.f * 1.01f * gq * gk; }
  for (int unit = blockIdx.x; unit < NB * 8 * (SEQ / 256); unit += gridDim.x) {
    const int h = unit % 8, qb = (unit / 8) % 32, b = unit / 256;
    bf16_t* Qp = P + ((size_t)b * SKV + qb * 256) * PLD + PC_Q + h * 128;
    const bf16_t* Kp = (const bf16_t*)(p.ws + WS_KC) + (size_t)(b * 2 + (h >> 2)) * SKV * 128;
    const bf16_t* Vp = (const bf16_t*)(p.ws + WS_VC) + (size_t)(b * 2 + (h >> 2)) * SKV * 128;
    att::attn_dense_body(Qp, Kp, Vp, Qp, seq, negMC, p.in[I_QG], qb * 256, lds);
  }
}

#if MK_TS_PHASE >= 16
#define RT_TS(k) do { if (gw == 0 && row0 == 0 && lane0 == 0) ((unsigned long long*)((unsigned*)(p.ws + WS_CTL) + CTL_TS))[k] = __builtin_amdgcn_s_memrealtime(); } while (0)
#else
#define RT_TS(k) do { } while (0)
#endif
constexpr int LDS_RTLOG = LDS_STAGE + 10240;
__device__ __forceinline__ void phase_ln1_router(const Params& p, LAS unsigned char* lds) {
  const float* mod = (const float*)(p.ws + WS_MOD);
  const float* R1 = p.out; bf16_t* X1b = (bf16_t*)(p.ws + WS_X1B);
  bf16_t* H2 = (bf16_t*)(p.ws + WS_RH);
  float* ew = (float*)(p.ws + WS_ROUTE + RT_EW); int* lists = (int*)(p.ws + WS_ROUTE + RT_LIST);
  unsigned* cnt = (unsigned*)(p.ws + WS_CTL) + CTL_CNT;
  const int tid_ = opaque_tid(); const int lane0 = tid_ & 63, wave = tid_ >> 6;
  const int gw = blockIdx.x * NWAVES + wave, NGW = gridDim.x * NWAVES;
  LAS f32x4* Wl = (LAS f32x4*)lds;
  LAS float* lg = (LAS float*)(lds + LDS_RTLOG) + wave * 160;
  const float* Wre = p.in[I_WRE]; const float* Wrg = p.in[I_WRG];
  f32x4 vv[4][4];
#define RT_LOAD(row0_) do { int _ln = lane0; asm volatile("" : "+v"(_ln)); const int _r0 = ((row0_) < NLAT) ? (row0_) : (NLAT - 4); _Pragma("unroll") for (int r = 0; r < 4; ++r) _Pragma("unroll") for (int j = 0; j < 4; ++j) \
    vv[r][j] = ((const f32x4*)(R1 + (size_t)(_r0 + r) * DM))[_ln + 64 * j]; } while (0)
  RT_LOAD(gw * 4);
  {
#pragma unroll 1
    for (int q0 = 0; q0 < 16; q0 += 8) {
      f32x4 wt[8];
#pragma unroll
      for (int q = 0; q < 8; ++q) wt[q] = ((const f32x4*)Wre)[tid_ + 512 * (q0 + q)];
#pragma unroll
      for (int q = 0; q < 8; ++q) { const int idx = tid_ + 512 * (q0 + q), k = idx >> 3, c4 = idx & 7;
        Wl[((c4 * 16 + (k & 3) * 4 + (k >> 8)) << 6) + ((k >> 2) & 63)] = wt[q]; }
    }
  }
  __syncthreads();
  for (int row0 = gw * 4; row0 < NLAT; row0 += NGW * 4) {
    const float* mrow = mod + (row0 / SEQ) * NMOD;
    RT_TS(16);
#pragma unroll
    for (int r = 0; r < 4; ++r) {
      const int row = row0 + r, pr = lat2pad(row);
      int lane = lane0; asm volatile("" : "+v"(lane));
      f32x4 v[4]; float s = 0;
#pragma unroll
      for (int j = 0; j < 4; ++j) { v[j] = vv[r][j]; s += (v[j].x + v[j].y) + (v[j].z + v[j].w); }
      float mean = wave_sum(s) * (1.f / DM); float s2 = 0;
#pragma unroll
      for (int j = 0; j < 4; ++j) { v[j] = v[j] - mean; s2 += (v[j].x * v[j].x + v[j].y * v[j].y) + (v[j].z * v[j].z + v[j].w * v[j].w); }
      float rstd = rsqrtf(wave_sum(s2) * (1.f / DM) + LN_EPS);
      s = 0;
#pragma unroll
      for (int j = 0; j < 4; ++j) {
        const int col = (lane + 64 * j) * 4;
        const f32x4 g = *(const f32x4*)(p.in[I_LN1G] + col), bb = *(const f32x4*)(p.in[I_LN1B] + col);
        v[j] = v[j] * rstd * g + bb;
        { u32x2 xw; xw.x = cvt_pk_bf16(v[j].x, v[j].y); xw.y = cvt_pk_bf16(v[j].z, v[j].w); *(u32x2*)(X1b + (size_t)row * DM + col) = xw; }
        s += (v[j].x + v[j].y) + (v[j].z + v[j].w);
      }
      mean = wave_sum(s) * (1.f / DM); s2 = 0;
#pragma unroll
      for (int j = 0; j < 4; ++j) { v[j] = v[j] - mean; s2 += (v[j].x * v[j].x + v[j].y * v[j].y) + (v[j].z * v[j].z + v[j].w * v[j].w); }
      rstd = rsqrtf(wave_sum(s2) * (1.f / DM) + LN_EPS);
#pragma unroll
      for (int j = 0; j < 4; ++j) {
        const int col = (lane + 64 * j) * 4;
        const f32x4 sh = *(const f32x4*)(mrow + 3 * DM + col), sc = *(const f32x4*)(mrow + 4 * DM + col);
        const f32x4 hv = v[j] * rstd * (sc + 1.f) + sh;
        u32x2 w; w.x = cvt_pk_bf16(hv.x, hv.y); w.y = cvt_pk_bf16(hv.z, hv.w);
        *(u32x2*)(H2 + (size_t)pr * DM + col) = w;
        vv[r][j] = hv;
      }
    }
    RT_TS(17);
    int gsel[4];
    int lane = lane0; asm volatile("" : "+v"(lane));
    {
      f32x4 acc[4];
#pragma unroll
      for (int r = 0; r < 4; ++r) acc[r] = (f32x4){0.f, 0.f, 0.f, 0.f};
#pragma unroll
      for (int j = 0; j < 4; ++j)
#pragma unroll
        for (int e = 0; e < 4; ++e) { const f32x4 w = *(const f32x4*)(Wrg + (size_t)(j * 256 + e) * 4 + (unsigned)(lane * 16));
#pragma unroll
          for (int r = 0; r < 4; ++r) acc[r] += w * vv[r][j][e]; }
#pragma unroll
      for (int r = 0; r < 4; ++r)
#pragma unroll
        for (int e = 0; e < 4; ++e) acc[r][e] = wave_sum(acc[r][e]);
      if (lane == 0) {
#pragma unroll
        for (int r = 0; r < 4; ++r) *(LAS f32x4*)(lg + r * 40) = acc[r]; }
#pragma unroll
      for (int r = 0; r < 4; ++r) {
        int gi = 0; float gm = acc[r][0] + p.in[I_BRG][0];
#pragma unroll
        for (int i = 1; i < 4; ++i) { const float g = acc[r][i] + p.in[I_BRG][i]; if (g > gm) { gm = g; gi = i; } }
        gsel[r] = gi; }
    }
    RT_TS(18);
    {
      f32x4 ea[4][2];
#pragma unroll
      for (int r = 0; r < 4; ++r) { ea[r][0] = (f32x4){0.f, 0.f, 0.f, 0.f}; ea[r][1] = ea[r][0]; }
      const LAS f32x4* wb[4];
#pragma unroll
      for (int r = 0; r < 4; ++r) wb[r] = Wl + gsel[r] * 2048 + lane;
#pragma unroll
      for (int j = 0; j < 4; ++j)
#pragma unroll
        for (int e = 0; e < 4; ++e)
#pragma unroll
          for (int r = 0; r < 4; ++r) { const float h = vv[r][j][e];
            ea[r][0] += wb[r][(e * 4 + j) * 64] * h; ea[r][1] += wb[r][1024 + (e * 4 + j) * 64] * h; }
#pragma unroll
      for (int r = 0; r < 4; ++r)
#pragma unroll
        for (int hf = 0; hf < 2; ++hf)
#pragma unroll
          for (int e = 0; e < 4; ++e) ea[r][hf][e] = wave_sum(ea[r][hf][e]);
      if (lane == 0) {
#pragma unroll
        for (int r = 0; r < 4; ++r) { *(LAS f32x4*)(lg + r * 40 + 4 + gsel[r] * 8) = ea[r][0]; *(LAS f32x4*)(lg + r * 40 + 8 + gsel[r] * 8) = ea[r][1]; } }
    }
    RT_LOAD(row0 + NGW * 4);
    asm volatile("s_waitcnt lgkmcnt(0)" ::: "memory");
    RT_TS(19);
    if (lane < 4) {
      const int row = row0 + lane; const LAS float* L = lg + lane * 40;
      float gl[4]; int gi = 0;
#pragma unroll
      for (int i = 0; i < 4; ++i) gl[i] = L[i] + p.in[I_BRG][i];
      float gm = gl[0];
#pragma unroll
      for (int i = 1; i < 4; ++i) if (gl[i] > gm) { gm = gl[i]; gi = i; }
      float den = 0.f;
#pragma unroll
      for (int i = 0; i < 4; ++i) den += expf(gl[i] - gm);
      const float gw_ = 1.f / den;
      float el[8];
#pragma unroll
      for (int i = 0; i < 8; ++i) el[i] = L[4 + gi * 8 + i] + p.in[I_BRE][gi * 8 + i];
      int i1 = 0; float v1 = el[0];
#pragma unroll
      for (int i = 1; i < 8; ++i) if (el[i] > v1) { v1 = el[i]; i1 = i; }
      int i2 = -1; float v2 = -3.0e38f;
#pragma unroll
      for (int i = 0; i < 8; ++i) if (i != i1 && el[i] > v2) { v2 = el[i]; i2 = i; }
      const float e2 = expf(v2 - v1); const float w1 = 1.f / (1.f + e2), w2 = e2 / (1.f + e2);
      const int ea = gi * 8 + i1, eb = gi * 8 + i2;
      const unsigned pa = atomicAdd(cnt + ea * CNT_STRIDE, 1u), pb = atomicAdd(cnt + eb * CNT_STRIDE, 1u);
      lists[ea * NLAT + pa] = row * 2; lists[eb * NLAT + pb] = row * 2 + 1;
      ew[row * 2] = w1 * gw_; ew[row * 2 + 1] = w2 * gw_;
    }
    asm volatile("s_waitcnt vmcnt(0) lgkmcnt(0)" ::: "memory");
    RT_TS(20);
  }
}

enum { PH_PRO = 0, PH_LN, PH_GIN, PH_QK, PH_ATT, PH_G1, PH_G2, PH_G3, PH_RT, PH_UP, PH_DOWN, PH_FIN, PH_S5S, PH_SCAN, PH_S5Y, PH_COUNT };
template <int PH> __device__ __forceinline__ void run_phase(const Params& p, unsigned char* lds_raw) {
  LAS unsigned char* lds = (LAS unsigned char*)lds_raw;
  if constexpr (PH == PH_PRO) phase0(p, lds);
  if constexpr (PH == PH_LN) phase1(p, lds);
  if constexpr (PH == PH_GIN) phase2(p, lds);
  if constexpr (PH == PH_QK) phase_qknorm(p);
  if constexpr (PH == PH_ATT) phase_attn(p, (char*)lds_raw);
  if constexpr (PH == PH_G1) phase_g1(p, lds);
  if constexpr (PH == PH_G2) phase_g2(p, lds);
  if constexpr (PH == PH_G3) phase_g3(p, lds);
  if constexpr (PH == PH_RT) phase_ln1_router(p, lds);
  if constexpr (PH == PH_UP) phase_moe_up(p, lds);
  if constexpr (PH == PH_DOWN) phase_moe_down(p, lds);
  if constexpr (PH == PH_FIN) phase_final(p);
  if constexpr (PH == PH_S5S) phase_s5s(p, lds);
  if constexpr (PH == PH_SCAN) phase_s5scan(p);
  if constexpr (PH == PH_S5Y) phase_s5y(p, lds);
}
#ifndef MK_FUSED
#define MK_FUSED 1
#endif
#if !MK_FUSED
template <int PH> __global__ __launch_bounds__(512, 2) void k_phase(Params p) {
  extern __shared__ __attribute__((aligned(16))) unsigned char lds_raw[];
  run_phase<PH>(p, lds_raw);
}
template <int PH> static bool set_lds() { return hipFuncSetAttribute((const void*)k_phase<PH>, hipFuncAttributeMaxDynamicSharedMemorySize, LDS_BYTES) == hipSuccess; }
template <int PH> static void launch_ph(int grid, hipStream_t stream, const Params& p) { hipLaunchKernelGGL(k_phase<PH>, dim3(grid), dim3(512), LDS_BYTES, stream, p); }
#else
constexpr int CTL_SCAN = 2048;
constexpr int CTL_S5SCNT = 2432;
#ifndef MK_CG_SYNC
#define MK_CG_SYNC 0
#endif
constexpr int CTL_BAR = 4096;
constexpr int LDS_BARST = LDS_STAGE + 1024;
#if MK_CG_SYNC
#define GRID_BAR() cooperative_groups::this_grid().sync()
#else
#ifdef MK_DOUBLE_BAR
#define GRID_BAR() do { xcd_barrier(xbar); xcd_barrier(xbar); } while (0)
#else
#define GRID_BAR() xcd_barrier(xbar)
#endif
#endif
typedef const __attribute__((address_space(4))) Params* KParamsPtr;
__device__ __forceinline__ KParamsPtr kparams() { KParamsPtr k = (KParamsPtr)__builtin_amdgcn_kernarg_segment_ptr(); asm volatile("" : "+s"(k)); return k; }
#define KP (*(const Params*)kparams())
#ifndef MK_MASK
#define MK_MASK 0xFFFF
#endif
#ifndef MK_REP_MASK
#define MK_REP_MASK 0
#endif
#ifndef MK_REP
#define MK_REP 1
#endif
#define REP_PHASE(PH) do { if constexpr ((MK_REP_MASK >> PH) & 1) { for (int _r = 0; _r < MK_REP; ++_r) { run_phase<PH>(KP, lds_raw); GRID_BAR(); } } } while (0)
#ifndef MK_TS_PHASE
#define MK_TS_PHASE -1
#endif
#ifndef MK_TS_SCALE
#define MK_TS_SCALE 5.0e-8f
#endif
#if MK_TS_PHASE >= 0
#ifdef MK_TS_CLOCK
#define TS_MARK() do { if (blockIdx.x == 0 && opaque_tid() == 0) { ((unsigned long long*)((unsigned*)(KP.ws + WS_CTL) + CTL_TS))[ts_n] = __builtin_readcyclecounter(); } ++ts_n; } while (0)
#else
#define TS_MARK() do { if (blockIdx.x == 0 && opaque_tid() == 0) { ((unsigned long long*)((unsigned*)(KP.ws + WS_CTL) + CTL_TS))[ts_n] = __builtin_amdgcn_s_memrealtime(); } ++ts_n; } while (0)
#endif
#else
#define TS_MARK() do { } while (0)
#endif
__global__ __launch_bounds__(512, 2) void k_mega(Params p_unused) {
  extern __shared__ __attribute__((aligned(16))) unsigned char lds_raw[];
  int ts_n = 0; (void)ts_n;
#if !MK_CG_SYNC
  volatile LAS unsigned* bst = (volatile LAS unsigned*)((LAS unsigned char*)lds_raw + LDS_BARST);
  if (threadIdx.x < 2) bst[threadIdx.x] = 0u;
  tid_table_init();
  __syncthreads();
  const XcdBarrier xbar = xcd_barrier_post((unsigned*)(KP.ws + WS_CTL) + CTL_BAR, bst);
#endif
  TS_MARK();
  REP_PHASE(PH_PRO);
#if MK_LN_IN_PRO
  if constexpr ((MK_MASK >> PH_PRO) & 1) run_phase<PH_PRO>(KP, lds_raw);
  { if (opaque_tid() == 0) { unsigned spins = 0;
      while (__hip_atomic_load((unsigned*)(KP.ws + WS_CTL) + CTL_MODCNT, __ATOMIC_ACQUIRE, __HIP_MEMORY_SCOPE_AGENT) < gridDim.x && ++spins < (1u << 22)) __builtin_amdgcn_s_sleep(4); }
    __syncthreads();
    __builtin_amdgcn_fence(__ATOMIC_ACQUIRE, "agent"); }
  TS_MARK();
#else
  if constexpr ((MK_MASK >> PH_PRO) & 1) run_phase<PH_PRO>(KP, lds_raw);  GRID_BAR(); TS_MARK();
#endif
  REP_PHASE(PH_LN);
  if constexpr ((MK_MASK >> PH_LN) & 1) run_phase<PH_LN>(KP, lds_raw);   GRID_BAR(); TS_MARK();
  REP_PHASE(PH_GIN);
  if constexpr ((MK_MASK >> PH_GIN) & 1) run_phase<PH_GIN>(KP, lds_raw);  GRID_BAR(); TS_MARK();
  REP_PHASE(PH_S5S);
#if MK_S5_IN_P3
  {
    unsigned* c_s5s = (unsigned*)(KP.ws + WS_CTL) + CTL_S5SCNT; unsigned* c_scan = (unsigned*)(KP.ws + WS_CTL) + CTL_SCAN;
    const int cB = blockIdx.x;
    if (cB < 160) {
      run_phase<PH_S5S>(KP, lds_raw);
      if (opaque_tid() == 0) { __threadfence(); __hip_atomic_fetch_add(c_s5s, 1u, __ATOMIC_RELEASE, __HIP_MEMORY_SCOPE_AGENT); }
    } else if (cB < 176) {
      if (opaque_tid() == 0) { unsigned spins = 0; while (__hip_atomic_load(c_s5s, __ATOMIC_ACQUIRE, __HIP_MEMORY_SCOPE_AGENT) < 160u && ++spins < (1u << 22)) __builtin_amdgcn_s_sleep(4); }
      __syncthreads();
      __builtin_amdgcn_fence(__ATOMIC_ACQUIRE, "agent");
      { const int t_ = opaque_tid(); s5_scan_item(KP, (cB - 160) * NWAVES + (t_ >> 6), t_ & 63); }
      asm volatile("s_waitcnt vmcnt(0)" ::: "memory");
      __syncthreads();
      if (opaque_tid() == 0) { __threadfence(); __hip_atomic_fetch_add(c_scan, 1u, __ATOMIC_RELEASE, __HIP_MEMORY_SCOPE_AGENT); }
    }
    run_phase<PH_QK>(KP, lds_raw);
    if (cB < 128) {
      if (opaque_tid() == 0) { unsigned spins = 0; while (__hip_atomic_load(c_scan, __ATOMIC_ACQUIRE, __HIP_MEMORY_SCOPE_AGENT) < 16u && ++spins < (1u << 22)) __builtin_amdgcn_s_sleep(4); }
      __syncthreads();
      __builtin_amdgcn_fence(__ATOMIC_ACQUIRE, "agent");
      run_phase<PH_S5Y>(KP, lds_raw);
    }
  }
  GRID_BAR(); TS_MARK();
  run_phase<PH_ATT>(KP, lds_raw);
#else
#if MK_TS_PHASE >= 16
  if (blockIdx.x == 0 && opaque_tid() == 0) ((unsigned long long*)((unsigned*)(KP.ws + WS_CTL) + CTL_TS))[21] = __builtin_amdgcn_s_memrealtime();
#endif
  if constexpr ((MK_MASK >> PH_S5S) & 1) run_phase<PH_S5S>(KP, lds_raw);
#if MK_TS_PHASE >= 16
  if (blockIdx.x == 0 && opaque_tid() == 0) ((unsigned long long*)((unsigned*)(KP.ws + WS_CTL) + CTL_TS))[22] = __builtin_amdgcn_s_memrealtime();
#endif
  if constexpr ((MK_MASK >> PH_QK) & 1) run_phase<PH_QK>(KP, lds_raw);
#if MK_TS_PHASE >= 16
  asm volatile("s_waitcnt vmcnt(0)" ::: "memory");
  if (blockIdx.x == 0 && opaque_tid() == 0) ((unsigned long long*)((unsigned*)(KP.ws + WS_CTL) + CTL_TS))[23] = __builtin_amdgcn_s_memrealtime();
#endif
  GRID_BAR(); TS_MARK();
  {
    unsigned* ctr = (unsigned*)(KP.ws + WS_CTL) + CTL_SCAN;
    if (blockIdx.x * NWAVES < 128) {
#if MK_TS_PHASE >= 16
      if (blockIdx.x == 0 && opaque_tid() == 0) ((unsigned long long*)((unsigned*)(KP.ws + WS_CTL) + CTL_TS))[16] = __builtin_amdgcn_s_memrealtime();
#endif
      if constexpr ((MK_MASK >> PH_SCAN) & 1) run_phase<PH_SCAN>(KP, lds_raw);
#if MK_TS_PHASE >= 16
      asm volatile("s_waitcnt vmcnt(0)" ::: "memory");
      if (blockIdx.x == 0 && opaque_tid() == 0) ((unsigned long long*)((unsigned*)(KP.ws + WS_CTL) + CTL_TS))[17] = __builtin_amdgcn_s_memrealtime();
#endif
      __threadfence();
      if ((opaque_tid() & 63) == 0 && blockIdx.x * NWAVES + (opaque_tid() >> 6) < 128) __hip_atomic_fetch_add(ctr, 1u, __ATOMIC_RELEASE, __HIP_MEMORY_SCOPE_AGENT);
    }
    if constexpr ((MK_MASK >> PH_ATT) & 1) run_phase<PH_ATT>(KP, lds_raw);
    if (opaque_tid() == 0) { unsigned spins = 0; while (__hip_atomic_load(ctr, __ATOMIC_ACQUIRE, __HIP_MEMORY_SCOPE_AGENT) < 128u && ++spins < (1u << 24)) __builtin_amdgcn_s_sleep(8); }
    __syncthreads();
    __threadfence();
    if constexpr ((MK_MASK >> PH_S5Y) & 1) run_phase<PH_S5Y>(KP, lds_raw);
  }
#endif
  GRID_BAR(); TS_MARK();
  REP_PHASE(PH_S5Y);
  REP_PHASE(PH_G1);
  if constexpr ((MK_MASK >> PH_G1) & 1) run_phase<PH_G1>(KP, lds_raw);   GRID_BAR(); TS_MARK();
  if constexpr ((MK_MASK >> PH_G2) & 1) run_phase<PH_G2>(KP, lds_raw);   GRID_BAR(); TS_MARK();
  REP_PHASE(PH_G3);
  if constexpr ((MK_MASK >> PH_G3) & 1) run_phase<PH_G3>(KP, lds_raw);   GRID_BAR(); TS_MARK();
  if constexpr ((MK_MASK >> PH_RT) & 1) run_phase<PH_RT>(KP, lds_raw);   GRID_BAR(); TS_MARK();
  REP_PHASE(PH_UP);
  if constexpr ((MK_MASK >> PH_UP) & 1) run_phase<PH_UP>(KP, lds_raw);   GRID_BAR(); TS_MARK();
  REP_PHASE(PH_DOWN);
  if constexpr ((MK_MASK >> PH_DOWN) & 1) run_phase<PH_DOWN>(KP, lds_raw); GRID_BAR(); TS_MARK();
#if MK_TS_PHASE >= 0
  GRID_BAR();
#endif
  if constexpr ((MK_MASK >> PH_FIN) & 1) run_phase<PH_FIN>(KP, lds_raw);
}
#endif

extern "C" void kernel_launch(void* const* d_in, const int* in_sizes, int n_in, void* d_out, int out_size, void* d_ws, size_t ws_size, hipStream_t stream) {
  static int grid = 0;
  if (grid == 0) {
    if (n_in != 32 || out_size != NLAT * DM || ws_size < WS_END) { fprintf(stderr, "kernel_launch: unexpected shapes n_in %d out %d ws %zu\n", n_in, out_size, ws_size); grid = -1; return; }
    int dev = 0, cus = 0;
    hipGetDevice(&dev); hipDeviceGetAttribute(&cus, hipDeviceAttributeMultiprocessorCount, dev);
#if !MK_FUSED
    bool ok = set_lds<0>() && set_lds<1>() && set_lds<2>() && set_lds<3>() && set_lds<4>() && set_lds<5>() && set_lds<6>() && set_lds<7>() && set_lds<8>() && set_lds<9>() && set_lds<10>() && set_lds<11>() && set_lds<12>() && set_lds<13>() && set_lds<14>();
    if (!ok) { fprintf(stderr, "kernel_launch: hipFuncSetAttribute failed\n"); grid = -1; return; }
    grid = cus > 0 ? cus : 256;
#else
    if (hipFuncSetAttribute((const void*)k_mega, hipFuncAttributeMaxDynamicSharedMemorySize, LDS_BYTES) != hipSuccess) { fprintf(stderr, "kernel_launch: hipFuncSetAttribute failed\n"); grid = -1; return; }
    int per_cu = 0;
    if (hipOccupancyMaxActiveBlocksPerMultiprocessor(&per_cu, (const void*)k_mega, 512, LDS_BYTES) != hipSuccess || per_cu < 1) { fprintf(stderr, "kernel_launch: occupancy query says %d blocks per CU\n", per_cu); grid = -1; return; }
    grid = (cus > 0 ? cus : 256) * 1;
#endif
  }
  if (grid < 0) return;
  Params p{};
  for (int i = 0; i < 32; ++i) p.in[i] = (const float*)d_in[i];
  p.out = (float*)d_out; p.ws = (unsigned char*)d_ws;
  hipMemsetAsync((char*)d_ws + WS_CTL, 0, 64 * 1024, stream);
#if !MK_FUSED
  launch_ph<PH_PRO>(grid, stream, p);
  launch_ph<PH_LN>(grid, stream, p);
  launch_ph<PH_GIN>(grid, stream, p);
  launch_ph<PH_QK>(grid, stream, p);
  launch_ph<PH_S5S>(grid, stream, p);
  launch_ph<PH_SCAN>(grid, stream, p);
  launch_ph<PH_ATT>(grid, stream, p);
  launch_ph<PH_S5Y>(grid, stream, p);
  launch_ph<PH_G1>(grid, stream, p);
  launch_ph<PH_G2>(grid, stream, p);
  launch_ph<PH_G3>(grid, stream, p);
  launch_ph<PH_RT>(grid, stream, p);
  launch_ph<PH_UP>(grid, stream, p);
  launch_ph<PH_DOWN>(grid, stream, p);
  launch_ph<PH_FIN>(grid, stream, p);
#else
  void* args[] = {&p};
  hipError_t e = hipLaunchCooperativeKernel((const void*)k_mega, dim3(grid), dim3(512), args, LDS_BYTES, stream);
  if (e != hipSuccess) fprintf(stderr, "kernel_launch: cooperative launch failed: %s (grid %d)\n", hipGetErrorString(e), grid);
#endif
}
```

```cpp
#include <hip/hip_runtime.h>
#include <hip/hip_bf16.h>
#include <hip/hip_cooperative_groups.h>
#include <cstdint>
#include <cstdio>

typedef unsigned short bf16_t;
#define LAS __attribute__((address_space(3)))
typedef short bf16x8 __attribute__((ext_vector_type(8)));
typedef float f32x4 __attribute__((ext_vector_type(4)));
typedef float f32x2 __attribute__((ext_vector_type(2)));
typedef unsigned u32x4 __attribute__((ext_vector_type(4)));
typedef unsigned u32x2 __attribute__((ext_vector_type(2)));

__device__ __forceinline__ float bf2f(bf16_t v) { return __uint_as_float(((unsigned)v) << 16); }
__device__ __forceinline__ bf16_t f2bf(float f) { unsigned u = __float_as_uint(f); return (bf16_t)((u + 0x7fffu + ((u >> 16) & 1u)) >> 16); }
__device__ __forceinline__ unsigned cvt_pk_bf16(float lo, float hi) { unsigned r; asm volatile("v_cvt_pk_bf16_f32 %0, %1, %2" : "=v"(r) : "v"(lo), "v"(hi)); return r; }

constexpr int DM = 1024, NB = 2, SEQ = 8192, NCTX = 256;
constexpr int NLAT = NB * SEQ;
constexpr int SKV = SEQ + NCTX;
constexpr int NROW = NB * SKV;
constexpr int INW = 4096;
constexpr int NMOD = 6 * DM;
constexpr int PLD = 3584;
constexpr int PC_Q = 0, PC_K = 1024, PC_V = 1280, PC_G = 1536;
constexpr int NCHUNK = NROW / 16;
constexpr float LN_EPS = 1e-6f;
constexpr float ALPHA = 1.189207115002721f;

constexpr size_t MiB = 1u << 20;
constexpr size_t WS_CTL = 0;
constexpr size_t WS_MOD = 1 * MiB;
constexpr size_t WS_ROUTE = 2 * MiB;
constexpr size_t WS_S5AB = 5 * MiB;
constexpr size_t WS_S5T = 6 * MiB;
constexpr size_t WS_S5E = 14 * MiB;
constexpr size_t WS_WIN = 18 * MiB;
constexpr size_t WS_WGLU = 26 * MiB;
constexpr size_t WS_WAO = 28 * MiB;
constexpr size_t WS_WOUT = 30 * MiB;
constexpr size_t WS_WGU = 32 * MiB;
constexpr size_t WS_WD = 96 * MiB;
constexpr size_t WS_RH = 128 * MiB;
constexpr size_t WS_P = 162 * MiB;
constexpr size_t WS_KC = 280 * MiB;
constexpr size_t WS_VC = WS_KC + (size_t)NB * 2 * SKV * 128 * 2;
constexpr size_t WS_X1B = 268 * MiB;
constexpr size_t WS_END = 300 * MiB;
constexpr size_t DO_YA = 0, DO_GY = 34 * MiB;

struct Params {
  const float* in[32];
  float* out;
  unsigned char* ws;
};
enum { I_X = 0, I_C, I_CTX, I_CCTX, I_WMOD, I_BMOD, I_WIN, I_SARE, I_SAIM, I_SLDT, I_SBRE, I_SBIM, I_SCRE, I_SCIM, I_SD,
       I_WGA, I_WGB, I_QG, I_KG, I_WAO, I_WOUT, I_LN1G, I_LN1B, I_WRG, I_BRG, I_WRE, I_BRE, I_WEG, I_WEU, I_WED, I_LN2G, I_LN2B };

template <int CTRL> __device__ __forceinline__ float dpp_add(float v) { return v + __builtin_bit_cast(float, __builtin_amdgcn_update_dpp(0, __builtin_bit_cast(int, v), CTRL, 0xF, 0xF, false)); }
__device__ __forceinline__ float row16_sum(float v) {
  v = dpp_add<0xB1>(v); v = dpp_add<0x4E>(v); v = dpp_add<0x141>(v); v = dpp_add<0x140>(v); return v; }
__device__ __forceinline__ float wave_sum(float v) {
  v = row16_sum(v);
  { auto rr = __builtin_amdgcn_permlane16_swap(__float_as_uint(v), __float_as_uint(v), false, false); v = __uint_as_float(rr[0]) + __uint_as_float(rr[1]); }
  { auto rr = __builtin_amdgcn_permlane32_swap(__float_as_uint(v), __float_as_uint(v), false, false); v = __uint_as_float(rr[0]) + __uint_as_float(rr[1]); }
  return v;
}
__device__ __forceinline__ float lane_xor4(float x) {
  int t = __builtin_amdgcn_update_dpp(0, __builtin_bit_cast(int, x), 0x104, 0xF, 0x5, false);
  t = __builtin_amdgcn_update_dpp(t, __builtin_bit_cast(int, x), 0x114, 0xF, 0xA, false);
  return __builtin_bit_cast(float, t);
}
__device__ __forceinline__ float sigmoidf_(float x) { return 1.f / (1.f + __expf(-x)); }
__device__ __forceinline__ float siluf_(float x) { return x / (1.f + __expf(-x)); }
__device__ __forceinline__ float gelu_tanh(float x) {
  const float k0 = 0.7978845608028654f, k1 = 0.044715f;
  const float z = k0 * (x + k1 * x * x * x);
  return x / (1.f + __expf(-2.f * z));
}
__device__ __forceinline__ int lat2pad(int lr) { return lr + (lr / SEQ) * NCTX; }

constexpr int NWAVES = 8;
constexpr int LDS_STAGE = 131072;
constexpr int LDS_BYTES = 147456;


constexpr int LDS_WIDTAB = LDS_STAGE + 15872;
__device__ __forceinline__ unsigned hw_wave_slot() { return (unsigned)__builtin_amdgcn_s_getreg(((6 - 1) << 11) | 4) & 63u; }
__device__ __forceinline__ int opaque_tid() {
  extern __shared__ __attribute__((aligned(16))) unsigned char lds_dyn_[];
  const int wv = __builtin_amdgcn_readfirstlane(((const volatile LAS int*)((LAS unsigned char*)lds_dyn_ + LDS_WIDTAB))[hw_wave_slot()]);
  unsigned m = ~0u; asm volatile("" : "+s"(m));
  int t = (wv << 6) | (int)__builtin_amdgcn_mbcnt_hi(m, __builtin_amdgcn_mbcnt_lo(m, 0u));
  asm volatile("" : "+v"(t)); return t;
}
__device__ __forceinline__ void tid_table_init() {
  extern __shared__ __attribute__((aligned(16))) unsigned char lds_dyn_[];
  if ((threadIdx.x & 63) == 0) ((volatile LAS int*)((LAS unsigned char*)lds_dyn_ + LDS_WIDTAB))[hw_wave_slot()] = (int)(threadIdx.x >> 6);
}

#ifndef MK_TS_PHASE
#define MK_TS_PHASE -1
#endif
#ifndef MK_TS_SCALE
#define MK_TS_SCALE 5.0e-8f
#endif
constexpr int CTL_TS = 3072;
#ifndef MK_CTX_IN_P1
#define MK_CTX_IN_P1 0
#endif
#ifndef MK_N1_NUM
#define MK_N1_NUM 4
#define MK_N1_DEN 5
#endif
#ifndef MK_RB_BF16
#define MK_RB_BF16 1
#endif
#ifndef MK_LN_IN_PRO
#define MK_LN_IN_PRO 0
#endif
#ifndef MK_CTX_IN_PRO
#define MK_CTX_IN_PRO 0
#endif
constexpr int NCTXB = 8;
constexpr int CTL_CTXCNT = 2176;
constexpr int CTL_MODCNT = 2304, CTL_WINCNT = 2368;
#ifndef MK_MMA_PRIO
#define MK_MMA_PRIO 1
#endif
#ifndef MK_EARLY_DOWN
#define MK_EARLY_DOWN 0
#endif
#ifndef MK_WARM_G2
#define MK_WARM_G2 0
#endif
#ifndef MK_S5_IN_P3
#define MK_S5_IN_P3 0
#endif
#ifndef MK_MOE_HALF
#define MK_MOE_HALF 1
#endif
namespace pg {
constexpr int BM = 256, BK = 64, HALF = 128, HTB = HALF * BK * 2, STAGE_BYTES = 8 * HTB;
__host__ __device__ __forceinline__ int lds_byte(int r, int c) { const int st = (r >> 4) * 2 + (c >> 5), rr = r & 15, cc = c & 31, ob = rr * 64 + cc * 2; return st * 1024 + (ob ^ (((ob >> 9) & 1) << 5)); }
__host__ __device__ __forceinline__ void stage_rc(int b, int& R, int& C) { const int st = b / 1024, sb = b % 1024, swz = sb ^ (((sb >> 9) & 1) << 5); R = (st >> 1) * 16 + swz / 64; C = (st & 1) * 32 + (swz % 64) / 2; }
__host__ __device__ __forceinline__ int perm32(int rho) { const int n = rho >> 4, i = rho & 15; return 8 * (i >> 2) + 4 * n + (i & 3); }

struct Unit { int pm, pn, aux, arow, half; };
struct Addr {
  const bf16_t* A; int lda; size_t a_gs; const bf16_t* Bt; int K; size_t b_gs;
  bool gather;
  __device__ __forceinline__ const char* a_base(const Unit& u) const { return gather ? (const char*)A : (const char*)(A + (size_t)u.aux * a_gs + (size_t)u.arow * lda); }
  __device__ __forceinline__ const char* b_base(const Unit& u) const { return (const char*)(Bt + (size_t)u.aux * b_gs + (size_t)u.pn * BM * K); }
};
typedef f32x4 Acc[2][2][4][2];

template <class Epi, class Sched>
__device__ __forceinline__ void gemm_phase(LAS unsigned char* lds, const Addr AD, const Sched& S, const Epi& E) {
  const int tid = opaque_tid(), wid = __builtin_amdgcn_readfirstlane(tid >> 6), lane = tid & 63, wr = wid >> 2, wc = wid & 3, fr = lane & 15, fq = lane >> 4;
  int K_ = AD.K; asm volatile("" : "+s"(K_));
  const int K = K_, nt = K / BK, lda = AD.lda;
  int R0, C0; stage_rc(tid * 16, R0, C0);
  const unsigned voffB0 = (unsigned)(((Epi::PERM ? ((R0 & ~31) + perm32(R0 & 31)) : R0)) * K + C0) * 2u;
  const size_t pstepB = (size_t)64 * K * 2, pstepA = (size_t)64 * lda * 2, hstepA = (size_t)HALF * lda * 2;
  unsigned vA[2][2];
  const unsigned voffA0 = (unsigned)(R0 * lda + C0) * 2u;
#define PG_SETV(v, u) do { if constexpr (Sched::GATHER) { _Pragma("unroll") for (int _h = 0; _h < 2; ++_h) _Pragma("unroll") for (int _i = 0; _i < 2; ++_i) \
    v[_h][_i] = (unsigned)(S.arow(u, _h * HALF + _i * 64 + R0) * lda + C0) * 2u; } } while (0)
  const size_t kstep = (size_t)(BK * 2);
  const size_t hstepB = (size_t)HALF * K * 2;
  const unsigned ldsw = (unsigned)wid * 1024u;
  const int aoff = lds_byte(wr * 64 + fr, fq * 8), boff = lds_byte(wc * 32 + fr, fq * 8);
#define PG_SA(b, h) (((b) * 2 + (h)) * HTB)
#define PG_SB(b, h) ((4 + (b) * 2 + (h)) * HTB)
#define PG_STAGE_B(bufoff, gbase) do { _Pragma("unroll") for (int _i = 0; _i < 2; ++_i) { unsigned _vo = voffB0; asm volatile("" : "+v"(_vo)); \
    __builtin_amdgcn_global_load_lds((const unsigned*)((const char*)(gbase) + _i * pstepB + _vo), (LAS unsigned*)(lds + (bufoff) + ldsw + _i * 8192), 16, 0, 0); } } while (0)
#define PG_STAGE_A(b, h, gbase, V) do { _Pragma("unroll") for (int _i = 0; _i < 2; ++_i) { \
    if constexpr (Sched::GATHER) { unsigned _vo = V[h][_i]; asm volatile("" : "+v"(_vo)); __builtin_amdgcn_global_load_lds((const unsigned*)((const char*)(gbase) + _vo), (LAS unsigned*)(lds + PG_SA(b, h) + ldsw + _i * 8192), 16, 0, 0); } \
    else { unsigned _vo = voffA0; asm volatile("" : "+v"(_vo)); __builtin_amdgcn_global_load_lds((const unsigned*)((const char*)(gbase) + (h) * hstepA + _i * pstepA + _vo), (LAS unsigned*)(lds + PG_SA(b, h) + ldsw + _i * 8192), 16, 0, 0); } } } while (0)
#define PG_LDA(dst, b, h) do { _Pragma("unroll") for (int m = 0; m < 4; ++m) _Pragma("unroll") for (int k = 0; k < 2; ++k) dst[m][k] = *(const LAS bf16x8*)(lds + PG_SA(b, h) + aoff + m * 2048 + k * 1024); } while (0)
#define PG_LDB(dst, b, h) do { _Pragma("unroll") for (int n = 0; n < 2; ++n) _Pragma("unroll") for (int k = 0; k < 2; ++k) dst[n][k] = *(const LAS bf16x8*)(lds + PG_SB(b, h) + boff + n * 2048 + k * 1024); } while (0)
#define PG_MMA(ai, bj, At, Bt) do { __builtin_amdgcn_s_setprio(1); _Pragma("unroll") for (int m = 0; m < 4; ++m) _Pragma("unroll") for (int n = 0; n < 2; ++n) _Pragma("unroll") for (int k = 0; k < 2; ++k) \
    acc[ai][bj][m][n] = __builtin_amdgcn_mfma_f32_16x16x32_bf16(Bt[n][k], At[m][k], acc[ai][bj][m][n], 0, 0, 0); __builtin_amdgcn_s_setprio(0); } while (0)
#define PG_WAIT_V(n) asm volatile("s_waitcnt vmcnt(" #n ")" ::: "memory")
#define PG_WAIT_L(n) asm volatile("s_waitcnt lgkmcnt(" #n ")" ::: "memory")
#define PG_BAR __builtin_amdgcn_s_barrier()
#define PG_SCHED __builtin_amdgcn_sched_barrier(0)
  Unit cur, nxt; int ui = 0;
  if (!S.next(0, cur)) return;
  Acc acc;
#pragma unroll
  for (int a = 0; a < 2; ++a)
#pragma unroll
    for (int b = 0; b < 2; ++b)
#pragma unroll
      for (int m = 0; m < 4; ++m)
#pragma unroll
        for (int n = 0; n < 2; ++n) acc[a][b][m][n] = (f32x4){0.f, 0.f, 0.f, 0.f};
  bf16x8 At[4][2], B0[2][2], B1[2][2];
  const char* cA = AD.a_base(cur); const char* cB = AD.b_base(cur);
  PG_SETV(vA, cur);
  PG_STAGE_B(PG_SB(0, 0), cB); PG_STAGE_B(PG_SB(0, 1), cB + hstepB); PG_STAGE_A(0, 0, cA, vA); PG_STAGE_A(0, 1, cA, vA);
  if (wr == 1) PG_BAR;
  PG_WAIT_V(2); PG_BAR;
  PG_STAGE_B(PG_SB(1, 0), cB + kstep); PG_STAGE_A(1, 0, cA + kstep, vA); PG_STAGE_B(PG_SB(1, 1), cB + hstepB + kstep);
  PG_WAIT_V(6); PG_BAR;
#define PG_MMA1() do { if constexpr (Sched::HALF) { if (!cur.half) { PG_MMA(1, 0, At, B0); PG_MMA(1, 1, At, B1); } } else { PG_MMA(1, 0, At, B0); PG_MMA(1, 1, At, B1); } } while (0)
#define PG_KPAIR(a1, a2, b2, a3, b3, VN) do { \
      PG_LDB(B0, 0, 0); PG_LDB(B1, 0, 1); PG_SCHED; PG_LDA(At, 0, 0); PG_STAGE_A(1, 1, a1, vA); \
      PG_WAIT_V(8); PG_WAIT_L(0); PG_BAR; PG_MMA(0, 0, At, B0); PG_MMA(0, 1, At, B1); PG_BAR; PG_SCHED; \
      PG_LDA(At, 0, 1); PG_STAGE_B(PG_SB(0, 0), b2); PG_STAGE_B(PG_SB(0, 1), (b2) + hstepB); PG_STAGE_A(0, 0, a2, VN); \
      PG_WAIT_V(8); PG_WAIT_L(0); PG_BAR; PG_MMA1(); PG_BAR; PG_SCHED; \
      PG_LDB(B0, 1, 0); PG_LDB(B1, 1, 1); PG_SCHED; PG_LDA(At, 1, 0); PG_STAGE_A(0, 1, a2, VN); \
      PG_WAIT_V(8); PG_WAIT_L(0); PG_BAR; PG_MMA(0, 0, At, B0); PG_MMA(0, 1, At, B1); PG_BAR; PG_SCHED; \
      PG_LDA(At, 1, 1); PG_STAGE_B(PG_SB(1, 0), b3); PG_STAGE_B(PG_SB(1, 1), (b3) + hstepB); PG_STAGE_A(1, 0, a3, VN); \
      PG_WAIT_V(8); PG_WAIT_L(0); PG_BAR; PG_MMA1(); PG_BAR; PG_SCHED; } while (0)
  for (;;) {
    const bool has_next = S.next(ui + 1, nxt);
    const char* nA = has_next ? AD.a_base(nxt) : cA; const char* nB = has_next ? AD.b_base(nxt) : cB;
    if constexpr (Sched::GATHER) {
      unsigned vT[2][2];
      if (has_next) PG_SETV(vT, nxt); else {
#pragma unroll
        for (int _h = 0; _h < 2; ++_h)
#pragma unroll
          for (int _i = 0; _i < 2; ++_i) vT[_h][_i] = vA[_h][_i]; }
      *(LAS u32x4*)(lds + STAGE_BYTES + 2048 + tid * 16) = (u32x4){vT[0][0], vT[0][1], vT[1][0], vT[1][1]};
    }
    if constexpr (Sched::GATHER) {
      for (int t = 0; t < nt - 2; t += 2) {
        const char* a1 = cA + (size_t)(t + 1) * kstep; const char* a2 = cA + (size_t)(t + 2) * kstep; const char* b2 = cB + (size_t)(t + 2) * kstep;
        PG_KPAIR(a1, a2, b2, a2 + kstep, b2 + kstep, vA);
      }
      { const char* a1 = cA + (size_t)(nt - 1) * kstep;
        const u32x4 q = *(const LAS u32x4*)(lds + STAGE_BYTES + 2048 + tid * 16);
        unsigned vAn[2][2] = {{q.x, q.y}, {q.z, q.w}};
        PG_KPAIR(a1, nA, nB, nA + kstep, nB + kstep, vAn);
#pragma unroll
        for (int _h = 0; _h < 2; ++_h)
#pragma unroll
          for (int _i = 0; _i < 2; ++_i) vA[_h][_i] = vAn[_h][_i]; }
    } else {
      for (int t = 0; t < nt; t += 2) {
        const bool last = (t == nt - 2);
        const char* a1 = cA + (size_t)(t + 1) * kstep;
        const char* a2 = last ? nA : cA + (size_t)(t + 2) * kstep; const char* b2 = last ? nB : cB + (size_t)(t + 2) * kstep;
        PG_KPAIR(a1, a2, b2, a2 + kstep, b2 + kstep, vA);
      }
    }
    if (wr == 0) PG_BAR;
    E(acc, cur, wr, wc, fr, fq);
    if constexpr (Sched::HAS_DONE) S.done(cur, lane);
    if (!has_next) break;
#pragma unroll
    for (int a = 0; a < 2; ++a)
#pragma unroll
      for (int b = 0; b < 2; ++b)
#pragma unroll
        for (int m = 0; m < 4; ++m)
#pragma unroll
          for (int n = 0; n < 2; ++n) acc[a][b][m][n] = (f32x4){0.f, 0.f, 0.f, 0.f};
    cur = nxt; cA = nA; cB = nB; ++ui;
    if (wr == 1) PG_BAR;
  }
  PG_WAIT_V(0);
  PG_BAR;
#undef PG_MMA1
#undef PG_SETV
#undef PG_KPAIR
#undef PG_SA
#undef PG_SB
#undef PG_STAGE_A
#undef PG_STAGE_B
#undef PG_LDA
#undef PG_LDB
#undef PG_MMA
#undef PG_WAIT_V
#undef PG_WAIT_L
#undef PG_BAR
#undef PG_SCHED
}
}
namespace att {
using bf16x8 = __attribute__((ext_vector_type(8))) short;
using s16x4 = __attribute__((ext_vector_type(4))) short;
using f32x16 = __attribute__((ext_vector_type(16))) float;
using u32x4 = __attribute__((ext_vector_type(4))) unsigned;
constexpr int D = 128, NW = 8, QBLK = 32, KVBLK = 64;
constexpr float SCALE = 0.088388347648318440f;
constexpr float THR = 8.f;
constexpr int LDQ = PLD, LDK = 128, LDO = PLD;
constexpr int NRING = 3;
constexpr size_t SHM_V = KVBLK * D * 2, SHM_K = KVBLK * D * 2, SHM_ATTN = NRING * SHM_V + NRING * SHM_K + NW * 64 * 4;
constexpr float ROPE_C8[8] = {1.0f, 0.74989421f, 0.56234133f, 0.42169650f, 0.31622777f, 0.23713737f, 0.17782794f, 0.13335214f};
#define KSWZ(row, colB) ((row) * 256 + ((colB) ^ (((row) & 7) << 4)))
#define SBAR() __builtin_amdgcn_sched_barrier(0)
__device__ __forceinline__ int crow(int r, int hi) { return (r & 3) + 8 * (r >> 2) + 4 * hi; }
__device__ __forceinline__ unsigned cvtpk(float lo, float hi) { unsigned r; asm volatile("v_cvt_pk_bf16_f32 %0, %1, %2" : "=v"(r) : "v"(lo), "v"(hi)); return r; }
__device__ __forceinline__ void partialSM(f32x16& p0, f32x16& p1, float& m_reg, float& mn, float& alpha) {
  constexpr float C = SCALE * 1.4426950408889634f;
  float pmax = m_reg; asm volatile("" : "+v"(pmax));
  if (__builtin_expect(__all(pmax - m_reg <= THR / SCALE), 1)) { mn = m_reg; }
  else { mn = fmaxf(m_reg, pmax); m_reg = mn; }
  float mnC = -mn * C;
  for (int r = 0; r < 16; ++r) p0[r] = fmaf(p0[r], C, mnC); for (int r = 0; r < 16; ++r) p1[r] = fmaf(p1[r], C, mnC);
  for (int r = 0; r < 16; ++r) p0[r] = __builtin_amdgcn_exp2f(p0[r]);
}
__device__ __forceinline__ void finishSM(f32x16& p0, f32x16& p1, float alpha, float& l_reg, bf16x8& pa0, bf16x8& pa1, bf16x8& pa2, bf16x8& pa3) {
  for (int r = 0; r < 16; ++r) p1[r] = __builtin_amdgcn_exp2f(p1[r]);
  float ps = 0; for (int r = 0; r < 16; ++r) ps += p0[r]; for (int r = 0; r < 16; ++r) ps += p1[r];
  { auto rr = __builtin_amdgcn_permlane32_swap(__float_as_uint(ps), __float_as_uint(ps), false, false);
    ps = __uint_as_float(rr[0]) + __uint_as_float(rr[1]); }
  l_reg += ps;
#define PK4(P, BASE, OUT) do { unsigned a0 = cvtpk(P[BASE + 0], P[BASE + 1]), a1 = cvtpk(P[BASE + 2], P[BASE + 3]);   \
    unsigned b0 = cvtpk(P[BASE + 4], P[BASE + 5]), b1 = cvtpk(P[BASE + 6], P[BASE + 7]);                              \
    auto r0 = __builtin_amdgcn_permlane32_swap(a0, b0, false, false); auto r1 = __builtin_amdgcn_permlane32_swap(a1, b1, false, false); \
    u32x4 w = {r0[0], r1[0], r0[1], r1[1]}; OUT = *reinterpret_cast<bf16x8*>(&w); } while (0)
  PK4(p0, 0, pa0); PK4(p0, 8, pa1); PK4(p1, 0, pa2); PK4(p1, 8, pa3);
#undef PK4
}
__device__ __forceinline__ void qkt(f32x16& p0, f32x16& p1, const bf16_t* Ks, const bf16x8* qr, int r32, int hi) {
  p0 = f32x16{}; p1 = f32x16{};
  for (int d0 = 0; d0 < 8; ++d0) { int cb = (d0 * 16 + hi * 8) * 2;
    bf16x8 b0 = *reinterpret_cast<const bf16x8*>((const char*)Ks + KSWZ(r32, cb));
    bf16x8 b1 = *reinterpret_cast<const bf16x8*>((const char*)Ks + KSWZ(32 + r32, cb));
    p0 = __builtin_amdgcn_mfma_f32_32x32x16_bf16(b0, qr[d0], p0, 0, 0, 0);
    p1 = __builtin_amdgcn_mfma_f32_32x32x16_bf16(b1, qr[d0], p1, 0, 0, 0); }
}
__device__ __forceinline__ int v_st(int k, int c) { const int kk = (k & ~0xC) | ((k & 4) << 1) | ((k & 8) >> 1); return ((kk >> 3) * 4 + (c >> 5)) * 512 + ((kk & 7) * 32 + (c & 31)) * 2; }
__device__ __forceinline__ int v_rd_base(int lane) { return ((lane & 3) << 3) | (((lane >> 2) & 3) << 6) | (((lane >> 4) & 1) << 5) | (((lane >> 5) & 1) << 8); }
constexpr int v_rd_off(int d0, int ks, int half) { return d0 * 512 + ks * 4096 + half * 2048; }
template <int OFF> __device__ __forceinline__ s16x4 tr_read(int vb) {
  s16x4 r; asm volatile("ds_read_b64_tr_b16 %0, %1 offset:%2" : "=&v"(r) : "v"(vb), "i"(OFF) : "memory"); return r;
}
template <int D0> __device__ __forceinline__ void pv_one(f32x16& od, int vb, bf16x8 pa0, bf16x8 pa1, bf16x8 pa2, bf16x8 pa3) {
  const s16x4 l0 = tr_read<v_rd_off(D0, 0, 0)>(vb), h0 = tr_read<v_rd_off(D0, 0, 1)>(vb), l1 = tr_read<v_rd_off(D0, 1, 0)>(vb), h1 = tr_read<v_rd_off(D0, 1, 1)>(vb);
  const s16x4 l2 = tr_read<v_rd_off(D0, 2, 0)>(vb), h2 = tr_read<v_rd_off(D0, 2, 1)>(vb), l3 = tr_read<v_rd_off(D0, 3, 0)>(vb), h3 = tr_read<v_rd_off(D0, 3, 1)>(vb);
  asm volatile("s_waitcnt lgkmcnt(0)" ::: "memory"); SBAR();
#define PK(L, H) (bf16x8){L[0], L[1], L[2], L[3], H[0], H[1], H[2], H[3]}
  od = __builtin_amdgcn_mfma_f32_32x32x16_bf16(pa0, PK(l0, h0), od, 0, 0, 0);
  od = __builtin_amdgcn_mfma_f32_32x32x16_bf16(pa1, PK(l1, h1), od, 0, 0, 0);
  od = __builtin_amdgcn_mfma_f32_32x32x16_bf16(pa2, PK(l2, h2), od, 0, 0, 0);
  od = __builtin_amdgcn_mfma_f32_32x32x16_bf16(pa3, PK(l3, h3), od, 0, 0, 0);
#undef PK
}
__device__ __forceinline__ void pv_d0(f32x16* o, int vb, bf16x8 pa0, bf16x8 pa1, bf16x8 pa2, bf16x8 pa3) {
  pv_one<0>(o[0], vb, pa0, pa1, pa2, pa3); pv_one<1>(o[1], vb, pa0, pa1, pa2, pa3); pv_one<2>(o[2], vb, pa0, pa1, pa2, pa3); pv_one<3>(o[3], vb, pa0, pa1, pa2, pa3);
}
__device__ __forceinline__ void attn_dense_body(const bf16_t* __restrict__ Qb, const bf16_t* __restrict__ Kh, const bf16_t* __restrict__ Vh, bf16_t* __restrict__ Ob, int seq, float mbound, const float* __restrict__ qgain, int t0, char* lds) {
  const int tid = opaque_tid(), wid = tid >> 6, lane = tid & 63, r32 = lane & 31, hi = lane >> 5;
  bf16_t* V_lds = (bf16_t*)lds; bf16_t* K_lds = (bf16_t*)(lds + NRING * SHM_V);
  float* ws = (float*)(lds + NRING * SHM_V + NRING * SHM_K) + wid * 64; float* li_l = ws; float* al_l = ws + 32;
  float m_reg = mbound, l_reg = 0; f32x16 o[4]; bf16x8 qr[8];
  const bf16_t* Qw = Qb + (long)(wid * QBLK + r32) * LDQ + hi * 8;
#pragma unroll
  for (int d0 = 0; d0 < 8; ++d0) qr[d0] = *reinterpret_cast<const bf16x8*>(Qw + d0 * 16);
  {
#define UNPK8(W, X) do { X[0] = __uint_as_float(W.x << 16); X[1] = __uint_as_float(W.x & 0xffff0000u); X[2] = __uint_as_float(W.y << 16); X[3] = __uint_as_float(W.y & 0xffff0000u); \
                         X[4] = __uint_as_float(W.z << 16); X[5] = __uint_as_float(W.z & 0xffff0000u); X[6] = __uint_as_float(W.w << 16); X[7] = __uint_as_float(W.w & 0xffff0000u); } while (0)
    char* qs = lds + wid * 8192 + lane * 16;
    float ss = 0.f;
#pragma unroll
    for (int d0 = 0; d0 < 8; ++d0) { const u32x4 w = *reinterpret_cast<const u32x4*>(&qr[d0]); float x[8]; UNPK8(w, x);
#pragma unroll
      for (int j = 0; j < 8; ++j) ss += x[j] * x[j];
      *(u32x4*)(qs + d0 * 1024) = w; }
    { auto rr = __builtin_amdgcn_permlane32_swap(__float_as_uint(ss), __float_as_uint(ss), false, false); ss = __uint_as_float(rr[0]) + __uint_as_float(rr[1]); }
    const float rn = rsqrtf(ss * (1.f / 128.f) + 1e-6f);
    const int tq = t0 + wid * QBLK + r32;
#pragma unroll 1
    for (int it = 0; it < 4; ++it) { const int ax = it >> 1, d = it & 1, da = 4 * ax + d, db = da + 2;
      const float ph = (ax == 0 ? (float)(tq >> 6) : (float)(tq & 63)) * (hi ? 0.1f : 1.f) * (d ? 0.01f : 1.f);
      const u32x4 wa = *(const u32x4*)(qs + da * 1024), wb = *(const u32x4*)(qs + db * 1024);
      float xa[8], xb[8]; UNPK8(wa, xa); UNPK8(wb, xb);
      const f32x4 ga0 = *(const f32x4*)(qgain + 16 * da + 8 * hi), ga1 = *(const f32x4*)(qgain + 16 * da + 8 * hi + 4), gb0 = *(const f32x4*)(qgain + 16 * db + 8 * hi), gb1 = *(const f32x4*)(qgain + 16 * db + 8 * hi + 4);
      const float ga[8] = {ga0.x, ga0.y, ga0.z, ga0.w, ga1.x, ga1.y, ga1.z, ga1.w}, gb[8] = {gb0.x, gb0.y, gb0.z, gb0.w, gb1.x, gb1.y, gb1.z, gb1.w};
#pragma unroll
      for (int j = 0; j < 8; ++j) { const float ang = ph * ROPE_C8[j];
        const float sn = __sinf(ang), cs = __cosf(ang);
        const float x1 = xa[j] * rn * ga[j], x2 = xb[j] * rn * gb[j];
        xa[j] = x1 * cs - x2 * sn; xb[j] = x1 * sn + x2 * cs; }
      *(u32x4*)(qs + da * 1024) = (u32x4){cvtpk(xa[0], xa[1]), cvtpk(xa[2], xa[3]), cvtpk(xa[4], xa[5]), cvtpk(xa[6], xa[7])};
      *(u32x4*)(qs + db * 1024) = (u32x4){cvtpk(xb[0], xb[1]), cvtpk(xb[2], xb[3]), cvtpk(xb[4], xb[5]), cvtpk(xb[6], xb[7])}; }
#pragma unroll
    for (int d0 = 0; d0 < 8; ++d0) qr[d0] = *reinterpret_cast<const bf16x8*>(qs + d0 * 1024);
    asm volatile("s_waitcnt lgkmcnt(0)" ::: "memory");
    __syncthreads();
#undef UNPK8
  }
  SBAR();
#pragma unroll
  for (int d = 0; d < 4; ++d) o[d] = f32x16{};
  SBAR();
  const int sr = tid >> 4, sc = (tid & 15) * 8, vst0 = v_st(sr, sc), vst1 = v_st(32 + sr, sc);
  const int vb0 = (int)(uintptr_t)V_lds + v_rd_base(lane);
  struct { bf16x8 vs0, vs1, ks0, ks1; } sr_[2];
#define SLOAD(i, k0) do { sr_[i].vs0 = *(const bf16x8*)(&Vh[(long)((k0) + sr) * LDK + sc]); sr_[i].vs1 = *(const bf16x8*)(&Vh[(long)((k0) + 32 + sr) * LDK + sc]); \
    sr_[i].ks0 = *(const bf16x8*)(&Kh[(long)((k0) + sr) * LDK + sc]); sr_[i].ks1 = *(const bf16x8*)(&Kh[(long)((k0) + 32 + sr) * LDK + sc]); } while (0)
#define SWRITE(b, i) do { *(bf16x8*)((char*)V_lds + (b) * SHM_V + vst0) = sr_[i].vs0;          \
    *(bf16x8*)((char*)V_lds + (b) * SHM_V + vst1) = sr_[i].vs1; int kc = sc * 2;               \
    *(bf16x8*)((char*)K_lds + (b) * SHM_K + KSWZ(sr, kc)) = sr_[i].ks0;                       \
    *(bf16x8*)((char*)K_lds + (b) * SHM_K + KSWZ(32 + sr, kc)) = sr_[i].ks1; } while (0)
#define SWAIT() asm volatile("s_waitcnt vmcnt(4)" ::: "memory")
#define RESC(a) do { if (__any((a) < 1.f)) { if (hi == 0) al_l[r32] = (a); asm volatile("s_waitcnt lgkmcnt(0)" ::: "memory"); \
    for (int d = 0; d < 4; ++d) for (int r = 0; r < 16; ++r) o[d][r] *= al_l[crow(r, hi)]; } } while (0)
  f32x16 pA0, pA1, pB0, pB1; float mnA, mnB, alA, alB; bf16x8 pa0, pa1, pa2, pa3; const int NT = seq / KVBLK;
#define KRING(b) ((bf16_t*)((char*)K_lds + (b) * SHM_K))
#define ATT_STEP(PC0, PC1, MNC, ALC, PP0, PP1, ALP, KB, VBP, WB, SLW, SLL, TLOAD, DO_LOAD, DO_WRITE, WAIT0) do { \
    SBAR(); qkt(PC0, PC1, KRING(KB), qr, r32, hi); \
    finishSM(PP0, PP1, ALP, l_reg, pa0, pa1, pa2, pa3); SBAR(); \
    if (DO_LOAD) SLOAD(SLL, (TLOAD) * KVBLK); SBAR(); \
    pv_d0(o, vb0 + (VBP) * (int)SHM_V, pa0, pa1, pa2, pa3); partialSM(PC0, PC1, m_reg, MNC, ALC); \
    if (DO_WRITE) { if (WAIT0) asm volatile("s_waitcnt vmcnt(0)" ::: "memory"); else SWAIT(); SWRITE(WB, SLW); } \
    __syncthreads(); } while (0)
#define STEP_B(t, KB, VBP, WB, DL, DW, W0) ATT_STEP(pB0, pB1, mnB, alB, pA0, pA1, alA, KB, VBP, WB, 0, 1, (t) + 2, DL, DW, W0)
#define STEP_A(t, KB, VBP, WB, DL, DW, W0) ATT_STEP(pA0, pA1, mnA, alA, pB0, pB1, alB, KB, VBP, WB, 1, 0, (t) + 2, DL, DW, W0)
  SLOAD(0, 0); SLOAD(1, KVBLK); SWAIT(); SWRITE(0, 0); __syncthreads();
  SLOAD(0, 2 * KVBLK);
  qkt(pA0, pA1, KRING(0), qr, r32, hi); partialSM(pA0, pA1, m_reg, mnA, alA);
  SWAIT(); SWRITE(1, 1); __syncthreads();
  int t = 1, r0 = 0, r1 = 1, r2 = 2;
#define ATT_STEPR(PC0, PC1, MNC, ALC, PP0, PP1, ALP, SLW, SLL, DO_LOAD, DO_WRITE, WAIT0) do { \
    SBAR(); qkt(PC0, PC1, (bf16_t*)((char*)K_lds + r1 * (int)SHM_K), qr, r32, hi); \
    finishSM(PP0, PP1, ALP, l_reg, pa0, pa1, pa2, pa3); SBAR(); \
    if (DO_LOAD) SLOAD(SLL, (t + 2) * KVBLK); SBAR(); \
    pv_d0(o, vb0 + r0 * (int)SHM_V, pa0, pa1, pa2, pa3); partialSM(PC0, PC1, m_reg, MNC, ALC); \
    if (DO_WRITE) { if (WAIT0) asm volatile("s_waitcnt vmcnt(0)" ::: "memory"); else SWAIT(); SWRITE(r2, SLW); } \
    __syncthreads(); { const int _r = r0; r0 = r1; r1 = r2; r2 = _r; } ++t; } while (0)
#define STEPR_B(DL, DW, W0) ATT_STEPR(pB0, pB1, mnB, alB, pA0, pA1, alA, 0, 1, DL, DW, W0)
#define STEPR_A(DL, DW, W0) ATT_STEPR(pA0, pA1, mnA, alA, pB0, pB1, alB, 1, 0, DL, DW, W0)
  while (t + 3 < NT) { STEPR_B(true, true, false); STEPR_A(true, true, false); }
  STEPR_B(true, true, false);
  STEPR_A(false, true, true);
  STEPR_B(false, false, false);
  finishSM(pB0, pB1, alB, l_reg, pa0, pa1, pa2, pa3); SBAR();
  pv_d0(o, vb0 + r0 * (int)SHM_V, pa0, pa1, pa2, pa3);
#undef ATT_STEPR
#undef STEPR_A
#undef STEPR_B
#undef KRING
#undef ATT_STEP
#undef STEP_A
#undef STEP_B
  if (hi == 0) li_l[r32] = l_reg; asm volatile("s_waitcnt lgkmcnt(0)" ::: "memory");
  float rli[16];
#pragma unroll
  for (int r = 0; r < 16; ++r) rli[r] = __builtin_amdgcn_rcpf(li_l[crow(r, hi)]);
  int lane_e = lane; asm volatile("" : "+v"(lane_e));
  const int r32e = lane_e & 31, hie = lane_e >> 5;
  bf16_t* Ow = Ob + (long)(wid * QBLK) * LDO;
#pragma unroll
  for (int r = 0; r < 16; ++r) { int orow = crow(r, hie);
    for (int d0 = 0; d0 < 4; ++d0) Ow[(long)orow * LDO + d0 * 32 + r32e] = f2bf(o[d0][r] * rli[r]); }
  __syncthreads();
#undef SLOAD
#undef SWRITE
#undef SWAIT
#undef RESC
}
}

#define XB_TMO      128
#define XB_XCNT(j)  (256  + 64 * (j))
#define XB_XSUB(j)  (1280 + 64 * (j))
#define XB_XGEN(j)  (2304 + 64 * (j))
#define XB_TOP      3328
#define XB_TOPGEN   3392
#define XCD_BAR_WORDS 3456
#define XB_SPIN_CAP (1u << 18)

__device__ __forceinline__ unsigned xb_ld(unsigned* p)              { return __hip_atomic_load(p, __ATOMIC_RELAXED, __HIP_MEMORY_SCOPE_AGENT); }
__device__ __forceinline__ unsigned xb_add(unsigned* p, unsigned v) { return __hip_atomic_fetch_add(p, v, __ATOMIC_RELAXED, __HIP_MEMORY_SCOPE_AGENT); }
__device__ __forceinline__ unsigned xb_xcc_id() { return (unsigned)__builtin_amdgcn_s_getreg((3 << 11) | 20) & 0xFu; }
#define XB_SPIN(cond, bar) do { unsigned _sp = 0; while (cond) { __builtin_amdgcn_s_sleep(1); \
    if ((++_sp & 255u) == 0u) { if (xb_ld(&(bar)[XB_TMO])) break; if (_sp > XB_SPIN_CAP) { atomicAdd(&(bar)[XB_TMO], 1u); break; } } } } while (0)

struct XcdBarrier {
    unsigned* bar; unsigned x;
    volatile LAS unsigned* st;
};

__device__ __forceinline__ XcdBarrier xcd_barrier_post(unsigned* bar, volatile LAS unsigned* st) {
    XcdBarrier b; b.bar = bar; b.x = (unsigned)__builtin_amdgcn_readfirstlane((int)xb_xcc_id()); b.st = st;
    if (opaque_tid() == 0) (void)xb_add(&bar[XB_XCNT(b.x)], 1u);
    return b;
}
__device__ __forceinline__ void xcd_barrier_complete(unsigned* bar, unsigned x, unsigned& nloc, unsigned& nx) {
    const unsigned G = gridDim.x * gridDim.y * gridDim.z;
    unsigned sum, cnt, mine, sp = 0u;
    for (;;) {
        sum = 0u; cnt = 0u; mine = 0u;
#pragma unroll 1
        for (unsigned j = 0; j < 16; ++j) { const unsigned c = xb_ld(&bar[XB_XCNT(j)]); sum += c; cnt += (c > 0u) ? 1u : 0u; mine = (j == x) ? c : mine; }
        if (sum == G) break;
        __builtin_amdgcn_s_sleep(1);
        if ((++sp & 255u) == 0u) { if (xb_ld(&bar[XB_TMO])) break; if (sp > XB_SPIN_CAP) { atomicAdd(&bar[XB_TMO], 1u); break; } }
    }
    nloc = mine > 0u ? mine : 1u; nx = cnt > 0u ? cnt : 1u;
}

__device__ __forceinline__ void xcd_barrier(const XcdBarrier& b) {
    asm volatile("s_waitcnt vmcnt(0)" ::: "memory");
    __syncthreads();
    if (opaque_tid() == 0) {
        unsigned* bar = b.bar; unsigned bx = b.x; asm volatile("" : "+s"(bx));
        __builtin_amdgcn_s_waitcnt(0);
        unsigned nloc = b.st[0], nx = b.st[1];
        if (nloc == 0u) { xcd_barrier_complete(bar, bx, nloc, nx); b.st[0] = nloc; b.st[1] = nx; }
        const unsigned old = xb_add(&bar[XB_XSUB(bx)], 1u);
        const unsigned gen = old / nloc;
        if (old + 1u == (gen + 1u) * nloc) {
            __builtin_amdgcn_fence(__ATOMIC_RELEASE, "agent");
            asm volatile("s_waitcnt vmcnt(0)" ::: "memory");
            const unsigned og = xb_add(&bar[XB_TOP], 1u);
            const unsigned tg = og / nx;
            if (og + 1u == (tg + 1u) * nx) xb_add(&bar[XB_TOPGEN], 1u);
            else XB_SPIN(xb_ld(&bar[XB_TOPGEN]) == tg, bar);
            __builtin_amdgcn_fence(__ATOMIC_ACQUIRE, "agent");
            xb_add(&bar[XB_XGEN(bx)], 1u);
            asm volatile("s_waitcnt vmcnt(0)" ::: "memory");
        } else {
            XB_SPIN(xb_ld(&bar[XB_XGEN(bx)]) == gen, bar);
            __builtin_amdgcn_fence(__ATOMIC_ACQUIRE, "agent");
            asm volatile("s_waitcnt vmcnt(0)" ::: "memory");
        }
    }
    __syncthreads();
}


#if MK_TS_PHASE >= 16
#define BLD_TS(k) do { if (blockIdx.x == 0 && tid == 0) ((unsigned long long*)((unsigned*)(p.ws + WS_CTL) + CTL_TS))[k] = __builtin_amdgcn_s_memrealtime(); } while (0)
#else
#define BLD_TS(k) do { } while (0)
#endif
__device__ __forceinline__ void s5_build_tables(const Params& p, LAS unsigned char* lds, int g) {
  const int tid = opaque_tid();
  BLD_TS(16);
  LAS float* Bb = (LAS float*)lds;
  LAS float* Cc = Bb + 4096;
  LAS float* PW = Cc + 4096;
  LAS float* KK = PW + 4352;
  if (tid < 128) {
    const int d = tid >> 6, pi = tid & 63, dg = d * 32 + g, idx = dg * 64 + pi;
    const float are = p.in[I_SARE][idx], aim = p.in[I_SAIM][idx];
    const float dt = expf(p.in[I_SLDT][dg]);
    const float lam = are * dt, om = aim * dt;
    for (int n = 0; n <= 16; ++n) { const float ea = expf(lam * (float)n); float sn, cs; sincosf(om * (float)n, &sn, &cs);
      PW[((d * 17 + n) * 64 + pi) * 2] = ea * cs; PW[((d * 17 + n) * 64 + pi) * 2 + 1] = ea * sn; }
    const float abr = PW[((d * 17 + 1) * 64 + pi) * 2], abi = PW[((d * 17 + 1) * 64 + pi) * 2 + 1];
    const float den = are * are + aim * aim;
    const float nr = abr - 1.f, ni = abi;
    const float rr = (nr * are + ni * aim) / den, ri = (ni * are - nr * aim) / den;
    for (int c = 0; c < 16; ++c) {
      const float bre = p.in[I_SBRE][idx * 16 + c], bim = p.in[I_SBIM][idx * 16 + c];
      Bb[((d * 64 + pi) * 16 + c) * 2] = rr * bre - ri * bim; Bb[((d * 64 + pi) * 16 + c) * 2 + 1] = rr * bim + ri * bre;
      Cc[((d * 16 + c) * 64 + pi) * 2] = p.in[I_SCRE][(dg * 16 + c) * 64 + pi]; Cc[((d * 16 + c) * 64 + pi) * 2 + 1] = p.in[I_SCIM][(dg * 16 + c) * 64 + pi];
    }
  }
  __syncthreads();
  BLD_TS(17);
  {
    const int d = tid >> 8, tau = (tid >> 4) & 15, c = tid & 15;
    float s[16];
#pragma unroll
    for (int c2 = 0; c2 < 16; ++c2) s[c2] = 0.f;
    for (int pi = 0; pi < 64; ++pi) {
      const f32x2 cv = *(const LAS f32x2*)(Cc + ((d * 16 + c) * 64 + pi) * 2), av = *(const LAS f32x2*)(PW + ((d * 17 + tau) * 64 + pi) * 2);
      const float mr = cv.x * av.x - cv.y * av.y, mi = cv.x * av.y + cv.y * av.x;
      const LAS f32x4* bp = (const LAS f32x4*)(Bb + ((d * 64 + pi) * 16) * 2);
#pragma unroll
      for (int q = 0; q < 8; ++q) { const f32x4 b = bp[q]; s[2 * q] += mr * b.x - mi * b.y; s[2 * q + 1] += mr * b.z - mi * b.w; }
    }
#pragma unroll
    for (int c2 = 0; c2 < 16; ++c2) KK[((d * 16 + tau) * 16 + c) * 16 + c2] = s[c2];
  }
  __syncthreads();
  BLD_TS(18);
  bf16_t* T = (bf16_t*)(p.ws + WS_S5T) + (size_t)g * 256 * 512;
  for (int o = tid; o < 256 * 256; o += 512) {
    const int n = o >> 8, k = (o & 255) * 2, i = n >> 4, c = n & 15;
    float v[2];
#pragma unroll
    for (int q = 0; q < 2; ++q) { const int kk = k + q; float x;
      if (kk < 256) { const int j = kk >> 4, c2 = kk & 15; x = 0.f;
        if (i >= j) x += KK[((0 * 16 + (i - j)) * 16 + c) * 16 + c2];
        if (j >= i) x += KK[((1 * 16 + (j - i)) * 16 + c) * 16 + c2];
        if (i == j && c == c2) x += p.in[I_SD][g * 16 + c];
      } else { const int d = (kk - 256) >> 7, qq = (kk - 256) & 127, part = qq >> 6, pi = qq & 63, n_pw = d ? (16 - i) : (i + 1);
        const float cr = Cc[((d * 16 + c) * 64 + pi) * 2], ci = Cc[((d * 16 + c) * 64 + pi) * 2 + 1];
        const float ar = PW[((d * 17 + n_pw) * 64 + pi) * 2], ai = PW[((d * 17 + n_pw) * 64 + pi) * 2 + 1];
        x = part ? -(cr * ai + ci * ar) : (cr * ar - ci * ai); }
      v[q] = x; }
    *(unsigned*)(T + (size_t)n * 512 + k) = cvt_pk_bf16(v[0], v[1]);
  }
  BLD_TS(19);
  bf16_t* E = (bf16_t*)(p.ws + WS_S5E) + (size_t)g * 256 * 256;
  for (int o = tid; o < 256 * 128; o += 512) {
    const int n = o >> 7, k = (o & 127) * 2, d = n >> 7, part = (n >> 6) & 1, pi = n & 63;
    float v[2];
#pragma unroll
    for (int q = 0; q < 2; ++q) { const int kk = k + q, j = kk >> 4, c2 = kk & 15, n_pw = d ? j : (15 - j);
      const float ar = PW[((d * 17 + n_pw) * 64 + pi) * 2], ai = PW[((d * 17 + n_pw) * 64 + pi) * 2 + 1];
      const float br = Bb[((d * 64 + pi) * 16 + c2) * 2], bi = Bb[((d * 64 + pi) * 16 + c2) * 2 + 1];
      v[q] = part ? (ar * bi + ai * br) : (ar * br - ai * bi); }
    *(unsigned*)(E + (size_t)n * 256 + k) = cvt_pk_bf16(v[0], v[1]);
  }
  BLD_TS(20);
  __syncthreads();
}

struct SchedS5S {
  static constexpr bool GATHER = false, HAS_DONE = false, HALF = false;
  int G, c;
  __device__ __forceinline__ bool next(int i, pg::Unit& u) const {
    const int L = i * G + c; if (L >= 160) return false;
    u.aux = L / 5; u.pm = L % 5; u.pn = 0; u.arow = u.pm * 256; return true;
  }
};
struct EpiS5S {
  static constexpr bool PERM = false;
  float* S;
  __device__ __forceinline__ void operator()(const pg::Acc& acc, const pg::Unit& u, int wr, int wc, int fr, int fq) const {
    const int row0 = u.arow + wr * 64 + fr, col0 = wc * 32 + 4 * fq;
#pragma unroll
    for (int ai = 0; ai < 2; ++ai)
#pragma unroll
      for (int m = 0; m < 4; ++m) { const int r = row0 + ai * 128 + m * 16;
        if (r < NCHUNK) { float* rowp = S + ((size_t)u.aux * NCHUNK + r) * 256 + col0;
#pragma unroll
          for (int bj = 0; bj < 2; ++bj)
#pragma unroll
            for (int n = 0; n < 2; ++n) *(f32x4*)(rowp + bj * 128 + n * 16) = acc[ai][bj][m][n]; } }
  }
};
__device__ __forceinline__ void phase_s5s(const Params& p, LAS unsigned char* lds) {
  pg::Addr AD{(const bf16_t*)((unsigned char*)p.out + DO_YA), 512, (size_t)NCHUNK * 512, (const bf16_t*)(p.ws + WS_S5E), 256, (size_t)256 * 256, false};
  SchedS5S S{(int)gridDim.x, (int)blockIdx.x};
  EpiS5S E{(float*)(p.ws + WS_RH)};
  pg::gemm_phase(lds, AD, S, E);
}

__device__ __forceinline__ void s5_scan_item(const Params& p, int item, int lane) {
  const int d = item & 1, g = (item >> 1) & 31, b = item >> 6;
  const float* S = (const float*)(p.ws + WS_RH) + (size_t)g * NCHUNK * 256 + d * 128 + lane;
  bf16_t* YA = (bf16_t*)((unsigned char*)p.out + DO_YA) + (size_t)g * NCHUNK * 512 + 256 + d * 128 + lane;
  const int idx = (d * 32 + g) * 64 + lane;
  const float dt = expf(p.in[I_SLDT][d * 32 + g]);
  const float ea = expf(p.in[I_SARE][idx] * dt * 16.f); float sn, cs; sincosf(p.in[I_SAIM][idx] * dt * 16.f, &sn, &cs);
  const float ar = ea * cs, ai = ea * sn;
  float hr = 0.f, hi = 0.f;
  const int r0 = b * 528;
#pragma unroll 4
  for (int s = 0; s < 16; ++s) { const int r = r0 + 512 + (d ? 15 - s : s);
    const float sr = S[(size_t)r * 256], si = S[(size_t)r * 256 + 64];
    const float nr = ar * hr - ai * hi + sr, ni = ar * hi + ai * hr + si; hr = nr; hi = ni; }
  float sa[16], sb[16];
#define SCAN_LOAD(buf, s0) do { _Pragma("unroll") for (int q = 0; q < 8; ++q) { const int r = r0 + (d ? 511 - ((s0) + q) : (s0) + q); buf[2 * q] = S[(size_t)r * 256]; buf[2 * q + 1] = S[(size_t)r * 256 + 64]; } } while (0)
#define SCAN_STEP(buf, s0) do { _Pragma("unroll") for (int q = 0; q < 8; ++q) { const int r = r0 + (d ? 511 - ((s0) + q) : (s0) + q); \
    YA[(size_t)r * 512] = f2bf(hr); YA[(size_t)r * 512 + 64] = f2bf(hi); \
    const float nr = ar * hr - ai * hi + buf[2 * q], ni = ar * hi + ai * hr + buf[2 * q + 1]; hr = nr; hi = ni; } } while (0)
  SCAN_LOAD(sa, 0);
  for (int s = 0; s < 512; s += 16) {
    SCAN_LOAD(sb, s + 8);
    SCAN_STEP(sa, s);
    if (s + 16 < 512) SCAN_LOAD(sa, s + 16);
    SCAN_STEP(sb, s + 8);
  }
#undef SCAN_LOAD
#undef SCAN_STEP
}
__device__ __forceinline__ void phase_s5scan(const Params& p) {
  const int tid_ = opaque_tid(); const int lane = tid_ & 63, wave = tid_ >> 6;
  const int gw = blockIdx.x * NWAVES + wave;
  if (gw < 128) s5_scan_item(p, gw, lane);
}

struct SchedS5Y {
  static constexpr bool GATHER = false, HAS_DONE = false, HALF = false;
  int G, c;
  __device__ __forceinline__ bool next(int i, pg::Unit& u) const {
    const int L = i * G + (MK_S5_IN_P3 ? c : ((c + G / 2) % G)); if (L >= 128) return false;
    u.aux = L >> 2; u.pm = L & 3; u.pn = 0; u.arow = (u.pm >> 1) * 528 + (u.pm & 1) * 256; return true;
  }
};
struct EpiS5Y {
  static constexpr bool PERM = true;
  bf16_t* GY;
  __device__ __forceinline__ void operator()(const pg::Acc& acc, const pg::Unit& u, int wr, int wc, int fr, int fq) const {
    const int row0 = u.arow + wr * 64 + fr;
#pragma unroll
    for (int ai = 0; ai < 2; ++ai)
#pragma unroll
      for (int m = 0; m < 4; ++m) { const int chunk = row0 + ai * 128 + m * 16;
#pragma unroll
        for (int bj = 0; bj < 2; ++bj) { const int col = bj * 128 + wc * 32 + 8 * fq, ti = col >> 4, c0 = col & 15;
          float o[8];
#pragma unroll
          for (int n = 0; n < 2; ++n)
#pragma unroll
            for (int e = 0; e < 4; ++e) o[n * 4 + e] = gelu_tanh(acc[ai][bj][m][n][e]);
          u32x4 w; w.x = cvt_pk_bf16(o[0], o[1]); w.y = cvt_pk_bf16(o[2], o[3]); w.z = cvt_pk_bf16(o[4], o[5]); w.w = cvt_pk_bf16(o[6], o[7]);
          *(u32x4*)(GY + (size_t)(chunk * 16 + ti) * 512 + u.aux * 16 + c0) = w; } }
  }
};
__device__ __forceinline__ void phase_s5y(const Params& p, LAS unsigned char* lds) {
  pg::Addr AD{(const bf16_t*)((unsigned char*)p.out + DO_YA), 512, (size_t)NCHUNK * 512, (const bf16_t*)(p.ws + WS_S5T), 512, (size_t)256 * 512, false};
  SchedS5Y S{(int)gridDim.x, (int)blockIdx.x};
  EpiS5Y E{(bf16_t*)((unsigned char*)p.out + DO_GY)};
  pg::gemm_phase(lds, AD, S, E);
}
__device__ __forceinline__ void map_static(int L, int nM, int nN, int& pm, int& pn) {
  const int nwg = nM * nN; int wgid = L;
  { const int q = nwg / 8, r = nwg % 8, xcd = wgid % 8, off = wgid / 8; wgid = (xcd < r ? xcd * (q + 1) : r * (q + 1) + (xcd - r) * q) + off; }
  const int nig = 8 * nN, gid = wgid / nig, fm = gid * 8, gsz = (nM - fm) < 8 ? (nM - fm) : 8;
  pm = fm + ((wgid % nig) % gsz); pn = (wgid % nig) / gsz;
}

struct CvtItem { const float* src; bf16_t* dst; int ldw, ldd; };
__device__ __forceinline__ void cvt_load(const CvtItem& d, f32x4 (&r)[8], int lane) {
  const float* s = d.src + (size_t)(lane >> 3) * d.ldw + 4 * (lane & 7);
#pragma unroll
  for (int i = 0; i < 8; ++i) r[i] = __builtin_nontemporal_load((const f32x4*)(s + (size_t)(8 * i) * d.ldw));
}
__device__ __forceinline__ void cvt_store(const CvtItem& d, const f32x4 (&r)[8], LAS float* scr, int lane) {
  LAS float* w = scr + (lane >> 3) * 33 + 4 * (lane & 7);
#pragma unroll
  for (int i = 0; i < 8; ++i) { w[(8 * i) * 33 + 0] = r[i].x; w[(8 * i) * 33 + 1] = r[i].y; w[(8 * i) * 33 + 2] = r[i].z; w[(8 * i) * 33 + 3] = r[i].w; }
  asm volatile("s_waitcnt lgkmcnt(0)" ::: "memory");
  const int c = lane & 7;
#pragma unroll
  for (int j = 0; j < 4; ++j) { const int n = (lane >> 3) + 8 * j; const LAS float* s = scr + (8 * c) * 33 + n;
    u32x4 o; o.x = cvt_pk_bf16(s[0 * 33], s[1 * 33]); o.y = cvt_pk_bf16(s[2 * 33], s[3 * 33]); o.z = cvt_pk_bf16(s[4 * 33], s[5 * 33]); o.w = cvt_pk_bf16(s[6 * 33], s[7 * 33]);
    *(u32x4*)(d.dst + (size_t)n * d.ldd + 8 * c) = o; }
  asm volatile("s_waitcnt lgkmcnt(0)" ::: "memory");
}
__device__ __forceinline__ int ilv_row(int n, int second) { return (n >> 7) * 256 + (n & 127) + second * 128; }

constexpr int CV_WIN = (1024 / 64) * (4096 / 32);
constexpr int CV_GLU = (512 / 64) * (1024 / 32);
constexpr int CV_SQ = (1024 / 64) * (1024 / 32);
constexpr int CV_EGU = (1024 / 64) * (512 / 32);
constexpr int CV_ED = (512 / 64) * (1024 / 32);
constexpr int CV_SMALL = CV_WIN + 2 * CV_GLU + 2 * CV_SQ;
constexpr int CV_TOTAL = CV_SMALL + 32 * (2 * CV_EGU + CV_ED);

__device__ __forceinline__ void cvt_kn(int it, int nb, int& kb_, int& nb_) { const int grp = it >> 3, w = it & 7, gpr = nb >> 2; kb_ = 2 * (grp / gpr) + (w >> 2); nb_ = 4 * (grp % gpr) + (w & 3); }
__device__ __forceinline__ CvtItem cvt_desc(const Params& p, int it) {
  unsigned char* ws = p.ws;
  if (it < CV_WIN) { const int nb = 4096 / 32; int kb_, nb_; cvt_kn(it, nb, kb_, nb_); const int n0 = 32 * nb_, k0 = 64 * kb_;
    return CvtItem{p.in[I_WIN] + (size_t)k0 * 4096 + n0, (bf16_t*)(ws + WS_WIN) + (size_t)n0 * 1024 + k0, 4096, 1024}; }
  it -= CV_WIN;
  if (it < 2 * CV_GLU) { const int second = it / CV_GLU; it %= CV_GLU; const int nb = 1024 / 32; int kb_, nb_; cvt_kn(it, nb, kb_, nb_); const int n0 = 32 * nb_, k0 = 64 * kb_;
    return CvtItem{p.in[second ? I_WGB : I_WGA] + (size_t)k0 * 1024 + n0, (bf16_t*)(ws + WS_WGLU) + (size_t)ilv_row(n0, second) * 512 + k0, 1024, 512}; }
  it -= 2 * CV_GLU;
  if (it < 2 * CV_SQ) { const int second = it / CV_SQ; it %= CV_SQ; const int nb = 1024 / 32; int kb_, nb_; cvt_kn(it, nb, kb_, nb_); const int n0 = 32 * nb_, k0 = 64 * kb_;
    return CvtItem{p.in[second ? I_WOUT : I_WAO] + (size_t)k0 * 1024 + n0, (bf16_t*)(ws + (second ? WS_WOUT : WS_WAO)) + (size_t)n0 * 1024 + k0, 1024, 1024}; }
  it -= 2 * CV_SQ;
  const int per_e = 2 * CV_EGU + CV_ED, e = it / per_e; it %= per_e;
  if (it < 2 * CV_EGU) { const int second = it / CV_EGU; it %= CV_EGU; const int nb = 512 / 32; int kb_, nb_; cvt_kn(it, nb, kb_, nb_); const int n0 = 32 * nb_, k0 = 64 * kb_;
    return CvtItem{p.in[second ? I_WEU : I_WEG] + (size_t)e * 1024 * 512 + (size_t)k0 * 512 + n0, (bf16_t*)(ws + WS_WGU) + ((size_t)e * 1024 + ilv_row(n0, second)) * 1024 + k0, 512, 1024}; }
  it -= 2 * CV_EGU;
  { const int nb = 1024 / 32; int kb_, nb_; cvt_kn(it, nb, kb_, nb_); const int n0 = 32 * nb_, k0 = 64 * kb_;
    return CvtItem{p.in[I_WED] + (size_t)e * 512 * 1024 + (size_t)k0 * 1024 + n0, (bf16_t*)(ws + WS_WD) + ((size_t)e * 1024 + n0) * 512 + k0, 1024, 512}; }
}
template <bool SIGNAL_WIN> __device__ __forceinline__ void cvt_run(const Params& p, int lo, int CV_END, int gw, int NGW, LAS float* scr, int lane) {
  int it = lo + gw; if (it >= CV_END) return;
  CvtItem d = cvt_desc(p, it); f32x4 ra[8], rb[8];
  cvt_load(d, ra, lane);
  for (;;) {
    const int nit = it + NGW; const bool more = nit < CV_END; CvtItem dn = d;
    if (more) { dn = cvt_desc(p, nit); cvt_load(dn, rb, lane); }
    cvt_store(d, ra, scr, lane);
#if MK_CTX_IN_PRO
    if (SIGNAL_WIN && it < CV_WIN && nit >= CV_WIN) {
      asm volatile("s_waitcnt vmcnt(0)" ::: "memory"); __builtin_amdgcn_fence(__ATOMIC_RELEASE, "agent");
      if (lane == 0) __hip_atomic_fetch_add((unsigned*)(p.ws + WS_CTL) + CTL_WINCNT, 1u, __ATOMIC_RELAXED, __HIP_MEMORY_SCOPE_AGENT); }
#endif
    if (!more) break;
#pragma unroll
    for (int i = 0; i < 8; ++i) ra[i] = rb[i];
    d = dn; it = nit;
  }
}

__device__ __forceinline__ const float* ln_src_row(const Params& p, int pr) {
  const int b = pr / SKV, t = pr % SKV;
  return (t < SEQ) ? p.in[I_X] + ((size_t)b * SEQ + t) * DM : p.in[I_CTX] + ((size_t)b * NCTX + (t - SEQ)) * DM;
}
template <bool LAT> __device__ __forceinline__ void ln_batch_load_t(const Params& p, int r0, int NGW, f32x4 (&v)[4][4], int lane) {
#pragma unroll
  for (int r = 0; r < 4; ++r) { const int ri = r0 + r * NGW;
    if (ri < (LAT ? NLAT : NROW)) { const float* xr = LAT ? p.in[I_X] + (size_t)ri * DM : ln_src_row(p, ri);
#pragma unroll
      for (int j = 0; j < 4; ++j) v[r][j] = ((const f32x4*)xr)[lane + 64 * j]; } }
}
__device__ __forceinline__ void ln_batch_load(const Params& p, int pr0, int NGW, f32x4 (&v)[4][4], int lane) { ln_batch_load_t<false>(p, pr0, NGW, v, lane); }
__device__ __forceinline__ void ln_batch_load_lat(const Params& p, int lr0, int NGW, f32x4 (&v)[4][4], int lane) { ln_batch_load_t<true>(p, lr0, NGW, v, lane); }
template <bool LAT> __device__ __forceinline__ void ln_batch_run_t(const Params& p, int r0, int NGW, f32x4 (&v)[4][4], int lane) {
  const float* mod = (const float*)(p.ws + WS_MOD);
  bf16_t* H = (bf16_t*)(p.ws + WS_RH);
#pragma unroll
  for (int r = 0; r < 4; ++r) { const int ri = r0 + r * NGW; const int pr = LAT ? lat2pad(ri) : ri;
    if (ri < (LAT ? NLAT : NROW)) {
      const int b = pr / SKV, t = pr % SKV;
      const float* mrow = mod + ((t < SEQ) ? b : 2) * NMOD;
      f32x4 sh[4], sc[4];
#pragma unroll
      for (int j = 0; j < 4; ++j) { const int col = (lane + 64 * j) * 4; sh[j] = *(const f32x4*)(mrow + col); sc[j] = *(const f32x4*)(mrow + DM + col); }
      float s = 0;
#pragma unroll
      for (int j = 0; j < 4; ++j) s += (v[r][j].x + v[r][j].y) + (v[r][j].z + v[r][j].w);
      const float mean = wave_sum(s) * (1.f / DM); float s2 = 0;
#pragma unroll
      for (int j = 0; j < 4; ++j) { v[r][j] = v[r][j] - mean; s2 += (v[r][j].x * v[r][j].x + v[r][j].y * v[r][j].y) + (v[r][j].z * v[r][j].z + v[r][j].w * v[r][j].w); }
      const float rstd = rsqrtf(wave_sum(s2) * (1.f / DM) + LN_EPS);
#pragma unroll
      for (int j = 0; j < 4; ++j) {
        const int col = (lane + 64 * j) * 4;
        const f32x4 o = v[r][j] * rstd * (sc[j] + 1.f) + sh[j];
        u32x2 w; w.x = cvt_pk_bf16(o.x, o.y); w.y = cvt_pk_bf16(o.z, o.w);
        *(u32x2*)(H + (size_t)pr * DM + col) = w;
      }
    } }
}
__device__ __forceinline__ void ln_batch_run(const Params& p, int pr0, int NGW, f32x4 (&v)[4][4], int lane) { ln_batch_run_t<false>(p, pr0, NGW, v, lane); }
__device__ __forceinline__ void ln_batch_run_lat(const Params& p, int lr0, int NGW, f32x4 (&v)[4][4], int lane) { ln_batch_run_t<true>(p, lr0, NGW, v, lane); }
struct SchedIn {
  static constexpr bool GATHER = false, HAS_DONE = false, HALF = false;
  int G, c;
  __device__ __forceinline__ bool next(int i, pg::Unit& u) const {
    const int L = i * G + c; u.aux = 0;
    if (L < 1024) { int lm, pn; map_static(L, 64, 16, lm, pn); u.pm = lm + (lm >> 5); u.pn = pn; u.arow = u.pm * 256; return true; }
    if (((!MK_CTX_IN_P1 && !MK_CTX_IN_PRO) || G < 64) && L < 1032) { const int j = L - 1024; u.pm = (j < 4) ? 32 : 65; const int q = j & 3; u.pn = (q < 2) ? q : q + 4; u.arow = u.pm * 256; return true; }
    return false;
  }
};
struct EpiIn {
  static constexpr bool PERM = true;
  bf16_t* YA; bf16_t* P;
  __device__ __forceinline__ void operator()(const pg::Acc& acc, const pg::Unit& u, int wr, int wc, int fr, int fq) const {
    const int row0 = u.pm * 256 + wr * 64 + fr;
    if (u.pn < 2) {
#pragma unroll
      for (int ai = 0; ai < 2; ++ai)
#pragma unroll
        for (int m = 0; m < 4; ++m) { const int r = row0 + ai * 128 + m * 16, chunk = r >> 4, ti = r & 15;
#pragma unroll
          for (int bj = 0; bj < 2; ++bj) { const int ch = u.pn * 256 + bj * 128 + wc * 32 + 8 * fq, g = ch >> 4, off = ch & 15;
            const f32x4 v0 = acc[ai][bj][m][0], v1 = acc[ai][bj][m][1];
            u32x4 w; w.x = cvt_pk_bf16(v0[0], v0[1]); w.y = cvt_pk_bf16(v0[2], v0[3]); w.z = cvt_pk_bf16(v1[0], v1[1]); w.w = cvt_pk_bf16(v1[2], v1[3]);
            *(u32x4*)(YA + ((size_t)g * NCHUNK + chunk) * 512 + ti * 16 + off) = w; } }
    } else {
      const int colb = (u.pn - 2) * 256 + wc * 32 + 8 * fq; const bool sig = u.pn >= 8;
#pragma unroll
      for (int ai = 0; ai < 2; ++ai)
#pragma unroll
        for (int m = 0; m < 4; ++m) { bf16_t* rowp = P + (size_t)(row0 + ai * 128 + m * 16) * PLD + colb;
#pragma unroll
          for (int bj = 0; bj < 2; ++bj) { f32x4 v0 = acc[ai][bj][m][0], v1 = acc[ai][bj][m][1];
            if (sig) {
#pragma unroll
              for (int e = 0; e < 4; ++e) { v0[e] = __builtin_amdgcn_rcpf(1.f + __builtin_amdgcn_exp2f(-1.4426950408889634f * v0[e])); v1[e] = __builtin_amdgcn_rcpf(1.f + __builtin_amdgcn_exp2f(-1.4426950408889634f * v1[e])); } }
            u32x4 w; w.x = cvt_pk_bf16(v0[0], v0[1]); w.y = cvt_pk_bf16(v0[2], v0[3]); w.z = cvt_pk_bf16(v1[0], v1[1]); w.w = cvt_pk_bf16(v1[2], v1[3]);
            *(u32x4*)(rowp + bj * 128) = w; } }
    }
  }
};
__device__ __forceinline__ void phase2(const Params& p, LAS unsigned char* lds) {
  pg::Addr AD{(const bf16_t*)(p.ws + WS_RH), DM, 0, (const bf16_t*)(p.ws + WS_WIN), DM, 0, false};
  SchedIn S{(int)gridDim.x, (int)blockIdx.x};
  EpiIn E{(bf16_t*)((unsigned char*)p.out + DO_YA), (bf16_t*)(p.ws + WS_P)};
  pg::gemm_phase(lds, AD, S, E);
}

struct SchedOne {
  static constexpr bool GATHER = false, HAS_DONE = false, HALF = false;
  int pm, pn;
  __device__ __forceinline__ bool next(int i, pg::Unit& u) const { if (i > 0) return false; u.pm = pm; u.pn = pn; u.aux = 0; u.arow = pm * 256; return true; }
};
__device__ __forceinline__ void ctx_ln_and_unit(const Params& p, LAS unsigned char* lds, int c, int tid_) {
  const int lane = tid_ & 63, wave = tid_ >> 6;
  const int tile = c >> 2, pm = tile ? 65 : 32, quarter = c & 3;
  f32x4 va[4][4];
#pragma unroll 1
  for (int h = 0; h < 2; ++h) { const int pr0 = pm * 256 + quarter * 64 + wave * 8 + h * 4;
    ln_batch_load(p, pr0, 1, va, lane); ln_batch_run(p, pr0, 1, va, lane); }
  unsigned* ctr = (unsigned*)(p.ws + WS_CTL) + CTL_CTXCNT + tile * 64;
  asm volatile("s_waitcnt vmcnt(0)" ::: "memory");
  __syncthreads();
  if (tid_ == 0) { __threadfence(); __hip_atomic_fetch_add(ctr, 1u, __ATOMIC_RELEASE, __HIP_MEMORY_SCOPE_AGENT);
    unsigned spins = 0; while (__hip_atomic_load(ctr, __ATOMIC_ACQUIRE, __HIP_MEMORY_SCOPE_AGENT) < 4u && ++spins < (1u << 22)) __builtin_amdgcn_s_sleep(4);
    __threadfence(); }
  __syncthreads();
  __builtin_amdgcn_fence(__ATOMIC_ACQUIRE, "agent");
  pg::Addr AD{(const bf16_t*)(p.ws + WS_RH), DM, 0, (const bf16_t*)(p.ws + WS_WIN), DM, 0, false};
  SchedOne S{pm, (quarter < 2) ? quarter : quarter + 4};
  EpiIn E{(bf16_t*)((unsigned char*)p.out + DO_YA), (bf16_t*)(p.ws + WS_P)};
  pg::gemm_phase(lds, AD, S, E);
}
__device__ __forceinline__ void phase0(const Params& p, LAS unsigned char* lds) {
  const int tid = opaque_tid(), lane = tid & 63, wave = tid >> 6, c = blockIdx.x, G = gridDim.x;
  {
    LAS float* sv = (LAS float*)lds;
    LAS float* red = sv + 3 * DM;
    for (int i = tid; i < DM; i += 512) { sv[i] = siluf_(p.in[I_C][i]); sv[DM + i] = siluf_(p.in[I_C][DM + i]); sv[2 * DM + i] = siluf_(p.in[I_CCTX][i]); }
    __syncthreads();
    for (int cg = c; cg < NMOD / 24; cg += G) {
      const int c4 = tid % 6, rs = tid / 6;
      if (rs < 85) {
        const float* w = p.in[I_WMOD] + cg * 24 + 4 * c4;
        f32x4 wv[13];
#pragma unroll
        for (int q = 0; q < 13; ++q) { const int k = rs + 85 * q; wv[q] = (k < DM) ? *(const f32x4*)(w + (size_t)k * NMOD) : (f32x4){0.f, 0.f, 0.f, 0.f}; }
        f32x4 a0 = {0.f, 0.f, 0.f, 0.f}, a1 = a0, a2 = a0;
#pragma unroll
        for (int q = 0; q < 13; ++q) { const int k = rs + 85 * q; if (k < DM) { a0 += wv[q] * sv[k]; a1 += wv[q] * sv[DM + k]; a2 += wv[q] * sv[2 * DM + k]; } }
#pragma unroll
        for (int e = 0; e < 4; ++e) { red[(rs * 24 + 4 * c4 + e) * 3 + 0] = a0[e]; red[(rs * 24 + 4 * c4 + e) * 3 + 1] = a1[e]; red[(rs * 24 + 4 * c4 + e) * 3 + 2] = a2[e]; }
      }
      __syncthreads();
      if (tid < 72) { const int cc = tid / 3, r = tid % 3; float s = 0.f;
        for (int q = 0; q < 85; ++q) s += red[(q * 24 + cc) * 3 + r];
        ((float*)(p.ws + WS_MOD))[r * NMOD + cg * 24 + cc] = s + p.in[I_BMOD][cg * 24 + cc]; }
      __syncthreads();
    }
#if MK_CTX_IN_PRO || MK_LN_IN_PRO
    asm volatile("s_waitcnt vmcnt(0)" ::: "memory"); __syncthreads();
    if (tid == 0) { __threadfence(); __hip_atomic_fetch_add((unsigned*)(p.ws + WS_CTL) + CTL_MODCNT, 1u, __ATOMIC_RELEASE, __HIP_MEMORY_SCOPE_AGENT); }
#endif
  }
  const int nb = (G >= 64) ? 32 : 0;
  for (int g = c; g < 32; g += G) s5_build_tables(p, lds, g);
#if MK_CTX_IN_PRO
  if (G >= 64 && c < NCTXB) {
    if (tid == 0) { unsigned spins = 0;
      while (__hip_atomic_load((unsigned*)(p.ws + WS_CTL) + CTL_MODCNT, __ATOMIC_ACQUIRE, __HIP_MEMORY_SCOPE_AGENT) < (unsigned)G && ++spins < (1u << 22)) __builtin_amdgcn_s_sleep(4);
      while (__hip_atomic_load((unsigned*)(p.ws + WS_CTL) + CTL_WINCNT, __ATOMIC_ACQUIRE, __HIP_MEMORY_SCOPE_AGENT) < (unsigned)((G - nb) * NWAVES) && ++spins < (1u << 22)) __builtin_amdgcn_s_sleep(4);
      __threadfence(); }
    __syncthreads();
    __builtin_amdgcn_fence(__ATOMIC_ACQUIRE, "agent");
    ctx_ln_and_unit(p, lds, c, tid);
    return;
  }
#endif
  {
    LAS float* scr = (LAS float*)(lds + 8192) + wave * (64 * 33);
    const int N1 = (nb > 0) ? ((CV_TOTAL * MK_N1_NUM) / MK_N1_DEN) & ~7 : 0;
    if (c >= nb) cvt_run<true>(p, 0, N1, (c - nb) * NWAVES + wave, (G - nb) * NWAVES, scr, lane);
    { const int skip = (MK_CTX_IN_PRO && G >= 64) ? NCTXB : 0;
      cvt_run<false>(p, N1, CV_TOTAL, (c - skip) * NWAVES + wave, (G - skip) * NWAVES, scr, lane); }
  }
}

__device__ __forceinline__ void phase1(const Params& p, LAS unsigned char* lds) {
  const int tid_ = opaque_tid(); const int lane = tid_ & 63, wave = tid_ >> 6;
  const int c = blockIdx.x, G = gridDim.x;
  if (MK_CTX_IN_P1 && G > 2 * NCTXB && c < NCTXB) { ctx_ln_and_unit(p, lds, c, tid_); return; }
  if (!MK_CTX_IN_P1 && !MK_CTX_IN_PRO) {
    const int gwa = c * NWAVES + wave, NGWa = G * NWAVES;
    f32x4 va[4][4], vb[4][4];
    ln_batch_load(p, gwa, NGWa, va, lane);
    for (int pr0 = gwa; pr0 < NROW; pr0 += 8 * NGWa) {
      ln_batch_load(p, pr0 + 4 * NGWa, NGWa, vb, lane);
      ln_batch_run(p, pr0, NGWa, va, lane);
      ln_batch_load(p, pr0 + 8 * NGWa, NGWa, va, lane);
      ln_batch_run(p, pr0 + 4 * NGWa, NGWa, vb, lane);
    }
    return;
  }
  const int nb = (MK_CTX_IN_P1 && G > 2 * NCTXB) ? NCTXB : 0;
  const int gw = (c - nb) * NWAVES + wave, NGW = (G - nb) * NWAVES;
  f32x4 va[4][4], vb[4][4];
  ln_batch_load_lat(p, gw, NGW, va, lane);
  for (int lr0 = gw; lr0 < NLAT; lr0 += 8 * NGW) {
    ln_batch_load_lat(p, lr0 + 4 * NGW, NGW, vb, lane);
    ln_batch_run_lat(p, lr0, NGW, va, lane);
    ln_batch_load_lat(p, lr0 + 8 * NGW, NGW, va, lane);
    ln_batch_run_lat(p, lr0 + 4 * NGW, NGW, vb, lane);
  }
  if (nb == 0) {
    for (int pr0 = gw; pr0 < NROW; pr0 += 4 * NGW) {   }
  }
}

__device__ __forceinline__ void phase_qknorm(const Params& p) {
  const bf16_t* P = (const bf16_t*)(p.ws + WS_P); bf16_t* KC = (bf16_t*)(p.ws + WS_KC); bf16_t* VC = (bf16_t*)(p.ws + WS_VC);
  const int tid_ = opaque_tid(); const int lane = tid_ & 63, wave = tid_ >> 6;
  const int gw = blockIdx.x * NWAVES + wave, NGW = gridDim.x * NWAVES;
  const int sub = lane & 15, grp = lane >> 4, e0 = sub * 8, axis = sub >> 3; const bool hi_half = (sub & 4) != 0;
  float inv[8], gk[8];
#pragma unroll
  for (int j = 0; j < 8; ++j) { const int f = (e0 + j) & 31; inv[j] = exp2f(-(float)(2 * f) * (13.287712379549449f / 64.f)); gk[j] = p.in[I_KG][e0 + j]; }
  for (int pr = gw; pr < NROW; pr += NGW) {
    const int b = pr / SKV, t = pr % SKV; const bool isctx = t >= SEQ;
    const u32x4 w = *(const u32x4*)(P + (size_t)pr * PLD + PC_K + lane * 8);
    bf16_t* dst = (grp < 2 ? KC : VC) + ((size_t)(b * 2 + (grp & 1)) * SKV + t) * 128 + e0;
    if (grp >= 2) { *(u32x4*)dst = w; }
    float x[8] = {__uint_as_float(w.x << 16), __uint_as_float(w.x & 0xffff0000u), __uint_as_float(w.y << 16), __uint_as_float(w.y & 0xffff0000u),
                  __uint_as_float(w.z << 16), __uint_as_float(w.z & 0xffff0000u), __uint_as_float(w.w << 16), __uint_as_float(w.w & 0xffff0000u)};
    float ss = 0.f;
#pragma unroll
    for (int j = 0; j < 8; ++j) ss += x[j] * x[j];
    ss = row16_sum(ss);
    const float r = rsqrtf(ss * (1.f / 128.f) + LN_EPS);
    const float posf = (axis == 0) ? (float)(t >> 6) : (float)(t & 63);
    float o[8];
#pragma unroll
    for (int j = 0; j < 8; ++j) { x[j] = x[j] * r * gk[j];
      const float y = lane_xor4(x[j]);
      float sn = 0.f, cs = 1.f; if (!isctx) sincosf(posf * inv[j], &sn, &cs);
      o[j] = hi_half ? (y * sn + x[j] * cs) : (x[j] * cs - y * sn); }
    if (grp < 2) { u32x4 ow; ow.x = cvt_pk_bf16(o[0], o[1]); ow.y = cvt_pk_bf16(o[2], o[3]); ow.z = cvt_pk_bf16(o[4], o[5]); ow.w = cvt_pk_bf16(o[6], o[7]); *(u32x4*)dst = ow; }
  }
}
struct SchedLat {
  static constexpr bool GATHER = false, HAS_DONE = false, HALF = false;
  int G, c, nN;
  __device__ __forceinline__ bool next(int i, pg::Unit& u) const {
    const int L = i * G + c; u.aux = 0;
    if (L >= 64 * nN) return false;
    int lm, pn; map_static(L, 64, nN, lm, pn); u.pm = lm + (lm >> 5); u.pn = pn; u.arow = u.pm * 256; return true;
  }
};
struct EpiGlu {
  static constexpr bool PERM = true;
  const bf16_t* P; bf16_t* Z;
  __device__ __forceinline__ void operator()(const pg::Acc& acc, const pg::Unit& u, int wr, int wc, int fr, int fq) const {
    const int row0 = u.pm * 256 + wr * 64 + fr, ch = u.pn * 128 + wc * 32 + 8 * fq;
    u32x4 gwv[2][4];
#pragma unroll
    for (int ai = 0; ai < 2; ++ai)
#pragma unroll
      for (int m = 0; m < 4; ++m) gwv[ai][m] = *(const u32x4*)(P + (size_t)(row0 + ai * 128 + m * 16) * PLD + PC_G + ch);
#pragma unroll
    for (int ai = 0; ai < 2; ++ai)
#pragma unroll
      for (int m = 0; m < 4; ++m) { const int r = row0 + ai * 128 + m * 16;
        const u32x4 gw = gwv[ai][m];
        float gt[8] = {__uint_as_float(gw.x << 16), __uint_as_float(gw.x & 0xffff0000u), __uint_as_float(gw.y << 16), __uint_as_float(gw.y & 0xffff0000u),
                       __uint_as_float(gw.z << 16), __uint_as_float(gw.z & 0xffff0000u), __uint_as_float(gw.w << 16), __uint_as_float(gw.w & 0xffff0000u)};
        float o[8];
#pragma unroll
        for (int n = 0; n < 2; ++n)
#pragma unroll
          for (int e = 0; e < 4; ++e) { const float a_ = acc[ai][0][m][n][e], b_ = acc[ai][1][m][n][e];
            o[n * 4 + e] = gt[n * 4 + e] * a_ * __builtin_amdgcn_rcpf(1.f + __builtin_amdgcn_exp2f(-1.4426950408889634f * b_)); }
        u32x4 w; w.x = cvt_pk_bf16(o[0], o[1]); w.y = cvt_pk_bf16(o[2], o[3]); w.z = cvt_pk_bf16(o[4], o[5]); w.w = cvt_pk_bf16(o[6], o[7]);
        *(u32x4*)(Z + (size_t)r * DM + ch) = w; }
  }
};
struct EpiMix {
  static constexpr bool PERM = true;
  const bf16_t* P; bf16_t* Z;
  __device__ __forceinline__ void operator()(const pg::Acc& acc, const pg::Unit& u, int wr, int wc, int fr, int fq) const {
    const int row0 = u.pm * 256 + wr * 64 + fr, col0 = u.pn * 256 + wc * 32 + 8 * fq;
#pragma unroll
    for (int ai = 0; ai < 2; ++ai) {
      u32x4 gwv[4][2], zwv[4][2];
#pragma unroll
      for (int m = 0; m < 4; ++m)
#pragma unroll
        for (int bj = 0; bj < 2; ++bj) { const int r = row0 + ai * 128 + m * 16, cc = col0 + bj * 128;
          gwv[m][bj] = *(const u32x4*)(P + (size_t)r * PLD + PC_G + 1024 + cc); zwv[m][bj] = *(const u32x4*)(Z + (size_t)r * DM + cc); }
#pragma unroll
      for (int m = 0; m < 4; ++m)
#pragma unroll
        for (int bj = 0; bj < 2; ++bj) { const int r = row0 + ai * 128 + m * 16, cc = col0 + bj * 128;
          const u32x4 gw = gwv[m][bj], zw = zwv[m][bj];
          const unsigned gq[4] = {gw.x, gw.y, gw.z, gw.w}, zq[4] = {zw.x, zw.y, zw.z, zw.w};
          unsigned ow[4];
#pragma unroll
          for (int q = 0; q < 4; ++q) { const float a0 = acc[ai][bj][m][q >> 1][(q & 1) * 2], a1 = acc[ai][bj][m][q >> 1][(q & 1) * 2 + 1];
            ow[q] = cvt_pk_bf16(__uint_as_float(zq[q] << 16) + __uint_as_float(gq[q] << 16) * a0, __uint_as_float(zq[q] & 0xffff0000u) + __uint_as_float(gq[q] & 0xffff0000u) * a1); }
          *(u32x4*)(Z + (size_t)r * DM + cc) = (u32x4){ow[0], ow[1], ow[2], ow[3]}; }
    }
  }
};
#if MK_RB_BF16
struct EpiOut {
  static constexpr bool PERM = true;
  const float* X; const float* mod; float* R1;
  __device__ __forceinline__ void operator()(const pg::Acc& acc, const pg::Unit& u, int wr, int wc, int fr, int fq) const {
    const int b = u.pm / 33, lrow0 = (u.pm - b) * 256 + wr * 64 + fr, colb = u.pn * 256 + wc * 32 + 8 * fq;
    const float* g1 = mod + b * NMOD + 2 * DM;
    bf16_t* RB = (bf16_t*)R1;
    f32x4 gv[2][2];
#pragma unroll
    for (int bj = 0; bj < 2; ++bj)
#pragma unroll
      for (int n = 0; n < 2; ++n) gv[bj][n] = *(const f32x4*)(g1 + colb + bj * 128 + 4 * n);
#pragma unroll
    for (int ai = 0; ai < 2; ++ai)
#pragma unroll
      for (int m = 0; m < 4; ++m) { bf16_t* rowp = RB + (size_t)(lrow0 + ai * 128 + m * 16) * DM + colb;
#pragma unroll
        for (int bj = 0; bj < 2; ++bj) { const f32x4 v0 = acc[ai][bj][m][0] * gv[bj][0], v1 = acc[ai][bj][m][1] * gv[bj][1];
          u32x4 w; w.x = cvt_pk_bf16(v0[0], v0[1]); w.y = cvt_pk_bf16(v0[2], v0[3]); w.z = cvt_pk_bf16(v1[0], v1[1]); w.w = cvt_pk_bf16(v1[2], v1[3]);
          *(u32x4*)(rowp + bj * 128) = w; } }
  }
};
#else
struct EpiOut {
  static constexpr bool PERM = false;
  const float* X; const float* mod; float* R1;
  __device__ __forceinline__ void operator()(const pg::Acc& acc, const pg::Unit& u, int wr, int wc, int fr, int fq) const {
    const int b = u.pm / 33, lrow0 = (u.pm - b) * 256 + wr * 64 + fr, col0 = u.pn * 256 + wc * 32 + 4 * fq;
    const float* g1 = mod + b * NMOD + 2 * DM;
    f32x4 gv[2][2];
#pragma unroll
    for (int bj = 0; bj < 2; ++bj)
#pragma unroll
      for (int n = 0; n < 2; ++n) gv[bj][n] = *(const f32x4*)(g1 + col0 + bj * 128 + n * 16);
#pragma unroll
    for (int ai = 0; ai < 2; ++ai) {
      f32x4 xv[4][2][2];
#pragma unroll
      for (int m = 0; m < 4; ++m) { const size_t off = (size_t)(lrow0 + ai * 128 + m * 16) * DM + col0;
#pragma unroll
        for (int bj = 0; bj < 2; ++bj)
#pragma unroll
          for (int n = 0; n < 2; ++n) xv[m][bj][n] = *(const f32x4*)(X + off + bj * 128 + n * 16); }
#pragma unroll
      for (int m = 0; m < 4; ++m) { const size_t off = (size_t)(lrow0 + ai * 128 + m * 16) * DM + col0;
#pragma unroll
        for (int bj = 0; bj < 2; ++bj)
#pragma unroll
          for (int n = 0; n < 2; ++n) *(f32x4*)(R1 + off + bj * 128 + n * 16) = xv[m][bj][n] * ALPHA + gv[bj][n] * acc[ai][bj][m][n]; }
    }
  }
};
#endif
__device__ __forceinline__ void phase_g1(const Params& p, LAS unsigned char* lds) {
  pg::Addr AD{(const bf16_t*)((unsigned char*)p.out + DO_GY), 512, 0, (const bf16_t*)(p.ws + WS_WGLU), 512, 0, false};
  SchedLat S{(int)gridDim.x, (int)blockIdx.x, 8};
  EpiGlu E{(const bf16_t*)(p.ws + WS_P), (bf16_t*)(p.ws + WS_RH)};
  pg::gemm_phase(lds, AD, S, E);
}
__device__ __forceinline__ void phase_g2(const Params& p, LAS unsigned char* lds) {
  pg::Addr AD{(const bf16_t*)(p.ws + WS_P) + PC_Q, PLD, 0, (const bf16_t*)(p.ws + WS_WAO), DM, 0, false};
  SchedLat S{(int)gridDim.x, (int)blockIdx.x, 4};
  EpiMix E{(const bf16_t*)(p.ws + WS_P), (bf16_t*)(p.ws + WS_RH)};
  pg::gemm_phase(lds, AD, S, E);
}
__device__ __forceinline__ void phase_g3(const Params& p, LAS unsigned char* lds) {
  pg::Addr AD{(const bf16_t*)(p.ws + WS_RH), DM, 0, (const bf16_t*)(p.ws + WS_WOUT), DM, 0, false};
  SchedLat S{(int)gridDim.x, (int)blockIdx.x, 4};
  EpiOut E{p.in[I_X], (const float*)(p.ws + WS_MOD), p.out};
  pg::gemm_phase(lds, AD, S, E);
}

constexpr size_t RT_EW = 0, RT_LIST = 256 * 1024;
constexpr int CTL_CNT = 8192, CNT_STRIDE = 64;
constexpr int ACT_TILES_MAX = 160;
constexpr size_t PR_ACT = 66 * MiB;

struct MoeTab { const LAS int* tb; const LAS int* cn; };
__device__ __forceinline__ MoeTab moe_tables(const Params& p, LAS unsigned char* lds) {
  LAS int* tb = (LAS int*)(lds + LDS_STAGE); LAS int* cn = tb + 64;
  const unsigned* cnt = (const unsigned*)(p.ws + WS_CTL) + CTL_CNT;
  if (opaque_tid() == 0) { int acc = 0; for (int e = 0; e < 32; ++e) { const int c = (int)cnt[e * CNT_STRIDE]; cn[e] = c; tb[e] = acc; acc += (c + 255) >> 8; } tb[32] = acc; }
  __syncthreads();
  return MoeTab{tb, cn};
}
struct SchedMoe {
  static constexpr bool GATHER_ = true;
  int G, c, nN; MoeTab tab; const int* lists;
  __device__ __forceinline__ bool next_(int i, pg::Unit& u) const {
    if ((G & 7) != 0) {
      const int L = i * G + c, T = L / nN;
      if (T >= tab.tb[32]) return false;
      int e = 0;
#pragma unroll 1
      for (int q = 1; q < 32; ++q) e = (tab.tb[q] <= T) ? q : e;
      u.pm = T; u.pn = L % nN; u.aux = e; u.arow = T * 256; return true;
    }
    const int x = c & 7, j = c >> 3, nper = G >> 3;
    int idx = j + nper * i;
#pragma unroll 1
    for (int k = 0; k < 4; ++k) { const int e = x + 8 * k, n_e = (tab.tb[e + 1] - tab.tb[e]) * nN;
      if (idx < n_e) { const int T = tab.tb[e] + idx / nN; u.pm = T; u.pn = idx % nN; u.aux = e; u.arow = T * 256; return true; }
      idx -= n_e; }
    return false;
  }
  __device__ __forceinline__ int arow_(const pg::Unit& u, int r) const {
    const int slot = (u.pm - tab.tb[u.aux]) * 256 + r;
    if (slot >= tab.cn[u.aux]) return 0;
    return lat2pad(lists[u.aux * NLAT + slot] >> 1);
  }
};
constexpr int NEARLY = 48;
constexpr int CTL_TILECNT = 10496;
struct SchedMoeUp : SchedMoe { static constexpr bool GATHER = true, HAS_DONE = true, HALF = false;
  unsigned* tilecnt; bool early;
  __device__ __forceinline__ bool next(int i, pg::Unit& u) const { return next_(i, u); }
  __device__ __forceinline__ int arow(const pg::Unit& u, int r) const { return arow_(u, r); }
  __device__ __forceinline__ void done(const pg::Unit& u, int lane) const {
    if (early && u.pm < NEARLY) { asm volatile("s_waitcnt vmcnt(0)" ::: "memory"); __builtin_amdgcn_fence(__ATOMIC_RELEASE, "agent"); asm volatile("s_waitcnt vmcnt(0)" ::: "memory");
      if (lane == 0) __hip_atomic_fetch_add(tilecnt + 64 * u.pm, 1u, __ATOMIC_RELAXED, __HIP_MEMORY_SCOPE_AGENT); } } };
struct SchedMoeDown : SchedMoe { static constexpr bool GATHER = false, HAS_DONE = false, HALF = false;
  int t_first;
  __device__ __forceinline__ bool next(int i, pg::Unit& u) const {
    if (t_first == 0) return next_(i, u);
    const int L = i * G + c, T = t_first + L / nN;
    if (T >= tab.tb[32]) return false;
    int e = 0;
#pragma unroll 1
    for (int q = 1; q < 32; ++q) e = (tab.tb[q] <= T) ? q : e;
    u.pm = T; u.pn = L % nN; u.aux = e; u.arow = T * 256; return true; } };
struct SchedMoeDownOne : SchedMoe { static constexpr bool GATHER = false, HAS_DONE = false, HALF = false;
  int T, pn;
  __device__ __forceinline__ bool next(int i, pg::Unit& u) const {
    if (i > 0) return false;
    int e = 0;
#pragma unroll 1
    for (int q = 1; q < 32; ++q) e = (tab.tb[q] <= T) ? q : e;
    u.pm = T; u.pn = pn; u.aux = e; u.arow = T * 256; return true; } };
struct EpiGU {
  static constexpr bool PERM = true;
  bf16_t* ACT;
  __device__ __forceinline__ void operator()(const pg::Acc& acc, const pg::Unit& u, int wr, int wc, int fr, int fq) const {
    const int row0 = u.pm * 256 + wr * 64 + fr, ch = u.pn * 128 + wc * 32 + 8 * fq;
#pragma unroll
    for (int ai = 0; ai < 2; ++ai)
#pragma unroll
      for (int m = 0; m < 4; ++m) { const int r = row0 + ai * 128 + m * 16;
        float o[8];
#pragma unroll
        for (int n = 0; n < 2; ++n)
#pragma unroll
          for (int e = 0; e < 4; ++e) { const float a = acc[ai][0][m][n][e], b = acc[ai][1][m][n][e];
            o[n * 4 + e] = a * b * __builtin_amdgcn_rcpf(1.f + __builtin_amdgcn_exp2f(-1.4426950408889634f * a)); }
        u32x4 w; w.x = cvt_pk_bf16(o[0], o[1]); w.y = cvt_pk_bf16(o[2], o[3]); w.z = cvt_pk_bf16(o[4], o[5]); w.w = cvt_pk_bf16(o[6], o[7]);
        *(u32x4*)(ACT + (size_t)r * 512 + ch) = w; }
  }
};
struct EpiDown {
  static constexpr bool PERM = true;
  bf16_t* Y2; const int* lists; const float* ew; MoeTab tab;
  __device__ __forceinline__ void operator()(const pg::Acc& acc, const pg::Unit& u, int wr, int wc, int fr, int fq) const {
    const int slot0 = (u.pm - tab.tb[u.aux]) * 256 + wr * 64 + fr, n_e = tab.cn[u.aux], col0 = u.pn * 256 + wc * 32 + 8 * fq;
    int ids[2][4]; float wts[2][4];
#pragma unroll
    for (int ai = 0; ai < 2; ++ai)
#pragma unroll
      for (int m = 0; m < 4; ++m) { const int slot = slot0 + ai * 128 + m * 16; ids[ai][m] = (slot < n_e) ? lists[u.aux * NLAT + slot] : -1; }
#pragma unroll
    for (int ai = 0; ai < 2; ++ai)
#pragma unroll
      for (int m = 0; m < 4; ++m) wts[ai][m] = (ids[ai][m] >= 0) ? ew[ids[ai][m]] : 0.f;
#pragma unroll
    for (int ai = 0; ai < 2; ++ai)
#pragma unroll
      for (int m = 0; m < 4; ++m) {
        if (ids[ai][m] >= 0) { const int id = ids[ai][m]; const float w = wts[ai][m];
#pragma unroll
          for (int bj = 0; bj < 2; ++bj) { const f32x4 v0 = acc[ai][bj][m][0] * w, v1 = acc[ai][bj][m][1] * w;
            u32x4 o; o.x = cvt_pk_bf16(v0[0], v0[1]); o.y = cvt_pk_bf16(v0[2], v0[3]); o.z = cvt_pk_bf16(v1[0], v1[1]); o.w = cvt_pk_bf16(v1[2], v1[3]);
            *(u32x4*)(Y2 + (size_t)id * DM + col0 + bj * 128) = o; } } }
  }
};
__device__ __forceinline__ void phase_moe_up(const Params& p, LAS unsigned char* lds) {
  const MoeTab tab = moe_tables(p, lds);
  const bool early = (MK_EARLY_DOWN != 0) && gridDim.x == 256;
  unsigned* tilecnt = (unsigned*)(p.ws + WS_CTL) + CTL_TILECNT;
  {
    pg::Addr AD{(const bf16_t*)(p.ws + WS_RH), DM, 0, (const bf16_t*)(p.ws + WS_WGU), DM, (size_t)1024 * 1024, true};
    SchedMoeUp S; S.G = gridDim.x; S.c = blockIdx.x; S.nN = 4; S.tab = tab; S.lists = (const int*)(p.ws + WS_ROUTE + RT_LIST); S.tilecnt = tilecnt; S.early = early;
    EpiGU E{(bf16_t*)(p.ws + WS_P + PR_ACT)};
    pg::gemm_phase(lds, AD, S, E);
  }
  if (early && blockIdx.x >= 64) {
    const int Le = blockIdx.x - 64, T = Le >> 2, pn = Le & 3;
    if (opaque_tid() == 0) { unsigned spins = 0;
      while (__hip_atomic_load(tilecnt + 64 * T, __ATOMIC_RELAXED, __HIP_MEMORY_SCOPE_AGENT) < 32u && ++spins < (1u << 22)) __builtin_amdgcn_s_sleep(4); }
    __syncthreads();
    __builtin_amdgcn_fence(__ATOMIC_ACQUIRE, "agent");
    asm volatile("s_waitcnt vmcnt(0)" ::: "memory");
    pg::Addr AD{(const bf16_t*)(p.ws + WS_P + PR_ACT), 512, 0, (const bf16_t*)(p.ws + WS_WD), 512, (size_t)1024 * 512, false};
    SchedMoeDownOne S; S.G = gridDim.x; S.c = blockIdx.x; S.nN = 4; S.tab = tab; S.lists = (const int*)(p.ws + WS_ROUTE + RT_LIST); S.T = T; S.pn = pn;
    EpiDown E{(bf16_t*)(p.ws + WS_P), (const int*)(p.ws + WS_ROUTE + RT_LIST), (const float*)(p.ws + WS_ROUTE + RT_EW), tab};
    pg::gemm_phase(lds, AD, S, E);
  }
}
__device__ __forceinline__ void phase_moe_down(const Params& p, LAS unsigned char* lds) {
  const MoeTab tab = moe_tables(p, lds);
  const bool early = (MK_EARLY_DOWN != 0) && gridDim.x == 256;
  pg::Addr AD{(const bf16_t*)(p.ws + WS_P + PR_ACT), 512, 0, (const bf16_t*)(p.ws + WS_WD), 512, (size_t)1024 * 512, false};
  SchedMoeDown S; S.G = gridDim.x; S.c = blockIdx.x; S.nN = 4; S.tab = tab; S.lists = (const int*)(p.ws + WS_ROUTE + RT_LIST); S.t_first = early ? NEARLY : 0;
  EpiDown E{(bf16_t*)(p.ws + WS_P), (const int*)(p.ws + WS_ROUTE + RT_LIST), (const float*)(p.ws + WS_ROUTE + RT_EW), tab};
  pg::gemm_phase(lds, AD, S, E);
}

__device__ __forceinline__ void phase_final(const Params& p) {
  const float* mod = (const float*)(p.ws + WS_MOD);
  const bf16_t* Y2 = (const bf16_t*)(p.ws + WS_P);
  const bf16_t* X1b = (const bf16_t*)(p.ws + WS_X1B); float* OUT = p.out;
  const int tid_ = opaque_tid(); const int lane = tid_ & 63, wave = tid_ >> 6;
  const int gw = blockIdx.x * NWAVES + wave, NGW = gridDim.x * NWAVES;
  u32x2 x1[4], x1n[4]; u32x2 ya[4], yb[4], yan[4], ybn[4];
#define FIN_LOAD(row, X, A, B) do { _Pragma("unroll") for (int j = 0; j < 4; ++j) { const int col = (lane + 64 * j) * 4; \
    X[j] = *(const u32x2*)(X1b + (size_t)(row) * DM + col); A[j] = *(const u32x2*)(Y2 + (size_t)(2 * (row)) * DM + col); B[j] = *(const u32x2*)(Y2 + (size_t)(2 * (row) + 1) * DM + col); } } while (0)
  if (gw < NLAT) FIN_LOAD(gw, x1, ya, yb);
  for (int row = gw; row < NLAT; row += NGW) {
    const int rown = row + NGW;
    if (rown < NLAT) FIN_LOAD(rown, x1n, yan, ybn);
    const float* mrow = mod + (row / SEQ) * NMOD;
    float probe_scale = 1.f;
#if MK_TS_PHASE >= 0
    if (row < 164) { const unsigned long long* ts = (const unsigned long long*)((const unsigned*)(p.ws + WS_CTL) + CTL_TS); probe_scale = 1.f + sqrtf((float)(ts[MK_TS_PHASE + 1] - ts[MK_TS_PHASE]) * MK_TS_SCALE); }
#endif
    f32x4 g2[4], gg[4], bb[4];
#pragma unroll
    for (int j = 0; j < 4; ++j) { const int col = (lane + 64 * j) * 4; g2[j] = *(const f32x4*)(mrow + 5 * DM + col); gg[j] = *(const f32x4*)(p.in[I_LN2G] + col); bb[j] = *(const f32x4*)(p.in[I_LN2B] + col); }
    f32x4 v[4]; float s = 0;
#pragma unroll
    for (int j = 0; j < 4; ++j) {
      f32x4 ym;
      ym.x = __uint_as_float(ya[j].x << 16) + __uint_as_float(yb[j].x << 16); ym.y = __uint_as_float(ya[j].x & 0xffff0000u) + __uint_as_float(yb[j].x & 0xffff0000u);
      ym.z = __uint_as_float(ya[j].y << 16) + __uint_as_float(yb[j].y << 16); ym.w = __uint_as_float(ya[j].y & 0xffff0000u) + __uint_as_float(yb[j].y & 0xffff0000u);
      const f32x4 xf = {__uint_as_float(x1[j].x << 16), __uint_as_float(x1[j].x & 0xffff0000u), __uint_as_float(x1[j].y << 16), __uint_as_float(x1[j].y & 0xffff0000u)};
      v[j] = xf * ALPHA + g2[j] * ym;
      s += (v[j].x + v[j].y) + (v[j].z + v[j].w);
    }
    const float mean = wave_sum(s) * (1.f / DM); float s2 = 0;
#pragma unroll
    for (int j = 0; j < 4; ++j) { v[j] = v[j] - mean; s2 += (v[j].x * v[j].x + v[j].y * v[j].y) + (v[j].z * v[j].z + v[j].w * v[j].w); }
    const float rstd = rsqrtf(wave_sum(s2) * (1.f / DM) + LN_EPS);
#pragma unroll
    for (int j = 0; j < 4; ++j) ((f32x4*)(OUT + (size_t)row * DM))[lane + 64 * j] = (v[j] * rstd * gg[j] + bb[j]) * probe_scale;
#pragma unroll
    for (int j = 0; j < 4; ++j) { x1[j] = x1n[j]; ya[j] = yan[j]; yb[j] = ybn[j]; }
  }
#undef FIN_LOAD
}
__device__ __forceinline__ void phase_attn(const Params& p, char* lds) {
  bf16_t* P = (bf16_t*)(p.ws + WS_P);
  int seq = SKV; asm volatile("" : "+s"(seq));
  float negMC;
  { const int l_ = opaque_tid() & 63; float gq = fmaxf(fabsf(p.in[I_QG][l_]), fabsf(p.in[I_QG][64 + l_])), gk = fmaxf(fabsf(p.in[I_KG][l_]), fabsf(p.in[I_KG][64 + l_]));
#pragma unroll
    for (int o = 1; o < 64; o <<= 1) { gq = fmaxf(gq, __shfl_xor(gq, o)); gk = fmaxf(gk, __shfl_xor(gk, o)); }
    negMC = 128.f * 1.01f * gq * gk; }
  for (int unit = blockIdx.x; unit < NB * 8 * (SEQ / 256); unit += gridDim.x) {
    const int h = unit % 8, qb = (unit / 8) % 32, b = unit / 256;
    bf16_t* Qp = P + ((size_t)b * SKV + qb * 256) * PLD + PC_Q + h * 128;
    const bf16_t* Kp = (const bf16_t*)(p.ws + WS_KC) + (size_t)(b * 2 + (h >> 2)) * SKV * 128;
    const bf16_t* Vp = (const bf16_t*)(p.ws + WS_VC) + (size_t)(b * 2 + (h >> 2)) * SKV * 128;
    att::attn_dense_body(Qp, Kp, Vp, Qp, seq, negMC, p.in[I_QG], qb * 256, lds);
  }
}

#if MK_TS_PHASE >= 16
#define RT_TS(k) do { if (gw == 0 && row0 == 0 && lane0 == 0) ((unsigned long long*)((unsigned*)(p.ws + WS_CTL) + CTL_TS))[k] = __builtin_amdgcn_s_memrealtime(); } while (0)
#else
#define RT_TS(k) do { } while (0)
#endif
constexpr int LDS_RTLOG = LDS_STAGE + 10240;
__device__ __forceinline__ void phase_ln1_router(const Params& p, LAS unsigned char* lds) {
  const float* mod = (const float*)(p.ws + WS_MOD);
  const float* R1 = p.out; bf16_t* X1b = (bf16_t*)(p.ws + WS_X1B);
  bf16_t* H2 = (bf16_t*)(p.ws + WS_RH);
  float* ew = (float*)(p.ws + WS_ROUTE + RT_EW); int* lists = (int*)(p.ws + WS_ROUTE + RT_LIST);
  unsigned* cnt = (unsigned*)(p.ws + WS_CTL) + CTL_CNT;
  const int tid_ = opaque_tid(); const int lane0 = tid_ & 63, wave = tid_ >> 6;
  const int gw = blockIdx.x * NWAVES + wave, NGW = gridDim.x * NWAVES;
  LAS f32x4* Wl = (LAS f32x4*)lds;
  LAS float* lg = (LAS float*)(lds + LDS_RTLOG) + wave * 160;
  const float* Wre = p.in[I_WRE]; const float* Wrg = p.in[I_WRG];
  f32x4 vv[4][4];
#if MK_RB_BF16
  u32x2 rb[4][4];
  const float* Xin = p.in[I_X];
#define RT_LOAD(row0_) do { int _ln = lane0; asm volatile("" : "+v"(_ln)); const int _r0 = ((row0_) < NLAT) ? (row0_) : (NLAT - 4); _Pragma("unroll") for (int r = 0; r < 4; ++r) _Pragma("unroll") for (int j = 0; j < 4; ++j) { \
    vv[r][j] = ((const f32x4*)(Xin + (size_t)(_r0 + r) * DM))[_ln + 64 * j]; rb[r][j] = ((const u32x2*)((const bf16_t*)R1 + (size_t)(_r0 + r) * DM))[_ln + 64 * j]; } } while (0)
#else
#define RT_LOAD(row0_) do { int _ln = lane0; asm volatile("" : "+v"(_ln)); const int _r0 = ((row0_) < NLAT) ? (row0_) : (NLAT - 4); _Pragma("unroll") for (int r = 0; r < 4; ++r) _Pragma("unroll") for (int j = 0; j < 4; ++j) \
    vv[r][j] = ((const f32x4*)(R1 + (size_t)(_r0 + r) * DM))[_ln + 64 * j]; } while (0)
#endif
  RT_LOAD(gw * 4);
  {
#pragma unroll 1
    for (int q0 = 0; q0 < 16; q0 += 8) {
      f32x4 wt[8];
#pragma unroll
      for (int q = 0; q < 8; ++q) wt[q] = ((const f32x4*)Wre)[tid_ + 512 * (q0 + q)];
#pragma unroll
      for (int q = 0; q < 8; ++q) { const int idx = tid_ + 512 * (q0 + q), k = idx >> 3, c4 = idx & 7;
        Wl[((c4 * 16 + (k & 3) * 4 + (k >> 8)) << 6) + ((k >> 2) & 63)] = wt[q]; }
    }
  }
  __syncthreads();
  for (int row0 = gw * 4; row0 < NLAT; row0 += NGW * 4) {
    const float* mrow = mod + (row0 / SEQ) * NMOD;
    RT_TS(16);
#pragma unroll
    for (int r = 0; r < 4; ++r) {
      const int row = row0 + r, pr = lat2pad(row);
      int lane = lane0; asm volatile("" : "+v"(lane));
      f32x4 v[4]; float s = 0;
#pragma unroll
      for (int j = 0; j < 4; ++j) {
#if MK_RB_BF16
        const u32x2 q = rb[r][j];
        v[j] = vv[r][j] * ALPHA + (f32x4){__uint_as_float(q.x << 16), __uint_as_float(q.x & 0xffff0000u), __uint_as_float(q.y << 16), __uint_as_float(q.y & 0xffff0000u)};
#else
        v[j] = vv[r][j];
#endif
        s += (v[j].x + v[j].y) + (v[j].z + v[j].w); }
      float mean = wave_sum(s) * (1.f / DM); float s2 = 0;
#pragma unroll
      for (int j = 0; j < 4; ++j) { v[j] = v[j] - mean; s2 += (v[j].x * v[j].x + v[j].y * v[j].y) + (v[j].z * v[j].z + v[j].w * v[j].w); }
      float rstd = rsqrtf(wave_sum(s2) * (1.f / DM) + LN_EPS);
      s = 0;
#pragma unroll
      for (int j = 0; j < 4; ++j) {
        const int col = (lane + 64 * j) * 4;
        const f32x4 g = *(const f32x4*)(p.in[I_LN1G] + col), bb = *(const f32x4*)(p.in[I_LN1B] + col);
        v[j] = v[j] * rstd * g + bb;
        { u32x2 xw; xw.x = cvt_pk_bf16(v[j].x, v[j].y); xw.y = cvt_pk_bf16(v[j].z, v[j].w); *(u32x2*)(X1b + (size_t)row * DM + col) = xw; }
        s += (v[j].x + v[j].y) + (v[j].z + v[j].w);
      }
      mean = wave_sum(s) * (1.f / DM); s2 = 0;
#pragma unroll
      for (int j = 0; j < 4; ++j) { v[j] = v[j] - mean; s2 += (v[j].x * v[j].x + v[j].y * v[j].y) + (v[j].z * v[j].z + v[j].w * v[j].w); }
      rstd = rsqrtf(wave_sum(s2) * (1.f / DM) + LN_EPS);
#pragma unroll
      for (int j = 0; j < 4; ++j) {
        const int col = (lane + 64 * j) * 4;
        const f32x4 sh = *(const f32x4*)(mrow + 3 * DM + col), sc = *(const f32x4*)(mrow + 4 * DM + col);
        const f32x4 hv = v[j] * rstd * (sc + 1.f) + sh;
        u32x2 w; w.x = cvt_pk_bf16(hv.x, hv.y); w.y = cvt_pk_bf16(hv.z, hv.w);
        *(u32x2*)(H2 + (size_t)pr * DM + col) = w;
        vv[r][j] = hv;
      }
    }
    RT_TS(17);
    int gsel[4];
    int lane = lane0; asm volatile("" : "+v"(lane));
    {
      f32x4 acc[4];
#pragma unroll
      for (int r = 0; r < 4; ++r) acc[r] = (f32x4){0.f, 0.f, 0.f, 0.f};
#pragma unroll
      for (int j = 0; j < 4; ++j)
#pragma unroll
        for (int e = 0; e < 4; ++e) { const f32x4 w = *(const f32x4*)(Wrg + (size_t)(j * 256 + e) * 4 + (unsigned)(lane * 16));
#pragma unroll
          for (int r = 0; r < 4; ++r) acc[r] += w * vv[r][j][e]; }
#pragma unroll
      for (int r = 0; r < 4; ++r)
#pragma unroll
        for (int e = 0; e < 4; ++e) acc[r][e] = wave_sum(acc[r][e]);
      if (lane == 0) {
#pragma unroll
        for (int r = 0; r < 4; ++r) *(LAS f32x4*)(lg + r * 40) = acc[r]; }
#pragma unroll
      for (int r = 0; r < 4; ++r) {
        int gi = 0; float gm = acc[r][0] + p.in[I_BRG][0];
#pragma unroll
        for (int i = 1; i < 4; ++i) { const float g = acc[r][i] + p.in[I_BRG][i]; if (g > gm) { gm = g; gi = i; } }
        gsel[r] = gi; }
    }
    RT_TS(18);
    {
      f32x4 ea[4][2];
#pragma unroll
      for (int r = 0; r < 4; ++r) { ea[r][0] = (f32x4){0.f, 0.f, 0.f, 0.f}; ea[r][1] = ea[r][0]; }
      const LAS f32x4* wb[4];
#pragma unroll
      for (int r = 0; r < 4; ++r) wb[r] = Wl + gsel[r] * 2048 + lane;
#pragma unroll
      for (int j = 0; j < 4; ++j)
#pragma unroll
        for (int e = 0; e < 4; ++e)
#pragma unroll
          for (int r = 0; r < 4; ++r) { const float h = vv[r][j][e];
            ea[r][0] += wb[r][(e * 4 + j) * 64] * h; ea[r][1] += wb[r][1024 + (e * 4 + j) * 64] * h; }
#pragma unroll
      for (int r = 0; r < 4; ++r)
#pragma unroll
        for (int hf = 0; hf < 2; ++hf)
#pragma unroll
          for (int e = 0; e < 4; ++e) ea[r][hf][e] = wave_sum(ea[r][hf][e]);
      if (lane == 0) {
#pragma unroll
        for (int r = 0; r < 4; ++r) { *(LAS f32x4*)(lg + r * 40 + 4 + gsel[r] * 8) = ea[r][0]; *(LAS f32x4*)(lg + r * 40 + 8 + gsel[r] * 8) = ea[r][1]; } }
    }
    RT_LOAD(row0 + NGW * 4);
    asm volatile("s_waitcnt lgkmcnt(0)" ::: "memory");
    RT_TS(19);
    if (lane < 4) {
      const int row = row0 + lane; const LAS float* L = lg + lane * 40;
      float gl[4]; int gi = 0;
#pragma unroll
      for (int i = 0; i < 4; ++i) gl[i] = L[i] + p.in[I_BRG][i];
      float gm = gl[0];
#pragma unroll
      for (int i = 1; i < 4; ++i) if (gl[i] > gm) { gm = gl[i]; gi = i; }
      float den = 0.f;
#pragma unroll
      for (int i = 0; i < 4; ++i) den += expf(gl[i] - gm);
      const float gw_ = 1.f / den;
      float el[8];
#pragma unroll
      for (int i = 0; i < 8; ++i) el[i] = L[4 + gi * 8 + i] + p.in[I_BRE][gi * 8 + i];
      int i1 = 0; float v1 = el[0];
#pragma unroll
      for (int i = 1; i < 8; ++i) if (el[i] > v1) { v1 = el[i]; i1 = i; }
      int i2 = -1; float v2 = -3.0e38f;
#pragma unroll
      for (int i = 0; i < 8; ++i) if (i != i1 && el[i] > v2) { v2 = el[i]; i2 = i; }
      const float e2 = expf(v2 - v1); const float w1 = 1.f / (1.f + e2), w2 = e2 / (1.f + e2);
      const int ea = gi * 8 + i1, eb = gi * 8 + i2;
      const unsigned pa = atomicAdd(cnt + ea * CNT_STRIDE, 1u), pb = atomicAdd(cnt + eb * CNT_STRIDE, 1u);
      lists[ea * NLAT + pa] = row * 2; lists[eb * NLAT + pb] = row * 2 + 1;
      ew[row * 2] = w1 * gw_; ew[row * 2 + 1] = w2 * gw_;
    }
    asm volatile("s_waitcnt vmcnt(0) lgkmcnt(0)" ::: "memory");
    RT_TS(20);
  }
}

enum { PH_PRO = 0, PH_LN, PH_GIN, PH_QK, PH_ATT, PH_G1, PH_G2, PH_G3, PH_RT, PH_UP, PH_DOWN, PH_FIN, PH_S5S, PH_SCAN, PH_S5Y, PH_COUNT };
template <int PH> __device__ __forceinline__ void run_phase(const Params& p, unsigned char* lds_raw) {
  LAS unsigned char* lds = (LAS unsigned char*)lds_raw;
  if constexpr (PH == PH_PRO) phase0(p, lds);
  if constexpr (PH == PH_LN) phase1(p, lds);
  if constexpr (PH == PH_GIN) phase2(p, lds);
  if constexpr (PH == PH_QK) phase_qknorm(p);
  if constexpr (PH == PH_ATT) phase_attn(p, (char*)lds_raw);
  if constexpr (PH == PH_G1) phase_g1(p, lds);
  if constexpr (PH == PH_G2) phase_g2(p, lds);
  if constexpr (PH == PH_G3) phase_g3(p, lds);
  if constexpr (PH == PH_RT) phase_ln1_router(p, lds);
  if constexpr (PH == PH_UP) phase_moe_up(p, lds);
  if constexpr (PH == PH_DOWN) phase_moe_down(p, lds);
  if constexpr (PH == PH_FIN) phase_final(p);
  if constexpr (PH == PH_S5S) phase_s5s(p, lds);
  if constexpr (PH == PH_SCAN) phase_s5scan(p);
  if constexpr (PH == PH_S5Y) phase_s5y(p, lds);
}
#ifndef MK_FUSED
#define MK_FUSED 1
#endif
#if !MK_FUSED
template <int PH> __global__ __launch_bounds__(512, 2) void k_phase(Params p) {
  extern __shared__ __attribute__((aligned(16))) unsigned char lds_raw[];
  run_phase<PH>(p, lds_raw);
}
template <int PH> static bool set_lds() { return hipFuncSetAttribute((const void*)k_phase<PH>, hipFuncAttributeMaxDynamicSharedMemorySize, LDS_BYTES) == hipSuccess; }
template <int PH> static void launch_ph(int grid, hipStream_t stream, const Params& p) { hipLaunchKernelGGL(k_phase<PH>, dim3(grid), dim3(512), LDS_BYTES, stream, p); }
#else
constexpr int CTL_SCAN = 2048;
constexpr int CTL_S5SCNT = 2432;
#ifndef MK_CG_SYNC
#define MK_CG_SYNC 0
#endif
constexpr int CTL_BAR = 4096;
constexpr int LDS_BARST = LDS_STAGE + 1024;
#if MK_CG_SYNC
#define GRID_BAR() cooperative_groups::this_grid().sync()
#else
#ifdef MK_DOUBLE_BAR
#define GRID_BAR() do { xcd_barrier(xbar); xcd_barrier(xbar); } while (0)
#else
#define GRID_BAR() xcd_barrier(xbar)
#endif
#endif
typedef const __attribute__((address_space(4))) Params* KParamsPtr;
__device__ __forceinline__ KParamsPtr kparams() { KParamsPtr k = (KParamsPtr)__builtin_amdgcn_kernarg_segment_ptr(); asm volatile("" : "+s"(k)); return k; }
#define KP (*(const Params*)kparams())
#ifndef MK_MASK
#define MK_MASK 0xFFFF
#endif
#ifndef MK_REP_MASK
#define MK_REP_MASK 0
#endif
#ifndef MK_REP
#define MK_REP 1
#endif
#define REP_PHASE(PH) do { if constexpr ((MK_REP_MASK >> PH) & 1) { for (int _r = 0; _r < MK_REP; ++_r) { run_phase<PH>(KP, lds_raw); GRID_BAR(); } } } while (0)
#ifndef MK_TS_PHASE
#define MK_TS_PHASE -1
#endif
#ifndef MK_TS_SCALE
#define MK_TS_SCALE 5.0e-8f
#endif
#if MK_TS_PHASE >= 0
#ifdef MK_TS_CLOCK
#define TS_MARK() do { if (blockIdx.x == 0 && opaque_tid() == 0) { ((unsigned long long*)((unsigned*)(KP.ws + WS_CTL) + CTL_TS))[ts_n] = __builtin_readcyclecounter(); } ++ts_n; } while (0)
#else
#define TS_MARK() do { if (blockIdx.x == 0 && opaque_tid() == 0) { ((unsigned long long*)((unsigned*)(KP.ws + WS_CTL) + CTL_TS))[ts_n] = __builtin_amdgcn_s_memrealtime(); } ++ts_n; } while (0)
#endif
#else
#define TS_MARK() do { } while (0)
#endif
__global__ __launch_bounds__(512, 2) void k_mega(Params p_unused) {
  extern __shared__ __attribute__((aligned(16))) unsigned char lds_raw[];
  int ts_n = 0; (void)ts_n;
#if !MK_CG_SYNC
  volatile LAS unsigned* bst = (volatile LAS unsigned*)((LAS unsigned char*)lds_raw + LDS_BARST);
  if (threadIdx.x < 2) bst[threadIdx.x] = 0u;
  tid_table_init();
  __syncthreads();
  const XcdBarrier xbar = xcd_barrier_post((unsigned*)(KP.ws + WS_CTL) + CTL_BAR, bst);
#endif
  TS_MARK();
  REP_PHASE(PH_PRO);
#if MK_LN_IN_PRO
  if constexpr ((MK_MASK >> PH_PRO) & 1) run_phase<PH_PRO>(KP, lds_raw);
  { if (opaque_tid() == 0) { unsigned spins = 0;
      while (__hip_atomic_load((unsigned*)(KP.ws + WS_CTL) + CTL_MODCNT, __ATOMIC_ACQUIRE, __HIP_MEMORY_SCOPE_AGENT) < gridDim.x && ++spins < (1u << 22)) __builtin_amdgcn_s_sleep(4); }
    __syncthreads();
    __builtin_amdgcn_fence(__ATOMIC_ACQUIRE, "agent"); }
  TS_MARK();
#else
  if constexpr ((MK_MASK >> PH_PRO) & 1) run_phase<PH_PRO>(KP, lds_raw);  GRID_BAR(); TS_MARK();
#endif
  REP_PHASE(PH_LN);
  if constexpr ((MK_MASK >> PH_LN) & 1) run_phase<PH_LN>(KP, lds_raw);   GRID_BAR(); TS_MARK();
  REP_PHASE(PH_GIN);
  if constexpr ((MK_MASK >> PH_GIN) & 1) run_phase<PH_GIN>(KP, lds_raw);  GRID_BAR(); TS_MARK();
  REP_PHASE(PH_S5S);
#if MK_S5_IN_P3
  {
    unsigned* c_s5s = (unsigned*)(KP.ws + WS_CTL) + CTL_S5SCNT; unsigned* c_scan = (unsigned*)(KP.ws + WS_CTL) + CTL_SCAN;
    const int cB = blockIdx.x;
    if (cB < 160) {
      run_phase<PH_S5S>(KP, lds_raw);
      if (opaque_tid() == 0) { __threadfence(); __hip_atomic_fetch_add(c_s5s, 1u, __ATOMIC_RELEASE, __HIP_MEMORY_SCOPE_AGENT); }
    } else if (cB < 176) {
      if (opaque_tid() == 0) { unsigned spins = 0; while (__hip_atomic_load(c_s5s, __ATOMIC_ACQUIRE, __HIP_MEMORY_SCOPE_AGENT) < 160u && ++spins < (1u << 22)) __builtin_amdgcn_s_sleep(4); }
      __syncthreads();
      __builtin_amdgcn_fence(__ATOMIC_ACQUIRE, "agent");
      { const int t_ = opaque_tid(); s5_scan_item(KP, (cB - 160) * NWAVES + (t_ >> 6), t_ & 63); }
      asm volatile("s_waitcnt vmcnt(0)" ::: "memory");
      __syncthreads();
      if (opaque_tid() == 0) { __threadfence(); __hip_atomic_fetch_add(c_scan, 1u, __ATOMIC_RELEASE, __HIP_MEMORY_SCOPE_AGENT); }
    }
    run_phase<PH_QK>(KP, lds_raw);
    if (cB < 128) {
      if (opaque_tid() == 0) { unsigned spins = 0; while (__hip_atomic_load(c_scan, __ATOMIC_ACQUIRE, __HIP_MEMORY_SCOPE_AGENT) < 16u && ++spins < (1u << 22)) __builtin_amdgcn_s_sleep(4); }
      __syncthreads();
      __builtin_amdgcn_fence(__ATOMIC_ACQUIRE, "agent");
      run_phase<PH_S5Y>(KP, lds_raw);
    }
  }
  GRID_BAR(); TS_MARK();
  run_phase<PH_ATT>(KP, lds_raw);
#else
#if MK_TS_PHASE >= 16
  if (blockIdx.x == 0 && opaque_tid() == 0) ((unsigned long long*)((unsigned*)(KP.ws + WS_CTL) + CTL_TS))[21] = __builtin_amdgcn_s_memrealtime();
#endif
  if constexpr ((MK_MASK >> PH_S5S) & 1) run_phase<PH_S5S>(KP, lds_raw);
#if MK_TS_PHASE >= 16
  if (blockIdx.x == 0 && opaque_tid() == 0) ((unsigned long long*)((unsigned*)(KP.ws + WS_CTL) + CTL_TS))[22] = __builtin_amdgcn_s_memrealtime();
#endif
  if constexpr ((MK_MASK >> PH_QK) & 1) run_phase<PH_QK>(KP, lds_raw);
#if MK_TS_PHASE >= 16
  asm volatile("s_waitcnt vmcnt(0)" ::: "memory");
  if (blockIdx.x == 0 && opaque_tid() == 0) ((unsigned long long*)((unsigned*)(KP.ws + WS_CTL) + CTL_TS))[23] = __builtin_amdgcn_s_memrealtime();
#endif
  GRID_BAR(); TS_MARK();
  {
    unsigned* ctr = (unsigned*)(KP.ws + WS_CTL) + CTL_SCAN;
    if (blockIdx.x * NWAVES < 128) {
#if MK_TS_PHASE >= 16
      if (blockIdx.x == 0 && opaque_tid() == 0) ((unsigned long long*)((unsigned*)(KP.ws + WS_CTL) + CTL_TS))[16] = __builtin_amdgcn_s_memrealtime();
#endif
      if constexpr ((MK_MASK >> PH_SCAN) & 1) run_phase<PH_SCAN>(KP, lds_raw);
#if MK_TS_PHASE >= 16
      asm volatile("s_waitcnt vmcnt(0)" ::: "memory");
      if (blockIdx.x == 0 && opaque_tid() == 0) ((unsigned long long*)((unsigned*)(KP.ws + WS_CTL) + CTL_TS))[17] = __builtin_amdgcn_s_memrealtime();
#endif
      __threadfence();
      if ((opaque_tid() & 63) == 0 && blockIdx.x * NWAVES + (opaque_tid() >> 6) < 128) __hip_atomic_fetch_add(ctr, 1u, __ATOMIC_RELEASE, __HIP_MEMORY_SCOPE_AGENT);
    }
    if constexpr ((MK_MASK >> PH_ATT) & 1) run_phase<PH_ATT>(KP, lds_raw);
    if (opaque_tid() == 0) { unsigned spins = 0; while (__hip_atomic_load(ctr, __ATOMIC_ACQUIRE, __HIP_MEMORY_SCOPE_AGENT) < 128u && ++spins < (1u << 24)) __builtin_amdgcn_s_sleep(8); }
    __syncthreads();
    __threadfence();
    if constexpr ((MK_MASK >> PH_S5Y) & 1) run_phase<PH_S5Y>(KP, lds_raw);
  }
#endif
  GRID_BAR(); TS_MARK();
  REP_PHASE(PH_S5Y);
  REP_PHASE(PH_G1);
  if constexpr ((MK_MASK >> PH_G1) & 1) run_phase<PH_G1>(KP, lds_raw);   GRID_BAR(); TS_MARK();
  if constexpr ((MK_MASK >> PH_G2) & 1) run_phase<PH_G2>(KP, lds_raw);   GRID_BAR(); TS_MARK();
  REP_PHASE(PH_G3);
  if constexpr ((MK_MASK >> PH_G3) & 1) run_phase<PH_G3>(KP, lds_raw);   GRID_BAR(); TS_MARK();
  if constexpr ((MK_MASK >> PH_RT) & 1) run_phase<PH_RT>(KP, lds_raw);   GRID_BAR(); TS_MARK();
  REP_PHASE(PH_UP);
  if constexpr ((MK_MASK >> PH_UP) & 1) run_phase<PH_UP>(KP, lds_raw);   GRID_BAR(); TS_MARK();
  REP_PHASE(PH_DOWN);
  if constexpr ((MK_MASK >> PH_DOWN) & 1) run_phase<PH_DOWN>(KP, lds_raw); GRID_BAR(); TS_MARK();
#if MK_TS_PHASE >= 0
  GRID_BAR();
#endif
  if constexpr ((MK_MASK >> PH_FIN) & 1) run_phase<PH_FIN>(KP, lds_raw);
}
#endif

extern "C" void kernel_launch(void* const* d_in, const int* in_sizes, int n_in, void* d_out, int out_size, void* d_ws, size_t ws_size, hipStream_t stream) {
  static int grid = 0;
  if (grid == 0) {
    if (n_in != 32 || out_size != NLAT * DM || ws_size < WS_END) { fprintf(stderr, "kernel_launch: unexpected shapes n_in %d out %d ws %zu\n", n_in, out_size, ws_size); grid = -1; return; }
    int dev = 0, cus = 0;
    hipGetDevice(&dev); hipDeviceGetAttribute(&cus, hipDeviceAttributeMultiprocessorCount, dev);
#if !MK_FUSED
    bool ok = set_lds<0>() && set_lds<1>() && set_lds<2>() && set_lds<3>() && set_lds<4>() && set_lds<5>() && set_lds<6>() && set_lds<7>() && set_lds<8>() && set_lds<9>() && set_lds<10>() && set_lds<11>() && set_lds<12>() && set_lds<13>() && set_lds<14>();
    if (!ok) { fprintf(stderr, "kernel_launch: hipFuncSetAttribute failed\n"); grid = -1; return; }
    grid = cus > 0 ? cus : 256;
#else
    if (hipFuncSetAttribute((const void*)k_mega, hipFuncAttributeMaxDynamicSharedMemorySize, LDS_BYTES) != hipSuccess) { fprintf(stderr, "kernel_launch: hipFuncSetAttribute failed\n"); grid = -1; return; }
    int per_cu = 0;
    if (hipOccupancyMaxActiveBlocksPerMultiprocessor(&per_cu, (const void*)k_mega, 512, LDS_BYTES) != hipSuccess || per_cu < 1) { fprintf(stderr, "kernel_launch: occupancy query says %d blocks per CU\n", per_cu); grid = -1; return; }
    grid = (cus > 0 ? cus : 256) * 1;
#endif
  }
  if (grid < 0) return;
  Params p{};
  for (int i = 0; i < 32; ++i) p.in[i] = (const float*)d_in[i];
  p.out = (float*)d_out; p.ws = (unsigned char*)d_ws;
  hipMemsetAsync((char*)d_ws + WS_CTL, 0, 64 * 1024, stream);
#if !MK_FUSED
  launch_ph<PH_PRO>(grid, stream, p);
  launch_ph<PH_LN>(grid, stream, p);
  launch_ph<PH_GIN>(grid, stream, p);
  launch_ph<PH_QK>(grid, stream, p);
  launch_ph<PH_S5S>(grid, stream, p);
  launch_ph<PH_SCAN>(grid, stream, p);
  launch_ph<PH_ATT>(grid, stream, p);
  launch_ph<PH_S5Y>(grid, stream, p);
  launch_ph<PH_G1>(grid, stream, p);
  launch_ph<PH_G2>(grid, stream, p);
  launch_ph<PH_G3>(grid, stream, p);
  launch_ph<PH_RT>(grid, stream, p);
  launch_ph<PH_UP>(grid, stream, p);
  launch_ph<PH_DOWN>(grid, stream, p);
  launch_ph<PH_FIN>(grid, stream, p);
#else
  void* args[] = {&p};
  hipError_t e = hipLaunchCooperativeKernel((const void*)k_mega, dim3(grid), dim3(512), args, LDS_BYTES, stream);
  if (e != hipSuccess) fprintf(stderr, "kernel_launch: cooperative launch failed: %s (grid %d)\n", hipGetErrorString(e), grid);
#endif
}
```

```cpp
#define MK_N1_NUM 1
#define MK_N1_DEN 2
#include <hip/hip_runtime.h>
#include <hip/hip_bf16.h>
#include <hip/hip_cooperative_groups.h>
#include <cstdint>
#include <cstdio>

typedef unsigned short bf16_t;
#define LAS __attribute__((address_space(3)))
typedef short bf16x8 __attribute__((ext_vector_type(8)));
typedef float f32x4 __attribute__((ext_vector_type(4)));
typedef float f32x2 __attribute__((ext_vector_type(2)));
typedef unsigned u32x4 __attribute__((ext_vector_type(4)));
typedef unsigned u32x2 __attribute__((ext_vector_type(2)));

__device__ __forceinline__ float bf2f(bf16_t v) { return __uint_as_float(((unsigned)v) << 16); }
__device__ __forceinline__ bf16_t f2bf(float f) { unsigned u = __float_as_uint(f); return (bf16_t)((u + 0x7fffu + ((u >> 16) & 1u)) >> 16); }
__device__ __forceinline__ unsigned cvt_pk_bf16(float lo, float hi) { unsigned r; asm volatile("v_cvt_pk_bf16_f32 %0, %1, %2" : "=v"(r) : "v"(lo), "v"(hi)); return r; }

constexpr int DM = 1024, NB = 2, SEQ = 8192, NCTX = 256;
constexpr int NLAT = NB * SEQ;
constexpr int SKV = SEQ + NCTX;
constexpr int NROW = NB * SKV;
constexpr int INW = 4096;
constexpr int NMOD = 6 * DM;
constexpr int PLD = 3584;
constexpr int PC_Q = 0, PC_K = 1024, PC_V = 1280, PC_G = 1536;
constexpr int NCHUNK = NROW / 16;
constexpr float LN_EPS = 1e-6f;
constexpr float ALPHA = 1.189207115002721f;

constexpr size_t MiB = 1u << 20;
constexpr size_t WS_CTL = 0;
constexpr size_t WS_MOD = 1 * MiB;
constexpr size_t WS_ROUTE = 2 * MiB;
constexpr size_t WS_S5AB = 5 * MiB;
constexpr size_t WS_S5T = 6 * MiB;
constexpr size_t WS_S5E = 14 * MiB;
constexpr size_t WS_WIN = 18 * MiB;
constexpr size_t WS_WGLU = 26 * MiB;
constexpr size_t WS_WAO = 28 * MiB;
constexpr size_t WS_WOUT = 30 * MiB;
constexpr size_t WS_WGU = 32 * MiB;
constexpr size_t WS_WD = 96 * MiB;
constexpr size_t WS_RH = 128 * MiB;
constexpr size_t WS_P = 162 * MiB;
constexpr size_t WS_KC = 280 * MiB;
constexpr size_t WS_VC = WS_KC + (size_t)NB * 2 * SKV * 128 * 2;
constexpr size_t WS_X1B = 268 * MiB;
constexpr size_t WS_END = 300 * MiB;
constexpr size_t DO_YA = 0, DO_GY = 34 * MiB;

struct Params {
  const float* in[32];
  float* out;
  unsigned char* ws;
};
enum { I_X = 0, I_C, I_CTX, I_CCTX, I_WMOD, I_BMOD, I_WIN, I_SARE, I_SAIM, I_SLDT, I_SBRE, I_SBIM, I_SCRE, I_SCIM, I_SD,
       I_WGA, I_WGB, I_QG, I_KG, I_WAO, I_WOUT, I_LN1G, I_LN1B, I_WRG, I_BRG, I_WRE, I_BRE, I_WEG, I_WEU, I_WED, I_LN2G, I_LN2B };

template <int CTRL> __device__ __forceinline__ float dpp_add(float v) { return v + __builtin_bit_cast(float, __builtin_amdgcn_update_dpp(0, __builtin_bit_cast(int, v), CTRL, 0xF, 0xF, false)); }
__device__ __forceinline__ float row16_sum(float v) {
  v = dpp_add<0xB1>(v); v = dpp_add<0x4E>(v); v = dpp_add<0x141>(v); v = dpp_add<0x140>(v); return v; }
__device__ __forceinline__ float wave_sum(float v) {
  v = row16_sum(v);
  { auto rr = __builtin_amdgcn_permlane16_swap(__float_as_uint(v), __float_as_uint(v), false, false); v = __uint_as_float(rr[0]) + __uint_as_float(rr[1]); }
  { auto rr = __builtin_amdgcn_permlane32_swap(__float_as_uint(v), __float_as_uint(v), false, false); v = __uint_as_float(rr[0]) + __uint_as_float(rr[1]); }
  return v;
}
__device__ __forceinline__ float lane_xor4(float x) {
  int t = __builtin_amdgcn_update_dpp(0, __builtin_bit_cast(int, x), 0x104, 0xF, 0x5, false);
  t = __builtin_amdgcn_update_dpp(t, __builtin_bit_cast(int, x), 0x114, 0xF, 0xA, false);
  return __builtin_bit_cast(float, t);
}
__device__ __forceinline__ float sigmoidf_(float x) { return 1.f / (1.f + __expf(-x)); }
__device__ __forceinline__ float siluf_(float x) { return x / (1.f + __expf(-x)); }
__device__ __forceinline__ float gelu_tanh(float x) {
  const float k0 = 0.7978845608028654f, k1 = 0.044715f;
  const float z = k0 * (x + k1 * x * x * x);
  return x / (1.f + __expf(-2.f * z));
}
__device__ __forceinline__ int lat2pad(int lr) { return lr + (lr / SEQ) * NCTX; }

constexpr int NWAVES = 8;
constexpr int LDS_STAGE = 131072;
constexpr int LDS_BYTES = 147456;


constexpr int LDS_WIDTAB = LDS_STAGE + 15872;
__device__ __forceinline__ unsigned hw_wave_slot() { return (unsigned)__builtin_amdgcn_s_getreg(((6 - 1) << 11) | 4) & 63u; }
__device__ __forceinline__ int opaque_tid() {
  extern __shared__ __attribute__((aligned(16))) unsigned char lds_dyn_[];
  const int wv = __builtin_amdgcn_readfirstlane(((const volatile LAS int*)((LAS unsigned char*)lds_dyn_ + LDS_WIDTAB))[hw_wave_slot()]);
  unsigned m = ~0u; asm volatile("" : "+s"(m));
  int t = (wv << 6) | (int)__builtin_amdgcn_mbcnt_hi(m, __builtin_amdgcn_mbcnt_lo(m, 0u));
  asm volatile("" : "+v"(t)); return t;
}
__device__ __forceinline__ void tid_table_init() {
  extern __shared__ __attribute__((aligned(16))) unsigned char lds_dyn_[];
  if ((threadIdx.x & 63) == 0) ((volatile LAS int*)((LAS unsigned char*)lds_dyn_ + LDS_WIDTAB))[hw_wave_slot()] = (int)(threadIdx.x >> 6);
}

#ifndef MK_TS_PHASE
#define MK_TS_PHASE -1
#endif
#ifndef MK_TS_SCALE
#define MK_TS_SCALE 5.0e-8f
#endif
constexpr int CTL_TS = 3072;
#ifndef MK_CTX_IN_P1
#define MK_CTX_IN_P1 0
#endif
#ifndef MK_N1_NUM
#define MK_N1_NUM 4
#define MK_N1_DEN 5
#endif
#ifndef MK_RB_BF16
#define MK_RB_BF16 1
#endif
#ifndef MK_CVT_DEPTH3
#define MK_CVT_DEPTH3 0
#endif
#ifndef MK_CVT_42
#define MK_CVT_42 0
#endif
#ifndef MK_CTX_KEEP
#define MK_CTX_KEEP 0
#endif
#ifndef MK_CTX_MINI
#define MK_CTX_MINI 0
#endif
#ifndef MK_LN_IN_PRO
#define MK_LN_IN_PRO 0
#endif
#ifndef MK_CTX_IN_PRO
#define MK_CTX_IN_PRO 0
#endif
constexpr int NCTXB = 8;
constexpr int CTL_CTXCNT = 2176;
constexpr int CTL_MODCNT = 2304, CTL_WINCNT = 2368;
#ifndef MK_MMA_PRIO
#define MK_MMA_PRIO 1
#endif
#ifndef MK_EARLY_DOWN
#define MK_EARLY_DOWN 0
#endif
#ifndef MK_WARM_G2
#define MK_WARM_G2 0
#endif
#ifndef MK_S5_IN_P3
#define MK_S5_IN_P3 0
#endif
#ifndef MK_MOE_HALF
#define MK_MOE_HALF 1
#endif
namespace pg {
constexpr int BM = 256, BK = 64, HALF = 128, HTB = HALF * BK * 2, STAGE_BYTES = 8 * HTB;
__host__ __device__ __forceinline__ int lds_byte(int r, int c) { const int st = (r >> 4) * 2 + (c >> 5), rr = r & 15, cc = c & 31, ob = rr * 64 + cc * 2; return st * 1024 + (ob ^ (((ob >> 9) & 1) << 5)); }
__host__ __device__ __forceinline__ void stage_rc(int b, int& R, int& C) { const int st = b / 1024, sb = b % 1024, swz = sb ^ (((sb >> 9) & 1) << 5); R = (st >> 1) * 16 + swz / 64; C = (st & 1) * 32 + (swz % 64) / 2; }
__host__ __device__ __forceinline__ int perm32(int rho) { const int n = rho >> 4, i = rho & 15; return 8 * (i >> 2) + 4 * n + (i & 3); }

struct Unit { int pm, pn, aux, arow, half; };
struct Addr {
  const bf16_t* A; int lda; size_t a_gs; const bf16_t* Bt; int K; size_t b_gs;
  bool gather;
  __device__ __forceinline__ const char* a_base(const Unit& u) const { return gather ? (const char*)A : (const char*)(A + (size_t)u.aux * a_gs + (size_t)u.arow * lda); }
  __device__ __forceinline__ const char* b_base(const Unit& u) const { return (const char*)(Bt + (size_t)u.aux * b_gs + (size_t)u.pn * BM * K); }
};
typedef f32x4 Acc[2][2][4][2];

template <class Epi, class Sched>
__device__ __forceinline__ void gemm_phase(LAS unsigned char* lds, const Addr AD, const Sched& S, const Epi& E) {
  const int tid = opaque_tid(), wid = __builtin_amdgcn_readfirstlane(tid >> 6), lane = tid & 63, wr = wid >> 2, wc = wid & 3, fr = lane & 15, fq = lane >> 4;
  int K_ = AD.K; asm volatile("" : "+s"(K_));
  const int K = K_, nt = K / BK, lda = AD.lda;
  int R0, C0; stage_rc(tid * 16, R0, C0);
  const unsigned voffB0 = (unsigned)(((Epi::PERM ? ((R0 & ~31) + perm32(R0 & 31)) : R0)) * K + C0) * 2u;
  const size_t pstepB = (size_t)64 * K * 2, pstepA = (size_t)64 * lda * 2, hstepA = (size_t)HALF * lda * 2;
  unsigned vA[2][2];
  const unsigned voffA0 = (unsigned)(R0 * lda + C0) * 2u;
#define PG_SETV(v, u) do { if constexpr (Sched::GATHER) { _Pragma("unroll") for (int _h = 0; _h < 2; ++_h) _Pragma("unroll") for (int _i = 0; _i < 2; ++_i) \
    v[_h][_i] = (unsigned)(S.arow(u, _h * HALF + _i * 64 + R0) * lda + C0) * 2u; } } while (0)
  const size_t kstep = (size_t)(BK * 2);
  const size_t hstepB = (size_t)HALF * K * 2;
  const unsigned ldsw = (unsigned)wid * 1024u;
  const int aoff = lds_byte(wr * 64 + fr, fq * 8), boff = lds_byte(wc * 32 + fr, fq * 8);
#define PG_SA(b, h) (((b) * 2 + (h)) * HTB)
#define PG_SB(b, h) ((4 + (b) * 2 + (h)) * HTB)
#define PG_STAGE_B(bufoff, gbase) do { _Pragma("unroll") for (int _i = 0; _i < 2; ++_i) { unsigned _vo = voffB0; asm volatile("" : "+v"(_vo)); \
    __builtin_amdgcn_global_load_lds((const unsigned*)((const char*)(gbase) + _i * pstepB + _vo), (LAS unsigned*)(lds + (bufoff) + ldsw + _i * 8192), 16, 0, 0); } } while (0)
#define PG_STAGE_A(b, h, gbase, V) do { _Pragma("unroll") for (int _i = 0; _i < 2; ++_i) { \
    if constexpr (Sched::GATHER) { unsigned _vo = V[h][_i]; asm volatile("" : "+v"(_vo)); __builtin_amdgcn_global_load_lds((const unsigned*)((const char*)(gbase) + _vo), (LAS unsigned*)(lds + PG_SA(b, h) + ldsw + _i * 8192), 16, 0, 0); } \
    else { unsigned _vo = voffA0; asm volatile("" : "+v"(_vo)); __builtin_amdgcn_global_load_lds((const unsigned*)((const char*)(gbase) + (h) * hstepA + _i * pstepA + _vo), (LAS unsigned*)(lds + PG_SA(b, h) + ldsw + _i * 8192), 16, 0, 0); } } } while (0)
#define PG_LDA(dst, b, h) do { _Pragma("unroll") for (int m = 0; m < 4; ++m) _Pragma("unroll") for (int k = 0; k < 2; ++k) dst[m][k] = *(const LAS bf16x8*)(lds + PG_SA(b, h) + aoff + m * 2048 + k * 1024); } while (0)
#define PG_LDB(dst, b, h) do { _Pragma("unroll") for (int n = 0; n < 2; ++n) _Pragma("unroll") for (int k = 0; k < 2; ++k) dst[n][k] = *(const LAS bf16x8*)(lds + PG_SB(b, h) + boff + n * 2048 + k * 1024); } while (0)
#define PG_MMA(ai, bj, At, Bt) do { __builtin_amdgcn_s_setprio(1); _Pragma("unroll") for (int m = 0; m < 4; ++m) _Pragma("unroll") for (int n = 0; n < 2; ++n) _Pragma("unroll") for (int k = 0; k < 2; ++k) \
    acc[ai][bj][m][n] = __builtin_amdgcn_mfma_f32_16x16x32_bf16(Bt[n][k], At[m][k], acc[ai][bj][m][n], 0, 0, 0); __builtin_amdgcn_s_setprio(0); } while (0)
#define PG_WAIT_V(n) asm volatile("s_waitcnt vmcnt(" #n ")" ::: "memory")
#define PG_WAIT_L(n) asm volatile("s_waitcnt lgkmcnt(" #n ")" ::: "memory")
#define PG_BAR __builtin_amdgcn_s_barrier()
#define PG_SCHED __builtin_amdgcn_sched_barrier(0)
  Unit cur, nxt; int ui = 0;
  if (!S.next(0, cur)) return;
  Acc acc;
#pragma unroll
  for (int a = 0; a < 2; ++a)
#pragma unroll
    for (int b = 0; b < 2; ++b)
#pragma unroll
      for (int m = 0; m < 4; ++m)
#pragma unroll
        for (int n = 0; n < 2; ++n) acc[a][b][m][n] = (f32x4){0.f, 0.f, 0.f, 0.f};
  bf16x8 At[4][2], B0[2][2], B1[2][2];
  const char* cA = AD.a_base(cur); const char* cB = AD.b_base(cur);
  PG_SETV(vA, cur);
  PG_STAGE_B(PG_SB(0, 0), cB); PG_STAGE_B(PG_SB(0, 1), cB + hstepB); PG_STAGE_A(0, 0, cA, vA); PG_STAGE_A(0, 1, cA, vA);
  if (wr == 1) PG_BAR;
  PG_WAIT_V(2); PG_BAR;
  PG_STAGE_B(PG_SB(1, 0), cB + kstep); PG_STAGE_A(1, 0, cA + kstep, vA); PG_STAGE_B(PG_SB(1, 1), cB + hstepB + kstep);
  PG_WAIT_V(6); PG_BAR;
#define PG_MMA1() do { if constexpr (Sched::HALF) { if (!cur.half) { PG_MMA(1, 0, At, B0); PG_MMA(1, 1, At, B1); } } else { PG_MMA(1, 0, At, B0); PG_MMA(1, 1, At, B1); } } while (0)
#define PG_KPAIR(a1, a2, b2, a3, b3, VN) do { \
      PG_LDB(B0, 0, 0); PG_LDB(B1, 0, 1); PG_SCHED; PG_LDA(At, 0, 0); PG_STAGE_A(1, 1, a1, vA); \
      PG_WAIT_V(8); PG_WAIT_L(0); PG_BAR; PG_MMA(0, 0, At, B0); PG_MMA(0, 1, At, B1); PG_BAR; PG_SCHED; \
      PG_LDA(At, 0, 1); PG_STAGE_B(PG_SB(0, 0), b2); PG_STAGE_B(PG_SB(0, 1), (b2) + hstepB); PG_STAGE_A(0, 0, a2, VN); \
      PG_WAIT_V(8); PG_WAIT_L(0); PG_BAR; PG_MMA1(); PG_BAR; PG_SCHED; \
      PG_LDB(B0, 1, 0); PG_LDB(B1, 1, 1); PG_SCHED; PG_LDA(At, 1, 0); PG_STAGE_A(0, 1, a2, VN); \
      PG_WAIT_V(8); PG_WAIT_L(0); PG_BAR; PG_MMA(0, 0, At, B0); PG_MMA(0, 1, At, B1); PG_BAR; PG_SCHED; \
      PG_LDA(At, 1, 1); PG_STAGE_B(PG_SB(1, 0), b3); PG_STAGE_B(PG_SB(1, 1), (b3) + hstepB); PG_STAGE_A(1, 0, a3, VN); \
      PG_WAIT_V(8); PG_WAIT_L(0); PG_BAR; PG_MMA1(); PG_BAR; PG_SCHED; } while (0)
  for (;;) {
    const bool has_next = S.next(ui + 1, nxt);
    const char* nA = has_next ? AD.a_base(nxt) : cA; const char* nB = has_next ? AD.b_base(nxt) : cB;
    if constexpr (Sched::GATHER) {
      unsigned vT[2][2];
      if (has_next) PG_SETV(vT, nxt); else {
#pragma unroll
        for (int _h = 0; _h < 2; ++_h)
#pragma unroll
          for (int _i = 0; _i < 2; ++_i) vT[_h][_i] = vA[_h][_i]; }
      *(LAS u32x4*)(lds + STAGE_BYTES + 2048 + tid * 16) = (u32x4){vT[0][0], vT[0][1], vT[1][0], vT[1][1]};
    }
    if constexpr (Sched::GATHER) {
      for (int t = 0; t < nt - 2; t += 2) {
        const char* a1 = cA + (size_t)(t + 1) * kstep; const char* a2 = cA + (size_t)(t + 2) * kstep; const char* b2 = cB + (size_t)(t + 2) * kstep;
        PG_KPAIR(a1, a2, b2, a2 + kstep, b2 + kstep, vA);
      }
      { const char* a1 = cA + (size_t)(nt - 1) * kstep;
        const u32x4 q = *(const LAS u32x4*)(lds + STAGE_BYTES + 2048 + tid * 16);
        unsigned vAn[2][2] = {{q.x, q.y}, {q.z, q.w}};
        PG_KPAIR(a1, nA, nB, nA + kstep, nB + kstep, vAn);
#pragma unroll
        for (int _h = 0; _h < 2; ++_h)
#pragma unroll
          for (int _i = 0; _i < 2; ++_i) vA[_h][_i] = vAn[_h][_i]; }
    } else {
      for (int t = 0; t < nt; t += 2) {
        const bool last = (t == nt - 2);
        const char* a1 = cA + (size_t)(t + 1) * kstep;
        const char* a2 = last ? nA : cA + (size_t)(t + 2) * kstep; const char* b2 = last ? nB : cB + (size_t)(t + 2) * kstep;
        PG_KPAIR(a1, a2, b2, a2 + kstep, b2 + kstep, vA);
      }
    }
    if (wr == 0) PG_BAR;
    E(acc, cur, wr, wc, fr, fq);
    if constexpr (Sched::HAS_DONE) S.done(cur, lane);
    if (!has_next) break;
#pragma unroll
    for (int a = 0; a < 2; ++a)
#pragma unroll
      for (int b = 0; b < 2; ++b)
#pragma unroll
        for (int m = 0; m < 4; ++m)
#pragma unroll
          for (int n = 0; n < 2; ++n) acc[a][b][m][n] = (f32x4){0.f, 0.f, 0.f, 0.f};
    cur = nxt; cA = nA; cB = nB; ++ui;
    if (wr == 1) PG_BAR;
  }
  PG_WAIT_V(0);
  PG_BAR;
#undef PG_MMA1
#undef PG_SETV
#undef PG_KPAIR
#undef PG_SA
#undef PG_SB
#undef PG_STAGE_A
#undef PG_STAGE_B
#undef PG_LDA
#undef PG_LDB
#undef PG_MMA
#undef PG_WAIT_V
#undef PG_WAIT_L
#undef PG_BAR
#undef PG_SCHED
}
}
namespace att {
using bf16x8 = __attribute__((ext_vector_type(8))) short;
using s16x4 = __attribute__((ext_vector_type(4))) short;
using f32x16 = __attribute__((ext_vector_type(16))) float;
using u32x4 = __attribute__((ext_vector_type(4))) unsigned;
constexpr int D = 128, NW = 8, QBLK = 32, KVBLK = 64;
constexpr float SCALE = 0.088388347648318440f;
constexpr float THR = 8.f;
constexpr int LDQ = PLD, LDK = 128, LDO = PLD;
constexpr int NRING = 3;
constexpr size_t SHM_V = KVBLK * D * 2, SHM_K = KVBLK * D * 2, SHM_ATTN = NRING * SHM_V + NRING * SHM_K + NW * 64 * 4;
constexpr float ROPE_C8[8] = {1.0f, 0.74989421f, 0.56234133f, 0.42169650f, 0.31622777f, 0.23713737f, 0.17782794f, 0.13335214f};
#define KSWZ(row, colB) ((row) * 256 + ((colB) ^ (((row) & 7) << 4)))
#define SBAR() __builtin_amdgcn_sched_barrier(0)
__device__ __forceinline__ int crow(int r, int hi) { return (r & 3) + 8 * (r >> 2) + 4 * hi; }
__device__ __forceinline__ unsigned cvtpk(float lo, float hi) { unsigned r; asm volatile("v_cvt_pk_bf16_f32 %0, %1, %2" : "=v"(r) : "v"(lo), "v"(hi)); return r; }
__device__ __forceinline__ void partialSM(f32x16& p0, f32x16& p1, float& m_reg, float& mn, float& alpha) {
  constexpr float C = SCALE * 1.4426950408889634f;
  float pmax = m_reg; asm volatile("" : "+v"(pmax));
  if (__builtin_expect(__all(pmax - m_reg <= THR / SCALE), 1)) { mn = m_reg; }
  else { mn = fmaxf(m_reg, pmax); m_reg = mn; }
  float mnC = -mn * C;
  for (int r = 0; r < 16; ++r) p0[r] = fmaf(p0[r], C, mnC); for (int r = 0; r < 16; ++r) p1[r] = fmaf(p1[r], C, mnC);
  for (int r = 0; r < 16; ++r) p0[r] = __builtin_amdgcn_exp2f(p0[r]);
}
__device__ __forceinline__ void finishSM(f32x16& p0, f32x16& p1, float alpha, float& l_reg, bf16x8& pa0, bf16x8& pa1, bf16x8& pa2, bf16x8& pa3) {
  for (int r = 0; r < 16; ++r) p1[r] = __builtin_amdgcn_exp2f(p1[r]);
  float ps = 0; for (int r = 0; r < 16; ++r) ps += p0[r]; for (int r = 0; r < 16; ++r) ps += p1[r];
  { auto rr = __builtin_amdgcn_permlane32_swap(__float_as_uint(ps), __float_as_uint(ps), false, false);
    ps = __uint_as_float(rr[0]) + __uint_as_float(rr[1]); }
  l_reg += ps;
#define PK4(P, BASE, OUT) do { unsigned a0 = cvtpk(P[BASE + 0], P[BASE + 1]), a1 = cvtpk(P[BASE + 2], P[BASE + 3]);   \
    unsigned b0 = cvtpk(P[BASE + 4], P[BASE + 5]), b1 = cvtpk(P[BASE + 6], P[BASE + 7]);                              \
    auto r0 = __builtin_amdgcn_permlane32_swap(a0, b0, false, false); auto r1 = __builtin_amdgcn_permlane32_swap(a1, b1, false, false); \
    u32x4 w = {r0[0], r1[0], r0[1], r1[1]}; OUT = *reinterpret_cast<bf16x8*>(&w); } while (0)
  PK4(p0, 0, pa0); PK4(p0, 8, pa1); PK4(p1, 0, pa2); PK4(p1, 8, pa3);
#undef PK4
}
__device__ __forceinline__ void qkt(f32x16& p0, f32x16& p1, const bf16_t* Ks, const bf16x8* qr, int r32, int hi) {
  p0 = f32x16{}; p1 = f32x16{};
  for (int d0 = 0; d0 < 8; ++d0) { int cb = (d0 * 16 + hi * 8) * 2;
    bf16x8 b0 = *reinterpret_cast<const bf16x8*>((const char*)Ks + KSWZ(r32, cb));
    bf16x8 b1 = *reinterpret_cast<const bf16x8*>((const char*)Ks + KSWZ(32 + r32, cb));
    p0 = __builtin_amdgcn_mfma_f32_32x32x16_bf16(b0, qr[d0], p0, 0, 0, 0);
    p1 = __builtin_amdgcn_mfma_f32_32x32x16_bf16(b1, qr[d0], p1, 0, 0, 0); }
}
__device__ __forceinline__ int v_st(int k, int c) { const int kk = (k & ~0xC) | ((k & 4) << 1) | ((k & 8) >> 1); return ((kk >> 3) * 4 + (c >> 5)) * 512 + ((kk & 7) * 32 + (c & 31)) * 2; }
__device__ __forceinline__ int v_rd_base(int lane) { return ((lane & 3) << 3) | (((lane >> 2) & 3) << 6) | (((lane >> 4) & 1) << 5) | (((lane >> 5) & 1) << 8); }
constexpr int v_rd_off(int d0, int ks, int half) { return d0 * 512 + ks * 4096 + half * 2048; }
template <int OFF> __device__ __forceinline__ s16x4 tr_read(int vb) {
  s16x4 r; asm volatile("ds_read_b64_tr_b16 %0, %1 offset:%2" : "=&v"(r) : "v"(vb), "i"(OFF) : "memory"); return r;
}
template <int D0> __device__ __forceinline__ void pv_one(f32x16& od, int vb, bf16x8 pa0, bf16x8 pa1, bf16x8 pa2, bf16x8 pa3) {
  const s16x4 l0 = tr_read<v_rd_off(D0, 0, 0)>(vb), h0 = tr_read<v_rd_off(D0, 0, 1)>(vb), l1 = tr_read<v_rd_off(D0, 1, 0)>(vb), h1 = tr_read<v_rd_off(D0, 1, 1)>(vb);
  const s16x4 l2 = tr_read<v_rd_off(D0, 2, 0)>(vb), h2 = tr_read<v_rd_off(D0, 2, 1)>(vb), l3 = tr_read<v_rd_off(D0, 3, 0)>(vb), h3 = tr_read<v_rd_off(D0, 3, 1)>(vb);
  asm volatile("s_waitcnt lgkmcnt(0)" ::: "memory"); SBAR();
#define PK(L, H) (bf16x8){L[0], L[1], L[2], L[3], H[0], H[1], H[2], H[3]}
  od = __builtin_amdgcn_mfma_f32_32x32x16_bf16(pa0, PK(l0, h0), od, 0, 0, 0);
  od = __builtin_amdgcn_mfma_f32_32x32x16_bf16(pa1, PK(l1, h1), od, 0, 0, 0);
  od = __builtin_amdgcn_mfma_f32_32x32x16_bf16(pa2, PK(l2, h2), od, 0, 0, 0);
  od = __builtin_amdgcn_mfma_f32_32x32x16_bf16(pa3, PK(l3, h3), od, 0, 0, 0);
#undef PK
}
__device__ __forceinline__ void pv_d0(f32x16* o, int vb, bf16x8 pa0, bf16x8 pa1, bf16x8 pa2, bf16x8 pa3) {
  pv_one<0>(o[0], vb, pa0, pa1, pa2, pa3); pv_one<1>(o[1], vb, pa0, pa1, pa2, pa3); pv_one<2>(o[2], vb, pa0, pa1, pa2, pa3); pv_one<3>(o[3], vb, pa0, pa1, pa2, pa3);
}
__device__ __forceinline__ void attn_dense_body(const bf16_t* __restrict__ Qb, const bf16_t* __restrict__ Kh, const bf16_t* __restrict__ Vh, bf16_t* __restrict__ Ob, int seq, float mbound, const float* __restrict__ qgain, int t0, char* lds) {
  const int tid = opaque_tid(), wid = tid >> 6, lane = tid & 63, r32 = lane & 31, hi = lane >> 5;
  bf16_t* V_lds = (bf16_t*)lds; bf16_t* K_lds = (bf16_t*)(lds + NRING * SHM_V);
  float* ws = (float*)(lds + NRING * SHM_V + NRING * SHM_K) + wid * 64; float* li_l = ws; float* al_l = ws + 32;
  float m_reg = mbound, l_reg = 0; f32x16 o[4]; bf16x8 qr[8];
  const bf16_t* Qw = Qb + (long)(wid * QBLK + r32) * LDQ + hi * 8;
#pragma unroll
  for (int d0 = 0; d0 < 8; ++d0) qr[d0] = *reinterpret_cast<const bf16x8*>(Qw + d0 * 16);
  {
#define UNPK8(W, X) do { X[0] = __uint_as_float(W.x << 16); X[1] = __uint_as_float(W.x & 0xffff0000u); X[2] = __uint_as_float(W.y << 16); X[3] = __uint_as_float(W.y & 0xffff0000u); \
                         X[4] = __uint_as_float(W.z << 16); X[5] = __uint_as_float(W.z & 0xffff0000u); X[6] = __uint_as_float(W.w << 16); X[7] = __uint_as_float(W.w & 0xffff0000u); } while (0)
    char* qs = lds + wid * 8192 + lane * 16;
    float ss = 0.f;
#pragma unroll
    for (int d0 = 0; d0 < 8; ++d0) { const u32x4 w = *reinterpret_cast<const u32x4*>(&qr[d0]); float x[8]; UNPK8(w, x);
#pragma unroll
      for (int j = 0; j < 8; ++j) ss += x[j] * x[j];
      *(u32x4*)(qs + d0 * 1024) = w; }
    { auto rr = __builtin_amdgcn_permlane32_swap(__float_as_uint(ss), __float_as_uint(ss), false, false); ss = __uint_as_float(rr[0]) + __uint_as_float(rr[1]); }
    const float rn = rsqrtf(ss * (1.f / 128.f) + 1e-6f);
    const int tq = t0 + wid * QBLK + r32;
#pragma unroll 1
    for (int it = 0; it < 4; ++it) { const int ax = it >> 1, d = it & 1, da = 4 * ax + d, db = da + 2;
      const float ph = (ax == 0 ? (float)(tq >> 6) : (float)(tq & 63)) * (hi ? 0.1f : 1.f) * (d ? 0.01f : 1.f);
      const u32x4 wa = *(const u32x4*)(qs + da * 1024), wb = *(const u32x4*)(qs + db * 1024);
      float xa[8], xb[8]; UNPK8(wa, xa); UNPK8(wb, xb);
      const f32x4 ga0 = *(const f32x4*)(qgain + 16 * da + 8 * hi), ga1 = *(const f32x4*)(qgain + 16 * da + 8 * hi + 4), gb0 = *(const f32x4*)(qgain + 16 * db + 8 * hi), gb1 = *(const f32x4*)(qgain + 16 * db + 8 * hi + 4);
      const float ga[8] = {ga0.x, ga0.y, ga0.z, ga0.w, ga1.x, ga1.y, ga1.z, ga1.w}, gb[8] = {gb0.x, gb0.y, gb0.z, gb0.w, gb1.x, gb1.y, gb1.z, gb1.w};
#pragma unroll
      for (int j = 0; j < 8; ++j) { const float ang = ph * ROPE_C8[j];
        const float sn = __sinf(ang), cs = __cosf(ang);
        const float x1 = xa[j] * rn * ga[j], x2 = xb[j] * rn * gb[j];
        xa[j] = x1 * cs - x2 * sn; xb[j] = x1 * sn + x2 * cs; }
      *(u32x4*)(qs + da * 1024) = (u32x4){cvtpk(xa[0], xa[1]), cvtpk(xa[2], xa[3]), cvtpk(xa[4], xa[5]), cvtpk(xa[6], xa[7])};
      *(u32x4*)(qs + db * 1024) = (u32x4){cvtpk(xb[0], xb[1]), cvtpk(xb[2], xb[3]), cvtpk(xb[4], xb[5]), cvtpk(xb[6], xb[7])}; }
#pragma unroll
    for (int d0 = 0; d0 < 8; ++d0) qr[d0] = *reinterpret_cast<const bf16x8*>(qs + d0 * 1024);
    asm volatile("s_waitcnt lgkmcnt(0)" ::: "memory");
    __syncthreads();
#undef UNPK8
  }
  SBAR();
#pragma unroll
  for (int d = 0; d < 4; ++d) o[d] = f32x16{};
  SBAR();
  const int sr = tid >> 4, sc = (tid & 15) * 8, vst0 = v_st(sr, sc), vst1 = v_st(32 + sr, sc);
  const int vb0 = (int)(uintptr_t)V_lds + v_rd_base(lane);
  struct { bf16x8 vs0, vs1, ks0, ks1; } sr_[2];
#define SLOAD(i, k0) do { sr_[i].vs0 = *(const bf16x8*)(&Vh[(long)((k0) + sr) * LDK + sc]); sr_[i].vs1 = *(const bf16x8*)(&Vh[(long)((k0) + 32 + sr) * LDK + sc]); \
    sr_[i].ks0 = *(const bf16x8*)(&Kh[(long)((k0) + sr) * LDK + sc]); sr_[i].ks1 = *(const bf16x8*)(&Kh[(long)((k0) + 32 + sr) * LDK + sc]); } while (0)
#define SWRITE(b, i) do { *(bf16x8*)((char*)V_lds + (b) * SHM_V + vst0) = sr_[i].vs0;          \
    *(bf16x8*)((char*)V_lds + (b) * SHM_V + vst1) = sr_[i].vs1; int kc = sc * 2;               \
    *(bf16x8*)((char*)K_lds + (b) * SHM_K + KSWZ(sr, kc)) = sr_[i].ks0;                       \
    *(bf16x8*)((char*)K_lds + (b) * SHM_K + KSWZ(32 + sr, kc)) = sr_[i].ks1; } while (0)
#define SWAIT() asm volatile("s_waitcnt vmcnt(4)" ::: "memory")
#define RESC(a) do { if (__any((a) < 1.f)) { if (hi == 0) al_l[r32] = (a); asm volatile("s_waitcnt lgkmcnt(0)" ::: "memory"); \
    for (int d = 0; d < 4; ++d) for (int r = 0; r < 16; ++r) o[d][r] *= al_l[crow(r, hi)]; } } while (0)
  f32x16 pA0, pA1, pB0, pB1; float mnA, mnB, alA, alB; bf16x8 pa0, pa1, pa2, pa3; const int NT = seq / KVBLK;
#define KRING(b) ((bf16_t*)((char*)K_lds + (b) * SHM_K))
#define ATT_STEP(PC0, PC1, MNC, ALC, PP0, PP1, ALP, KB, VBP, WB, SLW, SLL, TLOAD, DO_LOAD, DO_WRITE, WAIT0) do { \
    SBAR(); qkt(PC0, PC1, KRING(KB), qr, r32, hi); \
    finishSM(PP0, PP1, ALP, l_reg, pa0, pa1, pa2, pa3); SBAR(); \
    if (DO_LOAD) SLOAD(SLL, (TLOAD) * KVBLK); SBAR(); \
    pv_d0(o, vb0 + (VBP) * (int)SHM_V, pa0, pa1, pa2, pa3); partialSM(PC0, PC1, m_reg, MNC, ALC); \
    if (DO_WRITE) { if (WAIT0) asm volatile("s_waitcnt vmcnt(0)" ::: "memory"); else SWAIT(); SWRITE(WB, SLW); } \
    __syncthreads(); } while (0)
#define STEP_B(t, KB, VBP, WB, DL, DW, W0) ATT_STEP(pB0, pB1, mnB, alB, pA0, pA1, alA, KB, VBP, WB, 0, 1, (t) + 2, DL, DW, W0)
#define STEP_A(t, KB, VBP, WB, DL, DW, W0) ATT_STEP(pA0, pA1, mnA, alA, pB0, pB1, alB, KB, VBP, WB, 1, 0, (t) + 2, DL, DW, W0)
  SLOAD(0, 0); SLOAD(1, KVBLK); SWAIT(); SWRITE(0, 0); __syncthreads();
  SLOAD(0, 2 * KVBLK);
  qkt(pA0, pA1, KRING(0), qr, r32, hi); partialSM(pA0, pA1, m_reg, mnA, alA);
  SWAIT(); SWRITE(1, 1); __syncthreads();
  int t = 1, r0 = 0, r1 = 1, r2 = 2;
#define ATT_STEPR(PC0, PC1, MNC, ALC, PP0, PP1, ALP, SLW, SLL, DO_LOAD, DO_WRITE, WAIT0) do { \
    SBAR(); qkt(PC0, PC1, (bf16_t*)((char*)K_lds + r1 * (int)SHM_K), qr, r32, hi); \
    finishSM(PP0, PP1, ALP, l_reg, pa0, pa1, pa2, pa3); SBAR(); \
    if (DO_LOAD) SLOAD(SLL, (t + 2) * KVBLK); SBAR(); \
    pv_d0(o, vb0 + r0 * (int)SHM_V, pa0, pa1, pa2, pa3); partialSM(PC0, PC1, m_reg, MNC, ALC); \
    if (DO_WRITE) { if (WAIT0) asm volatile("s_waitcnt vmcnt(0)" ::: "memory"); else SWAIT(); SWRITE(r2, SLW); } \
    __syncthreads(); { const int _r = r0; r0 = r1; r1 = r2; r2 = _r; } ++t; } while (0)
#define STEPR_B(DL, DW, W0) ATT_STEPR(pB0, pB1, mnB, alB, pA0, pA1, alA, 0, 1, DL, DW, W0)
#define STEPR_A(DL, DW, W0) ATT_STEPR(pA0, pA1, mnA, alA, pB0, pB1, alB, 1, 0, DL, DW, W0)
  while (t + 3 < NT) { STEPR_B(true, true, false); STEPR_A(true, true, false); }
  STEPR_B(true, true, false);
  STEPR_A(false, true, true);
  STEPR_B(false, false, false);
  finishSM(pB0, pB1, alB, l_reg, pa0, pa1, pa2, pa3); SBAR();
  pv_d0(o, vb0 + r0 * (int)SHM_V, pa0, pa1, pa2, pa3);
#undef ATT_STEPR
#undef STEPR_A
#undef STEPR_B
#undef KRING
#undef ATT_STEP
#undef STEP_A
#undef STEP_B
  if (hi == 0) li_l[r32] = l_reg; asm volatile("s_waitcnt lgkmcnt(0)" ::: "memory");
  float rli[16];
#pragma unroll
  for (int r = 0; r < 16; ++r) rli[r] = __builtin_amdgcn_rcpf(li_l[crow(r, hi)]);
  int lane_e = lane; asm volatile("" : "+v"(lane_e));
  const int r32e = lane_e & 31, hie = lane_e >> 5;
  bf16_t* Ow = Ob + (long)(wid * QBLK) * LDO;
#pragma unroll
  for (int r = 0; r < 16; ++r) { int orow = crow(r, hie);
    for (int d0 = 0; d0 < 4; ++d0) Ow[(long)orow * LDO + d0 * 32 + r32e] = f2bf(o[d0][r] * rli[r]); }
  __syncthreads();
#undef SLOAD
#undef SWRITE
#undef SWAIT
#undef RESC
}
}

#define XB_TMO      128
#define XB_XCNT(j)  (256  + 64 * (j))
#define XB_XSUB(j)  (1280 + 64 * (j))
#define XB_XGEN(j)  (2304 + 64 * (j))
#define XB_TOP      3328
#define XB_TOPGEN   3392
#define XCD_BAR_WORDS 3456
#define XB_SPIN_CAP (1u << 18)

__device__ __forceinline__ unsigned xb_ld(unsigned* p)              { return __hip_atomic_load(p, __ATOMIC_RELAXED, __HIP_MEMORY_SCOPE_AGENT); }
__device__ __forceinline__ unsigned xb_add(unsigned* p, unsigned v) { return __hip_atomic_fetch_add(p, v, __ATOMIC_RELAXED, __HIP_MEMORY_SCOPE_AGENT); }
__device__ __forceinline__ unsigned xb_xcc_id() { return (unsigned)__builtin_amdgcn_s_getreg((3 << 11) | 20) & 0xFu; }
#define XB_SPIN(cond, bar) do { unsigned _sp = 0; while (cond) { __builtin_amdgcn_s_sleep(1); \
    if ((++_sp & 255u) == 0u) { if (xb_ld(&(bar)[XB_TMO])) break; if (_sp > XB_SPIN_CAP) { atomicAdd(&(bar)[XB_TMO], 1u); break; } } } } while (0)

struct XcdBarrier {
    unsigned* bar; unsigned x;
    volatile LAS unsigned* st;
};

__device__ __forceinline__ XcdBarrier xcd_barrier_post(unsigned* bar, volatile LAS unsigned* st) {
    XcdBarrier b; b.bar = bar; b.x = (unsigned)__builtin_amdgcn_readfirstlane((int)xb_xcc_id()); b.st = st;
    if (opaque_tid() == 0) (void)xb_add(&bar[XB_XCNT(b.x)], 1u);
    return b;
}
__device__ __forceinline__ void xcd_barrier_complete(unsigned* bar, unsigned x, unsigned& nloc, unsigned& nx) {
    const unsigned G = gridDim.x * gridDim.y * gridDim.z;
    unsigned sum, cnt, mine, sp = 0u;
    for (;;) {
        sum = 0u; cnt = 0u; mine = 0u;
#pragma unroll 1
        for (unsigned j = 0; j < 16; ++j) { const unsigned c = xb_ld(&bar[XB_XCNT(j)]); sum += c; cnt += (c > 0u) ? 1u : 0u; mine = (j == x) ? c : mine; }
        if (sum == G) break;
        __builtin_amdgcn_s_sleep(1);
        if ((++sp & 255u) == 0u) { if (xb_ld(&bar[XB_TMO])) break; if (sp > XB_SPIN_CAP) { atomicAdd(&bar[XB_TMO], 1u); break; } }
    }
    nloc = mine > 0u ? mine : 1u; nx = cnt > 0u ? cnt : 1u;
}

__device__ __forceinline__ void xcd_barrier(const XcdBarrier& b) {
    asm volatile("s_waitcnt vmcnt(0)" ::: "memory");
    __syncthreads();
    if (opaque_tid() == 0) {
        unsigned* bar = b.bar; unsigned bx = b.x; asm volatile("" : "+s"(bx));
        __builtin_amdgcn_s_waitcnt(0);
        unsigned nloc = b.st[0], nx = b.st[1];
        if (nloc == 0u) { xcd_barrier_complete(bar, bx, nloc, nx); b.st[0] = nloc; b.st[1] = nx; }
        const unsigned old = xb_add(&bar[XB_XSUB(bx)], 1u);
        const unsigned gen = old / nloc;
        if (old + 1u == (gen + 1u) * nloc) {
            __builtin_amdgcn_fence(__ATOMIC_RELEASE, "agent");
            asm volatile("s_waitcnt vmcnt(0)" ::: "memory");
            const unsigned og = xb_add(&bar[XB_TOP], 1u);
            const unsigned tg = og / nx;
            if (og + 1u == (tg + 1u) * nx) xb_add(&bar[XB_TOPGEN], 1u);
            else XB_SPIN(xb_ld(&bar[XB_TOPGEN]) == tg, bar);
            __builtin_amdgcn_fence(__ATOMIC_ACQUIRE, "agent");
            xb_add(&bar[XB_XGEN(bx)], 1u);
            asm volatile("s_waitcnt vmcnt(0)" ::: "memory");
        } else {
            XB_SPIN(xb_ld(&bar[XB_XGEN(bx)]) == gen, bar);
            __builtin_amdgcn_fence(__ATOMIC_ACQUIRE, "agent");
            asm volatile("s_waitcnt vmcnt(0)" ::: "memory");
        }
    }
    __syncthreads();
}


#if MK_TS_PHASE >= 16
#define BLD_TS(k) do { if (blockIdx.x == 0 && tid == 0) ((unsigned long long*)((unsigned*)(p.ws + WS_CTL) + CTL_TS))[(k) + 8] = __builtin_amdgcn_s_memrealtime(); } while (0)
#else
#define BLD_TS(k) do { } while (0)
#endif
__device__ __forceinline__ void s5_build_tables(const Params& p, LAS unsigned char* lds, int g) {
  const int tid = opaque_tid();
  BLD_TS(16);
  LAS float* Bb = (LAS float*)lds;
  LAS float* Cc = Bb + 4096;
  LAS float* PW = Cc + 4096;
  LAS float* KK = PW + 4352;
  {
    const int d = tid >> 8, pi = (tid >> 2) & 63, nq = tid & 3, dg = d * 32 + g, idx = dg * 64 + pi;
    const float are = p.in[I_SARE][idx], aim = p.in[I_SAIM][idx];
    const float dt = expf(p.in[I_SLDT][dg]);
    const float lam = are * dt, om = aim * dt;
    for (int n = nq; n <= 16; n += 4) { const float ea = expf(lam * (float)n); float sn, cs; sincosf(om * (float)n, &sn, &cs);
      PW[((d * 17 + n) * 64 + pi) * 2] = ea * cs; PW[((d * 17 + n) * 64 + pi) * 2 + 1] = ea * sn; }
  }
  __syncthreads();
  {
    const int d = tid >> 8, pi = (tid >> 2) & 63, c0 = (tid & 3) * 4, dg = d * 32 + g, idx = dg * 64 + pi;
    const float are = p.in[I_SARE][idx], aim = p.in[I_SAIM][idx];
    const f32x4 bre = *(const f32x4*)(p.in[I_SBRE] + idx * 16 + c0), bim = *(const f32x4*)(p.in[I_SBIM] + idx * 16 + c0);
    float cre[4], cim[4];
#pragma unroll
    for (int q = 0; q < 4; ++q) { cre[q] = p.in[I_SCRE][(dg * 16 + c0 + q) * 64 + pi]; cim[q] = p.in[I_SCIM][(dg * 16 + c0 + q) * 64 + pi]; }
    const float abr = PW[((d * 17 + 1) * 64 + pi) * 2], abi = PW[((d * 17 + 1) * 64 + pi) * 2 + 1];
    const float den = are * are + aim * aim;
    const float nr = abr - 1.f, ni = abi;
    const float rr = (nr * are + ni * aim) / den, ri = (ni * are - nr * aim) / den;
#pragma unroll
    for (int q = 0; q < 4; ++q) { const int c = c0 + q;
      Bb[((d * 64 + pi) * 16 + c) * 2] = rr * bre[q] - ri * bim[q]; Bb[((d * 64 + pi) * 16 + c) * 2 + 1] = rr * bim[q] + ri * bre[q];
      Cc[((d * 16 + c) * 64 + pi) * 2] = cre[q]; Cc[((d * 16 + c) * 64 + pi) * 2 + 1] = cim[q]; }
  }
  __syncthreads();
  BLD_TS(17);
  {
    const int d = tid >> 8, tau = (tid >> 4) & 15, c = tid & 15;
    float s[16];
#pragma unroll
    for (int c2 = 0; c2 < 16; ++c2) s[c2] = 0.f;
    for (int pi = 0; pi < 64; ++pi) {
      const f32x2 cv = *(const LAS f32x2*)(Cc + ((d * 16 + c) * 64 + pi) * 2), av = *(const LAS f32x2*)(PW + ((d * 17 + tau) * 64 + pi) * 2);
      const float mr = cv.x * av.x - cv.y * av.y, mi = cv.x * av.y + cv.y * av.x;
      const LAS f32x4* bp = (const LAS f32x4*)(Bb + ((d * 64 + pi) * 16) * 2);
#pragma unroll
      for (int q = 0; q < 8; ++q) { const f32x4 b = bp[q]; s[2 * q] += mr * b.x - mi * b.y; s[2 * q + 1] += mr * b.z - mi * b.w; }
    }
#pragma unroll
    for (int c2 = 0; c2 < 16; ++c2) KK[((d * 16 + tau) * 16 + c) * 16 + c2] = s[c2];
  }
  __syncthreads();
  BLD_TS(18);
  bf16_t* T = (bf16_t*)(p.ws + WS_S5T) + (size_t)g * 256 * 512;
  for (int o = tid; o < 256 * 32; o += 512) {
    const int n = o >> 5, ko = o & 31, i = n >> 4, c = n & 15, j = ko >> 1, c20 = (ko & 1) * 8;
    f32x4 x0 = (f32x4){0.f, 0.f, 0.f, 0.f}, x1 = x0;
    if (i >= j) { const LAS f32x4* kp = (const LAS f32x4*)(KK + ((0 * 16 + (i - j)) * 16 + c) * 16 + c20); x0 += kp[0]; x1 += kp[1]; }
    if (j >= i) { const LAS f32x4* kp = (const LAS f32x4*)(KK + ((1 * 16 + (j - i)) * 16 + c) * 16 + c20); x0 += kp[0]; x1 += kp[1]; }
    if (i == j && (c >> 3) == (ko & 1)) { const float dd = p.in[I_SD][g * 16 + c]; const int q = c & 7;
      if (q < 4) x0[q] += dd; else x1[q - 4] += dd; }
    u32x4 w; w.x = cvt_pk_bf16(x0[0], x0[1]); w.y = cvt_pk_bf16(x0[2], x0[3]); w.z = cvt_pk_bf16(x1[0], x1[1]); w.w = cvt_pk_bf16(x1[2], x1[3]);
    *(u32x4*)(T + (size_t)n * 512 + ko * 8) = w;
  }
  for (int o = tid; o < 256 * 32; o += 512) {
    const int n = o >> 5, ko = o & 31, i = n >> 4, c = n & 15, dd_ = ko >> 4, part = (ko >> 3) & 1, pi0 = (ko & 7) * 8, n_pw = dd_ ? (16 - i) : (i + 1);
    const LAS f32x4* cp = (const LAS f32x4*)(Cc + ((dd_ * 16 + c) * 64 + pi0) * 2);
    const LAS f32x4* ap = (const LAS f32x4*)(PW + ((dd_ * 17 + n_pw) * 64 + pi0) * 2);
    float x[8];
#pragma unroll
    for (int q = 0; q < 4; ++q) { const f32x4 cv = cp[q], av = ap[q];
      x[2 * q] = part ? -(cv.x * av.y + cv.y * av.x) : (cv.x * av.x - cv.y * av.y);
      x[2 * q + 1] = part ? -(cv.z * av.w + cv.w * av.z) : (cv.z * av.z - cv.w * av.w); }
    u32x4 w; w.x = cvt_pk_bf16(x[0], x[1]); w.y = cvt_pk_bf16(x[2], x[3]); w.z = cvt_pk_bf16(x[4], x[5]); w.w = cvt_pk_bf16(x[6], x[7]);
    *(u32x4*)(T + (size_t)n * 512 + 256 + ko * 8) = w;
  }
  BLD_TS(19);
  bf16_t* E = (bf16_t*)(p.ws + WS_S5E) + (size_t)g * 256 * 256;
  for (int o = tid; o < 256 * 32; o += 512) {
    const int n = o >> 5, ko = o & 31, dd_ = n >> 7, part = (n >> 6) & 1, pi = n & 63, j = ko >> 1, c20 = (ko & 1) * 8, n_pw = dd_ ? j : (15 - j);
    const f32x2 av = *(const LAS f32x2*)(PW + ((dd_ * 17 + n_pw) * 64 + pi) * 2);
    const LAS f32x4* bp = (const LAS f32x4*)(Bb + ((dd_ * 64 + pi) * 16 + c20) * 2);
    float x[8];
#pragma unroll
    for (int q = 0; q < 4; ++q) { const f32x4 bv = bp[q];
      x[2 * q] = part ? (av.x * bv.y + av.y * bv.x) : (av.x * bv.x - av.y * bv.y);
      x[2 * q + 1] = part ? (av.x * bv.w + av.y * bv.z) : (av.x * bv.z - av.y * bv.w); }
    u32x4 w; w.x = cvt_pk_bf16(x[0], x[1]); w.y = cvt_pk_bf16(x[2], x[3]); w.z = cvt_pk_bf16(x[4], x[5]); w.w = cvt_pk_bf16(x[6], x[7]);
    *(u32x4*)(E + (size_t)n * 256 + ko * 8) = w;
  }
  BLD_TS(20);
  __syncthreads();
}

struct SchedS5S {
  static constexpr bool GATHER = false, HAS_DONE = false, HALF = false;
  int G, c;
  __device__ __forceinline__ bool next(int i, pg::Unit& u) const {
    const int L = i * G + c; if (L >= 160) return false;
    u.aux = L / 5; u.pm = L % 5; u.pn = 0; u.arow = u.pm * 256; return true;
  }
};
struct EpiS5S {
  static constexpr bool PERM = false;
  float* S;
  __device__ __forceinline__ void operator()(const pg::Acc& acc, const pg::Unit& u, int wr, int wc, int fr, int fq) const {
    const int row0 = u.arow + wr * 64 + fr, col0 = wc * 32 + 4 * fq;
#pragma unroll
    for (int ai = 0; ai < 2; ++ai)
#pragma unroll
      for (int m = 0; m < 4; ++m) { const int r = row0 + ai * 128 + m * 16;
        if (r < NCHUNK) { float* rowp = S + ((size_t)u.aux * NCHUNK + r) * 256 + col0;
#pragma unroll
          for (int bj = 0; bj < 2; ++bj)
#pragma unroll
            for (int n = 0; n < 2; ++n) *(f32x4*)(rowp + bj * 128 + n * 16) = acc[ai][bj][m][n]; } }
  }
};
__device__ __forceinline__ void phase_s5s(const Params& p, LAS unsigned char* lds) {
  pg::Addr AD{(const bf16_t*)((unsigned char*)p.out + DO_YA), 512, (size_t)NCHUNK * 512, (const bf16_t*)(p.ws + WS_S5E), 256, (size_t)256 * 256, false};
  SchedS5S S{(int)gridDim.x, (int)blockIdx.x};
  EpiS5S E{(float*)(p.ws + WS_RH)};
  pg::gemm_phase(lds, AD, S, E);
}

__device__ __forceinline__ void s5_scan_item(const Params& p, int item, int lane) {
  const int d = item & 1, g = (item >> 1) & 31, b = item >> 6;
  const float* S = (const float*)(p.ws + WS_RH) + (size_t)g * NCHUNK * 256 + d * 128 + lane;
  bf16_t* YA = (bf16_t*)((unsigned char*)p.out + DO_YA) + (size_t)g * NCHUNK * 512 + 256 + d * 128 + lane;
  const int idx = (d * 32 + g) * 64 + lane;
  const float dt = expf(p.in[I_SLDT][d * 32 + g]);
  const float ea = expf(p.in[I_SARE][idx] * dt * 16.f); float sn, cs; sincosf(p.in[I_SAIM][idx] * dt * 16.f, &sn, &cs);
  const float ar = ea * cs, ai = ea * sn;
  float hr = 0.f, hi = 0.f;
  const int r0 = b * 528;
#pragma unroll 4
  for (int s = 0; s < 16; ++s) { const int r = r0 + 512 + (d ? 15 - s : s);
    const float sr = S[(size_t)r * 256], si = S[(size_t)r * 256 + 64];
    const float nr = ar * hr - ai * hi + sr, ni = ar * hi + ai * hr + si; hr = nr; hi = ni; }
  float sa[16], sb[16];
#define SCAN_LOAD(buf, s0) do { _Pragma("unroll") for (int q = 0; q < 8; ++q) { const int r = r0 + (d ? 511 - ((s0) + q) : (s0) + q); buf[2 * q] = S[(size_t)r * 256]; buf[2 * q + 1] = S[(size_t)r * 256 + 64]; } } while (0)
#define SCAN_STEP(buf, s0) do { _Pragma("unroll") for (int q = 0; q < 8; ++q) { const int r = r0 + (d ? 511 - ((s0) + q) : (s0) + q); \
    YA[(size_t)r * 512] = f2bf(hr); YA[(size_t)r * 512 + 64] = f2bf(hi); \
    const float nr = ar * hr - ai * hi + buf[2 * q], ni = ar * hi + ai * hr + buf[2 * q + 1]; hr = nr; hi = ni; } } while (0)
  SCAN_LOAD(sa, 0);
  for (int s = 0; s < 512; s += 16) {
    SCAN_LOAD(sb, s + 8);
    SCAN_STEP(sa, s);
    if (s + 16 < 512) SCAN_LOAD(sa, s + 16);
    SCAN_STEP(sb, s + 8);
  }
#undef SCAN_LOAD
#undef SCAN_STEP
}
__device__ __forceinline__ void phase_s5scan(const Params& p) {
  const int tid_ = opaque_tid(); const int lane = tid_ & 63, wave = tid_ >> 6;
  const int gw = blockIdx.x * NWAVES + wave;
  if (gw < 128) s5_scan_item(p, gw, lane);
}

struct SchedS5Y {
  static constexpr bool GATHER = false, HAS_DONE = false, HALF = false;
  int G, c;
  __device__ __forceinline__ bool next(int i, pg::Unit& u) const {
    const int L = i * G + (MK_S5_IN_P3 ? c : ((c + G / 2) % G)); if (L >= 128) return false;
    u.aux = L >> 2; u.pm = L & 3; u.pn = 0; u.arow = (u.pm >> 1) * 528 + (u.pm & 1) * 256; return true;
  }
};
struct EpiS5Y {
  static constexpr bool PERM = true;
  bf16_t* GY;
  __device__ __forceinline__ void operator()(const pg::Acc& acc, const pg::Unit& u, int wr, int wc, int fr, int fq) const {
    const int row0 = u.arow + wr * 64 + fr;
#pragma unroll
    for (int ai = 0; ai < 2; ++ai)
#pragma unroll
      for (int m = 0; m < 4; ++m) { const int chunk = row0 + ai * 128 + m * 16;
#pragma unroll
        for (int bj = 0; bj < 2; ++bj) { const int col = bj * 128 + wc * 32 + 8 * fq, ti = col >> 4, c0 = col & 15;
          float o[8];
#pragma unroll
          for (int n = 0; n < 2; ++n)
#pragma unroll
            for (int e = 0; e < 4; ++e) o[n * 4 + e] = gelu_tanh(acc[ai][bj][m][n][e]);
          u32x4 w; w.x = cvt_pk_bf16(o[0], o[1]); w.y = cvt_pk_bf16(o[2], o[3]); w.z = cvt_pk_bf16(o[4], o[5]); w.w = cvt_pk_bf16(o[6], o[7]);
          *(u32x4*)(GY + (size_t)(chunk * 16 + ti) * 512 + u.aux * 16 + c0) = w; } }
  }
};
__device__ __forceinline__ void phase_s5y(const Params& p, LAS unsigned char* lds) {
  pg::Addr AD{(const bf16_t*)((unsigned char*)p.out + DO_YA), 512, (size_t)NCHUNK * 512, (const bf16_t*)(p.ws + WS_S5T), 512, (size_t)256 * 512, false};
  SchedS5Y S{(int)gridDim.x, (int)blockIdx.x};
  EpiS5Y E{(bf16_t*)((unsigned char*)p.out + DO_GY)};
  pg::gemm_phase(lds, AD, S, E);
}
__device__ __forceinline__ void map_static(int L, int nM, int nN, int& pm, int& pn) {
  const int nwg = nM * nN; int wgid = L;
  { const int q = nwg / 8, r = nwg % 8, xcd = wgid % 8, off = wgid / 8; wgid = (xcd < r ? xcd * (q + 1) : r * (q + 1) + (xcd - r) * q) + off; }
  const int nig = 8 * nN, gid = wgid / nig, fm = gid * 8, gsz = (nM - fm) < 8 ? (nM - fm) : 8;
  pm = fm + ((wgid % nig) % gsz); pn = (wgid % nig) / gsz;
}

struct CvtItem { const float* src; bf16_t* dst; int ldw, ldd; };
__device__ __forceinline__ void cvt_load(const CvtItem& d, f32x4 (&r)[8], int lane) {
  const float* s = d.src + (size_t)(lane >> 3) * d.ldw + 4 * (lane & 7);
#pragma unroll
  for (int i = 0; i < 8; ++i) r[i] = __builtin_nontemporal_load((const f32x4*)(s + (size_t)(8 * i) * d.ldw));
}
__device__ __forceinline__ void cvt_store(const CvtItem& d, const f32x4 (&r)[8], LAS float* scr, int lane) {
  LAS float* w = scr + (lane >> 3) * 33 + 4 * (lane & 7);
#pragma unroll
  for (int i = 0; i < 8; ++i) { w[(8 * i) * 33 + 0] = r[i].x; w[(8 * i) * 33 + 1] = r[i].y; w[(8 * i) * 33 + 2] = r[i].z; w[(8 * i) * 33 + 3] = r[i].w; }
  asm volatile("s_waitcnt lgkmcnt(0)" ::: "memory");
  const int c = lane & 7;
#pragma unroll
  for (int j = 0; j < 4; ++j) { const int n = (lane >> 3) + 8 * j; const LAS float* s = scr + (8 * c) * 33 + n;
    u32x4 o; o.x = cvt_pk_bf16(s[0 * 33], s[1 * 33]); o.y = cvt_pk_bf16(s[2 * 33], s[3 * 33]); o.z = cvt_pk_bf16(s[4 * 33], s[5 * 33]); o.w = cvt_pk_bf16(s[6 * 33], s[7 * 33]);
    *(u32x4*)(d.dst + (size_t)n * d.ldd + 8 * c) = o; }
  asm volatile("s_waitcnt lgkmcnt(0)" ::: "memory");
}
__device__ __forceinline__ int ilv_row(int n, int second) { return (n >> 7) * 256 + (n & 127) + second * 128; }

constexpr int CV_WIN = (1024 / 64) * (4096 / 32);
constexpr int CV_GLU = (512 / 64) * (1024 / 32);
constexpr int CV_SQ = (1024 / 64) * (1024 / 32);
constexpr int CV_EGU = (1024 / 64) * (512 / 32);
constexpr int CV_ED = (512 / 64) * (1024 / 32);
constexpr int CV_SMALL = CV_WIN + 2 * CV_GLU + 2 * CV_SQ;
constexpr int CV_TOTAL = CV_SMALL + 32 * (2 * CV_EGU + CV_ED);

#if MK_CVT_42
__device__ __forceinline__ void cvt_kn(int it, int nb, int& kb_, int& nb_) { const int grp = it >> 3, w = it & 7, gpr = nb >> 1; kb_ = 4 * (grp / gpr) + (w >> 1); nb_ = 2 * (grp % gpr) + (w & 1); }
#else
__device__ __forceinline__ void cvt_kn(int it, int nb, int& kb_, int& nb_) { const int grp = it >> 3, w = it & 7, gpr = nb >> 2; kb_ = 2 * (grp / gpr) + (w >> 2); nb_ = 4 * (grp % gpr) + (w & 3); }
#endif
__device__ __forceinline__ CvtItem cvt_desc(const Params& p, int it) {
  unsigned char* ws = p.ws;
  if (it < CV_WIN) { const int nb = 4096 / 32; int kb_, nb_; cvt_kn(it, nb, kb_, nb_); const int n0 = 32 * nb_, k0 = 64 * kb_;
    return CvtItem{p.in[I_WIN] + (size_t)k0 * 4096 + n0, (bf16_t*)(ws + WS_WIN) + (size_t)n0 * 1024 + k0, 4096, 1024}; }
  it -= CV_WIN;
  if (it < 2 * CV_GLU) { const int second = it / CV_GLU; it %= CV_GLU; const int nb = 1024 / 32; int kb_, nb_; cvt_kn(it, nb, kb_, nb_); const int n0 = 32 * nb_, k0 = 64 * kb_;
    return CvtItem{p.in[second ? I_WGB : I_WGA] + (size_t)k0 * 1024 + n0, (bf16_t*)(ws + WS_WGLU) + (size_t)ilv_row(n0, second) * 512 + k0, 1024, 512}; }
  it -= 2 * CV_GLU;
  if (it < 2 * CV_SQ) { const int second = it / CV_SQ; it %= CV_SQ; const int nb = 1024 / 32; int kb_, nb_; cvt_kn(it, nb, kb_, nb_); const int n0 = 32 * nb_, k0 = 64 * kb_;
    return CvtItem{p.in[second ? I_WOUT : I_WAO] + (size_t)k0 * 1024 + n0, (bf16_t*)(ws + (second ? WS_WOUT : WS_WAO)) + (size_t)n0 * 1024 + k0, 1024, 1024}; }
  it -= 2 * CV_SQ;
  const int per_e = 2 * CV_EGU + CV_ED, e = it / per_e; it %= per_e;
  if (it < 2 * CV_EGU) { const int second = it / CV_EGU; it %= CV_EGU; const int nb = 512 / 32; int kb_, nb_; cvt_kn(it, nb, kb_, nb_); const int n0 = 32 * nb_, k0 = 64 * kb_;
    return CvtItem{p.in[second ? I_WEU : I_WEG] + (size_t)e * 1024 * 512 + (size_t)k0 * 512 + n0, (bf16_t*)(ws + WS_WGU) + ((size_t)e * 1024 + ilv_row(n0, second)) * 1024 + k0, 512, 1024}; }
  it -= 2 * CV_EGU;
  { const int nb = 1024 / 32; int kb_, nb_; cvt_kn(it, nb, kb_, nb_); const int n0 = 32 * nb_, k0 = 64 * kb_;
    return CvtItem{p.in[I_WED] + (size_t)e * 512 * 1024 + (size_t)k0 * 1024 + n0, (bf16_t*)(ws + WS_WD) + ((size_t)e * 1024 + n0) * 512 + k0, 1024, 512}; }
}
#if MK_CVT_DEPTH3
template <bool SIGNAL_WIN> __device__ __forceinline__ void cvt_run(const Params& p, int lo, int CV_END, int gw, int NGW, LAS float* scr, int lane) {
  int it = lo + gw; if (it >= CV_END) return;
  f32x4 ra[8], rb[8], rc[8];
  CvtItem da = cvt_desc(p, it), db = da, dc = da;
  cvt_load(da, ra, lane);
  if (it + NGW < CV_END) { db = cvt_desc(p, it + NGW); cvt_load(db, rb, lane); }
  for (;;) {
    if (it + 2 * NGW < CV_END) { dc = cvt_desc(p, it + 2 * NGW); cvt_load(dc, rc, lane); }
    cvt_store(da, ra, scr, lane); it += NGW; if (it >= CV_END) break;
    if (it + 2 * NGW < CV_END) { da = cvt_desc(p, it + 2 * NGW); cvt_load(da, ra, lane); }
    cvt_store(db, rb, scr, lane); it += NGW; if (it >= CV_END) break;
    if (it + 2 * NGW < CV_END) { db = cvt_desc(p, it + 2 * NGW); cvt_load(db, rb, lane); }
    cvt_store(dc, rc, scr, lane); it += NGW; if (it >= CV_END) break;
  }
}
#else
template <bool SIGNAL_WIN> __device__ __forceinline__ void cvt_run(const Params& p, int lo, int CV_END, int gw, int NGW, LAS float* scr, int lane) {
  int it = lo + gw; if (it >= CV_END) return;
  CvtItem d = cvt_desc(p, it); f32x4 ra[8], rb[8];
  cvt_load(d, ra, lane);
  for (;;) {
    const int nit = it + NGW; const bool more = nit < CV_END; CvtItem dn = d;
    if (more) { dn = cvt_desc(p, nit); cvt_load(dn, rb, lane); }
    cvt_store(d, ra, scr, lane);
#if MK_CTX_IN_PRO
    if (SIGNAL_WIN && it < CV_WIN && nit >= CV_WIN) {
      asm volatile("s_waitcnt vmcnt(0)" ::: "memory"); __builtin_amdgcn_fence(__ATOMIC_RELEASE, "agent");
      if (lane == 0) __hip_atomic_fetch_add((unsigned*)(p.ws + WS_CTL) + CTL_WINCNT, 1u, __ATOMIC_RELAXED, __HIP_MEMORY_SCOPE_AGENT); }
#endif
    if (!more) break;
#pragma unroll
    for (int i = 0; i < 8; ++i) ra[i] = rb[i];
    d = dn; it = nit;
  }
}

#endif
__device__ __forceinline__ const float* ln_src_row(const Params& p, int pr) {
  const int b = pr / SKV, t = pr % SKV;
  return (t < SEQ) ? p.in[I_X] + ((size_t)b * SEQ + t) * DM : p.in[I_CTX] + ((size_t)b * NCTX + (t - SEQ)) * DM;
}
template <bool LAT> __device__ __forceinline__ void ln_batch_load_t(const Params& p, int r0, int NGW, f32x4 (&v)[4][4], int lane) {
#pragma unroll
  for (int r = 0; r < 4; ++r) { const int ri = r0 + r * NGW;
    if (ri < (LAT ? NLAT : NROW)) { const float* xr = LAT ? p.in[I_X] + (size_t)ri * DM : ln_src_row(p, ri);
#pragma unroll
      for (int j = 0; j < 4; ++j) v[r][j] = ((const f32x4*)xr)[lane + 64 * j]; } }
}
__device__ __forceinline__ void ln_batch_load(const Params& p, int pr0, int NGW, f32x4 (&v)[4][4], int lane) { ln_batch_load_t<false>(p, pr0, NGW, v, lane); }
__device__ __forceinline__ void ln_batch_load_lat(const Params& p, int lr0, int NGW, f32x4 (&v)[4][4], int lane) { ln_batch_load_t<true>(p, lr0, NGW, v, lane); }
template <bool LAT> __device__ __forceinline__ void ln_batch_run_t(const Params& p, int r0, int NGW, f32x4 (&v)[4][4], int lane) {
  const float* mod = (const float*)(p.ws + WS_MOD);
  bf16_t* H = (bf16_t*)(p.ws + WS_RH);
#pragma unroll
  for (int r = 0; r < 4; ++r) { const int ri = r0 + r * NGW; const int pr = LAT ? lat2pad(ri) : ri;
    if (ri < (LAT ? NLAT : NROW)) {
      const int b = pr / SKV, t = pr % SKV;
      const float* mrow = mod + ((t < SEQ) ? b : 2) * NMOD;
      f32x4 sh[4], sc[4];
#pragma unroll
      for (int j = 0; j < 4; ++j) { const int col = (lane + 64 * j) * 4; sh[j] = *(const f32x4*)(mrow + col); sc[j] = *(const f32x4*)(mrow + DM + col); }
      float s = 0;
#pragma unroll
      for (int j = 0; j < 4; ++j) s += (v[r][j].x + v[r][j].y) + (v[r][j].z + v[r][j].w);
      const float mean = wave_sum(s) * (1.f / DM); float s2 = 0;
#pragma unroll
      for (int j = 0; j < 4; ++j) { v[r][j] = v[r][j] - mean; s2 += (v[r][j].x * v[r][j].x + v[r][j].y * v[r][j].y) + (v[r][j].z * v[r][j].z + v[r][j].w * v[r][j].w); }
      const float rstd = rsqrtf(wave_sum(s2) * (1.f / DM) + LN_EPS);
#pragma unroll
      for (int j = 0; j < 4; ++j) {
        const int col = (lane + 64 * j) * 4;
        const f32x4 o = v[r][j] * rstd * (sc[j] + 1.f) + sh[j];
        u32x2 w; w.x = cvt_pk_bf16(o.x, o.y); w.y = cvt_pk_bf16(o.z, o.w);
        *(u32x2*)(H + (size_t)pr * DM + col) = w;
      }
    } }
}
__device__ __forceinline__ void ln_batch_run(const Params& p, int pr0, int NGW, f32x4 (&v)[4][4], int lane) { ln_batch_run_t<false>(p, pr0, NGW, v, lane); }
__device__ __forceinline__ void ln_batch_run_lat(const Params& p, int lr0, int NGW, f32x4 (&v)[4][4], int lane) { ln_batch_run_t<true>(p, lr0, NGW, v, lane); }
struct SchedIn {
  static constexpr bool GATHER = false, HAS_DONE = false, HALF = false;
  int G, c;
  __device__ __forceinline__ bool next(int i, pg::Unit& u) const {
    const int L = i * G + c; u.aux = 0;
    if (L < 1024) { int lm, pn; map_static(L, 64, 16, lm, pn); u.pm = lm + (lm >> 5); u.pn = pn; u.arow = u.pm * 256; return true; }
    int nctxu = (MK_CTX_MINI && !MK_CTX_KEEP) ? 0 : 8; asm volatile("" : "+s"(nctxu));
    if (((!MK_CTX_IN_P1 && !MK_CTX_IN_PRO) || G < 64) && L < 1024 + nctxu) { const int j = L - 1024; u.pm = (j < 4) ? 32 : 65; const int q = j & 3; u.pn = (q < 2) ? q : q + 4; u.arow = u.pm * 256; return true; }
    return false;
  }
};
struct EpiIn {
  static constexpr bool PERM = true;
  bf16_t* YA; bf16_t* P;
#ifdef MK_NOEPI_PROBE
  volatile LAS int* skipflag;
#endif
  __device__ __forceinline__ void operator()(const pg::Acc& acc, const pg::Unit& u, int wr, int wc, int fr, int fq) const {
    const int row0 = u.pm * 256 + wr * 64 + fr;
#ifdef MK_NOEPI_PROBE
    if (*skipflag) return;
#endif
    if (u.pn < 2) {
#pragma unroll
      for (int ai = 0; ai < 2; ++ai)
#pragma unroll
        for (int m = 0; m < 4; ++m) { const int r = row0 + ai * 128 + m * 16, chunk = r >> 4, ti = r & 15;
#pragma unroll
          for (int bj = 0; bj < 2; ++bj) { const int ch = u.pn * 256 + bj * 128 + wc * 32 + 8 * fq, g = ch >> 4, off = ch & 15;
            const f32x4 v0 = acc[ai][bj][m][0], v1 = acc[ai][bj][m][1];
            u32x4 w; w.x = cvt_pk_bf16(v0[0], v0[1]); w.y = cvt_pk_bf16(v0[2], v0[3]); w.z = cvt_pk_bf16(v1[0], v1[1]); w.w = cvt_pk_bf16(v1[2], v1[3]);
            *(u32x4*)(YA + ((size_t)g * NCHUNK + chunk) * 512 + ti * 16 + off) = w; } }
    } else {
      const int colb = (u.pn - 2) * 256 + wc * 32 + 8 * fq; const bool sig = u.pn >= 8;
#pragma unroll
      for (int ai = 0; ai < 2; ++ai)
#pragma unroll
        for (int m = 0; m < 4; ++m) { bf16_t* rowp = P + (size_t)(row0 + ai * 128 + m * 16) * PLD + colb;
#pragma unroll
          for (int bj = 0; bj < 2; ++bj) { f32x4 v0 = acc[ai][bj][m][0], v1 = acc[ai][bj][m][1];
            if (sig) {
#pragma unroll
              for (int e = 0; e < 4; ++e) { v0[e] = __builtin_amdgcn_rcpf(1.f + __builtin_amdgcn_exp2f(-1.4426950408889634f * v0[e])); v1[e] = __builtin_amdgcn_rcpf(1.f + __builtin_amdgcn_exp2f(-1.4426950408889634f * v1[e])); } }
            u32x4 w; w.x = cvt_pk_bf16(v0[0], v0[1]); w.y = cvt_pk_bf16(v0[2], v0[3]); w.z = cvt_pk_bf16(v1[0], v1[1]); w.w = cvt_pk_bf16(v1[2], v1[3]);
            *(u32x4*)(rowp + bj * 128) = w; } }
    }
  }
};
#if MK_CTX_MINI
__device__ __forceinline__ void ctx_mini_gemm(const Params& p) {
  const int tid = opaque_tid(), lane = tid & 63, w = tid >> 6, fr = lane & 15, fq = lane >> 4;
  const bf16_t* H = (const bf16_t*)(p.ws + WS_RH); const bf16_t* W = (const bf16_t*)(p.ws + WS_WIN);
  bf16_t* YA = (bf16_t*)((unsigned char*)p.out + DO_YA); bf16_t* P = (bf16_t*)(p.ws + WS_P);
  for (int mu = blockIdx.x; mu < 256; mu += gridDim.x) {
    const int rg = mu >> 4, cg = mu & 15;
    const int row0 = (rg < 8 ? SEQ + rg * 32 : SKV + SEQ + (rg - 8) * 32) + (w >> 2) * 16;
    const int col0 = (cg < 8 ? cg * 64 : 1024 + cg * 64) + (w & 3) * 16;
    const bf16x8* ap = (const bf16x8*)(W + (size_t)(col0 + fr) * DM + fq * 8);
    const bf16x8* bp = (const bf16x8*)(H + (size_t)(row0 + fr) * DM + fq * 8);
    f32x4 acc = (f32x4){0.f, 0.f, 0.f, 0.f};
#pragma unroll 1
    for (int kb = 0; kb < 4; ++kb) {
      bf16x8 av[8], bv[8];
#pragma unroll
      for (int s = 0; s < 8; ++s) { av[s] = ap[(kb * 8 + s) * 4]; bv[s] = bp[(kb * 8 + s) * 4]; }
#pragma unroll
      for (int s = 0; s < 8; ++s) acc = __builtin_amdgcn_mfma_f32_16x16x32_bf16(av[s], bv[s], acc, 0, 0, 0);
    }
    u32x2 o; o.x = cvt_pk_bf16(acc[0], acc[1]); o.y = cvt_pk_bf16(acc[2], acc[3]);
    const int row = row0 + fr, ch = col0 + 4 * fq;
#ifdef MK_CTX_MINI_NOSTORE
    if (o.x == 0x12345678u)
#endif
    if (cg < 8) *(u32x2*)(YA + ((size_t)(ch >> 4) * NCHUNK + (row >> 4)) * 512 + (row & 15) * 16 + (ch & 15)) = o;
    else *(u32x2*)(P + (size_t)row * PLD + (ch - 512)) = o;
  }
}
#endif
__device__ __forceinline__ void phase2(const Params& p, LAS unsigned char* lds) {
#if MK_CTX_MINI
  ctx_mini_gemm(p);
#endif
  pg::Addr AD{(const bf16_t*)(p.ws + WS_RH), DM, 0, (const bf16_t*)(p.ws + WS_WIN), DM, 0, false};
  SchedIn S{(int)gridDim.x, (int)blockIdx.x};
#ifdef MK_NOEPI_PROBE
  EpiIn E{(bf16_t*)((unsigned char*)p.out + DO_YA), (bf16_t*)(p.ws + WS_P), (volatile LAS int*)(lds + LDS_STAGE + 2040)};
#else
  EpiIn E{(bf16_t*)((unsigned char*)p.out + DO_YA), (bf16_t*)(p.ws + WS_P)};
#endif
  pg::gemm_phase(lds, AD, S, E);
}

struct SchedOne {
  static constexpr bool GATHER = false, HAS_DONE = false, HALF = false;
  int pm, pn;
  __device__ __forceinline__ bool next(int i, pg::Unit& u) const { if (i > 0) return false; u.pm = pm; u.pn = pn; u.aux = 0; u.arow = pm * 256; return true; }
};
__device__ __forceinline__ void ctx_ln_and_unit(const Params& p, LAS unsigned char* lds, int c, int tid_) {
  const int lane = tid_ & 63, wave = tid_ >> 6;
  const int tile = c >> 2, pm = tile ? 65 : 32, quarter = c & 3;
  f32x4 va[4][4];
#pragma unroll 1
  for (int h = 0; h < 2; ++h) { const int pr0 = pm * 256 + quarter * 64 + wave * 8 + h * 4;
    ln_batch_load(p, pr0, 1, va, lane); ln_batch_run(p, pr0, 1, va, lane); }
  unsigned* ctr = (unsigned*)(p.ws + WS_CTL) + CTL_CTXCNT + tile * 64;
  asm volatile("s_waitcnt vmcnt(0)" ::: "memory");
  __syncthreads();
  if (tid_ == 0) { __threadfence(); __hip_atomic_fetch_add(ctr, 1u, __ATOMIC_RELEASE, __HIP_MEMORY_SCOPE_AGENT);
    unsigned spins = 0; while (__hip_atomic_load(ctr, __ATOMIC_ACQUIRE, __HIP_MEMORY_SCOPE_AGENT) < 4u && ++spins < (1u << 22)) __builtin_amdgcn_s_sleep(4);
    __threadfence(); }
  __syncthreads();
  __builtin_amdgcn_fence(__ATOMIC_ACQUIRE, "agent");
  pg::Addr AD{(const bf16_t*)(p.ws + WS_RH), DM, 0, (const bf16_t*)(p.ws + WS_WIN), DM, 0, false};
  SchedOne S{pm, (quarter < 2) ? quarter : quarter + 4};
#ifdef MK_NOEPI_PROBE
  EpiIn E{(bf16_t*)((unsigned char*)p.out + DO_YA), (bf16_t*)(p.ws + WS_P), (volatile LAS int*)(lds + LDS_STAGE + 2040)};
#else
  EpiIn E{(bf16_t*)((unsigned char*)p.out + DO_YA), (bf16_t*)(p.ws + WS_P)};
#endif
  pg::gemm_phase(lds, AD, S, E);
}
__device__ __forceinline__ void phase0(const Params& p, LAS unsigned char* lds) {
  const int tid = opaque_tid(), lane = tid & 63, wave = tid >> 6, c = blockIdx.x, G = gridDim.x;
  {
    LAS float* sv = (LAS float*)lds;
    LAS float* red = sv + 3 * DM;
    for (int i = tid; i < DM; i += 512) { sv[i] = siluf_(p.in[I_C][i]); sv[DM + i] = siluf_(p.in[I_C][DM + i]); sv[2 * DM + i] = siluf_(p.in[I_CCTX][i]); }
    __syncthreads();
    for (int cg = c; cg < NMOD / 24; cg += G) {
      const int c4 = tid % 6, rs = tid / 6;
      if (rs < 85) {
        const float* w = p.in[I_WMOD] + cg * 24 + 4 * c4;
        f32x4 wv[13];
#pragma unroll
        for (int q = 0; q < 13; ++q) { const int k = rs + 85 * q; wv[q] = (k < DM) ? *(const f32x4*)(w + (size_t)k * NMOD) : (f32x4){0.f, 0.f, 0.f, 0.f}; }
        f32x4 a0 = {0.f, 0.f, 0.f, 0.f}, a1 = a0, a2 = a0;
#pragma unroll
        for (int q = 0; q < 13; ++q) { const int k = rs + 85 * q; if (k < DM) { a0 += wv[q] * sv[k]; a1 += wv[q] * sv[DM + k]; a2 += wv[q] * sv[2 * DM + k]; } }
#pragma unroll
        for (int e = 0; e < 4; ++e) { red[(rs * 24 + 4 * c4 + e) * 3 + 0] = a0[e]; red[(rs * 24 + 4 * c4 + e) * 3 + 1] = a1[e]; red[(rs * 24 + 4 * c4 + e) * 3 + 2] = a2[e]; }
      }
      __syncthreads();
      if (tid < 72) { const int cc = tid / 3, r = tid % 3; float s = 0.f;
        for (int q = 0; q < 85; ++q) s += red[(q * 24 + cc) * 3 + r];
        ((float*)(p.ws + WS_MOD))[r * NMOD + cg * 24 + cc] = s + p.in[I_BMOD][cg * 24 + cc]; }
      __syncthreads();
    }
#if MK_CTX_IN_PRO || MK_LN_IN_PRO
    asm volatile("s_waitcnt vmcnt(0)" ::: "memory"); __syncthreads();
    if (tid == 0) { __threadfence(); __hip_atomic_fetch_add((unsigned*)(p.ws + WS_CTL) + CTL_MODCNT, 1u, __ATOMIC_RELEASE, __HIP_MEMORY_SCOPE_AGENT); }
#endif
  }
  const int nb = (G >= 64) ? 32 : 0;
  for (int g = c; g < 32; g += G) s5_build_tables(p, lds, g);
#if MK_CTX_IN_PRO
  if (G >= 64 && c < NCTXB) {
    if (tid == 0) { unsigned spins = 0;
      while (__hip_atomic_load((unsigned*)(p.ws + WS_CTL) + CTL_MODCNT, __ATOMIC_ACQUIRE, __HIP_MEMORY_SCOPE_AGENT) < (unsigned)G && ++spins < (1u << 22)) __builtin_amdgcn_s_sleep(4);
      while (__hip_atomic_load((unsigned*)(p.ws + WS_CTL) + CTL_WINCNT, __ATOMIC_ACQUIRE, __HIP_MEMORY_SCOPE_AGENT) < (unsigned)((G - nb) * NWAVES) && ++spins < (1u << 22)) __builtin_amdgcn_s_sleep(4);
      __threadfence(); }
    __syncthreads();
    __builtin_amdgcn_fence(__ATOMIC_ACQUIRE, "agent");
    ctx_ln_and_unit(p, lds, c, tid);
    return;
  }
#endif
  {
    LAS float* scr = (LAS float*)(lds + 8192) + wave * (64 * 33);
    const int N1 = (nb > 0) ? ((CV_TOTAL * MK_N1_NUM) / MK_N1_DEN) & ~7 : 0;
    if (c >= nb) cvt_run<true>(p, 0, N1, (c - nb) * NWAVES + wave, (G - nb) * NWAVES, scr, lane);
    { const int skip = (MK_CTX_IN_PRO && G >= 64) ? NCTXB : 0;
      cvt_run<false>(p, N1, CV_TOTAL, (c - skip) * NWAVES + wave, (G - skip) * NWAVES, scr, lane); }
  }
}

__device__ __forceinline__ void phase1(const Params& p, LAS unsigned char* lds) {
  const int tid_ = opaque_tid(); const int lane = tid_ & 63, wave = tid_ >> 6;
  const int c = blockIdx.x, G = gridDim.x;
  if (MK_CTX_IN_P1 && G > 2 * NCTXB && c < NCTXB) { ctx_ln_and_unit(p, lds, c, tid_); return; }
  if (!MK_CTX_IN_P1 && !MK_CTX_IN_PRO) {
    const int gwa = c * NWAVES + wave, NGWa = G * NWAVES;
    f32x4 va[4][4], vb[4][4];
    ln_batch_load(p, gwa, NGWa, va, lane);
    for (int pr0 = gwa; pr0 < NROW; pr0 += 8 * NGWa) {
      ln_batch_load(p, pr0 + 4 * NGWa, NGWa, vb, lane);
      ln_batch_run(p, pr0, NGWa, va, lane);
      ln_batch_load(p, pr0 + 8 * NGWa, NGWa, va, lane);
      ln_batch_run(p, pr0 + 4 * NGWa, NGWa, vb, lane);
    }
    return;
  }
  const int nb = (MK_CTX_IN_P1 && G > 2 * NCTXB) ? NCTXB : 0;
  const int gw = (c - nb) * NWAVES + wave, NGW = (G - nb) * NWAVES;
  f32x4 va[4][4], vb[4][4];
  ln_batch_load_lat(p, gw, NGW, va, lane);
  for (int lr0 = gw; lr0 < NLAT; lr0 += 8 * NGW) {
    ln_batch_load_lat(p, lr0 + 4 * NGW, NGW, vb, lane);
    ln_batch_run_lat(p, lr0, NGW, va, lane);
    ln_batch_load_lat(p, lr0 + 8 * NGW, NGW, va, lane);
    ln_batch_run_lat(p, lr0 + 4 * NGW, NGW, vb, lane);
  }
  if (nb == 0) {
    for (int pr0 = gw; pr0 < NROW; pr0 += 4 * NGW) {   }
  }
}

__device__ __forceinline__ void phase_qknorm(const Params& p) {
  const bf16_t* P = (const bf16_t*)(p.ws + WS_P); bf16_t* KC = (bf16_t*)(p.ws + WS_KC); bf16_t* VC = (bf16_t*)(p.ws + WS_VC);
  const int tid_ = opaque_tid(); const int lane = tid_ & 63, wave = tid_ >> 6;
  const int gw = blockIdx.x * NWAVES + wave, NGW = gridDim.x * NWAVES;
  const int sub = lane & 15, grp = lane >> 4, e0 = sub * 8, axis = sub >> 3; const bool hi_half = (sub & 4) != 0;
  float inv[8], gk[8];
#pragma unroll
  for (int j = 0; j < 8; ++j) { const int f = (e0 + j) & 31; inv[j] = exp2f(-(float)(2 * f) * (13.287712379549449f / 64.f)); gk[j] = p.in[I_KG][e0 + j]; }
  for (int pr = gw; pr < NROW; pr += NGW) {
    const int b = pr / SKV, t = pr % SKV; const bool isctx = t >= SEQ;
    const u32x4 w = *(const u32x4*)(P + (size_t)pr * PLD + PC_K + lane * 8);
    bf16_t* dst = (grp < 2 ? KC : VC) + ((size_t)(b * 2 + (grp & 1)) * SKV + t) * 128 + e0;
    if (grp >= 2) { *(u32x4*)dst = w; }
    float x[8] = {__uint_as_float(w.x << 16), __uint_as_float(w.x & 0xffff0000u), __uint_as_float(w.y << 16), __uint_as_float(w.y & 0xffff0000u),
                  __uint_as_float(w.z << 16), __uint_as_float(w.z & 0xffff0000u), __uint_as_float(w.w << 16), __uint_as_float(w.w & 0xffff0000u)};
    float ss = 0.f;
#pragma unroll
    for (int j = 0; j < 8; ++j) ss += x[j] * x[j];
    ss = row16_sum(ss);
    const float r = rsqrtf(ss * (1.f / 128.f) + LN_EPS);
    const float posf = (axis == 0) ? (float)(t >> 6) : (float)(t & 63);
    float o[8];
#pragma unroll
    for (int j = 0; j < 8; ++j) { x[j] = x[j] * r * gk[j];
      const float y = lane_xor4(x[j]);
      float sn = 0.f, cs = 1.f; if (!isctx) sincosf(posf * inv[j], &sn, &cs);
      o[j] = hi_half ? (y * sn + x[j] * cs) : (x[j] * cs - y * sn); }
    if (grp < 2) { u32x4 ow; ow.x = cvt_pk_bf16(o[0], o[1]); ow.y = cvt_pk_bf16(o[2], o[3]); ow.z = cvt_pk_bf16(o[4], o[5]); ow.w = cvt_pk_bf16(o[6], o[7]); *(u32x4*)dst = ow; }
  }
}
struct SchedLat {
  static constexpr bool GATHER = false, HAS_DONE = false, HALF = false;
  int G, c, nN;
  __device__ __forceinline__ bool next(int i, pg::Unit& u) const {
    const int L = i * G + c; u.aux = 0;
    if (L >= 64 * nN) return false;
    int lm, pn; map_static(L, 64, nN, lm, pn); u.pm = lm + (lm >> 5); u.pn = pn; u.arow = u.pm * 256; return true;
  }
};
struct EpiGlu {
  static constexpr bool PERM = true;
  const bf16_t* P; bf16_t* Z;
  __device__ __forceinline__ void operator()(const pg::Acc& acc, const pg::Unit& u, int wr, int wc, int fr, int fq) const {
    const int row0 = u.pm * 256 + wr * 64 + fr, ch = u.pn * 128 + wc * 32 + 8 * fq;
    u32x4 gwv[2][4];
#pragma unroll
    for (int ai = 0; ai < 2; ++ai)
#pragma unroll
      for (int m = 0; m < 4; ++m) gwv[ai][m] = *(const u32x4*)(P + (size_t)(row0 + ai * 128 + m * 16) * PLD + PC_G + ch);
#pragma unroll
    for (int ai = 0; ai < 2; ++ai)
#pragma unroll
      for (int m = 0; m < 4; ++m) { const int r = row0 + ai * 128 + m * 16;
        const u32x4 gw = gwv[ai][m];
        float gt[8] = {__uint_as_float(gw.x << 16), __uint_as_float(gw.x & 0xffff0000u), __uint_as_float(gw.y << 16), __uint_as_float(gw.y & 0xffff0000u),
                       __uint_as_float(gw.z << 16), __uint_as_float(gw.z & 0xffff0000u), __uint_as_float(gw.w << 16), __uint_as_float(gw.w & 0xffff0000u)};
        float o[8];
#pragma unroll
        for (int n = 0; n < 2; ++n)
#pragma unroll
          for (int e = 0; e < 4; ++e) { const float a_ = acc[ai][0][m][n][e], b_ = acc[ai][1][m][n][e];
            o[n * 4 + e] = gt[n * 4 + e] * a_ * __builtin_amdgcn_rcpf(1.f + __builtin_amdgcn_exp2f(-1.4426950408889634f * b_)); }
        u32x4 w; w.x = cvt_pk_bf16(o[0], o[1]); w.y = cvt_pk_bf16(o[2], o[3]); w.z = cvt_pk_bf16(o[4], o[5]); w.w = cvt_pk_bf16(o[6], o[7]);
        *(u32x4*)(Z + (size_t)r * DM + ch) = w; }
  }
};
struct EpiMix {
  static constexpr bool PERM = true;
  const bf16_t* P; bf16_t* Z;
  __device__ __forceinline__ void operator()(const pg::Acc& acc, const pg::Unit& u, int wr, int wc, int fr, int fq) const {
    const int row0 = u.pm * 256 + wr * 64 + fr, col0 = u.pn * 256 + wc * 32 + 8 * fq;
#pragma unroll
    for (int ai = 0; ai < 2; ++ai) {
      u32x4 gwv[4][2], zwv[4][2];
#pragma unroll
      for (int m = 0; m < 4; ++m)
#pragma unroll
        for (int bj = 0; bj < 2; ++bj) { const int r = row0 + ai * 128 + m * 16, cc = col0 + bj * 128;
          gwv[m][bj] = *(const u32x4*)(P + (size_t)r * PLD + PC_G + 1024 + cc); zwv[m][bj] = *(const u32x4*)(Z + (size_t)r * DM + cc); }
#pragma unroll
      for (int m = 0; m < 4; ++m)
#pragma unroll
        for (int bj = 0; bj < 2; ++bj) { const int r = row0 + ai * 128 + m * 16, cc = col0 + bj * 128;
          const u32x4 gw = gwv[m][bj], zw = zwv[m][bj];
          const unsigned gq[4] = {gw.x, gw.y, gw.z, gw.w}, zq[4] = {zw.x, zw.y, zw.z, zw.w};
          unsigned ow[4];
#pragma unroll
          for (int q = 0; q < 4; ++q) { const float a0 = acc[ai][bj][m][q >> 1][(q & 1) * 2], a1 = acc[ai][bj][m][q >> 1][(q & 1) * 2 + 1];
            ow[q] = cvt_pk_bf16(__uint_as_float(zq[q] << 16) + __uint_as_float(gq[q] << 16) * a0, __uint_as_float(zq[q] & 0xffff0000u) + __uint_as_float(gq[q] & 0xffff0000u) * a1); }
          *(u32x4*)(Z + (size_t)r * DM + cc) = (u32x4){ow[0], ow[1], ow[2], ow[3]}; }
    }
  }
};
#if MK_RB_BF16
struct EpiOut {
  static constexpr bool PERM = true;
  const float* X; const float* mod; float* R1;
  __device__ __forceinline__ void operator()(const pg::Acc& acc, const pg::Unit& u, int wr, int wc, int fr, int fq) const {
    const int b = u.pm / 33, lrow0 = (u.pm - b) * 256 + wr * 64 + fr, colb = u.pn * 256 + wc * 32 + 8 * fq;
    const float* g1 = mod + b * NMOD + 2 * DM;
    bf16_t* RB = (bf16_t*)R1;
    f32x4 gv[2][2];
#pragma unroll
    for (int bj = 0; bj < 2; ++bj)
#pragma unroll
      for (int n = 0; n < 2; ++n) gv[bj][n] = *(const f32x4*)(g1 + colb + bj * 128 + 4 * n);
#pragma unroll
    for (int ai = 0; ai < 2; ++ai)
#pragma unroll
      for (int m = 0; m < 4; ++m) { bf16_t* rowp = RB + (size_t)(lrow0 + ai * 128 + m * 16) * DM + colb;
#pragma unroll
        for (int bj = 0; bj < 2; ++bj) { const f32x4 v0 = acc[ai][bj][m][0] * gv[bj][0], v1 = acc[ai][bj][m][1] * gv[bj][1];
          u32x4 w; w.x = cvt_pk_bf16(v0[0], v0[1]); w.y = cvt_pk_bf16(v0[2], v0[3]); w.z = cvt_pk_bf16(v1[0], v1[1]); w.w = cvt_pk_bf16(v1[2], v1[3]);
          *(u32x4*)(rowp + bj * 128) = w; } }
  }
};
#else
struct EpiOut {
  static constexpr bool PERM = false;
  const float* X; const float* mod; float* R1;
  __device__ __forceinline__ void operator()(const pg::Acc& acc, const pg::Unit& u, int wr, int wc, int fr, int fq) const {
    const int b = u.pm / 33, lrow0 = (u.pm - b) * 256 + wr * 64 + fr, col0 = u.pn * 256 + wc * 32 + 4 * fq;
    const float* g1 = mod + b * NMOD + 2 * DM;
    f32x4 gv[2][2];
#pragma unroll
    for (int bj = 0; bj < 2; ++bj)
#pragma unroll
      for (int n = 0; n < 2; ++n) gv[bj][n] = *(const f32x4*)(g1 + col0 + bj * 128 + n * 16);
#pragma unroll
    for (int ai = 0; ai < 2; ++ai) {
      f32x4 xv[4][2][2];
#pragma unroll
      for (int m = 0; m < 4; ++m) { const size_t off = (size_t)(lrow0 + ai * 128 + m * 16) * DM + col0;
#pragma unroll
        for (int bj = 0; bj < 2; ++bj)
#pragma unroll
          for (int n = 0; n < 2; ++n) xv[m][bj][n] = *(const f32x4*)(X + off + bj * 128 + n * 16); }
#pragma unroll
      for (int m = 0; m < 4; ++m) { const size_t off = (size_t)(lrow0 + ai * 128 + m * 16) * DM + col0;
#pragma unroll
        for (int bj = 0; bj < 2; ++bj)
#pragma unroll
          for (int n = 0; n < 2; ++n) *(f32x4*)(R1 + off + bj * 128 + n * 16) = xv[m][bj][n] * ALPHA + gv[bj][n] * acc[ai][bj][m][n]; }
    }
  }
};
#endif
__device__ __forceinline__ void phase_g1(const Params& p, LAS unsigned char* lds) {
  pg::Addr AD{(const bf16_t*)((unsigned char*)p.out + DO_GY), 512, 0, (const bf16_t*)(p.ws + WS_WGLU), 512, 0, false};
  SchedLat S{(int)gridDim.x, (int)blockIdx.x, 8};
  EpiGlu E{(const bf16_t*)(p.ws + WS_P), (bf16_t*)(p.ws + WS_RH)};
  pg::gemm_phase(lds, AD, S, E);
}
__device__ __forceinline__ void phase_g2(const Params& p, LAS unsigned char* lds) {
  pg::Addr AD{(const bf16_t*)(p.ws + WS_P) + PC_Q, PLD, 0, (const bf16_t*)(p.ws + WS_WAO), DM, 0, false};
  SchedLat S{(int)gridDim.x, (int)blockIdx.x, 4};
  EpiMix E{(const bf16_t*)(p.ws + WS_P), (bf16_t*)(p.ws + WS_RH)};
  pg::gemm_phase(lds, AD, S, E);
}
__device__ __forceinline__ void phase_g3(const Params& p, LAS unsigned char* lds) {
  pg::Addr AD{(const bf16_t*)(p.ws + WS_RH), DM, 0, (const bf16_t*)(p.ws + WS_WOUT), DM, 0, false};
  SchedLat S{(int)gridDim.x, (int)blockIdx.x, 4};
  EpiOut E{p.in[I_X], (const float*)(p.ws + WS_MOD), p.out};
  pg::gemm_phase(lds, AD, S, E);
}

constexpr size_t RT_EW = 0, RT_LIST = 256 * 1024;
constexpr int CTL_CNT = 8192, CNT_STRIDE = 64;
constexpr int ACT_TILES_MAX = 160;
constexpr size_t PR_ACT = 66 * MiB;

struct MoeTab { const LAS int* tb; const LAS int* cn; };
__device__ __forceinline__ MoeTab moe_tables(const Params& p, LAS unsigned char* lds) {
  LAS int* tb = (LAS int*)(lds + LDS_STAGE); LAS int* cn = tb + 64;
  const unsigned* cnt = (const unsigned*)(p.ws + WS_CTL) + CTL_CNT;
  if (opaque_tid() == 0) { int acc = 0; for (int e = 0; e < 32; ++e) { const int c = (int)cnt[e * CNT_STRIDE]; cn[e] = c; tb[e] = acc; acc += (c + 255) >> 8; } tb[32] = acc; }
  __syncthreads();
  return MoeTab{tb, cn};
}
struct SchedMoe {
  static constexpr bool GATHER_ = true;
  int G, c, nN; MoeTab tab; const int* lists;
  __device__ __forceinline__ bool next_(int i, pg::Unit& u) const {
    if ((G & 7) != 0) {
      const int L = i * G + c, T = L / nN;
      if (T >= tab.tb[32]) return false;
      int e = 0;
#pragma unroll 1
      for (int q = 1; q < 32; ++q) e = (tab.tb[q] <= T) ? q : e;
      u.pm = T; u.pn = L % nN; u.aux = e; u.arow = T * 256; return true;
    }
    const int x = c & 7, j = c >> 3, nper = G >> 3;
    int idx = j + nper * i;
#pragma unroll 1
    for (int k = 0; k < 4; ++k) { const int e = x + 8 * k, n_e = (tab.tb[e + 1] - tab.tb[e]) * nN;
      if (idx < n_e) { const int T = tab.tb[e] + idx / nN; u.pm = T; u.pn = idx % nN; u.aux = e; u.arow = T * 256; return true; }
      idx -= n_e; }
    return false;
  }
  __device__ __forceinline__ int arow_(const pg::Unit& u, int r) const {
    const int slot = (u.pm - tab.tb[u.aux]) * 256 + r;
    if (slot >= tab.cn[u.aux]) return 0;
    return lat2pad(lists[u.aux * NLAT + slot] >> 1);
  }
};
constexpr int NEARLY = 48;
constexpr int CTL_TILECNT = 10496;
struct SchedMoeUp : SchedMoe { static constexpr bool GATHER = true, HAS_DONE = true, HALF = false;
  unsigned* tilecnt; bool early;
  __device__ __forceinline__ bool next(int i, pg::Unit& u) const { return next_(i, u); }
  __device__ __forceinline__ int arow(const pg::Unit& u, int r) const { return arow_(u, r); }
  __device__ __forceinline__ void done(const pg::Unit& u, int lane) const {
    if (early && u.pm < NEARLY) { asm volatile("s_waitcnt vmcnt(0)" ::: "memory"); __builtin_amdgcn_fence(__ATOMIC_RELEASE, "agent"); asm volatile("s_waitcnt vmcnt(0)" ::: "memory");
      if (lane == 0) __hip_atomic_fetch_add(tilecnt + 64 * u.pm, 1u, __ATOMIC_RELAXED, __HIP_MEMORY_SCOPE_AGENT); } } };
struct SchedMoeDown : SchedMoe { static constexpr bool GATHER = false, HAS_DONE = false, HALF = false;
  int t_first;
  __device__ __forceinline__ bool next(int i, pg::Unit& u) const {
    if (t_first == 0) return next_(i, u);
    const int L = i * G + c, T = t_first + L / nN;
    if (T >= tab.tb[32]) return false;
    int e = 0;
#pragma unroll 1
    for (int q = 1; q < 32; ++q) e = (tab.tb[q] <= T) ? q : e;
    u.pm = T; u.pn = L % nN; u.aux = e; u.arow = T * 256; return true; } };
struct SchedMoeDownOne : SchedMoe { static constexpr bool GATHER = false, HAS_DONE = false, HALF = false;
  int T, pn;
  __device__ __forceinline__ bool next(int i, pg::Unit& u) const {
    if (i > 0) return false;
    int e = 0;
#pragma unroll 1
    for (int q = 1; q < 32; ++q) e = (tab.tb[q] <= T) ? q : e;
    u.pm = T; u.pn = pn; u.aux = e; u.arow = T * 256; return true; } };
struct EpiGU {
  static constexpr bool PERM = true;
  bf16_t* ACT;
  __device__ __forceinline__ void operator()(const pg::Acc& acc, const pg::Unit& u, int wr, int wc, int fr, int fq) const {
    const int row0 = u.pm * 256 + wr * 64 + fr, ch = u.pn * 128 + wc * 32 + 8 * fq;
#pragma unroll
    for (int ai = 0; ai < 2; ++ai)
#pragma unroll
      for (int m = 0; m < 4; ++m) { const int r = row0 + ai * 128 + m * 16;
        float o[8];
#pragma unroll
        for (int n = 0; n < 2; ++n)
#pragma unroll
          for (int e = 0; e < 4; ++e) { const float a = acc[ai][0][m][n][e], b = acc[ai][1][m][n][e];
            o[n * 4 + e] = a * b * __builtin_amdgcn_rcpf(1.f + __builtin_amdgcn_exp2f(-1.4426950408889634f * a)); }
        u32x4 w; w.x = cvt_pk_bf16(o[0], o[1]); w.y = cvt_pk_bf16(o[2], o[3]); w.z = cvt_pk_bf16(o[4], o[5]); w.w = cvt_pk_bf16(o[6], o[7]);
        *(u32x4*)(ACT + (size_t)r * 512 + ch) = w; }
  }
};
struct EpiDown {
  static constexpr bool PERM = true;
  bf16_t* Y2; const int* lists; const float* ew; MoeTab tab;
  __device__ __forceinline__ void operator()(const pg::Acc& acc, const pg::Unit& u, int wr, int wc, int fr, int fq) const {
    const int slot0 = (u.pm - tab.tb[u.aux]) * 256 + wr * 64 + fr, n_e = tab.cn[u.aux], col0 = u.pn * 256 + wc * 32 + 8 * fq;
    int ids[2][4]; float wts[2][4];
#pragma unroll
    for (int ai = 0; ai < 2; ++ai)
#pragma unroll
      for (int m = 0; m < 4; ++m) { const int slot = slot0 + ai * 128 + m * 16; ids[ai][m] = (slot < n_e) ? lists[u.aux * NLAT + slot] : -1; }
#pragma unroll
    for (int ai = 0; ai < 2; ++ai)
#pragma unroll
      for (int m = 0; m < 4; ++m) wts[ai][m] = (ids[ai][m] >= 0) ? ew[ids[ai][m]] : 0.f;
#pragma unroll
    for (int ai = 0; ai < 2; ++ai)
#pragma unroll
      for (int m = 0; m < 4; ++m) {
        if (ids[ai][m] >= 0) { const int id = ids[ai][m]; const float w = wts[ai][m];
#pragma unroll
          for (int bj = 0; bj < 2; ++bj) { const f32x4 v0 = acc[ai][bj][m][0] * w, v1 = acc[ai][bj][m][1] * w;
            u32x4 o; o.x = cvt_pk_bf16(v0[0], v0[1]); o.y = cvt_pk_bf16(v0[2], v0[3]); o.z = cvt_pk_bf16(v1[0], v1[1]); o.w = cvt_pk_bf16(v1[2], v1[3]);
            *(u32x4*)(Y2 + (size_t)id * DM + col0 + bj * 128) = o; } } }
  }
};
__device__ __forceinline__ void phase_moe_up(const Params& p, LAS unsigned char* lds) {
  const MoeTab tab = moe_tables(p, lds);
  const bool early = (MK_EARLY_DOWN != 0) && gridDim.x == 256;
  unsigned* tilecnt = (unsigned*)(p.ws + WS_CTL) + CTL_TILECNT;
  {
    pg::Addr AD{(const bf16_t*)(p.ws + WS_RH), DM, 0, (const bf16_t*)(p.ws + WS_WGU), DM, (size_t)1024 * 1024, true};
    SchedMoeUp S; S.G = gridDim.x; S.c = blockIdx.x; S.nN = 4; S.tab = tab; S.lists = (const int*)(p.ws + WS_ROUTE + RT_LIST); S.tilecnt = tilecnt; S.early = early;
    EpiGU E{(bf16_t*)(p.ws + WS_P + PR_ACT)};
    pg::gemm_phase(lds, AD, S, E);
  }
  if (early && blockIdx.x >= 64) {
    const int Le = blockIdx.x - 64, T = Le >> 2, pn = Le & 3;
    if (opaque_tid() == 0) { unsigned spins = 0;
      while (__hip_atomic_load(tilecnt + 64 * T, __ATOMIC_RELAXED, __HIP_MEMORY_SCOPE_AGENT) < 32u && ++spins < (1u << 22)) __builtin_amdgcn_s_sleep(4); }
    __syncthreads();
    __builtin_amdgcn_fence(__ATOMIC_ACQUIRE, "agent");
    asm volatile("s_waitcnt vmcnt(0)" ::: "memory");
    pg::Addr AD{(const bf16_t*)(p.ws + WS_P + PR_ACT), 512, 0, (const bf16_t*)(p.ws + WS_WD), 512, (size_t)1024 * 512, false};
    SchedMoeDownOne S; S.G = gridDim.x; S.c = blockIdx.x; S.nN = 4; S.tab = tab; S.lists = (const int*)(p.ws + WS_ROUTE + RT_LIST); S.T = T; S.pn = pn;
    EpiDown E{(bf16_t*)(p.ws + WS_P), (const int*)(p.ws + WS_ROUTE + RT_LIST), (const float*)(p.ws + WS_ROUTE + RT_EW), tab};
    pg::gemm_phase(lds, AD, S, E);
  }
}
__device__ __forceinline__ void phase_moe_down(const Params& p, LAS unsigned char* lds) {
  const MoeTab tab = moe_tables(p, lds);
  const bool early = (MK_EARLY_DOWN != 0) && gridDim.x == 256;
  pg::Addr AD{(const bf16_t*)(p.ws + WS_P + PR_ACT), 512, 0, (const bf16_t*)(p.ws + WS_WD), 512, (size_t)1024 * 512, false};
  SchedMoeDown S; S.G = gridDim.x; S.c = blockIdx.x; S.nN = 4; S.tab = tab; S.lists = (const int*)(p.ws + WS_ROUTE + RT_LIST); S.t_first = early ? NEARLY : 0;
  EpiDown E{(bf16_t*)(p.ws + WS_P), (const int*)(p.ws + WS_ROUTE + RT_LIST), (const float*)(p.ws + WS_ROUTE + RT_EW), tab};
  pg::gemm_phase(lds, AD, S, E);
}

__device__ __forceinline__ void phase_final(const Params& p) {
  const float* mod = (const float*)(p.ws + WS_MOD);
  const bf16_t* Y2 = (const bf16_t*)(p.ws + WS_P);
  const bf16_t* X1b = (const bf16_t*)(p.ws + WS_X1B); float* OUT = p.out;
  const int tid_ = opaque_tid(); const int lane = tid_ & 63, wave = tid_ >> 6;
  const int gw = blockIdx.x * NWAVES + wave, NGW = gridDim.x * NWAVES;
  u32x2 x1[4], x1n[4]; u32x2 ya[4], yb[4], yan[4], ybn[4];
#define FIN_LOAD(row, X, A, B) do { _Pragma("unroll") for (int j = 0; j < 4; ++j) { const int col = (lane + 64 * j) * 4; \
    X[j] = *(const u32x2*)(X1b + (size_t)(row) * DM + col); A[j] = *(const u32x2*)(Y2 + (size_t)(2 * (row)) * DM + col); B[j] = *(const u32x2*)(Y2 + (size_t)(2 * (row) + 1) * DM + col); } } while (0)
  if (gw < NLAT) FIN_LOAD(gw, x1, ya, yb);
  for (int row = gw; row < NLAT; row += NGW) {
    const int rown = row + NGW;
    if (rown < NLAT) FIN_LOAD(rown, x1n, yan, ybn);
    const float* mrow = mod + (row / SEQ) * NMOD;
    float probe_scale = 1.f;
#ifndef MK_TS_A
#define MK_TS_A MK_TS_PHASE
#define MK_TS_B (MK_TS_PHASE + 1)
#endif
#if MK_TS_PHASE >= 0
    if (row < 164) { const unsigned long long* ts = (const unsigned long long*)((const unsigned*)(p.ws + WS_CTL) + CTL_TS); probe_scale = 1.f + sqrtf((float)(ts[MK_TS_B] - ts[MK_TS_A]) * MK_TS_SCALE); }
#endif
    f32x4 g2[4], gg[4], bb[4];
#pragma unroll
    for (int j = 0; j < 4; ++j) { const int col = (lane + 64 * j) * 4; g2[j] = *(const f32x4*)(mrow + 5 * DM + col); gg[j] = *(const f32x4*)(p.in[I_LN2G] + col); bb[j] = *(const f32x4*)(p.in[I_LN2B] + col); }
    f32x4 v[4]; float s = 0;
#pragma unroll
    for (int j = 0; j < 4; ++j) {
      f32x4 ym;
      ym.x = __uint_as_float(ya[j].x << 16) + __uint_as_float(yb[j].x << 16); ym.y = __uint_as_float(ya[j].x & 0xffff0000u) + __uint_as_float(yb[j].x & 0xffff0000u);
      ym.z = __uint_as_float(ya[j].y << 16) + __uint_as_float(yb[j].y << 16); ym.w = __uint_as_float(ya[j].y & 0xffff0000u) + __uint_as_float(yb[j].y & 0xffff0000u);
      const f32x4 xf = {__uint_as_float(x1[j].x << 16), __uint_as_float(x1[j].x & 0xffff0000u), __uint_as_float(x1[j].y << 16), __uint_as_float(x1[j].y & 0xffff0000u)};
      v[j] = xf * ALPHA + g2[j] * ym;
      s += (v[j].x + v[j].y) + (v[j].z + v[j].w);
    }
    const float mean = wave_sum(s) * (1.f / DM); float s2 = 0;
#pragma unroll
    for (int j = 0; j < 4; ++j) { v[j] = v[j] - mean; s2 += (v[j].x * v[j].x + v[j].y * v[j].y) + (v[j].z * v[j].z + v[j].w * v[j].w); }
    const float rstd = rsqrtf(wave_sum(s2) * (1.f / DM) + LN_EPS);
#pragma unroll
    for (int j = 0; j < 4; ++j) ((f32x4*)(OUT + (size_t)row * DM))[lane + 64 * j] = (v[j] * rstd * gg[j] + bb[j]) * probe_scale;
#pragma unroll
    for (int j = 0; j < 4; ++j) { x1[j] = x1n[j]; ya[j] = yan[j]; yb[j] = ybn[j]; }
  }
#undef FIN_LOAD
}
__device__ __forceinline__ void phase_attn(const Params& p, char* lds) {
  bf16_t* P = (bf16_t*)(p.ws + WS_P);
  int seq = SKV; asm volatile("" : "+s"(seq));
  float negMC;
  { const int l_ = opaque_tid() & 63; float gq = fmaxf(fabsf(p.in[I_QG][l_]), fabsf(p.in[I_QG][64 + l_])), gk = fmaxf(fabsf(p.in[I_KG][l_]), fabsf(p.in[I_KG][64 + l_]));
#pragma unroll
    for (int o = 1; o < 64; o <<= 1) { gq = fmaxf(gq, __shfl_xor(gq, o)); gk = fmaxf(gk, __shfl_xor(gk, o)); }
    negMC = 128.f * 1.01f * gq * gk; }
  for (int unit = blockIdx.x; unit < NB * 8 * (SEQ / 256); unit += gridDim.x) {
    const int h = unit % 8, qb = (unit / 8) % 32, b = unit / 256;
    bf16_t* Qp = P + ((size_t)b * SKV + qb * 256) * PLD + PC_Q + h * 128;
    const bf16_t* Kp = (const bf16_t*)(p.ws + WS_KC) + (size_t)(b * 2 + (h >> 2)) * SKV * 128;
    const bf16_t* Vp = (const bf16_t*)(p.ws + WS_VC) + (size_t)(b * 2 + (h >> 2)) * SKV * 128;
    att::attn_dense_body(Qp, Kp, Vp, Qp, seq, negMC, p.in[I_QG], qb * 256, lds);
  }
}

#if MK_TS_PHASE >= 16
#define RT_TS(k) do { if (gw == 0 && row0 == 0 && lane0 == 0) ((unsigned long long*)((unsigned*)(p.ws + WS_CTL) + CTL_TS))[k] = __builtin_amdgcn_s_memrealtime(); } while (0)
#else
#define RT_TS(k) do { } while (0)
#endif
constexpr int LDS_RTLOG = LDS_STAGE + 10240;
__device__ __forceinline__ void phase_ln1_router(const Params& p, LAS unsigned char* lds) {
  const float* mod = (const float*)(p.ws + WS_MOD);
  const float* R1 = p.out; bf16_t* X1b = (bf16_t*)(p.ws + WS_X1B);
  bf16_t* H2 = (bf16_t*)(p.ws + WS_RH);
  float* ew = (float*)(p.ws + WS_ROUTE + RT_EW); int* lists = (int*)(p.ws + WS_ROUTE + RT_LIST);
  unsigned* cnt = (unsigned*)(p.ws + WS_CTL) + CTL_CNT;
  const int tid_ = opaque_tid(); const int lane0 = tid_ & 63, wave = tid_ >> 6;
  const int gw = blockIdx.x * NWAVES + wave, NGW = gridDim.x * NWAVES;
  LAS f32x4* Wl = (LAS f32x4*)lds;
  LAS float* lg = (LAS float*)(lds + LDS_RTLOG) + wave * 160;
  const float* Wre = p.in[I_WRE]; const float* Wrg = p.in[I_WRG];
  f32x4 vv[4][4], hh[4][4];
#if MK_RB_BF16
  u32x2 rb[4][4];
  const float* Xin = p.in[I_X];
#define RT_LOAD_X(row0_) do { int _ln = lane0; asm volatile("" : "+v"(_ln)); const int _r0 = ((row0_) < NLAT) ? (row0_) : (NLAT - 4); _Pragma("unroll") for (int r = 0; r < 4; ++r) _Pragma("unroll") for (int j = 0; j < 4; ++j) \
    vv[r][j] = ((const f32x4*)(Xin + (size_t)(_r0 + r) * DM))[_ln + 64 * j]; } while (0)
#define RT_LOAD_B(row0_) do { int _ln = lane0; asm volatile("" : "+v"(_ln)); const int _r0 = ((row0_) < NLAT) ? (row0_) : (NLAT - 4); _Pragma("unroll") for (int r = 0; r < 4; ++r) _Pragma("unroll") for (int j = 0; j < 4; ++j) \
    rb[r][j] = ((const u32x2*)((const bf16_t*)R1 + (size_t)(_r0 + r) * DM))[_ln + 64 * j]; } while (0)
#define RT_LOAD(row0_) do { RT_LOAD_X(row0_); RT_LOAD_B(row0_); } while (0)
#else
#define RT_LOAD(row0_) do { int _ln = lane0; asm volatile("" : "+v"(_ln)); const int _r0 = ((row0_) < NLAT) ? (row0_) : (NLAT - 4); _Pragma("unroll") for (int r = 0; r < 4; ++r) _Pragma("unroll") for (int j = 0; j < 4; ++j) \
    vv[r][j] = ((const f32x4*)(R1 + (size_t)(_r0 + r) * DM))[_ln + 64 * j]; } while (0)
#endif
  RT_LOAD(gw * 4);
  {
#pragma unroll 1
    for (int q0 = 0; q0 < 16; q0 += 8) {
      f32x4 wt[8];
#pragma unroll
      for (int q = 0; q < 8; ++q) wt[q] = ((const f32x4*)Wre)[tid_ + 512 * (q0 + q)];
#pragma unroll
      for (int q = 0; q < 8; ++q) { const int idx = tid_ + 512 * (q0 + q), k = idx >> 3, c4 = idx & 7;
        Wl[((c4 * 16 + (k & 3) * 4 + (k >> 8)) << 6) + ((k >> 2) & 63)] = wt[q]; }
    }
  }
  __syncthreads();
  for (int row0 = gw * 4; row0 < NLAT; row0 += NGW * 4) {
    const float* mrow = mod + (row0 / SEQ) * NMOD;
    RT_TS(16);
#pragma unroll
    for (int r = 0; r < 4; ++r) {
      const int row = row0 + r, pr = lat2pad(row);
      int lane = lane0; asm volatile("" : "+v"(lane));
      f32x4 v[4]; float s = 0;
#pragma unroll
      for (int j = 0; j < 4; ++j) {
#if MK_RB_BF16
        const u32x2 q = rb[r][j];
        v[j] = vv[r][j] * ALPHA + (f32x4){__uint_as_float(q.x << 16), __uint_as_float(q.x & 0xffff0000u), __uint_as_float(q.y << 16), __uint_as_float(q.y & 0xffff0000u)};
#else
        v[j] = vv[r][j];
#endif
        s += (v[j].x + v[j].y) + (v[j].z + v[j].w); }
      float mean = wave_sum(s) * (1.f / DM); float s2 = 0;
#pragma unroll
      for (int j = 0; j < 4; ++j) { v[j] = v[j] - mean; s2 += (v[j].x * v[j].x + v[j].y * v[j].y) + (v[j].z * v[j].z + v[j].w * v[j].w); }
      float rstd = rsqrtf(wave_sum(s2) * (1.f / DM) + LN_EPS);
      s = 0;
#pragma unroll
      for (int j = 0; j < 4; ++j) {
        const int col = (lane + 64 * j) * 4;
        const f32x4 g = *(const f32x4*)(p.in[I_LN1G] + col), bb = *(const f32x4*)(p.in[I_LN1B] + col);
        v[j] = v[j] * rstd * g + bb;
        { u32x2 xw; xw.x = cvt_pk_bf16(v[j].x, v[j].y); xw.y = cvt_pk_bf16(v[j].z, v[j].w); *(u32x2*)(X1b + (size_t)row * DM + col) = xw; }
        s += (v[j].x + v[j].y) + (v[j].z + v[j].w);
      }
      mean = wave_sum(s) * (1.f / DM); s2 = 0;
#pragma unroll
      for (int j = 0; j < 4; ++j) { v[j] = v[j] - mean; s2 += (v[j].x * v[j].x + v[j].y * v[j].y) + (v[j].z * v[j].z + v[j].w * v[j].w); }
      rstd = rsqrtf(wave_sum(s2) * (1.f / DM) + LN_EPS);
#pragma unroll
      for (int j = 0; j < 4; ++j) {
        const int col = (lane + 64 * j) * 4;
        const f32x4 sh = *(const f32x4*)(mrow + 3 * DM + col), sc = *(const f32x4*)(mrow + 4 * DM + col);
        const f32x4 hv = v[j] * rstd * (sc + 1.f) + sh;
        u32x2 w; w.x = cvt_pk_bf16(hv.x, hv.y); w.y = cvt_pk_bf16(hv.z, hv.w);
        *(u32x2*)(H2 + (size_t)pr * DM + col) = w;
        hh[r][j] = hv;
      }
    }
    RT_TS(17);
    int gsel[4];
    int lane = lane0; asm volatile("" : "+v"(lane));
    {
      f32x4 acc[4];
#pragma unroll
      for (int r = 0; r < 4; ++r) acc[r] = (f32x4){0.f, 0.f, 0.f, 0.f};
#pragma unroll
      for (int j = 0; j < 4; ++j)
#pragma unroll
        for (int e = 0; e < 4; ++e) { const f32x4 w = *(const f32x4*)(Wrg + (size_t)(j * 256 + e) * 4 + (unsigned)(lane * 16));
#pragma unroll
          for (int r = 0; r < 4; ++r) acc[r] += w * hh[r][j][e]; }
#pragma unroll
      for (int r = 0; r < 4; ++r)
#pragma unroll
        for (int e = 0; e < 4; ++e) acc[r][e] = wave_sum(acc[r][e]);
      if (lane == 0) {
#pragma unroll
        for (int r = 0; r < 4; ++r) *(LAS f32x4*)(lg + r * 40) = acc[r]; }
#pragma unroll
      for (int r = 0; r < 4; ++r) {
        int gi = 0; float gm = acc[r][0] + p.in[I_BRG][0];
#pragma unroll
        for (int i = 1; i < 4; ++i) { const float g = acc[r][i] + p.in[I_BRG][i]; if (g > gm) { gm = g; gi = i; } }
        gsel[r] = __builtin_amdgcn_readfirstlane(gi); }
    }
    RT_TS(18);
#if MK_RB_BF16
    RT_LOAD_X(row0 + NGW * 4);
#endif
#pragma unroll
    for (int r = 0; r < 4; ++r) {
      f32x4 ea0 = (f32x4){0.f, 0.f, 0.f, 0.f}, ea1 = ea0;
      const LAS f32x4* wb = Wl + gsel[r] * 2048 + lane;
#pragma unroll
      for (int j = 0; j < 4; ++j) {
#pragma unroll
        for (int e = 0; e < 4; ++e) { const float h = hh[r][j][e];
          ea0 += wb[(e * 4 + j) * 64] * h; ea1 += wb[1024 + (e * 4 + j) * 64] * h; }
        asm volatile("" ::: "memory");
      }
#pragma unroll
      for (int e = 0; e < 4; ++e) { ea0[e] = wave_sum(ea0[e]); ea1[e] = wave_sum(ea1[e]); }
      if (lane == 0) { *(LAS f32x4*)(lg + r * 40 + 4 + gsel[r] * 8) = ea0; *(LAS f32x4*)(lg + r * 40 + 8 + gsel[r] * 8) = ea1; }
      asm volatile("" ::: "memory");
    }
#if MK_RB_BF16
    RT_LOAD_B(row0 + NGW * 4);
#else
    RT_LOAD(row0 + NGW * 4);
#endif
    asm volatile("s_waitcnt lgkmcnt(0)" ::: "memory");
    RT_TS(19);
    if (lane < 4) {
      const int row = row0 + lane; const LAS float* L = lg + lane * 40;
      float gl[4]; int gi = 0;
#pragma unroll
      for (int i = 0; i < 4; ++i) gl[i] = L[i] + p.in[I_BRG][i];
      float gm = gl[0];
#pragma unroll
      for (int i = 1; i < 4; ++i) if (gl[i] > gm) { gm = gl[i]; gi = i; }
      float den = 0.f;
#pragma unroll
      for (int i = 0; i < 4; ++i) den += expf(gl[i] - gm);
      const float gw_ = 1.f / den;
      float el[8];
#pragma unroll
      for (int i = 0; i < 8; ++i) el[i] = L[4 + gi * 8 + i] + p.in[I_BRE][gi * 8 + i];
      int i1 = 0; float v1 = el[0];
#pragma unroll
      for (int i = 1; i < 8; ++i) if (el[i] > v1) { v1 = el[i]; i1 = i; }
      int i2 = -1; float v2 = -3.0e38f;
#pragma unroll
      for (int i = 0; i < 8; ++i) if (i != i1 && el[i] > v2) { v2 = el[i]; i2 = i; }
      const float e2 = expf(v2 - v1); const float w1 = 1.f / (1.f + e2), w2 = e2 / (1.f + e2);
      const int ea = gi * 8 + i1, eb = gi * 8 + i2;
      const unsigned pa = atomicAdd(cnt + ea * CNT_STRIDE, 1u), pb = atomicAdd(cnt + eb * CNT_STRIDE, 1u);
      lists[ea * NLAT + pa] = row * 2; lists[eb * NLAT + pb] = row * 2 + 1;
      ew[row * 2] = w1 * gw_; ew[row * 2 + 1] = w2 * gw_;
    }
    asm volatile("s_waitcnt vmcnt(0) lgkmcnt(0)" ::: "memory");
    RT_TS(20);
  }
}

enum { PH_PRO = 0, PH_LN, PH_GIN, PH_QK, PH_ATT, PH_G1, PH_G2, PH_G3, PH_RT, PH_UP, PH_DOWN, PH_FIN, PH_S5S, PH_SCAN, PH_S5Y, PH_COUNT };
template <int PH> __device__ __forceinline__ void run_phase(const Params& p, unsigned char* lds_raw) {
  LAS unsigned char* lds = (LAS unsigned char*)lds_raw;
  if constexpr (PH == PH_PRO) phase0(p, lds);
  if constexpr (PH == PH_LN) phase1(p, lds);
  if constexpr (PH == PH_GIN) phase2(p, lds);
  if constexpr (PH == PH_QK) phase_qknorm(p);
  if constexpr (PH == PH_ATT) phase_attn(p, (char*)lds_raw);
  if constexpr (PH == PH_G1) phase_g1(p, lds);
  if constexpr (PH == PH_G2) phase_g2(p, lds);
  if constexpr (PH == PH_G3) phase_g3(p, lds);
  if constexpr (PH == PH_RT) phase_ln1_router(p, lds);
  if constexpr (PH == PH_UP) phase_moe_up(p, lds);
  if constexpr (PH == PH_DOWN) phase_moe_down(p, lds);
  if constexpr (PH == PH_FIN) phase_final(p);
  if constexpr (PH == PH_S5S) phase_s5s(p, lds);
  if constexpr (PH == PH_SCAN) phase_s5scan(p);
  if constexpr (PH == PH_S5Y) phase_s5y(p, lds);
}
#ifndef MK_FUSED
#define MK_FUSED 1
#endif
#if !MK_FUSED
template <int PH> __global__ __launch_bounds__(512, 2) void k_phase(Params p) {
  extern __shared__ __attribute__((aligned(16))) unsigned char lds_raw[];
  run_phase<PH>(p, lds_raw);
}
template <int PH> static bool set_lds() { return hipFuncSetAttribute((const void*)k_phase<PH>, hipFuncAttributeMaxDynamicSharedMemorySize, LDS_BYTES) == hipSuccess; }
template <int PH> static void launch_ph(int grid, hipStream_t stream, const Params& p) { hipLaunchKernelGGL(k_phase<PH>, dim3(grid), dim3(512), LDS_BYTES, stream, p); }
#else
constexpr int CTL_SCAN = 2048;
constexpr int CTL_S5SCNT = 2432;
#ifndef MK_CG_SYNC
#define MK_CG_SYNC 0
#endif
constexpr int CTL_BAR = 4096;
constexpr int LDS_BARST = LDS_STAGE + 1024;
#if MK_CG_SYNC
#define GRID_BAR() cooperative_groups::this_grid().sync()
#else
#ifdef MK_DOUBLE_BAR
#define GRID_BAR() do { xcd_barrier(xbar); xcd_barrier(xbar); } while (0)
#else
#define GRID_BAR() xcd_barrier(xbar)
#endif
#endif
typedef const __attribute__((address_space(4))) Params* KParamsPtr;
__device__ __forceinline__ KParamsPtr kparams() { KParamsPtr k = (KParamsPtr)__builtin_amdgcn_kernarg_segment_ptr(); asm volatile("" : "+s"(k)); return k; }
#define KP (*(const Params*)kparams())
#ifndef MK_MASK
#define MK_MASK 0xFFFF
#endif
#ifndef MK_REP_MASK
#define MK_REP_MASK 0
#endif
#ifndef MK_REP
#define MK_REP 1
#endif
#ifdef MK_NOEPI_PROBE
#define REP_PHASE(PH) do { if constexpr ((MK_REP_MASK >> PH) & 1) { if (opaque_tid() == 0) *(volatile LAS int*)((LAS unsigned char*)lds_raw + LDS_STAGE + 2040) = MK_NOEPI_PROBE; __syncthreads(); \
    for (int _r = 0; _r < MK_REP; ++_r) { run_phase<PH>(KP, lds_raw); GRID_BAR(); } } if (opaque_tid() == 0) *(volatile LAS int*)((LAS unsigned char*)lds_raw + LDS_STAGE + 2040) = 0; __syncthreads(); } while (0)
#else
#define REP_PHASE(PH) do { if constexpr ((MK_REP_MASK >> PH) & 1) { for (int _r = 0; _r < MK_REP; ++_r) { run_phase<PH>(KP, lds_raw); GRID_BAR(); } } } while (0)
#endif
#ifndef MK_TS_PHASE
#define MK_TS_PHASE -1
#endif
#ifndef MK_TS_SCALE
#define MK_TS_SCALE 5.0e-8f
#endif
#if MK_TS_PHASE >= 0
#ifdef MK_TS_CLOCK
#define TS_MARK() do { if (blockIdx.x == 0 && opaque_tid() == 0) { ((unsigned long long*)((unsigned*)(KP.ws + WS_CTL) + CTL_TS))[ts_n] = __builtin_readcyclecounter(); } ++ts_n; } while (0)
#else
#define TS_MARK() do { if (blockIdx.x == 0 && opaque_tid() == 0) { ((unsigned long long*)((unsigned*)(KP.ws + WS_CTL) + CTL_TS))[ts_n] = __builtin_amdgcn_s_memrealtime(); } ++ts_n; } while (0)
#endif
#else
#define TS_MARK() do { } while (0)
#endif
__global__ __launch_bounds__(512, 2) void k_mega(Params p_unused) {
  extern __shared__ __attribute__((aligned(16))) unsigned char lds_raw[];
  int ts_n = 0; (void)ts_n;
#if !MK_CG_SYNC
  volatile LAS unsigned* bst = (volatile LAS unsigned*)((LAS unsigned char*)lds_raw + LDS_BARST);
  if (threadIdx.x < 2) bst[threadIdx.x] = 0u;
  tid_table_init();
  __syncthreads();
  const XcdBarrier xbar = xcd_barrier_post((unsigned*)(KP.ws + WS_CTL) + CTL_BAR, bst);
#endif
  TS_MARK();
  REP_PHASE(PH_PRO);
#if MK_LN_IN_PRO
  if constexpr ((MK_MASK >> PH_PRO) & 1) run_phase<PH_PRO>(KP, lds_raw);
  { if (opaque_tid() == 0) { unsigned spins = 0;
      while (__hip_atomic_load((unsigned*)(KP.ws + WS_CTL) + CTL_MODCNT, __ATOMIC_ACQUIRE, __HIP_MEMORY_SCOPE_AGENT) < gridDim.x && ++spins < (1u << 22)) __builtin_amdgcn_s_sleep(4); }
    __syncthreads();
    __builtin_amdgcn_fence(__ATOMIC_ACQUIRE, "agent"); }
  TS_MARK();
#else
  if constexpr ((MK_MASK >> PH_PRO) & 1) run_phase<PH_PRO>(KP, lds_raw);  GRID_BAR(); TS_MARK();
#endif
  REP_PHASE(PH_LN);
  if constexpr ((MK_MASK >> PH_LN) & 1) run_phase<PH_LN>(KP, lds_raw);   GRID_BAR(); TS_MARK();
  REP_PHASE(PH_GIN);
  if constexpr ((MK_MASK >> PH_GIN) & 1) run_phase<PH_GIN>(KP, lds_raw);  GRID_BAR(); TS_MARK();
  REP_PHASE(PH_S5S);
#if MK_S5_IN_P3
  {
    unsigned* c_s5s = (unsigned*)(KP.ws + WS_CTL) + CTL_S5SCNT; unsigned* c_scan = (unsigned*)(KP.ws + WS_CTL) + CTL_SCAN;
    const int cB = blockIdx.x;
    if (cB < 160) {
      run_phase<PH_S5S>(KP, lds_raw);
      if (opaque_tid() == 0) { __threadfence(); __hip_atomic_fetch_add(c_s5s, 1u, __ATOMIC_RELEASE, __HIP_MEMORY_SCOPE_AGENT); }
    } else if (cB < 176) {
      if (opaque_tid() == 0) { unsigned spins = 0; while (__hip_atomic_load(c_s5s, __ATOMIC_ACQUIRE, __HIP_MEMORY_SCOPE_AGENT) < 160u && ++spins < (1u << 22)) __builtin_amdgcn_s_sleep(4); }
      __syncthreads();
      __builtin_amdgcn_fence(__ATOMIC_ACQUIRE, "agent");
      { const int t_ = opaque_tid(); s5_scan_item(KP, (cB - 160) * NWAVES + (t_ >> 6), t_ & 63); }
      asm volatile("s_waitcnt vmcnt(0)" ::: "memory");
      __syncthreads();
      if (opaque_tid() == 0) { __threadfence(); __hip_atomic_fetch_add(c_scan, 1u, __ATOMIC_RELEASE, __HIP_MEMORY_SCOPE_AGENT); }
    }
    run_phase<PH_QK>(KP, lds_raw);
    if (cB < 128) {
      if (opaque_tid() == 0) { unsigned spins = 0; while (__hip_atomic_load(c_scan, __ATOMIC_ACQUIRE, __HIP_MEMORY_SCOPE_AGENT) < 16u && ++spins < (1u << 22)) __builtin_amdgcn_s_sleep(4); }
      __syncthreads();
      __builtin_amdgcn_fence(__ATOMIC_ACQUIRE, "agent");
      run_phase<PH_S5Y>(KP, lds_raw);
    }
  }
  GRID_BAR(); TS_MARK();
  run_phase<PH_ATT>(KP, lds_raw);
#else
#if MK_TS_PHASE >= 16
  if (blockIdx.x == 0 && opaque_tid() == 0) ((unsigned long long*)((unsigned*)(KP.ws + WS_CTL) + CTL_TS))[21] = __builtin_amdgcn_s_memrealtime();
#endif
  if constexpr ((MK_MASK >> PH_S5S) & 1) run_phase<PH_S5S>(KP, lds_raw);
#if MK_TS_PHASE >= 16
  if (blockIdx.x == 0 && opaque_tid() == 0) ((unsigned long long*)((unsigned*)(KP.ws + WS_CTL) + CTL_TS))[22] = __builtin_amdgcn_s_memrealtime();
#endif
  if constexpr ((MK_MASK >> PH_QK) & 1) run_phase<PH_QK>(KP, lds_raw);
#if MK_TS_PHASE >= 16
  asm volatile("s_waitcnt vmcnt(0)" ::: "memory");
  if (blockIdx.x == 0 && opaque_tid() == 0) ((unsigned long long*)((unsigned*)(KP.ws + WS_CTL) + CTL_TS))[23] = __builtin_amdgcn_s_memrealtime();
#endif
  GRID_BAR(); TS_MARK();
  {
    unsigned* ctr = (unsigned*)(KP.ws + WS_CTL) + CTL_SCAN;
    if (blockIdx.x * NWAVES < 128) {
#if MK_TS_PHASE >= 16
      if (blockIdx.x == 0 && opaque_tid() == 0) ((unsigned long long*)((unsigned*)(KP.ws + WS_CTL) + CTL_TS))[16] = __builtin_amdgcn_s_memrealtime();
#endif
      if constexpr ((MK_MASK >> PH_SCAN) & 1) run_phase<PH_SCAN>(KP, lds_raw);
#if MK_TS_PHASE >= 16
      asm volatile("s_waitcnt vmcnt(0)" ::: "memory");
      if (blockIdx.x == 0 && opaque_tid() == 0) ((unsigned long long*)((unsigned*)(KP.ws + WS_CTL) + CTL_TS))[17] = __builtin_amdgcn_s_memrealtime();
#endif
      __threadfence();
      if ((opaque_tid() & 63) == 0 && blockIdx.x * NWAVES + (opaque_tid() >> 6) < 128) __hip_atomic_fetch_add(ctr, 1u, __ATOMIC_RELEASE, __HIP_MEMORY_SCOPE_AGENT);
    }
    if constexpr ((MK_MASK >> PH_ATT) & 1) run_phase<PH_ATT>(KP, lds_raw);
    if (opaque_tid() == 0) { unsigned spins = 0; while (__hip_atomic_load(ctr, __ATOMIC_ACQUIRE, __HIP_MEMORY_SCOPE_AGENT) < 128u && ++spins < (1u << 24)) __builtin_amdgcn_s_sleep(8); }
    __syncthreads();
    __threadfence();
    if constexpr ((MK_MASK >> PH_S5Y) & 1) run_phase<PH_S5Y>(KP, lds_raw);
  }
#endif
  GRID_BAR(); TS_MARK();
  REP_PHASE(PH_S5Y);
  REP_PHASE(PH_G1);
  if constexpr ((MK_MASK >> PH_G1) & 1) run_phase<PH_G1>(KP, lds_raw);   GRID_BAR(); TS_MARK();
  if constexpr ((MK_MASK >> PH_G2) & 1) run_phase<PH_G2>(KP, lds_raw);   GRID_BAR(); TS_MARK();
  REP_PHASE(PH_G3);
  if constexpr ((MK_MASK >> PH_G3) & 1) run_phase<PH_G3>(KP, lds_raw);   GRID_BAR(); TS_MARK();
  if constexpr ((MK_MASK >> PH_RT) & 1) run_phase<PH_RT>(KP, lds_raw);   GRID_BAR(); TS_MARK();
  REP_PHASE(PH_UP);
  if constexpr ((MK_MASK >> PH_UP) & 1) run_phase<PH_UP>(KP, lds_raw);   GRID_BAR(); TS_MARK();
  REP_PHASE(PH_DOWN);
  if constexpr ((MK_MASK >> PH_DOWN) & 1) run_phase<PH_DOWN>(KP, lds_raw); GRID_BAR(); TS_MARK();
#if MK_TS_PHASE >= 0
  GRID_BAR();
#endif
  if constexpr ((MK_MASK >> PH_FIN) & 1) run_phase<PH_FIN>(KP, lds_raw);
}
#endif

extern "C" void kernel_launch(void* const* d_in, const int* in_sizes, int n_in, void* d_out, int out_size, void* d_ws, size_t ws_size, hipStream_t stream) {
  static int grid = 0;
  if (grid == 0) {
    if (n_in != 32 || out_size != NLAT * DM || ws_size < WS_END) { fprintf(stderr, "kernel_launch: unexpected shapes n_in %d out %d ws %zu\n", n_in, out_size, ws_size); grid = -1; return; }
    int dev = 0, cus = 0;
    hipGetDevice(&dev); hipDeviceGetAttribute(&cus, hipDeviceAttributeMultiprocessorCount, dev);
#if !MK_FUSED
    bool ok = set_lds<0>() && set_lds<1>() && set_lds<2>() && set_lds<3>() && set_lds<4>() && set_lds<5>() && set_lds<6>() && set_lds<7>() && set_lds<8>() && set_lds<9>() && set_lds<10>() && set_lds<11>() && set_lds<12>() && set_lds<13>() && set_lds<14>();
    if (!ok) { fprintf(stderr, "kernel_launch: hipFuncSetAttribute failed\n"); grid = -1; return; }
    grid = cus > 0 ? cus : 256;
#else
    if (hipFuncSetAttribute((const void*)k_mega, hipFuncAttributeMaxDynamicSharedMemorySize, LDS_BYTES) != hipSuccess) { fprintf(stderr, "kernel_launch: hipFuncSetAttribute failed\n"); grid = -1; return; }
    int per_cu = 0;
    if (hipOccupancyMaxActiveBlocksPerMultiprocessor(&per_cu, (const void*)k_mega, 512, LDS_BYTES) != hipSuccess || per_cu < 1) { fprintf(stderr, "kernel_launch: occupancy query says %d blocks per CU\n", per_cu); grid = -1; return; }
    grid = (cus > 0 ? cus : 256) * 1;
#endif
  }
  if (grid < 0) return;
  Params p{};
  for (int i = 0; i < 32; ++i) p.in[i] = (const float*)d_in[i];
  p.out = (float*)d_out; p.ws = (unsigned char*)d_ws;
  hipMemsetAsync((char*)d_ws + WS_CTL, 0, 64 * 1024, stream);
#if !MK_FUSED
  launch_ph<PH_PRO>(grid, stream, p);
  launch_ph<PH_LN>(grid, stream, p);
  launch_ph<PH_GIN>(grid, stream, p);
  launch_ph<PH_QK>(grid, stream, p);
  launch_ph<PH_S5S>(grid, stream, p);
  launch_ph<PH_SCAN>(grid, stream, p);
  launch_ph<PH_ATT>(grid, stream, p);
  launch_ph<PH_S5Y>(grid, stream, p);
  launch_ph<PH_G1>(grid, stream, p);
  launch_ph<PH_G2>(grid, stream, p);
  launch_ph<PH_G3>(grid, stream, p);
  launch_ph<PH_RT>(grid, stream, p);
  launch_ph<PH_UP>(grid, stream, p);
  launch_ph<PH_DOWN>(grid, stream, p);
  launch_ph<PH_FIN>(grid, stream, p);
#else
  void* args[] = {&p};
  hipError_t e = hipLaunchCooperativeKernel((const void*)k_mega, dim3(grid), dim3(512), args, LDS_BYTES, stream);
  if (e != hipSuccess) fprintf(stderr, "kernel_launch: cooperative launch failed: %s (grid %d)\n", hipGetErrorString(e), grid);
#endif
}
```

```cpp
#define MK_HEAD_NOPS 13
#define MK_POSTRT_NOPS 1
#include <hip/hip_runtime.h>
#include <hip/hip_bf16.h>
#include <hip/hip_cooperative_groups.h>
#include <cstdint>
#include <cstdio>

typedef unsigned short bf16_t;
#define LAS __attribute__((address_space(3)))
typedef short bf16x8 __attribute__((ext_vector_type(8)));
typedef float f32x4 __attribute__((ext_vector_type(4)));
typedef float f32x2 __attribute__((ext_vector_type(2)));
typedef unsigned u32x4 __attribute__((ext_vector_type(4)));
typedef unsigned u32x2 __attribute__((ext_vector_type(2)));

__device__ __forceinline__ float bf2f(bf16_t v) { return __uint_as_float(((unsigned)v) << 16); }
__device__ __forceinline__ bf16_t f2bf(float f) { unsigned u = __float_as_uint(f); return (bf16_t)((u + 0x7fffu + ((u >> 16) & 1u)) >> 16); }
__device__ __forceinline__ unsigned cvt_pk_bf16(float lo, float hi) { unsigned r; asm volatile("v_cvt_pk_bf16_f32 %0, %1, %2" : "=v"(r) : "v"(lo), "v"(hi)); return r; }

constexpr int DM = 1024, NB = 2, SEQ = 8192, NCTX = 256;
constexpr int NLAT = NB * SEQ;
constexpr int SKV = SEQ + NCTX;
constexpr int NROW = NB * SKV;
constexpr int INW = 4096;
constexpr int NMOD = 6 * DM;
constexpr int PLD = 3584;
constexpr int PC_Q = 0, PC_K = 1024, PC_V = 1280, PC_G = 1536;
constexpr int NCHUNK = NROW / 16;
constexpr float LN_EPS = 1e-6f;
constexpr float ALPHA = 1.189207115002721f;

constexpr size_t MiB = 1u << 20;
constexpr size_t WS_CTL = 0;
constexpr size_t WS_MOD = 1 * MiB;
constexpr size_t WS_ROUTE = 2 * MiB;
constexpr size_t WS_S5AB = 5 * MiB;
constexpr size_t WS_S5T = 6 * MiB;
constexpr size_t WS_S5E = 14 * MiB;
constexpr size_t WS_WIN = 18 * MiB;
constexpr size_t WS_WGLU = 26 * MiB;
constexpr size_t WS_WAO = 28 * MiB;
constexpr size_t WS_WOUT = 30 * MiB;
constexpr size_t WS_WGU = 32 * MiB;
constexpr size_t WS_WD = 96 * MiB;
constexpr size_t WS_RH = 128 * MiB;
constexpr size_t WS_P = 162 * MiB;
constexpr size_t WS_KC = 280 * MiB;
constexpr size_t WS_VC = WS_KC + (size_t)NB * 2 * SKV * 128 * 2;
constexpr size_t WS_X1B = 268 * MiB;
constexpr size_t WS_END = 300 * MiB;
constexpr size_t DO_YA = 0, DO_GY = 34 * MiB;

struct Params {
  const float* in[32];
  float* out;
  unsigned char* ws;
};
enum { I_X = 0, I_C, I_CTX, I_CCTX, I_WMOD, I_BMOD, I_WIN, I_SARE, I_SAIM, I_SLDT, I_SBRE, I_SBIM, I_SCRE, I_SCIM, I_SD,
       I_WGA, I_WGB, I_QG, I_KG, I_WAO, I_WOUT, I_LN1G, I_LN1B, I_WRG, I_BRG, I_WRE, I_BRE, I_WEG, I_WEU, I_WED, I_LN2G, I_LN2B };

template <int CTRL> __device__ __forceinline__ float dpp_add(float v) { return v + __builtin_bit_cast(float, __builtin_amdgcn_update_dpp(0, __builtin_bit_cast(int, v), CTRL, 0xF, 0xF, false)); }
__device__ __forceinline__ float row16_sum(float v) {
  v = dpp_add<0xB1>(v); v = dpp_add<0x4E>(v); v = dpp_add<0x141>(v); v = dpp_add<0x140>(v); return v; }
__device__ __forceinline__ float wave_sum(float v) {
  v = row16_sum(v);
  { auto rr = __builtin_amdgcn_permlane16_swap(__float_as_uint(v), __float_as_uint(v), false, false); v = __uint_as_float(rr[0]) + __uint_as_float(rr[1]); }
  { auto rr = __builtin_amdgcn_permlane32_swap(__float_as_uint(v), __float_as_uint(v), false, false); v = __uint_as_float(rr[0]) + __uint_as_float(rr[1]); }
  return v;
}
__device__ __forceinline__ float lane_xor4(float x) {
  int t = __builtin_amdgcn_update_dpp(0, __builtin_bit_cast(int, x), 0x104, 0xF, 0x5, false);
  t = __builtin_amdgcn_update_dpp(t, __builtin_bit_cast(int, x), 0x114, 0xF, 0xA, false);
  return __builtin_bit_cast(float, t);
}
__device__ __forceinline__ float sigmoidf_(float x) { return 1.f / (1.f + __expf(-x)); }
__device__ __forceinline__ float siluf_(float x) { return x / (1.f + __expf(-x)); }
__device__ __forceinline__ float gelu_tanh(float x) {
  const float k0 = 0.7978845608028654f, k1 = 0.044715f;
  const float z = k0 * (x + k1 * x * x * x);
#if MK_GELU_RCP
  return x * __builtin_amdgcn_rcpf(1.f + __builtin_amdgcn_exp2f(-2.885390081777927f * z));
#else
  return x / (1.f + __expf(-2.f * z));
#endif
}
__device__ __forceinline__ int lat2pad(int lr) { return lr + (lr / SEQ) * NCTX; }

constexpr int NWAVES = 8;
constexpr int LDS_STAGE = 131072;
#ifndef MK_WRG_LDS
#define MK_WRG_LDS 1
#endif
constexpr int LDS_WRG = 147456;
constexpr int LDS_BYTES = MK_WRG_LDS ? 163840 : 147456;


constexpr int LDS_WIDTAB = LDS_STAGE + 15872;
__device__ __forceinline__ unsigned hw_wave_slot() { return (unsigned)__builtin_amdgcn_s_getreg(((6 - 1) << 11) | 4) & 63u; }
__device__ __forceinline__ int opaque_tid() {
  extern __shared__ __attribute__((aligned(16))) unsigned char lds_dyn_[];
  const int wv = __builtin_amdgcn_readfirstlane(((const volatile LAS int*)((LAS unsigned char*)lds_dyn_ + LDS_WIDTAB))[hw_wave_slot()]);
  unsigned m = ~0u; asm volatile("" : "+s"(m));
  int t = (wv << 6) | (int)__builtin_amdgcn_mbcnt_hi(m, __builtin_amdgcn_mbcnt_lo(m, 0u));
  asm volatile("" : "+v"(t)); return t;
}
__device__ __forceinline__ void tid_table_init() {
  extern __shared__ __attribute__((aligned(16))) unsigned char lds_dyn_[];
  if ((threadIdx.x & 63) == 0) ((volatile LAS int*)((LAS unsigned char*)lds_dyn_ + LDS_WIDTAB))[hw_wave_slot()] = (int)(threadIdx.x >> 6);
}

#ifndef MK_TS_PHASE
#define MK_TS_PHASE -1
#endif
#ifndef MK_TS_SCALE
#define MK_TS_SCALE 5.0e-8f
#endif
constexpr int CTL_TS = 3072;
#ifndef MK_CTX_IN_P1
#define MK_CTX_IN_P1 0
#endif
#ifndef MK_N1_NUM
#define MK_N1_NUM 3
#define MK_N1_DEN 5
#endif
#ifndef MK_RB_BF16
#define MK_RB_BF16 1
#endif
#ifndef MK_CVT_DEPTH3
#define MK_CVT_DEPTH3 0
#endif
#ifndef MK_CVT_42
#define MK_CVT_42 0
#endif
#ifndef MK_LAT_MINI
#define MK_LAT_MINI 1
#endif
#ifndef MK_BAR_TOPSPIN
#define MK_BAR_TOPSPIN 0
#endif
#ifndef MK_MOE_SPLIT
#define MK_MOE_SPLIT 0
#endif
#ifndef MK_NT_OUT
#define MK_NT_OUT 0
#endif
#ifndef MK_G12_MERGE
#define MK_G12_MERGE 1
#endif
#ifndef MK_GELU_RCP
#define MK_GELU_RCP 0
#endif
#ifndef MK_GEMM_ALIGN
#define MK_GEMM_ALIGN 0
#endif
#ifndef MK_GEMM_NOPS
#define MK_GEMM_NOPS 0
#endif
#ifndef MK_HEAD_NOPS
#define MK_HEAD_NOPS 0
#endif
#ifndef MK_CV_P3
#define MK_CV_P3 0
#endif
#ifndef MK_CV_ATT
#define MK_CV_ATT 0
#endif
#ifndef MK_KV_NUM
#define MK_KV_NUM 3
#endif
#ifndef MK_KV_DEN
#define MK_KV_DEN 4
#endif
#ifndef MK_WD_IN_UP
#define MK_WD_IN_UP 0
#endif
#ifndef MK_POST_NOPS
#define MK_POST_NOPS 0
#endif
#ifndef MK_MINI_LAST
#define MK_MINI_LAST 0
#endif
#ifndef MK_S5_XCD
#define MK_S5_XCD 0
#endif
#ifndef MK_WL_FILL2
#define MK_WL_FILL2 0
#endif
#ifndef MK_HOIST_CONST
#define MK_HOIST_CONST 1
#endif
#ifndef MK_POSTRT_NOPS
#define MK_POSTRT_NOPS 0
#endif
#ifndef MK_RT_HOIST2
#define MK_RT_HOIST2 1
#endif
#ifndef MK_ATT_NOPS
#define MK_ATT_NOPS 14
#endif
#ifndef MK_ATT_ALIGN
#define MK_ATT_ALIGN 0
#endif
#ifndef MK_CTX_KEEP
#define MK_CTX_KEEP 0
#endif
#ifndef MK_CTX_MINI
#define MK_CTX_MINI 0
#endif
#ifndef MK_LN_IN_PRO
#define MK_LN_IN_PRO 0
#endif
#ifndef MK_CTX_IN_PRO
#define MK_CTX_IN_PRO 0
#endif
constexpr int NCTXB = 8;
constexpr int CTL_CTXCNT = 2176;
constexpr int CTL_MODCNT = 2304, CTL_WINCNT = 2368;
#ifndef MK_MMA_PRIO
#define MK_MMA_PRIO 1
#endif
#ifndef MK_EARLY_DOWN
#define MK_EARLY_DOWN 0
#endif
#ifndef MK_WARM_G2
#define MK_WARM_G2 0
#endif
#ifndef MK_S5_IN_P3
#define MK_S5_IN_P3 0
#endif
#ifndef MK_MOE_HALF
#define MK_MOE_HALF 1
#endif
namespace pg {
constexpr int BM = 256, BK = 64, HALF = 128, HTB = HALF * BK * 2, STAGE_BYTES = 8 * HTB;
__host__ __device__ __forceinline__ int lds_byte(int r, int c) { const int st = (r >> 4) * 2 + (c >> 5), rr = r & 15, cc = c & 31, ob = rr * 64 + cc * 2; return st * 1024 + (ob ^ (((ob >> 9) & 1) << 5)); }
__host__ __device__ __forceinline__ void stage_rc(int b, int& R, int& C) { const int st = b / 1024, sb = b % 1024, swz = sb ^ (((sb >> 9) & 1) << 5); R = (st >> 1) * 16 + swz / 64; C = (st & 1) * 32 + (swz % 64) / 2; }
__host__ __device__ __forceinline__ int perm32(int rho) { const int n = rho >> 4, i = rho & 15; return 8 * (i >> 2) + 4 * n + (i & 3); }

struct Unit { int pm, pn, aux, arow, half; };
struct Addr {
  const bf16_t* A; int lda; size_t a_gs; const bf16_t* Bt; int K; size_t b_gs;
  bool gather;
  __device__ __forceinline__ const char* a_base(const Unit& u) const { return gather ? (const char*)A : (const char*)(A + (size_t)u.aux * a_gs + (size_t)u.arow * lda); }
  __device__ __forceinline__ const char* b_base(const Unit& u) const { return (const char*)(Bt + (size_t)u.aux * b_gs + (size_t)u.pn * BM * K); }
};
typedef f32x4 Acc[2][2][4][2];

template <class Epi, class Sched>
__device__ __forceinline__ void gemm_phase(LAS unsigned char* lds, const Addr AD, const Sched& S, const Epi& E) {
  const int tid = opaque_tid(), wid = __builtin_amdgcn_readfirstlane(tid >> 6), lane = tid & 63, wr = wid >> 2, wc = wid & 3, fr = lane & 15, fq = lane >> 4;
  int K_ = AD.K; asm volatile("" : "+s"(K_));
  const int K = K_, nt = K / BK, lda = AD.lda;
  int R0, C0; stage_rc(tid * 16, R0, C0);
  const unsigned voffB0 = (unsigned)(((Epi::PERM ? ((R0 & ~31) + perm32(R0 & 31)) : R0)) * K + C0) * 2u;
  const size_t pstepB = (size_t)64 * K * 2, pstepA = (size_t)64 * lda * 2, hstepA = (size_t)HALF * lda * 2;
  unsigned vA[2][2];
  const unsigned voffA0 = (unsigned)(R0 * lda + C0) * 2u;
#define PG_SETV(v, u) do { if constexpr (Sched::GATHER) { _Pragma("unroll") for (int _h = 0; _h < 2; ++_h) _Pragma("unroll") for (int _i = 0; _i < 2; ++_i) \
    v[_h][_i] = (unsigned)(S.arow(u, _h * HALF + _i * 64 + R0) * lda + C0) * 2u; } } while (0)
  const size_t kstep = (size_t)(BK * 2);
  const size_t hstepB = (size_t)HALF * K * 2;
  const unsigned ldsw = (unsigned)wid * 1024u;
  const int aoff = lds_byte(wr * 64 + fr, fq * 8), boff = lds_byte(wc * 32 + fr, fq * 8);
#define PG_SA(b, h) (((b) * 2 + (h)) * HTB)
#define PG_SB(b, h) ((4 + (b) * 2 + (h)) * HTB)
#define PG_STAGE_B(bufoff, gbase) do { _Pragma("unroll") for (int _i = 0; _i < 2; ++_i) { unsigned _vo = voffB0; asm volatile("" : "+v"(_vo)); \
    __builtin_amdgcn_global_load_lds((const unsigned*)((const char*)(gbase) + _i * pstepB + _vo), (LAS unsigned*)(lds + (bufoff) + ldsw + _i * 8192), 16, 0, 0); } } while (0)
#define PG_STAGE_A(b, h, gbase, V) do { _Pragma("unroll") for (int _i = 0; _i < 2; ++_i) { \
    if constexpr (Sched::GATHER) { unsigned _vo = V[h][_i]; asm volatile("" : "+v"(_vo)); __builtin_amdgcn_global_load_lds((const unsigned*)((const char*)(gbase) + _vo), (LAS unsigned*)(lds + PG_SA(b, h) + ldsw + _i * 8192), 16, 0, 0); } \
    else { unsigned _vo = voffA0; asm volatile("" : "+v"(_vo)); __builtin_amdgcn_global_load_lds((const unsigned*)((const char*)(gbase) + (h) * hstepA + _i * pstepA + _vo), (LAS unsigned*)(lds + PG_SA(b, h) + ldsw + _i * 8192), 16, 0, 0); } } } while (0)
#define PG_LDA(dst, b, h) do { _Pragma("unroll") for (int m = 0; m < 4; ++m) _Pragma("unroll") for (int k = 0; k < 2; ++k) dst[m][k] = *(const LAS bf16x8*)(lds + PG_SA(b, h) + aoff + m * 2048 + k * 1024); } while (0)
#define PG_LDB(dst, b, h) do { _Pragma("unroll") for (int n = 0; n < 2; ++n) _Pragma("unroll") for (int k = 0; k < 2; ++k) dst[n][k] = *(const LAS bf16x8*)(lds + PG_SB(b, h) + boff + n * 2048 + k * 1024); } while (0)
#define PG_MMA(ai, bj, At, Bt) do { __builtin_amdgcn_s_setprio(1); _Pragma("unroll") for (int m = 0; m < 4; ++m) _Pragma("unroll") for (int n = 0; n < 2; ++n) _Pragma("unroll") for (int k = 0; k < 2; ++k) \
    acc[ai][bj][m][n] = __builtin_amdgcn_mfma_f32_16x16x32_bf16(Bt[n][k], At[m][k], acc[ai][bj][m][n], 0, 0, 0); __builtin_amdgcn_s_setprio(0); } while (0)
#define PG_WAIT_V(n) asm volatile("s_waitcnt vmcnt(" #n ")" ::: "memory")
#define PG_WAIT_L(n) asm volatile("s_waitcnt lgkmcnt(" #n ")" ::: "memory")
#define PG_BAR __builtin_amdgcn_s_barrier()
#define PG_SCHED __builtin_amdgcn_sched_barrier(0)
  Unit cur, nxt; int ui = 0;
  if (!S.next(0, cur)) return;
  Acc acc;
#pragma unroll
  for (int a = 0; a < 2; ++a)
#pragma unroll
    for (int b = 0; b < 2; ++b)
#pragma unroll
      for (int m = 0; m < 4; ++m)
#pragma unroll
        for (int n = 0; n < 2; ++n) acc[a][b][m][n] = (f32x4){0.f, 0.f, 0.f, 0.f};
  bf16x8 At[4][2], B0[2][2], B1[2][2];
  const char* cA = AD.a_base(cur); const char* cB = AD.b_base(cur);
  PG_SETV(vA, cur);
  PG_STAGE_B(PG_SB(0, 0), cB); PG_STAGE_B(PG_SB(0, 1), cB + hstepB); PG_STAGE_A(0, 0, cA, vA); PG_STAGE_A(0, 1, cA, vA);
  if (wr == 1) PG_BAR;
  PG_WAIT_V(2); PG_BAR;
  PG_STAGE_B(PG_SB(1, 0), cB + kstep); PG_STAGE_A(1, 0, cA + kstep, vA); PG_STAGE_B(PG_SB(1, 1), cB + hstepB + kstep);
  PG_WAIT_V(6); PG_BAR;
#define PG_MMA1() do { if constexpr (Sched::HALF) { if (!cur.half) { PG_MMA(1, 0, At, B0); PG_MMA(1, 1, At, B1); } } else { PG_MMA(1, 0, At, B0); PG_MMA(1, 1, At, B1); } } while (0)
#define PG_KPAIR(a1, a2, b2, a3, b3, VN) do { \
      PG_LDB(B0, 0, 0); PG_LDB(B1, 0, 1); PG_SCHED; PG_LDA(At, 0, 0); PG_STAGE_A(1, 1, a1, vA); \
      PG_WAIT_V(8); PG_WAIT_L(0); PG_BAR; PG_MMA(0, 0, At, B0); PG_MMA(0, 1, At, B1); PG_BAR; PG_SCHED; \
      PG_LDA(At, 0, 1); PG_STAGE_B(PG_SB(0, 0), b2); PG_STAGE_B(PG_SB(0, 1), (b2) + hstepB); PG_STAGE_A(0, 0, a2, VN); \
      PG_WAIT_V(8); PG_WAIT_L(0); PG_BAR; PG_MMA1(); PG_BAR; PG_SCHED; \
      PG_LDB(B0, 1, 0); PG_LDB(B1, 1, 1); PG_SCHED; PG_LDA(At, 1, 0); PG_STAGE_A(0, 1, a2, VN); \
      PG_WAIT_V(8); PG_WAIT_L(0); PG_BAR; PG_MMA(0, 0, At, B0); PG_MMA(0, 1, At, B1); PG_BAR; PG_SCHED; \
      PG_LDA(At, 1, 1); PG_STAGE_B(PG_SB(1, 0), b3); PG_STAGE_B(PG_SB(1, 1), (b3) + hstepB); PG_STAGE_A(1, 0, a3, VN); \
      PG_WAIT_V(8); PG_WAIT_L(0); PG_BAR; PG_MMA1(); PG_BAR; PG_SCHED; } while (0)
#if MK_GEMM_ALIGN
  asm volatile(".p2align 8\n\t.rept %0\n\ts_nop 0\n\t.endr" :: "n"(MK_GEMM_NOPS));
#endif
  for (;;) {
    const bool has_next = S.next(ui + 1, nxt);
    const char* nA = has_next ? AD.a_base(nxt) : cA; const char* nB = has_next ? AD.b_base(nxt) : cB;
    if constexpr (Sched::GATHER) {
      unsigned vT[2][2];
      if (has_next) PG_SETV(vT, nxt); else {
#pragma unroll
        for (int _h = 0; _h < 2; ++_h)
#pragma unroll
          for (int _i = 0; _i < 2; ++_i) vT[_h][_i] = vA[_h][_i]; }
      *(LAS u32x4*)(lds + STAGE_BYTES + 2048 + tid * 16) = (u32x4){vT[0][0], vT[0][1], vT[1][0], vT[1][1]};
    }
    if constexpr (Sched::GATHER) {
      for (int t = 0; t < nt - 2; t += 2) {
        const char* a1 = cA + (size_t)(t + 1) * kstep; const char* a2 = cA + (size_t)(t + 2) * kstep; const char* b2 = cB + (size_t)(t + 2) * kstep;
        PG_KPAIR(a1, a2, b2, a2 + kstep, b2 + kstep, vA);
      }
      { const char* a1 = cA + (size_t)(nt - 1) * kstep;
        const u32x4 q = *(const LAS u32x4*)(lds + STAGE_BYTES + 2048 + tid * 16);
        unsigned vAn[2][2] = {{q.x, q.y}, {q.z, q.w}};
        PG_KPAIR(a1, nA, nB, nA + kstep, nB + kstep, vAn);
#pragma unroll
        for (int _h = 0; _h < 2; ++_h)
#pragma unroll
          for (int _i = 0; _i < 2; ++_i) vA[_h][_i] = vAn[_h][_i]; }
    } else {
      for (int t = 0; t < nt; t += 2) {
        const bool last = (t == nt - 2);
        const char* a1 = cA + (size_t)(t + 1) * kstep;
        const char* a2 = last ? nA : cA + (size_t)(t + 2) * kstep; const char* b2 = last ? nB : cB + (size_t)(t + 2) * kstep;
        PG_KPAIR(a1, a2, b2, a2 + kstep, b2 + kstep, vA);
      }
    }
    if (wr == 0) PG_BAR;
    E(acc, cur, wr, wc, fr, fq);
    if constexpr (Sched::HAS_DONE) S.done(cur, lane);
    if (!has_next) break;
#pragma unroll
    for (int a = 0; a < 2; ++a)
#pragma unroll
      for (int b = 0; b < 2; ++b)
#pragma unroll
        for (int m = 0; m < 4; ++m)
#pragma unroll
          for (int n = 0; n < 2; ++n) acc[a][b][m][n] = (f32x4){0.f, 0.f, 0.f, 0.f};
    cur = nxt; cA = nA; cB = nB; ++ui;
    if (wr == 1) PG_BAR;
  }
  PG_WAIT_V(0);
  PG_BAR;
#undef PG_MMA1
#undef PG_SETV
#undef PG_KPAIR
#undef PG_SA
#undef PG_SB
#undef PG_STAGE_A
#undef PG_STAGE_B
#undef PG_LDA
#undef PG_LDB
#undef PG_MMA
#undef PG_WAIT_V
#undef PG_WAIT_L
#undef PG_BAR
#undef PG_SCHED
}
}
namespace att {
using bf16x8 = __attribute__((ext_vector_type(8))) short;
using s16x4 = __attribute__((ext_vector_type(4))) short;
using f32x16 = __attribute__((ext_vector_type(16))) float;
using u32x4 = __attribute__((ext_vector_type(4))) unsigned;
constexpr int D = 128, NW = 8, QBLK = 32, KVBLK = 64;
constexpr float SCALE = 0.088388347648318440f;
constexpr float THR = 8.f;
constexpr int LDQ = PLD, LDK = 128, LDO = PLD;
constexpr int NRING = 3;
constexpr size_t SHM_V = KVBLK * D * 2, SHM_K = KVBLK * D * 2, SHM_ATTN = NRING * SHM_V + NRING * SHM_K + NW * 64 * 4;
constexpr float ROPE_C8[8] = {1.0f, 0.74989421f, 0.56234133f, 0.42169650f, 0.31622777f, 0.23713737f, 0.17782794f, 0.13335214f};
#define KSWZ(row, colB) ((row) * 256 + ((colB) ^ (((row) & 7) << 4)))
#define SBAR() __builtin_amdgcn_sched_barrier(0)
__device__ __forceinline__ int crow(int r, int hi) { return (r & 3) + 8 * (r >> 2) + 4 * hi; }
__device__ __forceinline__ unsigned cvtpk(float lo, float hi) { unsigned r; asm volatile("v_cvt_pk_bf16_f32 %0, %1, %2" : "=v"(r) : "v"(lo), "v"(hi)); return r; }
__device__ __forceinline__ void partialSM(f32x16& p0, f32x16& p1, float& m_reg, float& mn, float& alpha) {
  constexpr float C = SCALE * 1.4426950408889634f;
  float pmax = m_reg; asm volatile("" : "+v"(pmax));
  if (__builtin_expect(__all(pmax - m_reg <= THR / SCALE), 1)) { mn = m_reg; }
  else { mn = fmaxf(m_reg, pmax); m_reg = mn; }
  float mnC = -mn * C;
  for (int r = 0; r < 16; ++r) p0[r] = fmaf(p0[r], C, mnC); for (int r = 0; r < 16; ++r) p1[r] = fmaf(p1[r], C, mnC);
  for (int r = 0; r < 16; ++r) p0[r] = __builtin_amdgcn_exp2f(p0[r]);
}
__device__ __forceinline__ void finishSM(f32x16& p0, f32x16& p1, float alpha, float& l_reg, bf16x8& pa0, bf16x8& pa1, bf16x8& pa2, bf16x8& pa3) {
  for (int r = 0; r < 16; ++r) p1[r] = __builtin_amdgcn_exp2f(p1[r]);
  float ps = 0; for (int r = 0; r < 16; ++r) ps += p0[r]; for (int r = 0; r < 16; ++r) ps += p1[r];
  { auto rr = __builtin_amdgcn_permlane32_swap(__float_as_uint(ps), __float_as_uint(ps), false, false);
    ps = __uint_as_float(rr[0]) + __uint_as_float(rr[1]); }
  l_reg += ps;
#define PK4(P, BASE, OUT) do { unsigned a0 = cvtpk(P[BASE + 0], P[BASE + 1]), a1 = cvtpk(P[BASE + 2], P[BASE + 3]);   \
    unsigned b0 = cvtpk(P[BASE + 4], P[BASE + 5]), b1 = cvtpk(P[BASE + 6], P[BASE + 7]);                              \
    auto r0 = __builtin_amdgcn_permlane32_swap(a0, b0, false, false); auto r1 = __builtin_amdgcn_permlane32_swap(a1, b1, false, false); \
    u32x4 w = {r0[0], r1[0], r0[1], r1[1]}; OUT = *reinterpret_cast<bf16x8*>(&w); } while (0)
  PK4(p0, 0, pa0); PK4(p0, 8, pa1); PK4(p1, 0, pa2); PK4(p1, 8, pa3);
#undef PK4
}
__device__ __forceinline__ void qkt(f32x16& p0, f32x16& p1, const bf16_t* Ks, const bf16x8* qr, int r32, int hi) {
  p0 = f32x16{}; p1 = f32x16{};
  for (int d0 = 0; d0 < 8; ++d0) { int cb = (d0 * 16 + hi * 8) * 2;
    bf16x8 b0 = *reinterpret_cast<const bf16x8*>((const char*)Ks + KSWZ(r32, cb));
    bf16x8 b1 = *reinterpret_cast<const bf16x8*>((const char*)Ks + KSWZ(32 + r32, cb));
    p0 = __builtin_amdgcn_mfma_f32_32x32x16_bf16(b0, qr[d0], p0, 0, 0, 0);
    p1 = __builtin_amdgcn_mfma_f32_32x32x16_bf16(b1, qr[d0], p1, 0, 0, 0); }
}
__device__ __forceinline__ int v_st(int k, int c) { const int kk = (k & ~0xC) | ((k & 4) << 1) | ((k & 8) >> 1); return ((kk >> 3) * 4 + (c >> 5)) * 512 + ((kk & 7) * 32 + (c & 31)) * 2; }
__device__ __forceinline__ int v_rd_base(int lane) { return ((lane & 3) << 3) | (((lane >> 2) & 3) << 6) | (((lane >> 4) & 1) << 5) | (((lane >> 5) & 1) << 8); }
constexpr int v_rd_off(int d0, int ks, int half) { return d0 * 512 + ks * 4096 + half * 2048; }
template <int OFF> __device__ __forceinline__ s16x4 tr_read(int vb) {
  s16x4 r; asm volatile("ds_read_b64_tr_b16 %0, %1 offset:%2" : "=&v"(r) : "v"(vb), "i"(OFF) : "memory"); return r;
}
template <int D0> __device__ __forceinline__ void pv_one(f32x16& od, int vb, bf16x8 pa0, bf16x8 pa1, bf16x8 pa2, bf16x8 pa3) {
  const s16x4 l0 = tr_read<v_rd_off(D0, 0, 0)>(vb), h0 = tr_read<v_rd_off(D0, 0, 1)>(vb), l1 = tr_read<v_rd_off(D0, 1, 0)>(vb), h1 = tr_read<v_rd_off(D0, 1, 1)>(vb);
  const s16x4 l2 = tr_read<v_rd_off(D0, 2, 0)>(vb), h2 = tr_read<v_rd_off(D0, 2, 1)>(vb), l3 = tr_read<v_rd_off(D0, 3, 0)>(vb), h3 = tr_read<v_rd_off(D0, 3, 1)>(vb);
  asm volatile("s_waitcnt lgkmcnt(0)" ::: "memory"); SBAR();
#define PK(L, H) (bf16x8){L[0], L[1], L[2], L[3], H[0], H[1], H[2], H[3]}
  od = __builtin_amdgcn_mfma_f32_32x32x16_bf16(pa0, PK(l0, h0), od, 0, 0, 0);
  od = __builtin_amdgcn_mfma_f32_32x32x16_bf16(pa1, PK(l1, h1), od, 0, 0, 0);
  od = __builtin_amdgcn_mfma_f32_32x32x16_bf16(pa2, PK(l2, h2), od, 0, 0, 0);
  od = __builtin_amdgcn_mfma_f32_32x32x16_bf16(pa3, PK(l3, h3), od, 0, 0, 0);
#undef PK
}
__device__ __forceinline__ void pv_d0(f32x16* o, int vb, bf16x8 pa0, bf16x8 pa1, bf16x8 pa2, bf16x8 pa3) {
  pv_one<0>(o[0], vb, pa0, pa1, pa2, pa3); pv_one<1>(o[1], vb, pa0, pa1, pa2, pa3); pv_one<2>(o[2], vb, pa0, pa1, pa2, pa3); pv_one<3>(o[3], vb, pa0, pa1, pa2, pa3);
}
__device__ __forceinline__ void attn_dense_body(const bf16_t* __restrict__ Qb, const bf16_t* __restrict__ Kh, const bf16_t* __restrict__ Vh, bf16_t* __restrict__ Ob, int seq, float mbound, const float* __restrict__ qgain, int t0, char* lds) {
  const int tid = opaque_tid(), wid = tid >> 6, lane = tid & 63, r32 = lane & 31, hi = lane >> 5;
  bf16_t* V_lds = (bf16_t*)lds; bf16_t* K_lds = (bf16_t*)(lds + NRING * SHM_V);
  float* ws = (float*)(lds + NRING * SHM_V + NRING * SHM_K) + wid * 64; float* li_l = ws; float* al_l = ws + 32;
  float m_reg = mbound, l_reg = 0; f32x16 o[4]; bf16x8 qr[8];
  const bf16_t* Qw = Qb + (long)(wid * QBLK + r32) * LDQ + hi * 8;
#pragma unroll
  for (int d0 = 0; d0 < 8; ++d0) qr[d0] = *reinterpret_cast<const bf16x8*>(Qw + d0 * 16);
  {
#define UNPK8(W, X) do { X[0] = __uint_as_float(W.x << 16); X[1] = __uint_as_float(W.x & 0xffff0000u); X[2] = __uint_as_float(W.y << 16); X[3] = __uint_as_float(W.y & 0xffff0000u); \
                         X[4] = __uint_as_float(W.z << 16); X[5] = __uint_as_float(W.z & 0xffff0000u); X[6] = __uint_as_float(W.w << 16); X[7] = __uint_as_float(W.w & 0xffff0000u); } while (0)
    char* qs = lds + wid * 8192 + lane * 16;
    float ss = 0.f;
#pragma unroll
    for (int d0 = 0; d0 < 8; ++d0) { const u32x4 w = *reinterpret_cast<const u32x4*>(&qr[d0]); float x[8]; UNPK8(w, x);
#pragma unroll
      for (int j = 0; j < 8; ++j) ss += x[j] * x[j];
      *(u32x4*)(qs + d0 * 1024) = w; }
    { auto rr = __builtin_amdgcn_permlane32_swap(__float_as_uint(ss), __float_as_uint(ss), false, false); ss = __uint_as_float(rr[0]) + __uint_as_float(rr[1]); }
    const float rn = rsqrtf(ss * (1.f / 128.f) + 1e-6f);
    const int tq = t0 + wid * QBLK + r32;
#pragma unroll 1
    for (int it = 0; it < 4; ++it) { const int ax = it >> 1, d = it & 1, da = 4 * ax + d, db = da + 2;
      const float ph = (ax == 0 ? (float)(tq >> 6) : (float)(tq & 63)) * (hi ? 0.1f : 1.f) * (d ? 0.01f : 1.f);
      const u32x4 wa = *(const u32x4*)(qs + da * 1024), wb = *(const u32x4*)(qs + db * 1024);
      float xa[8], xb[8]; UNPK8(wa, xa); UNPK8(wb, xb);
      const f32x4 ga0 = *(const f32x4*)(qgain + 16 * da + 8 * hi), ga1 = *(const f32x4*)(qgain + 16 * da + 8 * hi + 4), gb0 = *(const f32x4*)(qgain + 16 * db + 8 * hi), gb1 = *(const f32x4*)(qgain + 16 * db + 8 * hi + 4);
      const float ga[8] = {ga0.x, ga0.y, ga0.z, ga0.w, ga1.x, ga1.y, ga1.z, ga1.w}, gb[8] = {gb0.x, gb0.y, gb0.z, gb0.w, gb1.x, gb1.y, gb1.z, gb1.w};
#pragma unroll
      for (int j = 0; j < 8; ++j) { const float ang = ph * ROPE_C8[j];
        const float sn = __sinf(ang), cs = __cosf(ang);
        const float x1 = xa[j] * rn * ga[j], x2 = xb[j] * rn * gb[j];
        xa[j] = x1 * cs - x2 * sn; xb[j] = x1 * sn + x2 * cs; }
      *(u32x4*)(qs + da * 1024) = (u32x4){cvtpk(xa[0], xa[1]), cvtpk(xa[2], xa[3]), cvtpk(xa[4], xa[5]), cvtpk(xa[6], xa[7])};
      *(u32x4*)(qs + db * 1024) = (u32x4){cvtpk(xb[0], xb[1]), cvtpk(xb[2], xb[3]), cvtpk(xb[4], xb[5]), cvtpk(xb[6], xb[7])}; }
#pragma unroll
    for (int d0 = 0; d0 < 8; ++d0) qr[d0] = *reinterpret_cast<const bf16x8*>(qs + d0 * 1024);
    asm volatile("s_waitcnt lgkmcnt(0)" ::: "memory");
    __syncthreads();
#undef UNPK8
  }
  SBAR();
#pragma unroll
  for (int d = 0; d < 4; ++d) o[d] = f32x16{};
  SBAR();
  const int sr = tid >> 4, sc = (tid & 15) * 8, vst0 = v_st(sr, sc), vst1 = v_st(32 + sr, sc);
  const int vb0 = (int)(uintptr_t)V_lds + v_rd_base(lane);
  struct { bf16x8 vs0, vs1, ks0, ks1; } sr_[2];
#define SLOAD(i, k0) do { sr_[i].vs0 = *(const bf16x8*)(&Vh[(long)((k0) + sr) * LDK + sc]); sr_[i].vs1 = *(const bf16x8*)(&Vh[(long)((k0) + 32 + sr) * LDK + sc]); \
    sr_[i].ks0 = *(const bf16x8*)(&Kh[(long)((k0) + sr) * LDK + sc]); sr_[i].ks1 = *(const bf16x8*)(&Kh[(long)((k0) + 32 + sr) * LDK + sc]); } while (0)
#define SWRITE(b, i) do { *(bf16x8*)((char*)V_lds + (b) * SHM_V + vst0) = sr_[i].vs0;          \
    *(bf16x8*)((char*)V_lds + (b) * SHM_V + vst1) = sr_[i].vs1; int kc = sc * 2;               \
    *(bf16x8*)((char*)K_lds + (b) * SHM_K + KSWZ(sr, kc)) = sr_[i].ks0;                       \
    *(bf16x8*)((char*)K_lds + (b) * SHM_K + KSWZ(32 + sr, kc)) = sr_[i].ks1; } while (0)
#define SWAIT() asm volatile("s_waitcnt vmcnt(4)" ::: "memory")
#define RESC(a) do { if (__any((a) < 1.f)) { if (hi == 0) al_l[r32] = (a); asm volatile("s_waitcnt lgkmcnt(0)" ::: "memory"); \
    for (int d = 0; d < 4; ++d) for (int r = 0; r < 16; ++r) o[d][r] *= al_l[crow(r, hi)]; } } while (0)
  f32x16 pA0, pA1, pB0, pB1; float mnA, mnB, alA, alB; bf16x8 pa0, pa1, pa2, pa3; const int NT = seq / KVBLK;
#define KRING(b) ((bf16_t*)((char*)K_lds + (b) * SHM_K))
#define ATT_STEP(PC0, PC1, MNC, ALC, PP0, PP1, ALP, KB, VBP, WB, SLW, SLL, TLOAD, DO_LOAD, DO_WRITE, WAIT0) do { \
    SBAR(); qkt(PC0, PC1, KRING(KB), qr, r32, hi); \
    finishSM(PP0, PP1, ALP, l_reg, pa0, pa1, pa2, pa3); SBAR(); \
    if (DO_LOAD) SLOAD(SLL, (TLOAD) * KVBLK); SBAR(); \
    pv_d0(o, vb0 + (VBP) * (int)SHM_V, pa0, pa1, pa2, pa3); partialSM(PC0, PC1, m_reg, MNC, ALC); \
    if (DO_WRITE) { if (WAIT0) asm volatile("s_waitcnt vmcnt(0)" ::: "memory"); else SWAIT(); SWRITE(WB, SLW); } \
    __syncthreads(); } while (0)
#define STEP_B(t, KB, VBP, WB, DL, DW, W0) ATT_STEP(pB0, pB1, mnB, alB, pA0, pA1, alA, KB, VBP, WB, 0, 1, (t) + 2, DL, DW, W0)
#define STEP_A(t, KB, VBP, WB, DL, DW, W0) ATT_STEP(pA0, pA1, mnA, alA, pB0, pB1, alB, KB, VBP, WB, 1, 0, (t) + 2, DL, DW, W0)
  SLOAD(0, 0); SLOAD(1, KVBLK); SWAIT(); SWRITE(0, 0); __syncthreads();
  SLOAD(0, 2 * KVBLK);
  qkt(pA0, pA1, KRING(0), qr, r32, hi); partialSM(pA0, pA1, m_reg, mnA, alA);
  SWAIT(); SWRITE(1, 1); __syncthreads();
  int t = 1, r0 = 0, r1 = 1, r2 = 2;
#define ATT_STEPR(PC0, PC1, MNC, ALC, PP0, PP1, ALP, SLW, SLL, DO_LOAD, DO_WRITE, WAIT0) do { \
    SBAR(); qkt(PC0, PC1, (bf16_t*)((char*)K_lds + r1 * (int)SHM_K), qr, r32, hi); \
    finishSM(PP0, PP1, ALP, l_reg, pa0, pa1, pa2, pa3); SBAR(); \
    if (DO_LOAD) SLOAD(SLL, (t + 2) * KVBLK); SBAR(); \
    pv_d0(o, vb0 + r0 * (int)SHM_V, pa0, pa1, pa2, pa3); partialSM(PC0, PC1, m_reg, MNC, ALC); \
    if (DO_WRITE) { if (WAIT0) asm volatile("s_waitcnt vmcnt(0)" ::: "memory"); else SWAIT(); SWRITE(r2, SLW); } \
    __syncthreads(); { const int _r = r0; r0 = r1; r1 = r2; r2 = _r; } ++t; } while (0)
#define STEPR_B(DL, DW, W0) ATT_STEPR(pB0, pB1, mnB, alB, pA0, pA1, alA, 0, 1, DL, DW, W0)
#define STEPR_A(DL, DW, W0) ATT_STEPR(pA0, pA1, mnA, alA, pB0, pB1, alB, 1, 0, DL, DW, W0)
#if MK_ATT_ALIGN
  asm volatile(".p2align 8\n\t.rept %0\n\ts_nop 0\n\t.endr" :: "n"(MK_ATT_NOPS));
#endif
  while (t + 3 < NT) { STEPR_B(true, true, false); STEPR_A(true, true, false); }
  STEPR_B(true, true, false);
  STEPR_A(false, true, true);
  STEPR_B(false, false, false);
  finishSM(pB0, pB1, alB, l_reg, pa0, pa1, pa2, pa3); SBAR();
  pv_d0(o, vb0 + r0 * (int)SHM_V, pa0, pa1, pa2, pa3);
#undef ATT_STEPR
#undef STEPR_A
#undef STEPR_B
#undef KRING
#undef ATT_STEP
#undef STEP_A
#undef STEP_B
  if (hi == 0) li_l[r32] = l_reg; asm volatile("s_waitcnt lgkmcnt(0)" ::: "memory");
  float rli[16];
#pragma unroll
  for (int r = 0; r < 16; ++r) rli[r] = __builtin_amdgcn_rcpf(li_l[crow(r, hi)]);
  int lane_e = lane; asm volatile("" : "+v"(lane_e));
  const int r32e = lane_e & 31, hie = lane_e >> 5;
  bf16_t* Ow = Ob + (long)(wid * QBLK) * LDO;
#pragma unroll
  for (int r = 0; r < 16; ++r) { int orow = crow(r, hie);
    for (int d0 = 0; d0 < 4; ++d0) Ow[(long)orow * LDO + d0 * 32 + r32e] = f2bf(o[d0][r] * rli[r]); }
  __syncthreads();
#undef SLOAD
#undef SWRITE
#undef SWAIT
#undef RESC
}
}

#define XB_TMO      128
#define XB_XCNT(j)  (256  + 64 * (j))
#define XB_XSUB(j)  (1280 + 64 * (j))
#define XB_XGEN(j)  (2304 + 64 * (j))
#define XB_TOP      3328
#define XB_TOPGEN   3392
#define XCD_BAR_WORDS 3456
#define XB_SPIN_CAP (1u << 18)

__device__ __forceinline__ unsigned xb_ld(unsigned* p)              { return __hip_atomic_load(p, __ATOMIC_RELAXED, __HIP_MEMORY_SCOPE_AGENT); }
__device__ __forceinline__ unsigned xb_add(unsigned* p, unsigned v) { return __hip_atomic_fetch_add(p, v, __ATOMIC_RELAXED, __HIP_MEMORY_SCOPE_AGENT); }
__device__ __forceinline__ unsigned xb_xcc_id() { return (unsigned)__builtin_amdgcn_s_getreg((3 << 11) | 20) & 0xFu; }
#define XB_SPIN(cond, bar) do { unsigned _sp = 0; while (cond) { __builtin_amdgcn_s_sleep(1); \
    if ((++_sp & 255u) == 0u) { if (xb_ld(&(bar)[XB_TMO])) break; if (_sp > XB_SPIN_CAP) { atomicAdd(&(bar)[XB_TMO], 1u); break; } } } } while (0)

struct XcdBarrier {
    unsigned* bar; unsigned x;
    volatile LAS unsigned* st;
};

__device__ __forceinline__ XcdBarrier xcd_barrier_post(unsigned* bar, volatile LAS unsigned* st) {
    XcdBarrier b; b.bar = bar; b.x = (unsigned)__builtin_amdgcn_readfirstlane((int)xb_xcc_id()); b.st = st;
    if (opaque_tid() == 0) (void)xb_add(&bar[XB_XCNT(b.x)], 1u);
    return b;
}
__device__ __forceinline__ void xcd_barrier_complete(unsigned* bar, unsigned x, unsigned& nloc, unsigned& nx) {
    const unsigned G = gridDim.x * gridDim.y * gridDim.z;
    unsigned sum, cnt, mine, sp = 0u;
    for (;;) {
        sum = 0u; cnt = 0u; mine = 0u;
#pragma unroll 1
        for (unsigned j = 0; j < 16; ++j) { const unsigned c = xb_ld(&bar[XB_XCNT(j)]); sum += c; cnt += (c > 0u) ? 1u : 0u; mine = (j == x) ? c : mine; }
        if (sum == G) break;
        __builtin_amdgcn_s_sleep(1);
        if ((++sp & 255u) == 0u) { if (xb_ld(&bar[XB_TMO])) break; if (sp > XB_SPIN_CAP) { atomicAdd(&bar[XB_TMO], 1u); break; } }
    }
    nloc = mine > 0u ? mine : 1u; nx = cnt > 0u ? cnt : 1u;
}

__device__ __forceinline__ void xcd_barrier(const XcdBarrier& b) {
    asm volatile("s_waitcnt vmcnt(0)" ::: "memory");
    __syncthreads();
    if (opaque_tid() == 0) {
        unsigned* bar = b.bar; unsigned bx = b.x; asm volatile("" : "+s"(bx));
        __builtin_amdgcn_s_waitcnt(0);
        unsigned nloc = b.st[0], nx = b.st[1];
        if (nloc == 0u) { xcd_barrier_complete(bar, bx, nloc, nx); b.st[0] = nloc; b.st[1] = nx; }
        const unsigned old = xb_add(&bar[XB_XSUB(bx)], 1u);
        const unsigned gen = old / nloc;
        if (old + 1u == (gen + 1u) * nloc) {
            __builtin_amdgcn_fence(__ATOMIC_RELEASE, "agent");
            asm volatile("s_waitcnt vmcnt(0)" ::: "memory");
            const unsigned og = xb_add(&bar[XB_TOP], 1u);
            const unsigned tg = og / nx;
            if (og + 1u == (tg + 1u) * nx) xb_add(&bar[XB_TOPGEN], 1u);
            else XB_SPIN(xb_ld(&bar[XB_TOPGEN]) == tg, bar);
            __builtin_amdgcn_fence(__ATOMIC_ACQUIRE, "agent");
#if !MK_BAR_TOPSPIN
            xb_add(&bar[XB_XGEN(bx)], 1u);
#endif
            asm volatile("s_waitcnt vmcnt(0)" ::: "memory");
        } else {
#if MK_BAR_TOPSPIN
            XB_SPIN(xb_ld(&bar[XB_TOPGEN]) == gen, bar);
#else
            XB_SPIN(xb_ld(&bar[XB_XGEN(bx)]) == gen, bar);
#endif
            __builtin_amdgcn_fence(__ATOMIC_ACQUIRE, "agent");
            asm volatile("s_waitcnt vmcnt(0)" ::: "memory");
        }
    }
    __syncthreads();
}


#if MK_TS_PHASE >= 16
#define BLD_TS(k) do { if (blockIdx.x == 0 && tid == 0) ((unsigned long long*)((unsigned*)(p.ws + WS_CTL) + CTL_TS))[(k) + 8] = __builtin_amdgcn_s_memrealtime(); } while (0)
#else
#define BLD_TS(k) do { } while (0)
#endif
__device__ __forceinline__ void s5_build_tables(const Params& p, LAS unsigned char* lds, int g) {
  const int tid = opaque_tid();
  BLD_TS(16);
  LAS float* Bb = (LAS float*)lds;
  LAS float* Cc = Bb + 4096;
  LAS float* PW = Cc + 4096;
  LAS float* KK = PW + 4352;
  {
    const int d = tid >> 8, pi = (tid >> 2) & 63, nq = tid & 3, dg = d * 32 + g, idx = dg * 64 + pi;
    const float are = p.in[I_SARE][idx], aim = p.in[I_SAIM][idx];
    const float dt = expf(p.in[I_SLDT][dg]);
    const float lam = are * dt, om = aim * dt;
    for (int n = nq; n <= 16; n += 4) { const float ea = expf(lam * (float)n); float sn, cs; sincosf(om * (float)n, &sn, &cs);
      PW[((d * 17 + n) * 64 + pi) * 2] = ea * cs; PW[((d * 17 + n) * 64 + pi) * 2 + 1] = ea * sn; }
  }
  __syncthreads();
  {
    const int d = tid >> 8, pi = (tid >> 2) & 63, c0 = (tid & 3) * 4, dg = d * 32 + g, idx = dg * 64 + pi;
    const float are = p.in[I_SARE][idx], aim = p.in[I_SAIM][idx];
    const f32x4 bre = *(const f32x4*)(p.in[I_SBRE] + idx * 16 + c0), bim = *(const f32x4*)(p.in[I_SBIM] + idx * 16 + c0);
    float cre[4], cim[4];
#pragma unroll
    for (int q = 0; q < 4; ++q) { cre[q] = p.in[I_SCRE][(dg * 16 + c0 + q) * 64 + pi]; cim[q] = p.in[I_SCIM][(dg * 16 + c0 + q) * 64 + pi]; }
    const float abr = PW[((d * 17 + 1) * 64 + pi) * 2], abi = PW[((d * 17 + 1) * 64 + pi) * 2 + 1];
    const float den = are * are + aim * aim;
    const float nr = abr - 1.f, ni = abi;
    const float rr = (nr * are + ni * aim) / den, ri = (ni * are - nr * aim) / den;
#pragma unroll
    for (int q = 0; q < 4; ++q) { const int c = c0 + q;
      Bb[((d * 64 + pi) * 16 + c) * 2] = rr * bre[q] - ri * bim[q]; Bb[((d * 64 + pi) * 16 + c) * 2 + 1] = rr * bim[q] + ri * bre[q];
      Cc[((d * 16 + c) * 64 + pi) * 2] = cre[q]; Cc[((d * 16 + c) * 64 + pi) * 2 + 1] = cim[q]; }
  }
  __syncthreads();
  BLD_TS(17);
  {
    const int d = tid >> 8, tau = (tid >> 4) & 15, c = tid & 15;
    float s[16];
#pragma unroll
    for (int c2 = 0; c2 < 16; ++c2) s[c2] = 0.f;
    for (int pi = 0; pi < 64; ++pi) {
      const f32x2 cv = *(const LAS f32x2*)(Cc + ((d * 16 + c) * 64 + pi) * 2), av = *(const LAS f32x2*)(PW + ((d * 17 + tau) * 64 + pi) * 2);
      const float mr = cv.x * av.x - cv.y * av.y, mi = cv.x * av.y + cv.y * av.x;
      const LAS f32x4* bp = (const LAS f32x4*)(Bb + ((d * 64 + pi) * 16) * 2);
#pragma unroll
      for (int q = 0; q < 8; ++q) { const f32x4 b = bp[q]; s[2 * q] += mr * b.x - mi * b.y; s[2 * q + 1] += mr * b.z - mi * b.w; }
    }
#pragma unroll
    for (int c2 = 0; c2 < 16; ++c2) KK[((d * 16 + tau) * 16 + c) * 16 + c2] = s[c2];
  }
  __syncthreads();
  BLD_TS(18);
  bf16_t* T = (bf16_t*)(p.ws + WS_S5T) + (size_t)g * 256 * 512;
  for (int o = tid; o < 256 * 32; o += 512) {
    const int n = o >> 5, ko = o & 31, i = n >> 4, c = n & 15, j = ko >> 1, c20 = (ko & 1) * 8;
    f32x4 x0 = (f32x4){0.f, 0.f, 0.f, 0.f}, x1 = x0;
    if (i >= j) { const LAS f32x4* kp = (const LAS f32x4*)(KK + ((0 * 16 + (i - j)) * 16 + c) * 16 + c20); x0 += kp[0]; x1 += kp[1]; }
    if (j >= i) { const LAS f32x4* kp = (const LAS f32x4*)(KK + ((1 * 16 + (j - i)) * 16 + c) * 16 + c20); x0 += kp[0]; x1 += kp[1]; }
    if (i == j && (c >> 3) == (ko & 1)) { const float dd = p.in[I_SD][g * 16 + c]; const int q = c & 7;
      if (q < 4) x0[q] += dd; else x1[q - 4] += dd; }
    u32x4 w; w.x = cvt_pk_bf16(x0[0], x0[1]); w.y = cvt_pk_bf16(x0[2], x0[3]); w.z = cvt_pk_bf16(x1[0], x1[1]); w.w = cvt_pk_bf16(x1[2], x1[3]);
    *(u32x4*)(T + (size_t)n * 512 + ko * 8) = w;
  }
  for (int o = tid; o < 256 * 32; o += 512) {
    const int n = o >> 5, ko = o & 31, i = n >> 4, c = n & 15, dd_ = ko >> 4, part = (ko >> 3) & 1, pi0 = (ko & 7) * 8, n_pw = dd_ ? (16 - i) : (i + 1);
    const LAS f32x4* cp = (const LAS f32x4*)(Cc + ((dd_ * 16 + c) * 64 + pi0) * 2);
    const LAS f32x4* ap = (const LAS f32x4*)(PW + ((dd_ * 17 + n_pw) * 64 + pi0) * 2);
    float x[8];
#pragma unroll
    for (int q = 0; q < 4; ++q) { const f32x4 cv = cp[q], av = ap[q];
      x[2 * q] = part ? -(cv.x * av.y + cv.y * av.x) : (cv.x * av.x - cv.y * av.y);
      x[2 * q + 1] = part ? -(cv.z * av.w + cv.w * av.z) : (cv.z * av.z - cv.w * av.w); }
    u32x4 w; w.x = cvt_pk_bf16(x[0], x[1]); w.y = cvt_pk_bf16(x[2], x[3]); w.z = cvt_pk_bf16(x[4], x[5]); w.w = cvt_pk_bf16(x[6], x[7]);
    *(u32x4*)(T + (size_t)n * 512 + 256 + ko * 8) = w;
  }
  BLD_TS(19);
  bf16_t* E = (bf16_t*)(p.ws + WS_S5E) + (size_t)g * 256 * 256;
  for (int o = tid; o < 256 * 32; o += 512) {
    const int n = o >> 5, ko = o & 31, dd_ = n >> 7, part = (n >> 6) & 1, pi = n & 63, j = ko >> 1, c20 = (ko & 1) * 8, n_pw = dd_ ? j : (15 - j);
    const f32x2 av = *(const LAS f32x2*)(PW + ((dd_ * 17 + n_pw) * 64 + pi) * 2);
    const LAS f32x4* bp = (const LAS f32x4*)(Bb + ((dd_ * 64 + pi) * 16 + c20) * 2);
    float x[8];
#pragma unroll
    for (int q = 0; q < 4; ++q) { const f32x4 bv = bp[q];
      x[2 * q] = part ? (av.x * bv.y + av.y * bv.x) : (av.x * bv.x - av.y * bv.y);
      x[2 * q + 1] = part ? (av.x * bv.w + av.y * bv.z) : (av.x * bv.z - av.y * bv.w); }
    u32x4 w; w.x = cvt_pk_bf16(x[0], x[1]); w.y = cvt_pk_bf16(x[2], x[3]); w.z = cvt_pk_bf16(x[4], x[5]); w.w = cvt_pk_bf16(x[6], x[7]);
    *(u32x4*)(E + (size_t)n * 256 + ko * 8) = w;
  }
  BLD_TS(20);
  __syncthreads();
}

struct SchedS5S {
  static constexpr bool GATHER = false, HAS_DONE = false, HALF = false;
  int G, c;
  __device__ __forceinline__ bool next(int i, pg::Unit& u) const {
    int L = i * G + c; if (L >= 160) return false;
#if MK_S5_XCD
    if (G == 256) { const int x = L & 7, j = L >> 3; L = (4 * x + j / 5) * 5 + j % 5; }
#endif
    u.aux = L / 5; u.pm = L % 5; u.pn = 0; u.arow = u.pm * 256; return true;
  }
};
struct EpiS5S {
  static constexpr bool PERM = false;
  float* S;
  __device__ __forceinline__ void operator()(const pg::Acc& acc, const pg::Unit& u, int wr, int wc, int fr, int fq) const {
    const int row0 = u.arow + wr * 64 + fr, col0 = wc * 32 + 4 * fq;
#pragma unroll
    for (int ai = 0; ai < 2; ++ai)
#pragma unroll
      for (int m = 0; m < 4; ++m) { const int r = row0 + ai * 128 + m * 16;
        if (r < NCHUNK) { float* rowp = S + ((size_t)u.aux * NCHUNK + r) * 256 + col0;
#pragma unroll
          for (int bj = 0; bj < 2; ++bj)
#pragma unroll
            for (int n = 0; n < 2; ++n) *(f32x4*)(rowp + bj * 128 + n * 16) = acc[ai][bj][m][n]; } }
  }
};
__device__ __forceinline__ void phase_s5s(const Params& p, LAS unsigned char* lds) {
  pg::Addr AD{(const bf16_t*)((unsigned char*)p.out + DO_YA), 512, (size_t)NCHUNK * 512, (const bf16_t*)(p.ws + WS_S5E), 256, (size_t)256 * 256, false};
  SchedS5S S{(int)gridDim.x, (int)blockIdx.x};
  EpiS5S E{(float*)(p.ws + WS_RH)};
  pg::gemm_phase(lds, AD, S, E);
}

__device__ __forceinline__ void s5_scan_item(const Params& p, int item, int lane) {
  const int d = item & 1, g = (item >> 1) & 31, b = item >> 6;
  const float* S = (const float*)(p.ws + WS_RH) + (size_t)g * NCHUNK * 256 + d * 128 + lane;
  bf16_t* YA = (bf16_t*)((unsigned char*)p.out + DO_YA) + (size_t)g * NCHUNK * 512 + 256 + d * 128 + lane;
  const int idx = (d * 32 + g) * 64 + lane;
  const float dt = expf(p.in[I_SLDT][d * 32 + g]);
  const float ea = expf(p.in[I_SARE][idx] * dt * 16.f); float sn, cs; sincosf(p.in[I_SAIM][idx] * dt * 16.f, &sn, &cs);
  const float ar = ea * cs, ai = ea * sn;
  float hr = 0.f, hi = 0.f;
  const int r0 = b * 528;
#pragma unroll 4
  for (int s = 0; s < 16; ++s) { const int r = r0 + 512 + (d ? 15 - s : s);
    const float sr = S[(size_t)r * 256], si = S[(size_t)r * 256 + 64];
    const float nr = ar * hr - ai * hi + sr, ni = ar * hi + ai * hr + si; hr = nr; hi = ni; }
  float sa[16], sb[16];
#define SCAN_LOAD(buf, s0) do { _Pragma("unroll") for (int q = 0; q < 8; ++q) { const int r = r0 + (d ? 511 - ((s0) + q) : (s0) + q); buf[2 * q] = S[(size_t)r * 256]; buf[2 * q + 1] = S[(size_t)r * 256 + 64]; } } while (0)
#define SCAN_STEP(buf, s0) do { _Pragma("unroll") for (int q = 0; q < 8; ++q) { const int r = r0 + (d ? 511 - ((s0) + q) : (s0) + q); \
    YA[(size_t)r * 512] = f2bf(hr); YA[(size_t)r * 512 + 64] = f2bf(hi); \
    const float nr = ar * hr - ai * hi + buf[2 * q], ni = ar * hi + ai * hr + buf[2 * q + 1]; hr = nr; hi = ni; } } while (0)
  SCAN_LOAD(sa, 0);
  for (int s = 0; s < 512; s += 16) {
    SCAN_LOAD(sb, s + 8);
    SCAN_STEP(sa, s);
    if (s + 16 < 512) SCAN_LOAD(sa, s + 16);
    SCAN_STEP(sb, s + 8);
  }
#undef SCAN_LOAD
#undef SCAN_STEP
}
__device__ __forceinline__ void phase_s5scan(const Params& p) {
  const int tid_ = opaque_tid(); const int lane = tid_ & 63, wave = tid_ >> 6;
  const int gw = blockIdx.x * NWAVES + wave;
  if (gw < 128) s5_scan_item(p, gw, lane);
}

struct SchedS5Y {
  static constexpr bool GATHER = false, HAS_DONE = false, HALF = false;
  int G, c;
  __device__ __forceinline__ bool next(int i, pg::Unit& u) const {
    int L = i * G + (MK_S5_IN_P3 ? c : ((c + G / 2) % G)); if (L >= 128) return false;
#if MK_S5_XCD
    if (G == 256) { const int x = L & 7, j = L >> 3; L = (4 * x + (j >> 2)) * 4 + (j & 3); }
#endif
    u.aux = L >> 2; u.pm = L & 3; u.pn = 0; u.arow = (u.pm >> 1) * 528 + (u.pm & 1) * 256; return true;
  }
};
struct EpiS5Y {
  static constexpr bool PERM = true;
  bf16_t* GY;
  __device__ __forceinline__ void operator()(const pg::Acc& acc, const pg::Unit& u, int wr, int wc, int fr, int fq) const {
    const int row0 = u.arow + wr * 64 + fr;
#pragma unroll
    for (int ai = 0; ai < 2; ++ai)
#pragma unroll
      for (int m = 0; m < 4; ++m) { const int chunk = row0 + ai * 128 + m * 16;
#pragma unroll
        for (int bj = 0; bj < 2; ++bj) { const int col = bj * 128 + wc * 32 + 8 * fq, ti = col >> 4, c0 = col & 15;
          float o[8];
#pragma unroll
          for (int n = 0; n < 2; ++n)
#pragma unroll
            for (int e = 0; e < 4; ++e) o[n * 4 + e] = gelu_tanh(acc[ai][bj][m][n][e]);
          u32x4 w; w.x = cvt_pk_bf16(o[0], o[1]); w.y = cvt_pk_bf16(o[2], o[3]); w.z = cvt_pk_bf16(o[4], o[5]); w.w = cvt_pk_bf16(o[6], o[7]);
          *(u32x4*)(GY + (size_t)(chunk * 16 + ti) * 512 + u.aux * 16 + c0) = w; } }
  }
};
__device__ __forceinline__ void phase_s5y(const Params& p, LAS unsigned char* lds) {
  pg::Addr AD{(const bf16_t*)((unsigned char*)p.out + DO_YA), 512, (size_t)NCHUNK * 512, (const bf16_t*)(p.ws + WS_S5T), 512, (size_t)256 * 512, false};
  SchedS5Y S{(int)gridDim.x, (int)blockIdx.x};
  EpiS5Y E{(bf16_t*)((unsigned char*)p.out + DO_GY)};
  pg::gemm_phase(lds, AD, S, E);
}
__device__ __forceinline__ void map_static(int L, int nM, int nN, int& pm, int& pn) {
  const int nwg = nM * nN; int wgid = L;
  { const int q = nwg / 8, r = nwg % 8, xcd = wgid % 8, off = wgid / 8; wgid = (xcd < r ? xcd * (q + 1) : r * (q + 1) + (xcd - r) * q) + off; }
  const int nig = 8 * nN, gid = wgid / nig, fm = gid * 8, gsz = (nM - fm) < 8 ? (nM - fm) : 8;
  pm = fm + ((wgid % nig) % gsz); pn = (wgid % nig) / gsz;
}

struct CvtItem { const float* src; bf16_t* dst; int ldw, ldd; };
__device__ __forceinline__ void cvt_load(const CvtItem& d, f32x4 (&r)[8], int lane) {
  const float* s = d.src + (size_t)(lane >> 3) * d.ldw + 4 * (lane & 7);
#pragma unroll
  for (int i = 0; i < 8; ++i) r[i] = __builtin_nontemporal_load((const f32x4*)(s + (size_t)(8 * i) * d.ldw));
}
__device__ __forceinline__ void cvt_store(const CvtItem& d, const f32x4 (&r)[8], LAS float* scr, int lane) {
  LAS float* w = scr + (lane >> 3) * 33 + 4 * (lane & 7);
#pragma unroll
  for (int i = 0; i < 8; ++i) { w[(8 * i) * 33 + 0] = r[i].x; w[(8 * i) * 33 + 1] = r[i].y; w[(8 * i) * 33 + 2] = r[i].z; w[(8 * i) * 33 + 3] = r[i].w; }
  asm volatile("s_waitcnt lgkmcnt(0)" ::: "memory");
  const int c = lane & 7;
#pragma unroll
  for (int j = 0; j < 4; ++j) { const int n = (lane >> 3) + 8 * j; const LAS float* s = scr + (8 * c) * 33 + n;
    u32x4 o; o.x = cvt_pk_bf16(s[0 * 33], s[1 * 33]); o.y = cvt_pk_bf16(s[2 * 33], s[3 * 33]); o.z = cvt_pk_bf16(s[4 * 33], s[5 * 33]); o.w = cvt_pk_bf16(s[6 * 33], s[7 * 33]);
    *(u32x4*)(d.dst + (size_t)n * d.ldd + 8 * c) = o; }
  asm volatile("s_waitcnt lgkmcnt(0)" ::: "memory");
}
__device__ __forceinline__ int ilv_row(int n, int second) { return (n >> 7) * 256 + (n & 127) + second * 128; }

constexpr int CV_WIN = (1024 / 64) * (4096 / 32);
constexpr int CV_GLU = (512 / 64) * (1024 / 32);
constexpr int CV_SQ = (1024 / 64) * (1024 / 32);
constexpr int CV_EGU = (1024 / 64) * (512 / 32);
constexpr int CV_ED = (512 / 64) * (1024 / 32);
constexpr int CV_SMALL = CV_WIN + 2 * CV_GLU + 2 * CV_SQ;
constexpr int CV_TOTAL = CV_SMALL + 32 * (2 * CV_EGU + CV_ED);
__device__ __forceinline__ int cv_pro_end() { return (MK_WD_IN_UP ? CV_TOTAL - 32 * CV_ED : CV_TOTAL) - ((gridDim.x == 256) ? MK_CV_P3 + MK_CV_ATT : 0); }

#if MK_CVT_42
__device__ __forceinline__ void cvt_kn(int it, int nb, int& kb_, int& nb_) { const int grp = it >> 3, w = it & 7, gpr = nb >> 1; kb_ = 4 * (grp / gpr) + (w >> 1); nb_ = 2 * (grp % gpr) + (w & 1); }
#else
__device__ __forceinline__ void cvt_kn(int it, int nb, int& kb_, int& nb_) { const int grp = it >> 3, w = it & 7, gpr = nb >> 2; kb_ = 2 * (grp / gpr) + (w >> 2); nb_ = 4 * (grp % gpr) + (w & 3); }
#endif
__device__ __forceinline__ CvtItem cvt_desc(const Params& p, int it) {
  unsigned char* ws = p.ws;
  if (it < CV_WIN) { const int nb = 4096 / 32; int kb_, nb_; cvt_kn(it, nb, kb_, nb_); const int n0 = 32 * nb_, k0 = 64 * kb_;
    return CvtItem{p.in[I_WIN] + (size_t)k0 * 4096 + n0, (bf16_t*)(ws + WS_WIN) + (size_t)n0 * 1024 + k0, 4096, 1024}; }
  it -= CV_WIN;
  if (it < 2 * CV_GLU) { const int second = it / CV_GLU; it %= CV_GLU; const int nb = 1024 / 32; int kb_, nb_; cvt_kn(it, nb, kb_, nb_); const int n0 = 32 * nb_, k0 = 64 * kb_;
    return CvtItem{p.in[second ? I_WGB : I_WGA] + (size_t)k0 * 1024 + n0, (bf16_t*)(ws + WS_WGLU) + (size_t)ilv_row(n0, second) * 512 + k0, 1024, 512}; }
  it -= 2 * CV_GLU;
  if (it < 2 * CV_SQ) { const int second = it / CV_SQ; it %= CV_SQ; const int nb = 1024 / 32; int kb_, nb_; cvt_kn(it, nb, kb_, nb_); const int n0 = 32 * nb_, k0 = 64 * kb_;
    return CvtItem{p.in[second ? I_WOUT : I_WAO] + (size_t)k0 * 1024 + n0, (bf16_t*)(ws + (second ? WS_WOUT : WS_WAO)) + (size_t)n0 * 1024 + k0, 1024, 1024}; }
  it -= 2 * CV_SQ;
#if MK_WD_IN_UP
  const bool is_d = it >= 32 * 2 * CV_EGU;
  const int e = is_d ? (it - 32 * 2 * CV_EGU) / CV_ED : it / (2 * CV_EGU);
  it = is_d ? 2 * CV_EGU + (it - 32 * 2 * CV_EGU) % CV_ED : it % (2 * CV_EGU);
#else
  const int per_e = 2 * CV_EGU + CV_ED, e = it / per_e; it %= per_e;
#endif
  if (it < 2 * CV_EGU) { const int second = it / CV_EGU; it %= CV_EGU; const int nb = 512 / 32; int kb_, nb_; cvt_kn(it, nb, kb_, nb_); const int n0 = 32 * nb_, k0 = 64 * kb_;
    return CvtItem{p.in[second ? I_WEU : I_WEG] + (size_t)e * 1024 * 512 + (size_t)k0 * 512 + n0, (bf16_t*)(ws + WS_WGU) + ((size_t)e * 1024 + ilv_row(n0, second)) * 1024 + k0, 512, 1024}; }
  it -= 2 * CV_EGU;
  { const int nb = 1024 / 32; int kb_, nb_; cvt_kn(it, nb, kb_, nb_); const int n0 = 32 * nb_, k0 = 64 * kb_;
    return CvtItem{p.in[I_WED] + (size_t)e * 512 * 1024 + (size_t)k0 * 1024 + n0, (bf16_t*)(ws + WS_WD) + ((size_t)e * 1024 + n0) * 512 + k0, 1024, 512}; }
}
#if MK_CVT_DEPTH3
template <bool SIGNAL_WIN> __device__ __forceinline__ void cvt_run(const Params& p, int lo, int CV_END, int gw, int NGW, LAS float* scr, int lane) {
  int it = lo + gw; if (it >= CV_END) return;
  f32x4 ra[8], rb[8], rc[8];
  CvtItem da = cvt_desc(p, it), db = da, dc = da;
  cvt_load(da, ra, lane);
  if (it + NGW < CV_END) { db = cvt_desc(p, it + NGW); cvt_load(db, rb, lane); }
  for (;;) {
    if (it + 2 * NGW < CV_END) { dc = cvt_desc(p, it + 2 * NGW); cvt_load(dc, rc, lane); }
    cvt_store(da, ra, scr, lane); it += NGW; if (it >= CV_END) break;
    if (it + 2 * NGW < CV_END) { da = cvt_desc(p, it + 2 * NGW); cvt_load(da, ra, lane); }
    cvt_store(db, rb, scr, lane); it += NGW; if (it >= CV_END) break;
    if (it + 2 * NGW < CV_END) { db = cvt_desc(p, it + 2 * NGW); cvt_load(db, rb, lane); }
    cvt_store(dc, rc, scr, lane); it += NGW; if (it >= CV_END) break;
  }
}
#else
template <bool SIGNAL_WIN> __device__ __forceinline__ void cvt_run(const Params& p, int lo, int CV_END, int gw, int NGW, LAS float* scr, int lane) {
  int it = lo + gw; if (it >= CV_END) return;
  CvtItem d = cvt_desc(p, it); f32x4 ra[8], rb[8];
  cvt_load(d, ra, lane);
  for (;;) {
    const int nit = it + NGW; const bool more = nit < CV_END; CvtItem dn = d;
    if (more) { dn = cvt_desc(p, nit); cvt_load(dn, rb, lane); }
    cvt_store(d, ra, scr, lane);
#if MK_CTX_IN_PRO
    if (SIGNAL_WIN && it < CV_WIN && nit >= CV_WIN) {
      asm volatile("s_waitcnt vmcnt(0)" ::: "memory"); __builtin_amdgcn_fence(__ATOMIC_RELEASE, "agent");
      if (lane == 0) __hip_atomic_fetch_add((unsigned*)(p.ws + WS_CTL) + CTL_WINCNT, 1u, __ATOMIC_RELAXED, __HIP_MEMORY_SCOPE_AGENT); }
#endif
    if (!more) break;
#pragma unroll
    for (int i = 0; i < 8; ++i) ra[i] = rb[i];
    d = dn; it = nit;
  }
}

#endif
__device__ __forceinline__ const float* ln_src_row(const Params& p, int pr) {
  const int b = pr / SKV, t = pr % SKV;
  return (t < SEQ) ? p.in[I_X] + ((size_t)b * SEQ + t) * DM : p.in[I_CTX] + ((size_t)b * NCTX + (t - SEQ)) * DM;
}
template <bool LAT> __device__ __forceinline__ void ln_batch_load_t(const Params& p, int r0, int NGW, f32x4 (&v)[4][4], int lane) {
#pragma unroll
  for (int r = 0; r < 4; ++r) { const int ri = r0 + r * NGW;
    if (ri < (LAT ? NLAT : NROW)) { const float* xr = LAT ? p.in[I_X] + (size_t)ri * DM : ln_src_row(p, ri);
#pragma unroll
      for (int j = 0; j < 4; ++j) v[r][j] = ((const f32x4*)xr)[lane + 64 * j]; } }
}
__device__ __forceinline__ void ln_batch_load(const Params& p, int pr0, int NGW, f32x4 (&v)[4][4], int lane) { ln_batch_load_t<false>(p, pr0, NGW, v, lane); }
__device__ __forceinline__ void ln_batch_load_lat(const Params& p, int lr0, int NGW, f32x4 (&v)[4][4], int lane) { ln_batch_load_t<true>(p, lr0, NGW, v, lane); }
struct LnCache { f32x4 sh[4], sc[4]; int idx; };
template <bool LAT> __device__ __forceinline__ void ln_batch_run_t(const Params& p, int r0, int NGW, f32x4 (&v)[4][4], int lane, LnCache& C) {
  const float* mod = (const float*)(p.ws + WS_MOD);
  bf16_t* H = (bf16_t*)(p.ws + WS_RH);
#pragma unroll
  for (int r = 0; r < 4; ++r) { const int ri = r0 + r * NGW; const int pr = LAT ? lat2pad(ri) : ri;
    if (ri < (LAT ? NLAT : NROW)) {
      const int b = pr / SKV, t = pr % SKV;
      const int mi = (t < SEQ) ? b : 2;
      const float* mrow = mod + mi * NMOD;
#if MK_HOIST_CONST
      if (mi != C.idx) { C.idx = mi;
#pragma unroll
        for (int j = 0; j < 4; ++j) { const int col = (lane + 64 * j) * 4; C.sh[j] = *(const f32x4*)(mrow + col); C.sc[j] = *(const f32x4*)(mrow + DM + col); } }
      f32x4 (&sh)[4] = C.sh; f32x4 (&sc)[4] = C.sc;
#else
      f32x4 sh[4], sc[4];
#pragma unroll
      for (int j = 0; j < 4; ++j) { const int col = (lane + 64 * j) * 4; sh[j] = *(const f32x4*)(mrow + col); sc[j] = *(const f32x4*)(mrow + DM + col); }
#endif
      float s = 0;
#pragma unroll
      for (int j = 0; j < 4; ++j) s += (v[r][j].x + v[r][j].y) + (v[r][j].z + v[r][j].w);
      const float mean = wave_sum(s) * (1.f / DM); float s2 = 0;
#pragma unroll
      for (int j = 0; j < 4; ++j) { v[r][j] = v[r][j] - mean; s2 += (v[r][j].x * v[r][j].x + v[r][j].y * v[r][j].y) + (v[r][j].z * v[r][j].z + v[r][j].w * v[r][j].w); }
      const float rstd = rsqrtf(wave_sum(s2) * (1.f / DM) + LN_EPS);
#pragma unroll
      for (int j = 0; j < 4; ++j) {
        const int col = (lane + 64 * j) * 4;
        const f32x4 o = v[r][j] * rstd * (sc[j] + 1.f) + sh[j];
        u32x2 w; w.x = cvt_pk_bf16(o.x, o.y); w.y = cvt_pk_bf16(o.z, o.w);
        *(u32x2*)(H + (size_t)pr * DM + col) = w;
      }
    } }
}
__device__ __forceinline__ void ln_batch_run(const Params& p, int pr0, int NGW, f32x4 (&v)[4][4], int lane, LnCache& C) { ln_batch_run_t<false>(p, pr0, NGW, v, lane, C); }
__device__ __forceinline__ void ln_batch_run(const Params& p, int pr0, int NGW, f32x4 (&v)[4][4], int lane) { LnCache C; C.idx = -1; ln_batch_run_t<false>(p, pr0, NGW, v, lane, C); }
__device__ __forceinline__ void ln_batch_run_lat(const Params& p, int lr0, int NGW, f32x4 (&v)[4][4], int lane) { LnCache C; C.idx = -1; ln_batch_run_t<true>(p, lr0, NGW, v, lane, C); }
struct SchedIn {
  static constexpr bool GATHER = false, HAS_DONE = false, HALF = false;
  int G, c;
  __device__ __forceinline__ bool next(int i, pg::Unit& u) const {
    const int L = i * G + c; u.aux = 0;
#if MK_LAT_MINI
    if (L < 1016) { int lm, pn; map_static(L, 64, 16, lm, pn); u.pm = lm + (lm >> 5); u.pn = pn; u.arow = u.pm * 256; return true; }
    if (L < 1024) { const int j = L - 1016; u.pm = (j < 4) ? 32 : 65; const int q = j & 3; u.pn = (q < 2) ? q : q + 4; u.arow = u.pm * 256; return true; }
    return false;
#endif
    if (L < 1024) { int lm, pn; map_static(L, 64, 16, lm, pn); u.pm = lm + (lm >> 5); u.pn = pn; u.arow = u.pm * 256; return true; }
    int nctxu = (MK_CTX_MINI && !MK_CTX_KEEP) ? 0 : 8; asm volatile("" : "+s"(nctxu));
    if (((!MK_CTX_IN_P1 && !MK_CTX_IN_PRO) || G < 64) && L < 1024 + nctxu) { const int j = L - 1024; u.pm = (j < 4) ? 32 : 65; const int q = j & 3; u.pn = (q < 2) ? q : q + 4; u.arow = u.pm * 256; return true; }
    return false;
  }
};
struct EpiIn {
  static constexpr bool PERM = true;
  bf16_t* YA; bf16_t* P;
#ifdef MK_NOEPI_PROBE
  volatile LAS int* skipflag;
#endif
  __device__ __forceinline__ void operator()(const pg::Acc& acc, const pg::Unit& u, int wr, int wc, int fr, int fq) const {
    const int row0 = u.pm * 256 + wr * 64 + fr;
#ifdef MK_NOEPI_PROBE
    if (*skipflag) return;
#endif
    if (u.pn < 2) {
#pragma unroll
      for (int ai = 0; ai < 2; ++ai)
#pragma unroll
        for (int m = 0; m < 4; ++m) { const int r = row0 + ai * 128 + m * 16, chunk = r >> 4, ti = r & 15;
#pragma unroll
          for (int bj = 0; bj < 2; ++bj) { const int ch = u.pn * 256 + bj * 128 + wc * 32 + 8 * fq, g = ch >> 4, off = ch & 15;
            const f32x4 v0 = acc[ai][bj][m][0], v1 = acc[ai][bj][m][1];
            u32x4 w; w.x = cvt_pk_bf16(v0[0], v0[1]); w.y = cvt_pk_bf16(v0[2], v0[3]); w.z = cvt_pk_bf16(v1[0], v1[1]); w.w = cvt_pk_bf16(v1[2], v1[3]);
            *(u32x4*)(YA + ((size_t)g * NCHUNK + chunk) * 512 + ti * 16 + off) = w; } }
    } else {
      const int colb = (u.pn - 2) * 256 + wc * 32 + 8 * fq; const bool sig = u.pn >= 8;
#pragma unroll
      for (int ai = 0; ai < 2; ++ai)
#pragma unroll
        for (int m = 0; m < 4; ++m) { bf16_t* rowp = P + (size_t)(row0 + ai * 128 + m * 16) * PLD + colb;
#pragma unroll
          for (int bj = 0; bj < 2; ++bj) { f32x4 v0 = acc[ai][bj][m][0], v1 = acc[ai][bj][m][1];
            if (sig) {
#pragma unroll
              for (int e = 0; e < 4; ++e) { v0[e] = __builtin_amdgcn_rcpf(1.f + __builtin_amdgcn_exp2f(-1.4426950408889634f * v0[e])); v1[e] = __builtin_amdgcn_rcpf(1.f + __builtin_amdgcn_exp2f(-1.4426950408889634f * v1[e])); } }
            u32x4 w; w.x = cvt_pk_bf16(v0[0], v0[1]); w.y = cvt_pk_bf16(v0[2], v0[3]); w.z = cvt_pk_bf16(v1[0], v1[1]); w.w = cvt_pk_bf16(v1[2], v1[3]);
            *(u32x4*)(rowp + bj * 128) = w; } }
    }
  }
};
#if MK_CTX_MINI
__device__ __forceinline__ void ctx_mini_gemm(const Params& p) {
  const int tid = opaque_tid(), lane = tid & 63, w = tid >> 6, fr = lane & 15, fq = lane >> 4;
  const bf16_t* H = (const bf16_t*)(p.ws + WS_RH); const bf16_t* W = (const bf16_t*)(p.ws + WS_WIN);
  bf16_t* YA = (bf16_t*)((unsigned char*)p.out + DO_YA); bf16_t* P = (bf16_t*)(p.ws + WS_P);
  for (int mu = blockIdx.x; mu < 256; mu += gridDim.x) {
    const int rg = mu >> 4, cg = mu & 15;
    const int row0 = (rg < 8 ? SEQ + rg * 32 : SKV + SEQ + (rg - 8) * 32) + (w >> 2) * 16;
    const int col0 = (cg < 8 ? cg * 64 : 1024 + cg * 64) + (w & 3) * 16;
    const bf16x8* ap = (const bf16x8*)(W + (size_t)(col0 + fr) * DM + fq * 8);
    const bf16x8* bp = (const bf16x8*)(H + (size_t)(row0 + fr) * DM + fq * 8);
    f32x4 acc = (f32x4){0.f, 0.f, 0.f, 0.f};
#pragma unroll 1
    for (int kb = 0; kb < 4; ++kb) {
      bf16x8 av[8], bv[8];
#pragma unroll
      for (int s = 0; s < 8; ++s) { av[s] = ap[(kb * 8 + s) * 4]; bv[s] = bp[(kb * 8 + s) * 4]; }
#pragma unroll
      for (int s = 0; s < 8; ++s) acc = __builtin_amdgcn_mfma_f32_16x16x32_bf16(av[s], bv[s], acc, 0, 0, 0);
    }
    u32x2 o; o.x = cvt_pk_bf16(acc[0], acc[1]); o.y = cvt_pk_bf16(acc[2], acc[3]);
    const int row = row0 + fr, ch = col0 + 4 * fq;
#ifdef MK_CTX_MINI_NOSTORE
    if (o.x == 0x12345678u)
#endif
    if (cg < 8) *(u32x2*)(YA + ((size_t)(ch >> 4) * NCHUNK + (row >> 4)) * 512 + (row & 15) * 16 + (ch & 15)) = o;
    else *(u32x2*)(P + (size_t)row * PLD + (ch - 512)) = o;
  }
}
#endif
#if MK_LAT_MINI
__device__ __forceinline__ void lat_mini_gemm(const Params& p) {
  const int tid = opaque_tid(), lane = tid & 63, w = tid >> 6, fr = lane & 15, fq = lane >> 4;
  const bf16_t* H = (const bf16_t*)(p.ws + WS_RH); const bf16_t* W = (const bf16_t*)(p.ws + WS_WIN);
  bf16_t* YA = (bf16_t*)((unsigned char*)p.out + DO_YA); bf16_t* P = (bf16_t*)(p.ws + WS_P);
  for (int mu = blockIdx.x; mu < 256; mu += gridDim.x) {
    int lm, pn; map_static(1016 + (mu >> 5), 64, 16, lm, pn);
    const int pm = lm + (lm >> 5), sub = mu & 31;
    const int row0 = pm * 256 + (sub >> 2) * 32 + (w >> 2) * 16, col0 = pn * 256 + (sub & 3) * 64 + (w & 3) * 16;
    const bf16x8* ap = (const bf16x8*)(W + (size_t)(col0 + fr) * DM + fq * 8);
    const bf16x8* bp = (const bf16x8*)(H + (size_t)(row0 + fr) * DM + fq * 8);
    f32x4 acc = (f32x4){0.f, 0.f, 0.f, 0.f};
#pragma unroll 1
    for (int kb = 0; kb < 2; ++kb) {
      bf16x8 av[16], bv[16];
#pragma unroll
      for (int s = 0; s < 16; ++s) { av[s] = ap[(kb * 16 + s) * 4]; bv[s] = bp[(kb * 16 + s) * 4]; }
#pragma unroll
      for (int s = 0; s < 16; ++s) acc = __builtin_amdgcn_mfma_f32_16x16x32_bf16(av[s], bv[s], acc, 0, 0, 0);
    }
    if (pn >= 8) {
#pragma unroll
      for (int e = 0; e < 4; ++e) acc[e] = __builtin_amdgcn_rcpf(1.f + __builtin_amdgcn_exp2f(-1.4426950408889634f * acc[e])); }
    u32x2 o; o.x = cvt_pk_bf16(acc[0], acc[1]); o.y = cvt_pk_bf16(acc[2], acc[3]);
    const int row = row0 + fr, ch = col0 + 4 * fq;
    if (pn < 2) *(u32x2*)(YA + ((size_t)(ch >> 4) * NCHUNK + (row >> 4)) * 512 + (row & 15) * 16 + (ch & 15)) = o;
    else *(u32x2*)(P + (size_t)row * PLD + (ch - 512)) = o;
  }
}
#endif
__device__ __forceinline__ void phase2(const Params& p, LAS unsigned char* lds) {
#if MK_CTX_MINI
  ctx_mini_gemm(p);
#endif
#if MK_LAT_MINI && !MK_MINI_LAST
  lat_mini_gemm(p);
#endif
  pg::Addr AD{(const bf16_t*)(p.ws + WS_RH), DM, 0, (const bf16_t*)(p.ws + WS_WIN), DM, 0, false};
  SchedIn S{(int)gridDim.x, (int)blockIdx.x};
#ifdef MK_NOEPI_PROBE
  EpiIn E{(bf16_t*)((unsigned char*)p.out + DO_YA), (bf16_t*)(p.ws + WS_P), (volatile LAS int*)(lds + LDS_STAGE + 2040)};
#else
  EpiIn E{(bf16_t*)((unsigned char*)p.out + DO_YA), (bf16_t*)(p.ws + WS_P)};
#endif
  pg::gemm_phase(lds, AD, S, E);
#if MK_LAT_MINI && MK_MINI_LAST
  lat_mini_gemm(p);
#endif
}

struct SchedOne {
  static constexpr bool GATHER = false, HAS_DONE = false, HALF = false;
  int pm, pn;
  __device__ __forceinline__ bool next(int i, pg::Unit& u) const { if (i > 0) return false; u.pm = pm; u.pn = pn; u.aux = 0; u.arow = pm * 256; return true; }
};
__device__ __forceinline__ void ctx_ln_and_unit(const Params& p, LAS unsigned char* lds, int c, int tid_) {
  const int lane = tid_ & 63, wave = tid_ >> 6;
  const int tile = c >> 2, pm = tile ? 65 : 32, quarter = c & 3;
  f32x4 va[4][4];
#pragma unroll 1
  for (int h = 0; h < 2; ++h) { const int pr0 = pm * 256 + quarter * 64 + wave * 8 + h * 4;
    ln_batch_load(p, pr0, 1, va, lane); ln_batch_run(p, pr0, 1, va, lane); }
  unsigned* ctr = (unsigned*)(p.ws + WS_CTL) + CTL_CTXCNT + tile * 64;
  asm volatile("s_waitcnt vmcnt(0)" ::: "memory");
  __syncthreads();
  if (tid_ == 0) { __threadfence(); __hip_atomic_fetch_add(ctr, 1u, __ATOMIC_RELEASE, __HIP_MEMORY_SCOPE_AGENT);
    unsigned spins = 0; while (__hip_atomic_load(ctr, __ATOMIC_ACQUIRE, __HIP_MEMORY_SCOPE_AGENT) < 4u && ++spins < (1u << 22)) __builtin_amdgcn_s_sleep(4);
    __threadfence(); }
  __syncthreads();
  __builtin_amdgcn_fence(__ATOMIC_ACQUIRE, "agent");
  pg::Addr AD{(const bf16_t*)(p.ws + WS_RH), DM, 0, (const bf16_t*)(p.ws + WS_WIN), DM, 0, false};
  SchedOne S{pm, (quarter < 2) ? quarter : quarter + 4};
#ifdef MK_NOEPI_PROBE
  EpiIn E{(bf16_t*)((unsigned char*)p.out + DO_YA), (bf16_t*)(p.ws + WS_P), (volatile LAS int*)(lds + LDS_STAGE + 2040)};
#else
  EpiIn E{(bf16_t*)((unsigned char*)p.out + DO_YA), (bf16_t*)(p.ws + WS_P)};
#endif
  pg::gemm_phase(lds, AD, S, E);
}
__device__ __forceinline__ void phase0(const Params& p, LAS unsigned char* lds) {
  const int tid = opaque_tid(), lane = tid & 63, wave = tid >> 6, c = blockIdx.x, G = gridDim.x;
  {
    LAS float* sv = (LAS float*)lds;
    LAS float* red = sv + 3 * DM;
    for (int i = tid; i < DM; i += 512) { sv[i] = siluf_(p.in[I_C][i]); sv[DM + i] = siluf_(p.in[I_C][DM + i]); sv[2 * DM + i] = siluf_(p.in[I_CCTX][i]); }
    __syncthreads();
    for (int cg = c; cg < NMOD / 24; cg += G) {
      const int c4 = tid % 6, rs = tid / 6;
      if (rs < 85) {
        const float* w = p.in[I_WMOD] + cg * 24 + 4 * c4;
        f32x4 wv[13];
#pragma unroll
        for (int q = 0; q < 13; ++q) { const int k = rs + 85 * q; wv[q] = (k < DM) ? *(const f32x4*)(w + (size_t)k * NMOD) : (f32x4){0.f, 0.f, 0.f, 0.f}; }
        f32x4 a0 = {0.f, 0.f, 0.f, 0.f}, a1 = a0, a2 = a0;
#pragma unroll
        for (int q = 0; q < 13; ++q) { const int k = rs + 85 * q; if (k < DM) { a0 += wv[q] * sv[k]; a1 += wv[q] * sv[DM + k]; a2 += wv[q] * sv[2 * DM + k]; } }
#pragma unroll
        for (int e = 0; e < 4; ++e) { red[(rs * 24 + 4 * c4 + e) * 3 + 0] = a0[e]; red[(rs * 24 + 4 * c4 + e) * 3 + 1] = a1[e]; red[(rs * 24 + 4 * c4 + e) * 3 + 2] = a2[e]; }
      }
      __syncthreads();
      if (tid < 72) { const int cc = tid / 3, r = tid % 3; float s = 0.f;
        for (int q = 0; q < 85; ++q) s += red[(q * 24 + cc) * 3 + r];
        ((float*)(p.ws + WS_MOD))[r * NMOD + cg * 24 + cc] = s + p.in[I_BMOD][cg * 24 + cc]; }
      __syncthreads();
    }
#if MK_CTX_IN_PRO || MK_LN_IN_PRO
    asm volatile("s_waitcnt vmcnt(0)" ::: "memory"); __syncthreads();
    if (tid == 0) { __threadfence(); __hip_atomic_fetch_add((unsigned*)(p.ws + WS_CTL) + CTL_MODCNT, 1u, __ATOMIC_RELEASE, __HIP_MEMORY_SCOPE_AGENT); }
#endif
  }
  const int nb = (G >= 64) ? 32 : 0;
  for (int g = c; g < 32; g += G) s5_build_tables(p, lds, g);
#if MK_CTX_IN_PRO
  if (G >= 64 && c < NCTXB) {
    if (tid == 0) { unsigned spins = 0;
      while (__hip_atomic_load((unsigned*)(p.ws + WS_CTL) + CTL_MODCNT, __ATOMIC_ACQUIRE, __HIP_MEMORY_SCOPE_AGENT) < (unsigned)G && ++spins < (1u << 22)) __builtin_amdgcn_s_sleep(4);
      while (__hip_atomic_load((unsigned*)(p.ws + WS_CTL) + CTL_WINCNT, __ATOMIC_ACQUIRE, __HIP_MEMORY_SCOPE_AGENT) < (unsigned)((G - nb) * NWAVES) && ++spins < (1u << 22)) __builtin_amdgcn_s_sleep(4);
      __threadfence(); }
    __syncthreads();
    __builtin_amdgcn_fence(__ATOMIC_ACQUIRE, "agent");
    ctx_ln_and_unit(p, lds, c, tid);
    return;
  }
#endif
  {
    LAS float* scr = (LAS float*)(lds + 8192) + wave * (64 * 33);
    const int CV_PRO = cv_pro_end();
    const int N1 = (nb > 0) ? ((CV_PRO * MK_N1_NUM) / MK_N1_DEN) & ~7 : 0;
    if (c >= nb) cvt_run<true>(p, 0, N1, (c - nb) * NWAVES + wave, (G - nb) * NWAVES, scr, lane);
    { const int skip = (MK_CTX_IN_PRO && G >= 64) ? NCTXB : 0;
      cvt_run<false>(p, N1, CV_PRO, (c - skip) * NWAVES + wave, (G - skip) * NWAVES, scr, lane); }
  }
}

__device__ __forceinline__ void phase1(const Params& p, LAS unsigned char* lds) {
  const int tid_ = opaque_tid(); const int lane = tid_ & 63, wave = tid_ >> 6;
  const int c = blockIdx.x, G = gridDim.x;
  if (MK_CTX_IN_P1 && G > 2 * NCTXB && c < NCTXB) { ctx_ln_and_unit(p, lds, c, tid_); return; }
  if (!MK_CTX_IN_P1 && !MK_CTX_IN_PRO) {
    const int gwa = c * NWAVES + wave, NGWa = G * NWAVES;
    f32x4 va[4][4], vb[4][4]; LnCache lnc; lnc.idx = -1;
    ln_batch_load(p, gwa, NGWa, va, lane);
    for (int pr0 = gwa; pr0 < NROW; pr0 += 8 * NGWa) {
      ln_batch_load(p, pr0 + 4 * NGWa, NGWa, vb, lane);
      ln_batch_run(p, pr0, NGWa, va, lane, lnc);
      ln_batch_load(p, pr0 + 8 * NGWa, NGWa, va, lane);
      ln_batch_run(p, pr0 + 4 * NGWa, NGWa, vb, lane, lnc);
    }
    return;
  }
  const int nb = (MK_CTX_IN_P1 && G > 2 * NCTXB) ? NCTXB : 0;
  const int gw = (c - nb) * NWAVES + wave, NGW = (G - nb) * NWAVES;
  f32x4 va[4][4], vb[4][4];
  ln_batch_load_lat(p, gw, NGW, va, lane);
  for (int lr0 = gw; lr0 < NLAT; lr0 += 8 * NGW) {
    ln_batch_load_lat(p, lr0 + 4 * NGW, NGW, vb, lane);
    ln_batch_run_lat(p, lr0, NGW, va, lane);
    ln_batch_load_lat(p, lr0 + 8 * NGW, NGW, va, lane);
    ln_batch_run_lat(p, lr0 + 4 * NGW, NGW, vb, lane);
  }
  if (nb == 0) {
    for (int pr0 = gw; pr0 < NROW; pr0 += 4 * NGW) {   }
  }
}

__device__ __forceinline__ void phase_qknorm(const Params& p) {
  const bf16_t* P = (const bf16_t*)(p.ws + WS_P); bf16_t* KC = (bf16_t*)(p.ws + WS_KC); bf16_t* VC = (bf16_t*)(p.ws + WS_VC);
  const int tid_ = opaque_tid(); const int lane = tid_ & 63, wave = tid_ >> 6;
  const int gw = blockIdx.x * NWAVES + wave, NGW = gridDim.x * NWAVES;
  const int sub = lane & 15, grp = lane >> 4, e0 = sub * 8, axis = sub >> 3; const bool hi_half = (sub & 4) != 0;
  float inv[8], gk[8];
#pragma unroll
  for (int j = 0; j < 8; ++j) { const int f = (e0 + j) & 31; inv[j] = exp2f(-(float)(2 * f) * (13.287712379549449f / 64.f)); gk[j] = p.in[I_KG][e0 + j]; }
  const bool weighted = MK_KV_NUM > 0 && gridDim.x == 256;
  const int R1 = ((NROW * MK_KV_NUM) / MK_KV_DEN) & ~3;
#pragma unroll 1
  for (int pass = 0; pass < 2; ++pass) {
    int lo_, hi_, g_, n_;
    if (weighted) { if (pass == 0) { if (blockIdx.x < 160) continue; lo_ = 0; hi_ = R1; g_ = ((int)blockIdx.x - 160) * NWAVES + wave; n_ = 96 * NWAVES; } else { lo_ = R1; hi_ = NROW; g_ = gw; n_ = NGW; } }
    else { if (pass == 1) break; lo_ = 0; hi_ = NROW; g_ = gw; n_ = NGW; }
  for (int pr0 = lo_ + g_; pr0 < hi_; pr0 += 4 * n_) {
    u32x4 wq[4];
#pragma unroll
    for (int q = 0; q < 4; ++q) { const int prq = pr0 + q * n_; if (prq < hi_) wq[q] = *(const u32x4*)(P + (size_t)prq * PLD + PC_K + lane * 8); }
#pragma unroll
    for (int q = 0; q < 4; ++q) { const int pr = pr0 + q * n_; if (pr < hi_) {
    const int b = pr / SKV, t = pr % SKV; const bool isctx = t >= SEQ;
    const u32x4 w = wq[q];
    bf16_t* dst = (grp < 2 ? KC : VC) + ((size_t)(b * 2 + (grp & 1)) * SKV + t) * 128 + e0;
    if (grp >= 2) { *(u32x4*)dst = w; }
    float x[8] = {__uint_as_float(w.x << 16), __uint_as_float(w.x & 0xffff0000u), __uint_as_float(w.y << 16), __uint_as_float(w.y & 0xffff0000u),
                  __uint_as_float(w.z << 16), __uint_as_float(w.z & 0xffff0000u), __uint_as_float(w.w << 16), __uint_as_float(w.w & 0xffff0000u)};
    float ss = 0.f;
#pragma unroll
    for (int j = 0; j < 8; ++j) ss += x[j] * x[j];
    ss = row16_sum(ss);
    const float r = rsqrtf(ss * (1.f / 128.f) + LN_EPS);
    const float posf = (axis == 0) ? (float)(t >> 6) : (float)(t & 63);
    float o[8];
#pragma unroll
    for (int j = 0; j < 8; ++j) { x[j] = x[j] * r * gk[j];
      const float y = lane_xor4(x[j]);
      float sn = 0.f, cs = 1.f; if (!isctx) { const float ang = posf * inv[j]; sn = __sinf(ang); cs = __cosf(ang); }
      o[j] = hi_half ? (y * sn + x[j] * cs) : (x[j] * cs - y * sn); }
    if (grp < 2) { u32x4 ow; ow.x = cvt_pk_bf16(o[0], o[1]); ow.y = cvt_pk_bf16(o[2], o[3]); ow.z = cvt_pk_bf16(o[4], o[5]); ow.w = cvt_pk_bf16(o[6], o[7]); *(u32x4*)dst = ow; }
    } }
  }
  }
}

__device__ __forceinline__ void cvt_idle_slot(const Params& p, LAS unsigned char* lds, int lo, int hi, int b0, int nb) {
  const int c = blockIdx.x; if (c < b0 || c >= b0 + nb || lo >= hi) return;
  const int tid = opaque_tid(), lane = tid & 63, wave = tid >> 6;
  __syncthreads();
  LAS float* scr = (LAS float*)(lds + 8192) + wave * (64 * 33);
  cvt_run<false>(p, lo, hi, (c - b0) * NWAVES + wave, nb * NWAVES, scr, lane);
  __syncthreads();
}

__device__ __forceinline__ void cvt_down_dynamic(const Params& p, LAS unsigned char* lds) {
  const int tid = opaque_tid(), lane = tid & 63, wave = tid >> 6;
  unsigned* ctr = (unsigned*)(p.ws + WS_CTL) + 10496;
  LAS float* scr = (LAS float*)(lds + 8192) + wave * (64 * 33);
  const int lo = CV_TOTAL - 32 * CV_ED;
  for (;;) {
    unsigned base = 0; if (lane == 0) base = __hip_atomic_fetch_add(ctr, 4u, __ATOMIC_RELAXED, __HIP_MEMORY_SCOPE_AGENT);
    base = (unsigned)__builtin_amdgcn_readfirstlane((int)base);
    if ((int)base >= 32 * CV_ED) break;
    cvt_run<false>(p, lo + (int)base, lo + (int)base + 4, 0, 1, scr, lane);
  }
}
struct SchedLat {
  static constexpr bool GATHER = false, HAS_DONE = false, HALF = false;
  int G, c, nN;
  __device__ __forceinline__ bool next(int i, pg::Unit& u) const {
    const int L = i * G + c; u.aux = 0;
    if (L >= 64 * nN) return false;
    int lm, pn; map_static(L, 64, nN, lm, pn); u.pm = lm + (lm >> 5); u.pn = pn; u.arow = u.pm * 256; return true;
  }
};
struct EpiGlu {
  static constexpr bool PERM = true;
  const bf16_t* P; bf16_t* Z;
  __device__ __forceinline__ void operator()(const pg::Acc& acc, const pg::Unit& u, int wr, int wc, int fr, int fq) const {
    const int row0 = u.pm * 256 + wr * 64 + fr, ch = u.pn * 128 + wc * 32 + 8 * fq;
    u32x4 gwv[2][4];
#pragma unroll
    for (int ai = 0; ai < 2; ++ai)
#pragma unroll
      for (int m = 0; m < 4; ++m) gwv[ai][m] = *(const u32x4*)(P + (size_t)(row0 + ai * 128 + m * 16) * PLD + PC_G + ch);
#pragma unroll
    for (int ai = 0; ai < 2; ++ai)
#pragma unroll
      for (int m = 0; m < 4; ++m) { const int r = row0 + ai * 128 + m * 16;
        const u32x4 gw = gwv[ai][m];
        float gt[8] = {__uint_as_float(gw.x << 16), __uint_as_float(gw.x & 0xffff0000u), __uint_as_float(gw.y << 16), __uint_as_float(gw.y & 0xffff0000u),
                       __uint_as_float(gw.z << 16), __uint_as_float(gw.z & 0xffff0000u), __uint_as_float(gw.w << 16), __uint_as_float(gw.w & 0xffff0000u)};
        float o[8];
#pragma unroll
        for (int n = 0; n < 2; ++n)
#pragma unroll
          for (int e = 0; e < 4; ++e) { const float a_ = acc[ai][0][m][n][e], b_ = acc[ai][1][m][n][e];
            o[n * 4 + e] = gt[n * 4 + e] * a_ * __builtin_amdgcn_rcpf(1.f + __builtin_amdgcn_exp2f(-1.4426950408889634f * b_)); }
        u32x4 w; w.x = cvt_pk_bf16(o[0], o[1]); w.y = cvt_pk_bf16(o[2], o[3]); w.z = cvt_pk_bf16(o[4], o[5]); w.w = cvt_pk_bf16(o[6], o[7]);
        *(u32x4*)(Z + (size_t)r * DM + ch) = w; }
  }
};
struct EpiMix {
  static constexpr bool PERM = true;
  const bf16_t* P; bf16_t* Z;
  __device__ __forceinline__ void operator()(const pg::Acc& acc, const pg::Unit& u, int wr, int wc, int fr, int fq) const {
    const int row0 = u.pm * 256 + wr * 64 + fr, col0 = u.pn * 256 + wc * 32 + 8 * fq;
#pragma unroll
    for (int ai = 0; ai < 2; ++ai) {
      u32x4 gwv[4][2], zwv[4][2];
#pragma unroll
      for (int m = 0; m < 4; ++m)
#pragma unroll
        for (int bj = 0; bj < 2; ++bj) { const int r = row0 + ai * 128 + m * 16, cc = col0 + bj * 128;
          gwv[m][bj] = *(const u32x4*)(P + (size_t)r * PLD + PC_G + 1024 + cc); zwv[m][bj] = *(const u32x4*)(Z + (size_t)r * DM + cc); }
#pragma unroll
      for (int m = 0; m < 4; ++m)
#pragma unroll
        for (int bj = 0; bj < 2; ++bj) { const int r = row0 + ai * 128 + m * 16, cc = col0 + bj * 128;
          const u32x4 gw = gwv[m][bj], zw = zwv[m][bj];
          const unsigned gq[4] = {gw.x, gw.y, gw.z, gw.w}, zq[4] = {zw.x, zw.y, zw.z, zw.w};
          unsigned ow[4];
#pragma unroll
          for (int q = 0; q < 4; ++q) { const float a0 = acc[ai][bj][m][q >> 1][(q & 1) * 2], a1 = acc[ai][bj][m][q >> 1][(q & 1) * 2 + 1];
            ow[q] = cvt_pk_bf16(__uint_as_float(zq[q] << 16) + __uint_as_float(gq[q] << 16) * a0, __uint_as_float(zq[q] & 0xffff0000u) + __uint_as_float(gq[q] & 0xffff0000u) * a1); }
          *(u32x4*)(Z + (size_t)r * DM + cc) = (u32x4){ow[0], ow[1], ow[2], ow[3]}; }
    }
  }
};
#if MK_RB_BF16
struct EpiOut {
  static constexpr bool PERM = true;
  const float* X; const float* mod; float* R1;
  __device__ __forceinline__ void operator()(const pg::Acc& acc, const pg::Unit& u, int wr, int wc, int fr, int fq) const {
    const int b = u.pm / 33, lrow0 = (u.pm - b) * 256 + wr * 64 + fr, colb = u.pn * 256 + wc * 32 + 8 * fq;
    const float* g1 = mod + b * NMOD + 2 * DM;
    bf16_t* RB = (bf16_t*)R1;
    f32x4 gv[2][2];
#pragma unroll
    for (int bj = 0; bj < 2; ++bj)
#pragma unroll
      for (int n = 0; n < 2; ++n) gv[bj][n] = *(const f32x4*)(g1 + colb + bj * 128 + 4 * n);
#pragma unroll
    for (int ai = 0; ai < 2; ++ai)
#pragma unroll
      for (int m = 0; m < 4; ++m) { bf16_t* rowp = RB + (size_t)(lrow0 + ai * 128 + m * 16) * DM + colb;
#pragma unroll
        for (int bj = 0; bj < 2; ++bj) { const f32x4 v0 = acc[ai][bj][m][0] * gv[bj][0], v1 = acc[ai][bj][m][1] * gv[bj][1];
          u32x4 w; w.x = cvt_pk_bf16(v0[0], v0[1]); w.y = cvt_pk_bf16(v0[2], v0[3]); w.z = cvt_pk_bf16(v1[0], v1[1]); w.w = cvt_pk_bf16(v1[2], v1[3]);
          *(u32x4*)(rowp + bj * 128) = w; } }
  }
};
#else
struct EpiOut {
  static constexpr bool PERM = false;
  const float* X; const float* mod; float* R1;
  __device__ __forceinline__ void operator()(const pg::Acc& acc, const pg::Unit& u, int wr, int wc, int fr, int fq) const {
    const int b = u.pm / 33, lrow0 = (u.pm - b) * 256 + wr * 64 + fr, col0 = u.pn * 256 + wc * 32 + 4 * fq;
    const float* g1 = mod + b * NMOD + 2 * DM;
    f32x4 gv[2][2];
#pragma unroll
    for (int bj = 0; bj < 2; ++bj)
#pragma unroll
      for (int n = 0; n < 2; ++n) gv[bj][n] = *(const f32x4*)(g1 + col0 + bj * 128 + n * 16);
#pragma unroll
    for (int ai = 0; ai < 2; ++ai) {
      f32x4 xv[4][2][2];
#pragma unroll
      for (int m = 0; m < 4; ++m) { const size_t off = (size_t)(lrow0 + ai * 128 + m * 16) * DM + col0;
#pragma unroll
        for (int bj = 0; bj < 2; ++bj)
#pragma unroll
          for (int n = 0; n < 2; ++n) xv[m][bj][n] = *(const f32x4*)(X + off + bj * 128 + n * 16); }
#pragma unroll
      for (int m = 0; m < 4; ++m) { const size_t off = (size_t)(lrow0 + ai * 128 + m * 16) * DM + col0;
#pragma unroll
        for (int bj = 0; bj < 2; ++bj)
#pragma unroll
          for (int n = 0; n < 2; ++n) *(f32x4*)(R1 + off + bj * 128 + n * 16) = xv[m][bj][n] * ALPHA + gv[bj][n] * acc[ai][bj][m][n]; }
    }
  }
};
#endif
struct SchedG1Pair {
  static constexpr bool GATHER = false, HAS_DONE = false, HALF = false;
  int c;
  __device__ __forceinline__ bool next(int i, pg::Unit& u) const {
    if (i >= 2) return false;
    int lm, pn; map_static(c, 64, 4, lm, pn); u.pm = lm + (lm >> 5); u.pn = 2 * pn + i; u.aux = 0; u.arow = u.pm * 256; return true;
  }
};
__device__ __forceinline__ void phase_g1(const Params& p, LAS unsigned char* lds) {
  pg::Addr AD{(const bf16_t*)((unsigned char*)p.out + DO_GY), 512, 0, (const bf16_t*)(p.ws + WS_WGLU), 512, 0, false};
  EpiGlu E{(const bf16_t*)(p.ws + WS_P), (bf16_t*)(p.ws + WS_RH)};
#if MK_G12_MERGE
  if (gridDim.x == 256) { SchedG1Pair S{(int)blockIdx.x}; pg::gemm_phase(lds, AD, S, E); return; }
#endif
  SchedLat S{(int)gridDim.x, (int)blockIdx.x, 8};
  pg::gemm_phase(lds, AD, S, E);
}
__device__ __forceinline__ void phase_g2(const Params& p, LAS unsigned char* lds) {
  pg::Addr AD{(const bf16_t*)(p.ws + WS_P) + PC_Q, PLD, 0, (const bf16_t*)(p.ws + WS_WAO), DM, 0, false};
  SchedLat S{(int)gridDim.x, (int)blockIdx.x, 4};
  EpiMix E{(const bf16_t*)(p.ws + WS_P), (bf16_t*)(p.ws + WS_RH)};
  pg::gemm_phase(lds, AD, S, E);
}
__device__ __forceinline__ void phase_g3(const Params& p, LAS unsigned char* lds) {
  pg::Addr AD{(const bf16_t*)(p.ws + WS_RH), DM, 0, (const bf16_t*)(p.ws + WS_WOUT), DM, 0, false};
  SchedLat S{(int)gridDim.x, (int)blockIdx.x, 4};
  EpiOut E{p.in[I_X], (const float*)(p.ws + WS_MOD), p.out};
  pg::gemm_phase(lds, AD, S, E);
}

constexpr size_t RT_EW = 0, RT_LIST = 256 * 1024;
constexpr int CTL_CNT = 8192, CNT_STRIDE = 64;
constexpr int ACT_TILES_MAX = 160;
constexpr size_t PR_ACT = 66 * MiB;

struct MoeTab { const LAS int* tb; const LAS int* cn; };
__device__ __forceinline__ MoeTab moe_tables(const Params& p, LAS unsigned char* lds) {
  LAS int* tb = (LAS int*)(lds + LDS_STAGE); LAS int* cn = tb + 64;
  const unsigned* cnt = (const unsigned*)(p.ws + WS_CTL) + CTL_CNT;
  if (opaque_tid() == 0) { int acc = 0; for (int e = 0; e < 32; ++e) { const int c = (int)cnt[e * CNT_STRIDE]; cn[e] = c; tb[e] = acc; acc += (c + 255) >> 8; } tb[32] = acc; }
  __syncthreads();
  return MoeTab{tb, cn};
}
struct SchedMoe {
  static constexpr bool GATHER_ = true;
  int G, c, nN; MoeTab tab; const int* lists;
  __device__ __forceinline__ bool next_(int i, pg::Unit& u) const {
    if ((G & 7) != 0) {
      const int L = i * G + c, T = L / nN;
      if (T >= tab.tb[32]) return false;
      int e = 0;
#pragma unroll 1
      for (int q = 1; q < 32; ++q) e = (tab.tb[q] <= T) ? q : e;
      u.pm = T; u.pn = L % nN; u.aux = e; u.arow = T * 256; return true;
    }
    const int x = c & 7, j = c >> 3, nper = G >> 3;
    int idx = j + nper * i;
#pragma unroll 1
    for (int k = 0; k < 4; ++k) { const int e = x + 8 * k, n_e = (tab.tb[e + 1] - tab.tb[e]) * nN;
      if (idx < n_e) { const int T = tab.tb[e] + idx / nN; u.pm = T; u.pn = idx % nN; u.aux = e; u.arow = T * 256; return true; }
      idx -= n_e; }
    return false;
  }
  __device__ __forceinline__ int arow_(const pg::Unit& u, int r) const {
    const int slot = (u.pm - tab.tb[u.aux]) * 256 + r;
    if (slot >= tab.cn[u.aux]) return 0;
    return lat2pad(lists[u.aux * NLAT + slot] >> 1);
  }
};
constexpr int NEARLY = 48;
constexpr int CTL_TILECNT = 10496;
struct SchedMoeUp : SchedMoe { static constexpr bool GATHER = true, HAS_DONE = true, HALF = false;
  unsigned* tilecnt; bool early;
  __device__ __forceinline__ bool next(int i, pg::Unit& u) const { return next_(i, u); }
  __device__ __forceinline__ int arow(const pg::Unit& u, int r) const { return arow_(u, r); }
  __device__ __forceinline__ void done(const pg::Unit& u, int lane) const {
    if (early && u.pm < NEARLY) { asm volatile("s_waitcnt vmcnt(0)" ::: "memory"); __builtin_amdgcn_fence(__ATOMIC_RELEASE, "agent"); asm volatile("s_waitcnt vmcnt(0)" ::: "memory");
      if (lane == 0) __hip_atomic_fetch_add(tilecnt + 64 * u.pm, 1u, __ATOMIC_RELAXED, __HIP_MEMORY_SCOPE_AGENT); } } };
struct SchedMoeDown : SchedMoe { static constexpr bool GATHER = false, HAS_DONE = false, HALF = false;
  int t_first;
  __device__ __forceinline__ bool next(int i, pg::Unit& u) const {
    if (t_first == 0) return next_(i, u);
    const int L = i * G + c, T = t_first + L / nN;
    if (T >= tab.tb[32]) return false;
    int e = 0;
#pragma unroll 1
    for (int q = 1; q < 32; ++q) e = (tab.tb[q] <= T) ? q : e;
    u.pm = T; u.pn = L % nN; u.aux = e; u.arow = T * 256; return true; } };
struct SchedMoeDownOne : SchedMoe { static constexpr bool GATHER = false, HAS_DONE = false, HALF = false;
  int T, pn;
  __device__ __forceinline__ bool next(int i, pg::Unit& u) const {
    if (i > 0) return false;
    int e = 0;
#pragma unroll 1
    for (int q = 1; q < 32; ++q) e = (tab.tb[q] <= T) ? q : e;
    u.pm = T; u.pn = pn; u.aux = e; u.arow = T * 256; return true; } };
struct EpiGU {
  static constexpr bool PERM = true;
  bf16_t* ACT;
  __device__ __forceinline__ void operator()(const pg::Acc& acc, const pg::Unit& u, int wr, int wc, int fr, int fq) const {
    const int row0 = u.pm * 256 + wr * 64 + fr, ch = u.pn * 128 + wc * 32 + 8 * fq;
#pragma unroll
    for (int ai = 0; ai < 2; ++ai)
#pragma unroll
      for (int m = 0; m < 4; ++m) { const int r = row0 + ai * 128 + m * 16;
        float o[8];
#pragma unroll
        for (int n = 0; n < 2; ++n)
#pragma unroll
          for (int e = 0; e < 4; ++e) { const float a = acc[ai][0][m][n][e], b = acc[ai][1][m][n][e];
            o[n * 4 + e] = a * b * __builtin_amdgcn_rcpf(1.f + __builtin_amdgcn_exp2f(-1.4426950408889634f * a)); }
        u32x4 w; w.x = cvt_pk_bf16(o[0], o[1]); w.y = cvt_pk_bf16(o[2], o[3]); w.z = cvt_pk_bf16(o[4], o[5]); w.w = cvt_pk_bf16(o[6], o[7]);
        *(u32x4*)(ACT + (size_t)r * 512 + ch) = w; }
  }
};
struct EpiDown {
  static constexpr bool PERM = true;
  bf16_t* Y2; const int* lists; const float* ew; MoeTab tab;
  __device__ __forceinline__ void operator()(const pg::Acc& acc, const pg::Unit& u, int wr, int wc, int fr, int fq) const {
    const int slot0 = (u.pm - tab.tb[u.aux]) * 256 + wr * 64 + fr, n_e = tab.cn[u.aux], col0 = u.pn * 256 + wc * 32 + 8 * fq;
    int ids[2][4]; float wts[2][4];
#pragma unroll
    for (int ai = 0; ai < 2; ++ai)
#pragma unroll
      for (int m = 0; m < 4; ++m) { const int slot = slot0 + ai * 128 + m * 16; ids[ai][m] = (slot < n_e) ? lists[u.aux * NLAT + slot] : -1; }
#pragma unroll
    for (int ai = 0; ai < 2; ++ai)
#pragma unroll
      for (int m = 0; m < 4; ++m) wts[ai][m] = (ids[ai][m] >= 0) ? ew[ids[ai][m]] : 0.f;
#pragma unroll
    for (int ai = 0; ai < 2; ++ai)
#pragma unroll
      for (int m = 0; m < 4; ++m) {
        if (ids[ai][m] >= 0) { const int id = ids[ai][m]; const float w = wts[ai][m];
#pragma unroll
          for (int bj = 0; bj < 2; ++bj) { const f32x4 v0 = acc[ai][bj][m][0] * w, v1 = acc[ai][bj][m][1] * w;
            u32x4 o; o.x = cvt_pk_bf16(v0[0], v0[1]); o.y = cvt_pk_bf16(v0[2], v0[3]); o.z = cvt_pk_bf16(v1[0], v1[1]); o.w = cvt_pk_bf16(v1[2], v1[3]);
            *(u32x4*)(Y2 + (size_t)id * DM + col0 + bj * 128) = o; } } }
  }
};
__device__ __forceinline__ void phase_moe_up(const Params& p, LAS unsigned char* lds) {
  const MoeTab tab = moe_tables(p, lds);
  const bool early = (MK_EARLY_DOWN != 0) && gridDim.x == 256;
  unsigned* tilecnt = (unsigned*)(p.ws + WS_CTL) + CTL_TILECNT;
  {
    pg::Addr AD{(const bf16_t*)(p.ws + WS_RH), DM, 0, (const bf16_t*)(p.ws + WS_WGU), DM, (size_t)1024 * 1024, true};
    SchedMoeUp S; S.G = gridDim.x; S.c = blockIdx.x; S.nN = 4; S.tab = tab; S.lists = (const int*)(p.ws + WS_ROUTE + RT_LIST); S.tilecnt = tilecnt; S.early = early;
    EpiGU E{(bf16_t*)(p.ws + WS_P + PR_ACT)};
    pg::gemm_phase(lds, AD, S, E);
  }
#if MK_WD_IN_UP
  cvt_down_dynamic(p, lds);
#endif
  if (early && blockIdx.x >= 64) {
    const int Le = blockIdx.x - 64, T = Le >> 2, pn = Le & 3;
    if (opaque_tid() == 0) { unsigned spins = 0;
      while (__hip_atomic_load(tilecnt + 64 * T, __ATOMIC_RELAXED, __HIP_MEMORY_SCOPE_AGENT) < 32u && ++spins < (1u << 22)) __builtin_amdgcn_s_sleep(4); }
    __syncthreads();
    __builtin_amdgcn_fence(__ATOMIC_ACQUIRE, "agent");
    asm volatile("s_waitcnt vmcnt(0)" ::: "memory");
    pg::Addr AD{(const bf16_t*)(p.ws + WS_P + PR_ACT), 512, 0, (const bf16_t*)(p.ws + WS_WD), 512, (size_t)1024 * 512, false};
    SchedMoeDownOne S; S.G = gridDim.x; S.c = blockIdx.x; S.nN = 4; S.tab = tab; S.lists = (const int*)(p.ws + WS_ROUTE + RT_LIST); S.T = T; S.pn = pn;
    EpiDown E{(bf16_t*)(p.ws + WS_P), (const int*)(p.ws + WS_ROUTE + RT_LIST), (const float*)(p.ws + WS_ROUTE + RT_EW), tab};
    pg::gemm_phase(lds, AD, S, E);
  }
}
__device__ __forceinline__ void phase_moe_down(const Params& p, LAS unsigned char* lds) {
  const MoeTab tab = moe_tables(p, lds);
  const bool early = (MK_EARLY_DOWN != 0) && gridDim.x == 256;
  pg::Addr AD{(const bf16_t*)(p.ws + WS_P + PR_ACT), 512, 0, (const bf16_t*)(p.ws + WS_WD), 512, (size_t)1024 * 512, false};
  SchedMoeDown S; S.G = gridDim.x; S.c = blockIdx.x; S.nN = 4; S.tab = tab; S.lists = (const int*)(p.ws + WS_ROUTE + RT_LIST); S.t_first = early ? NEARLY : 0;
  EpiDown E{(bf16_t*)(p.ws + WS_P), (const int*)(p.ws + WS_ROUTE + RT_LIST), (const float*)(p.ws + WS_ROUTE + RT_EW), tab};
  pg::gemm_phase(lds, AD, S, E);
}

__device__ __forceinline__ void phase_final(const Params& p) {
  const float* mod = (const float*)(p.ws + WS_MOD);
  const bf16_t* Y2 = (const bf16_t*)(p.ws + WS_P);
  const bf16_t* X1b = (const bf16_t*)(p.ws + WS_X1B); float* OUT = p.out;
  const int tid_ = opaque_tid(); const int lane = tid_ & 63, wave = tid_ >> 6;
  const int gw = blockIdx.x * NWAVES + wave, NGW = gridDim.x * NWAVES;
  u32x2 x1[4], x1n[4]; u32x2 ya[4], yb[4], yan[4], ybn[4];
#define FIN_LOAD(row, X, A, B) do { _Pragma("unroll") for (int j = 0; j < 4; ++j) { const int col = (lane + 64 * j) * 4; \
    X[j] = *(const u32x2*)(X1b + (size_t)(row) * DM + col); A[j] = *(const u32x2*)(Y2 + (size_t)(2 * (row)) * DM + col); B[j] = *(const u32x2*)(Y2 + (size_t)(2 * (row) + 1) * DM + col); } } while (0)
  if (gw < NLAT) FIN_LOAD(gw, x1, ya, yb);
#if MK_HOIST_CONST
  f32x4 g2[4], gg[4], bb[4]; int g2_b = -1;
#pragma unroll
  for (int j = 0; j < 4; ++j) { const int col = (lane + 64 * j) * 4; gg[j] = *(const f32x4*)(p.in[I_LN2G] + col); bb[j] = *(const f32x4*)(p.in[I_LN2B] + col); g2[j] = gg[j]; }
#endif
  for (int row = gw; row < NLAT; row += NGW) {
    const int rown = row + NGW;
    if (rown < NLAT) FIN_LOAD(rown, x1n, yan, ybn);
    const float* mrow = mod + (row / SEQ) * NMOD;
    float probe_scale = 1.f;
#ifndef MK_TS_OFF
#define MK_TS_OFF 0
#endif
#ifndef MK_TS_A
#define MK_TS_A MK_TS_PHASE
#define MK_TS_B (MK_TS_PHASE + 1)
#endif
#if MK_TS_PHASE >= 0
    if (row < 164) { const unsigned long long* ts = (const unsigned long long*)((const unsigned*)(p.ws + WS_CTL) + CTL_TS); probe_scale = 1.f + sqrtf((float)((long long)(ts[MK_TS_B] - ts[MK_TS_A]) - (long long)MK_TS_OFF > 0 ? (long long)(ts[MK_TS_B] - ts[MK_TS_A]) - (long long)MK_TS_OFF : 0ll) * MK_TS_SCALE); }
#endif
#if MK_HOIST_CONST
    if (row / SEQ != g2_b) { g2_b = row / SEQ;
#pragma unroll
      for (int j = 0; j < 4; ++j) { const int col = (lane + 64 * j) * 4; g2[j] = *(const f32x4*)(mrow + 5 * DM + col); } }
#else
    f32x4 g2[4], gg[4], bb[4];
#pragma unroll
    for (int j = 0; j < 4; ++j) { const int col = (lane + 64 * j) * 4; g2[j] = *(const f32x4*)(mrow + 5 * DM + col); gg[j] = *(const f32x4*)(p.in[I_LN2G] + col); bb[j] = *(const f32x4*)(p.in[I_LN2B] + col); }
#endif
    f32x4 v[4]; float s = 0;
#pragma unroll
    for (int j = 0; j < 4; ++j) {
      f32x4 ym;
      ym.x = __uint_as_float(ya[j].x << 16) + __uint_as_float(yb[j].x << 16); ym.y = __uint_as_float(ya[j].x & 0xffff0000u) + __uint_as_float(yb[j].x & 0xffff0000u);
      ym.z = __uint_as_float(ya[j].y << 16) + __uint_as_float(yb[j].y << 16); ym.w = __uint_as_float(ya[j].y & 0xffff0000u) + __uint_as_float(yb[j].y & 0xffff0000u);
      const f32x4 xf = {__uint_as_float(x1[j].x << 16), __uint_as_float(x1[j].x & 0xffff0000u), __uint_as_float(x1[j].y << 16), __uint_as_float(x1[j].y & 0xffff0000u)};
      v[j] = xf * ALPHA + g2[j] * ym;
      s += (v[j].x + v[j].y) + (v[j].z + v[j].w);
    }
    const float mean = wave_sum(s) * (1.f / DM); float s2 = 0;
#pragma unroll
    for (int j = 0; j < 4; ++j) { v[j] = v[j] - mean; s2 += (v[j].x * v[j].x + v[j].y * v[j].y) + (v[j].z * v[j].z + v[j].w * v[j].w); }
    const float rstd = rsqrtf(wave_sum(s2) * (1.f / DM) + LN_EPS);
#pragma unroll
    for (int j = 0; j < 4; ++j) {
#if MK_NT_OUT
      __builtin_nontemporal_store((v[j] * rstd * gg[j] + bb[j]) * probe_scale, (f32x4*)(OUT + (size_t)row * DM) + lane + 64 * j);
#else
      ((f32x4*)(OUT + (size_t)row * DM))[lane + 64 * j] = (v[j] * rstd * gg[j] + bb[j]) * probe_scale;
#endif
    }
#pragma unroll
    for (int j = 0; j < 4; ++j) { x1[j] = x1n[j]; ya[j] = yan[j]; yb[j] = ybn[j]; }
  }
#undef FIN_LOAD
}
__device__ __forceinline__ void phase_attn(const Params& p, char* lds) {
  bf16_t* P = (bf16_t*)(p.ws + WS_P);
  int seq = SKV; asm volatile("" : "+s"(seq));
  float negMC;
  { const int l_ = opaque_tid() & 63; float gq = fmaxf(fabsf(p.in[I_QG][l_]), fabsf(p.in[I_QG][64 + l_])), gk = fmaxf(fabsf(p.in[I_KG][l_]), fabsf(p.in[I_KG][64 + l_]));
#pragma unroll
    for (int o = 1; o < 64; o <<= 1) { gq = fmaxf(gq, __shfl_xor(gq, o)); gk = fmaxf(gk, __shfl_xor(gk, o)); }
    negMC = 128.f * 1.01f * gq * gk; }
  for (int unit = blockIdx.x; unit < NB * 8 * (SEQ / 256); unit += gridDim.x) {
    const int h = unit % 8, qb = (unit / 8) % 32, b = unit / 256;
    bf16_t* Qp = P + ((size_t)b * SKV + qb * 256) * PLD + PC_Q + h * 128;
    const bf16_t* Kp = (const bf16_t*)(p.ws + WS_KC) + (size_t)(b * 2 + (h >> 2)) * SKV * 128;
    const bf16_t* Vp = (const bf16_t*)(p.ws + WS_VC) + (size_t)(b * 2 + (h >> 2)) * SKV * 128;
    att::attn_dense_body(Qp, Kp, Vp, Qp, seq, negMC, p.in[I_QG], qb * 256, lds);
  }
}

#if MK_TS_PHASE >= 16
#define RT_TS(k) do { if (gw == 0 && row0 == 0 && lane0 == 0) ((unsigned long long*)((unsigned*)(p.ws + WS_CTL) + CTL_TS))[k] = __builtin_amdgcn_s_memrealtime(); } while (0)
#else
#define RT_TS(k) do { } while (0)
#endif
constexpr int LDS_RTLOG = LDS_STAGE + 10240;
__device__ __forceinline__ void phase_ln1_router(const Params& p, LAS unsigned char* lds) {
  const float* mod = (const float*)(p.ws + WS_MOD);
  const float* R1 = p.out; bf16_t* X1b = (bf16_t*)(p.ws + WS_X1B);
  bf16_t* H2 = (bf16_t*)(p.ws + WS_RH);
  float* ew = (float*)(p.ws + WS_ROUTE + RT_EW); int* lists = (int*)(p.ws + WS_ROUTE + RT_LIST);
  unsigned* cnt = (unsigned*)(p.ws + WS_CTL) + CTL_CNT;
  const int tid_ = opaque_tid(); const int lane0 = tid_ & 63, wave = tid_ >> 6;
  const int gw = blockIdx.x * NWAVES + wave, NGW = gridDim.x * NWAVES;
  LAS f32x4* Wl = (LAS f32x4*)lds;
  LAS float* lg = (LAS float*)(lds + LDS_RTLOG) + wave * 160;
  const float* Wre = p.in[I_WRE]; const float* Wrg = p.in[I_WRG];
  f32x4 vv[4][4], hh[4][4];
#if MK_RB_BF16
  u32x2 rb[4][4];
  const float* Xin = p.in[I_X];
#define RT_LOAD_X(row0_) do { int _ln = lane0; asm volatile("" : "+v"(_ln)); const int _r0 = ((row0_) < NLAT) ? (row0_) : (NLAT - 4); _Pragma("unroll") for (int r = 0; r < 4; ++r) _Pragma("unroll") for (int j = 0; j < 4; ++j) \
    vv[r][j] = ((const f32x4*)(Xin + (size_t)(_r0 + r) * DM))[_ln + 64 * j]; } while (0)
#define RT_LOAD_B(row0_) do { int _ln = lane0; asm volatile("" : "+v"(_ln)); const int _r0 = ((row0_) < NLAT) ? (row0_) : (NLAT - 4); _Pragma("unroll") for (int r = 0; r < 4; ++r) _Pragma("unroll") for (int j = 0; j < 4; ++j) \
    rb[r][j] = ((const u32x2*)((const bf16_t*)R1 + (size_t)(_r0 + r) * DM))[_ln + 64 * j]; } while (0)
#define RT_LOAD(row0_) do { RT_LOAD_X(row0_); RT_LOAD_B(row0_); } while (0)
#else
#define RT_LOAD(row0_) do { int _ln = lane0; asm volatile("" : "+v"(_ln)); const int _r0 = ((row0_) < NLAT) ? (row0_) : (NLAT - 4); _Pragma("unroll") for (int r = 0; r < 4; ++r) _Pragma("unroll") for (int j = 0; j < 4; ++j) \
    vv[r][j] = ((const f32x4*)(R1 + (size_t)(_r0 + r) * DM))[_ln + 64 * j]; } while (0)
#endif
  RT_LOAD(gw * 4);
  {
#pragma unroll 1
    for (int q0 = 0; q0 < 16; q0 += 8) {
      f32x4 wt[8];
#pragma unroll
#if MK_WL_FILL2
      for (int q = 0; q < 8; ++q) { const int m = wave * 16 + q0 + q, e = m & 3, j = (m >> 2) & 3, ln = (m >> 4) * 8 + (lane0 & 7), c4 = lane0 >> 3;
        wt[q] = ((const f32x4*)Wre)[(((ln + 64 * j) * 4 + e) << 3) + c4]; }
#pragma unroll
      for (int q = 0; q < 8; ++q) { const int m = wave * 16 + q0 + q, e = m & 3, j = (m >> 2) & 3, ln = (m >> 4) * 8 + (lane0 & 7), c4 = lane0 >> 3;
        Wl[((c4 * 16 + e * 4 + j) << 6) + ln] = wt[q]; }
#else
      for (int q = 0; q < 8; ++q) wt[q] = ((const f32x4*)Wre)[tid_ + 512 * (q0 + q)];
#pragma unroll
      for (int q = 0; q < 8; ++q) { const int idx = tid_ + 512 * (q0 + q), k = idx >> 3, c4 = idx & 7;
        Wl[((c4 * 16 + (k & 3) * 4 + (k >> 8)) << 6) + ((k >> 2) & 63)] = wt[q]; }
#endif
    }
  }
#if MK_WRG_LDS
  LAS f32x4* Wg = (LAS f32x4*)(lds + LDS_WRG);
  for (int idx = tid_; idx < 1024; idx += 512) Wg[(((idx & 3) * 4 + (idx >> 8)) << 6) + ((idx >> 2) & 63)] = ((const f32x4*)Wrg)[idx];
#endif
  __syncthreads();
#if MK_RT_HOIST2 && MK_HOIST_CONST
  f32x4 cg[4], cb[4];
  { int lane = lane0; asm volatile("" : "+v"(lane));
#pragma unroll
    for (int j = 0; j < 4; ++j) { const int col = (lane + 64 * j) * 4; cg[j] = *(const f32x4*)(p.in[I_LN1G] + col); cb[j] = *(const f32x4*)(p.in[I_LN1B] + col); } }
#endif
  for (int row0 = gw * 4; row0 < NLAT; row0 += NGW * 4) {
    const float* mrow = mod + (row0 / SEQ) * NMOD;
    RT_TS(16);
#if MK_HOIST_CONST
    {
#if !MK_RT_HOIST2
      f32x4 cg[4], cb[4];
      { int lane = lane0; asm volatile("" : "+v"(lane));
#pragma unroll
        for (int j = 0; j < 4; ++j) { const int col = (lane + 64 * j) * 4; cg[j] = *(const f32x4*)(p.in[I_LN1G] + col); cb[j] = *(const f32x4*)(p.in[I_LN1B] + col); } }
#endif
#pragma unroll
      for (int r = 0; r < 4; ++r) {
        const int row = row0 + r;
        int lane = lane0; asm volatile("" : "+v"(lane));
        f32x4 v[4]; float s = 0;
#pragma unroll
        for (int j = 0; j < 4; ++j) {
          const u32x2 q = rb[r][j];
          v[j] = vv[r][j] * ALPHA + (f32x4){__uint_as_float(q.x << 16), __uint_as_float(q.x & 0xffff0000u), __uint_as_float(q.y << 16), __uint_as_float(q.y & 0xffff0000u)};
          s += (v[j].x + v[j].y) + (v[j].z + v[j].w); }
        const float mean = wave_sum(s) * (1.f / DM); float s2 = 0;
#pragma unroll
        for (int j = 0; j < 4; ++j) { v[j] = v[j] - mean; s2 += (v[j].x * v[j].x + v[j].y * v[j].y) + (v[j].z * v[j].z + v[j].w * v[j].w); }
        const float rstd = rsqrtf(wave_sum(s2) * (1.f / DM) + LN_EPS);
#pragma unroll
        for (int j = 0; j < 4; ++j) {
          const int col = (lane + 64 * j) * 4;
          v[j] = v[j] * rstd * cg[j] + cb[j];
          { u32x2 xw; xw.x = cvt_pk_bf16(v[j].x, v[j].y); xw.y = cvt_pk_bf16(v[j].z, v[j].w); *(u32x2*)(X1b + (size_t)row * DM + col) = xw; }
          vv[r][j] = v[j];
        }
      }
    }
    {
      f32x4 csh[4], csc[4];
      { int lane = lane0; asm volatile("" : "+v"(lane));
#pragma unroll
        for (int j = 0; j < 4; ++j) { const int col = (lane + 64 * j) * 4; csh[j] = *(const f32x4*)(mrow + 3 * DM + col); csc[j] = *(const f32x4*)(mrow + 4 * DM + col); } }
#pragma unroll
      for (int r = 0; r < 4; ++r) {
        const int row = row0 + r, pr = lat2pad(row);
        int lane = lane0; asm volatile("" : "+v"(lane));
        f32x4 v[4]; float s = 0;
#pragma unroll
        for (int j = 0; j < 4; ++j) { v[j] = vv[r][j]; s += (v[j].x + v[j].y) + (v[j].z + v[j].w); }
        const float mean = wave_sum(s) * (1.f / DM); float s2 = 0;
#pragma unroll
        for (int j = 0; j < 4; ++j) { v[j] = v[j] - mean; s2 += (v[j].x * v[j].x + v[j].y * v[j].y) + (v[j].z * v[j].z + v[j].w * v[j].w); }
        const float rstd = rsqrtf(wave_sum(s2) * (1.f / DM) + LN_EPS);
#pragma unroll
        for (int j = 0; j < 4; ++j) {
          const int col = (lane + 64 * j) * 4;
          const f32x4 hv = v[j] * rstd * (csc[j] + 1.f) + csh[j];
          u32x2 w; w.x = cvt_pk_bf16(hv.x, hv.y); w.y = cvt_pk_bf16(hv.z, hv.w);
          *(u32x2*)(H2 + (size_t)pr * DM + col) = w;
          hh[r][j] = hv;
        }
      }
    }
#else
#pragma unroll
    for (int r = 0; r < 4; ++r) {
      const int row = row0 + r, pr = lat2pad(row);
      int lane = lane0; asm volatile("" : "+v"(lane));
      f32x4 v[4]; float s = 0;
#pragma unroll
      for (int j = 0; j < 4; ++j) {
#if MK_RB_BF16
        const u32x2 q = rb[r][j];
        v[j] = vv[r][j] * ALPHA + (f32x4){__uint_as_float(q.x << 16), __uint_as_float(q.x & 0xffff0000u), __uint_as_float(q.y << 16), __uint_as_float(q.y & 0xffff0000u)};
#else
        v[j] = vv[r][j];
#endif
        s += (v[j].x + v[j].y) + (v[j].z + v[j].w); }
      float mean = wave_sum(s) * (1.f / DM); float s2 = 0;
#pragma unroll
      for (int j = 0; j < 4; ++j) { v[j] = v[j] - mean; s2 += (v[j].x * v[j].x + v[j].y * v[j].y) + (v[j].z * v[j].z + v[j].w * v[j].w); }
      float rstd = rsqrtf(wave_sum(s2) * (1.f / DM) + LN_EPS);
      s = 0;
#pragma unroll
      for (int j = 0; j < 4; ++j) {
        const int col = (lane + 64 * j) * 4;
        const f32x4 g = *(const f32x4*)(p.in[I_LN1G] + col), bb = *(const f32x4*)(p.in[I_LN1B] + col);
        v[j] = v[j] * rstd * g + bb;
        { u32x2 xw; xw.x = cvt_pk_bf16(v[j].x, v[j].y); xw.y = cvt_pk_bf16(v[j].z, v[j].w); *(u32x2*)(X1b + (size_t)row * DM + col) = xw; }
        s += (v[j].x + v[j].y) + (v[j].z + v[j].w);
      }
      mean = wave_sum(s) * (1.f / DM); s2 = 0;
#pragma unroll
      for (int j = 0; j < 4; ++j) { v[j] = v[j] - mean; s2 += (v[j].x * v[j].x + v[j].y * v[j].y) + (v[j].z * v[j].z + v[j].w * v[j].w); }
      rstd = rsqrtf(wave_sum(s2) * (1.f / DM) + LN_EPS);
#pragma unroll
      for (int j = 0; j < 4; ++j) {
        const int col = (lane + 64 * j) * 4;
        const f32x4 sh = *(const f32x4*)(mrow + 3 * DM + col), sc = *(const f32x4*)(mrow + 4 * DM + col);
        const f32x4 hv = v[j] * rstd * (sc + 1.f) + sh;
        u32x2 w; w.x = cvt_pk_bf16(hv.x, hv.y); w.y = cvt_pk_bf16(hv.z, hv.w);
        *(u32x2*)(H2 + (size_t)pr * DM + col) = w;
        hh[r][j] = hv;
      }
    }
#endif
    RT_TS(17);
    int gsel[4];
    int lane = lane0; asm volatile("" : "+v"(lane));
    {
      f32x4 acc[4];
#pragma unroll
      for (int r = 0; r < 4; ++r) acc[r] = (f32x4){0.f, 0.f, 0.f, 0.f};
#pragma unroll
      for (int j = 0; j < 4; ++j)
#pragma unroll
        for (int e = 0; e < 4; ++e) {
#if MK_WRG_LDS
          const f32x4 w = Wg[((e * 4 + j) << 6) + lane];
#else
          const f32x4 w = *(const f32x4*)(Wrg + (size_t)(j * 256 + e) * 4 + (unsigned)(lane * 16));
#endif
#pragma unroll
          for (int r = 0; r < 4; ++r) acc[r] += w * hh[r][j][e]; }
#pragma unroll
      for (int r = 0; r < 4; ++r)
#pragma unroll
        for (int e = 0; e < 4; ++e) acc[r][e] = wave_sum(acc[r][e]);
      if (lane == 0) {
#pragma unroll
        for (int r = 0; r < 4; ++r) *(LAS f32x4*)(lg + r * 40) = acc[r]; }
#pragma unroll
      for (int r = 0; r < 4; ++r) {
        int gi = 0; float gm = acc[r][0] + p.in[I_BRG][0];
#pragma unroll
        for (int i = 1; i < 4; ++i) { const float g = acc[r][i] + p.in[I_BRG][i]; if (g > gm) { gm = g; gi = i; } }
        gsel[r] = __builtin_amdgcn_readfirstlane(gi); }
    }
    RT_TS(18);
#if MK_RB_BF16
    RT_LOAD_X(row0 + NGW * 4);
#endif
#pragma unroll
    for (int r = 0; r < 4; ++r) {
      f32x4 ea0 = (f32x4){0.f, 0.f, 0.f, 0.f}, ea1 = ea0;
      const LAS f32x4* wb = Wl + gsel[r] * 2048 + lane;
#pragma unroll
      for (int j = 0; j < 4; ++j) {
#pragma unroll
        for (int e = 0; e < 4; ++e) { const float h = hh[r][j][e];
          ea0 += wb[(e * 4 + j) * 64] * h; ea1 += wb[1024 + (e * 4 + j) * 64] * h; }
        asm volatile("" ::: "memory");
      }
#pragma unroll
      for (int e = 0; e < 4; ++e) { ea0[e] = wave_sum(ea0[e]) + p.in[I_BRE][gsel[r] * 8 + e]; ea1[e] = wave_sum(ea1[e]) + p.in[I_BRE][gsel[r] * 8 + 4 + e]; }
      if (lane == 0) { *(LAS f32x4*)(lg + r * 40 + 4 + gsel[r] * 8) = ea0; *(LAS f32x4*)(lg + r * 40 + 8 + gsel[r] * 8) = ea1; }
      asm volatile("" ::: "memory");
    }
#if MK_RB_BF16
    RT_LOAD_B(row0 + NGW * 4);
#else
    RT_LOAD(row0 + NGW * 4);
#endif
    asm volatile("s_waitcnt lgkmcnt(0)" ::: "memory");
    RT_TS(19);
    if (lane < 4) {
      const int row = row0 + lane; const LAS float* L = lg + lane * 40;
      float gl[4]; int gi = 0;
#pragma unroll
      for (int i = 0; i < 4; ++i) gl[i] = L[i] + p.in[I_BRG][i];
      float gm = gl[0];
#pragma unroll
      for (int i = 1; i < 4; ++i) if (gl[i] > gm) { gm = gl[i]; gi = i; }
      float den = 0.f;
#pragma unroll
      for (int i = 0; i < 4; ++i) den += expf(gl[i] - gm);
      const float gw_ = 1.f / den;
      float el[8];
#pragma unroll
      for (int i = 0; i < 8; ++i) el[i] = L[4 + gi * 8 + i];
      int i1 = 0; float v1 = el[0];
#pragma unroll
      for (int i = 1; i < 8; ++i) if (el[i] > v1) { v1 = el[i]; i1 = i; }
      int i2 = -1; float v2 = -3.0e38f;
#pragma unroll
      for (int i = 0; i < 8; ++i) if (i != i1 && el[i] > v2) { v2 = el[i]; i2 = i; }
      const float e2 = expf(v2 - v1); const float w1 = 1.f / (1.f + e2), w2 = e2 / (1.f + e2);
      const int ea = gi * 8 + i1, eb = gi * 8 + i2;
      const unsigned pa = atomicAdd(cnt + ea * CNT_STRIDE, 1u), pb = atomicAdd(cnt + eb * CNT_STRIDE, 1u);
      lists[ea * NLAT + pa] = row * 2; lists[eb * NLAT + pb] = row * 2 + 1;
      ew[row * 2] = w1 * gw_; ew[row * 2 + 1] = w2 * gw_;
    }
    asm volatile("s_waitcnt vmcnt(0) lgkmcnt(0)" ::: "memory");
    RT_TS(20);
  }
}

enum { PH_PRO = 0, PH_LN, PH_GIN, PH_QK, PH_ATT, PH_G1, PH_G2, PH_G3, PH_RT, PH_UP, PH_DOWN, PH_FIN, PH_S5S, PH_SCAN, PH_S5Y, PH_COUNT };
template <int PH> __device__ __forceinline__ void run_phase(const Params& p, unsigned char* lds_raw) {
  LAS unsigned char* lds = (LAS unsigned char*)lds_raw;
  if constexpr (PH == PH_PRO) phase0(p, lds);
  if constexpr (PH == PH_LN) phase1(p, lds);
  if constexpr (PH == PH_GIN) phase2(p, lds);
  if constexpr (PH == PH_QK) phase_qknorm(p);
  if constexpr (PH == PH_ATT) phase_attn(p, (char*)lds_raw);
  if constexpr (PH == PH_G1) phase_g1(p, lds);
  if constexpr (PH == PH_G2) phase_g2(p, lds);
  if constexpr (PH == PH_G3) phase_g3(p, lds);
  if constexpr (PH == PH_RT) phase_ln1_router(p, lds);
  if constexpr (PH == PH_UP) phase_moe_up(p, lds);
  if constexpr (PH == PH_DOWN) phase_moe_down(p, lds);
  if constexpr (PH == PH_FIN) phase_final(p);
  if constexpr (PH == PH_S5S) phase_s5s(p, lds);
  if constexpr (PH == PH_SCAN) phase_s5scan(p);
  if constexpr (PH == PH_S5Y) phase_s5y(p, lds);
}
#ifndef MK_FUSED
#define MK_FUSED 1
#endif
#if !MK_FUSED
template <int PH> __global__ __launch_bounds__(512, 2) void k_phase(Params p) {
  extern __shared__ __attribute__((aligned(16))) unsigned char lds_raw[];
  run_phase<PH>(p, lds_raw);
}
template <int PH> static bool set_lds() { return hipFuncSetAttribute((const void*)k_phase<PH>, hipFuncAttributeMaxDynamicSharedMemorySize, LDS_BYTES) == hipSuccess; }
template <int PH> static void launch_ph(int grid, hipStream_t stream, const Params& p) { hipLaunchKernelGGL(k_phase<PH>, dim3(grid), dim3(512), LDS_BYTES, stream, p); }
#else
constexpr int CTL_SCAN = 2048;
constexpr int CTL_S5SCNT = 2432;
#ifndef MK_CG_SYNC
#define MK_CG_SYNC 0
#endif
constexpr int CTL_BAR = 4096;
constexpr int LDS_BARST = LDS_STAGE + 1024;
#if MK_CG_SYNC
#define GRID_BAR() cooperative_groups::this_grid().sync()
#else
#ifdef MK_DOUBLE_BAR
#define GRID_BAR() do { xcd_barrier(xbar); xcd_barrier(xbar); } while (0)
#else
#define GRID_BAR() xcd_barrier(xbar)
#endif
#endif
typedef const __attribute__((address_space(4))) Params* KParamsPtr;
__device__ __forceinline__ KParamsPtr kparams() { KParamsPtr k = (KParamsPtr)__builtin_amdgcn_kernarg_segment_ptr(); asm volatile("" : "+s"(k)); return k; }
#define KP (*(const Params*)kparams())
#ifndef MK_MASK
#define MK_MASK 0xFFFF
#endif
#ifndef MK_REP_MASK
#define MK_REP_MASK 0
#endif
#ifndef MK_REP
#define MK_REP 1
#endif
#ifdef MK_NOEPI_PROBE
#define REP_PHASE(PH) do { if constexpr ((MK_REP_MASK >> PH) & 1) { if (opaque_tid() == 0) *(volatile LAS int*)((LAS unsigned char*)lds_raw + LDS_STAGE + 2040) = MK_NOEPI_PROBE; __syncthreads(); \
    for (int _r = 0; _r < MK_REP; ++_r) { run_phase<PH>(KP, lds_raw); GRID_BAR(); } } if (opaque_tid() == 0) *(volatile LAS int*)((LAS unsigned char*)lds_raw + LDS_STAGE + 2040) = 0; __syncthreads(); } while (0)
#else
#define REP_PHASE(PH) do { if constexpr ((MK_REP_MASK >> PH) & 1) { for (int _r = 0; _r < MK_REP; ++_r) { run_phase<PH>(KP, lds_raw); GRID_BAR(); } } } while (0)
#endif
#ifndef MK_TS_PHASE
#define MK_TS_PHASE -1
#endif
#ifndef MK_TS_SCALE
#define MK_TS_SCALE 5.0e-8f
#endif
#if MK_TS_PHASE >= 0
#ifdef MK_TS_CLOCK
#define TS_MARK() do { if (blockIdx.x == 0 && opaque_tid() == 0) { ((unsigned long long*)((unsigned*)(KP.ws + WS_CTL) + CTL_TS))[ts_n] = __builtin_readcyclecounter(); } ++ts_n; } while (0)
#else
#define TS_MARK() do { if (blockIdx.x == 0 && opaque_tid() == 0) { ((unsigned long long*)((unsigned*)(KP.ws + WS_CTL) + CTL_TS))[ts_n] = __builtin_amdgcn_s_memrealtime(); } ++ts_n; } while (0)
#endif
#else
#define TS_MARK() do { } while (0)
#endif
__global__ __launch_bounds__(512, 2) void k_mega(Params p_unused) {
  extern __shared__ __attribute__((aligned(16))) unsigned char lds_raw[];
  int ts_n = 0; (void)ts_n;
#if !MK_CG_SYNC
  volatile LAS unsigned* bst = (volatile LAS unsigned*)((LAS unsigned char*)lds_raw + LDS_BARST);
  if (threadIdx.x < 2) bst[threadIdx.x] = 0u;
#if MK_HEAD_NOPS > 0
  asm volatile(".rept %0\n\ts_nop 0\n\t.endr" :: "n"(MK_HEAD_NOPS));
#endif
  tid_table_init();
  __syncthreads();
  const XcdBarrier xbar = xcd_barrier_post((unsigned*)(KP.ws + WS_CTL) + CTL_BAR, bst);
#endif
  TS_MARK();
  REP_PHASE(PH_PRO);
#if MK_LN_IN_PRO
  if constexpr ((MK_MASK >> PH_PRO) & 1) run_phase<PH_PRO>(KP, lds_raw);
  { if (opaque_tid() == 0) { unsigned spins = 0;
      while (__hip_atomic_load((unsigned*)(KP.ws + WS_CTL) + CTL_MODCNT, __ATOMIC_ACQUIRE, __HIP_MEMORY_SCOPE_AGENT) < gridDim.x && ++spins < (1u << 22)) __builtin_amdgcn_s_sleep(4); }
    __syncthreads();
    __builtin_amdgcn_fence(__ATOMIC_ACQUIRE, "agent"); }
  TS_MARK();
#else
  if constexpr ((MK_MASK >> PH_PRO) & 1) run_phase<PH_PRO>(KP, lds_raw);  GRID_BAR(); TS_MARK();
#endif
  REP_PHASE(PH_LN);
  if constexpr ((MK_MASK >> PH_LN) & 1) run_phase<PH_LN>(KP, lds_raw);   GRID_BAR(); TS_MARK();
  REP_PHASE(PH_GIN);
  if constexpr ((MK_MASK >> PH_GIN) & 1) run_phase<PH_GIN>(KP, lds_raw);  GRID_BAR(); TS_MARK();
  REP_PHASE(PH_S5S);
#if MK_S5_IN_P3
  {
    unsigned* c_s5s = (unsigned*)(KP.ws + WS_CTL) + CTL_S5SCNT; unsigned* c_scan = (unsigned*)(KP.ws + WS_CTL) + CTL_SCAN;
    const int cB = blockIdx.x;
    if (cB < 160) {
      run_phase<PH_S5S>(KP, lds_raw);
      if (opaque_tid() == 0) { __threadfence(); __hip_atomic_fetch_add(c_s5s, 1u, __ATOMIC_RELEASE, __HIP_MEMORY_SCOPE_AGENT); }
    } else if (cB < 176) {
      if (opaque_tid() == 0) { unsigned spins = 0; while (__hip_atomic_load(c_s5s, __ATOMIC_ACQUIRE, __HIP_MEMORY_SCOPE_AGENT) < 160u && ++spins < (1u << 22)) __builtin_amdgcn_s_sleep(4); }
      __syncthreads();
      __builtin_amdgcn_fence(__ATOMIC_ACQUIRE, "agent");
      { const int t_ = opaque_tid(); s5_scan_item(KP, (cB - 160) * NWAVES + (t_ >> 6), t_ & 63); }
      asm volatile("s_waitcnt vmcnt(0)" ::: "memory");
      __syncthreads();
      if (opaque_tid() == 0) { __threadfence(); __hip_atomic_fetch_add(c_scan, 1u, __ATOMIC_RELEASE, __HIP_MEMORY_SCOPE_AGENT); }
    }
    run_phase<PH_QK>(KP, lds_raw);
    if (cB < 128) {
      if (opaque_tid() == 0) { unsigned spins = 0; while (__hip_atomic_load(c_scan, __ATOMIC_ACQUIRE, __HIP_MEMORY_SCOPE_AGENT) < 16u && ++spins < (1u << 22)) __builtin_amdgcn_s_sleep(4); }
      __syncthreads();
      __builtin_amdgcn_fence(__ATOMIC_ACQUIRE, "agent");
      run_phase<PH_S5Y>(KP, lds_raw);
    }
  }
  GRID_BAR(); TS_MARK();
  run_phase<PH_ATT>(KP, lds_raw);
#else
#if MK_TS_PHASE >= 16
  if (blockIdx.x == 0 && opaque_tid() == 0) ((unsigned long long*)((unsigned*)(KP.ws + WS_CTL) + CTL_TS))[21] = __builtin_amdgcn_s_memrealtime();
#endif
  if constexpr ((MK_MASK >> PH_S5S) & 1) run_phase<PH_S5S>(KP, lds_raw);
  if (gridDim.x == 256) cvt_idle_slot(KP, (LAS unsigned char*)lds_raw, CV_TOTAL - MK_CV_P3 - MK_CV_ATT, CV_TOTAL - MK_CV_ATT, 160, 96);
#if MK_TS_PHASE >= 16
  if (blockIdx.x == 0 && opaque_tid() == 0) ((unsigned long long*)((unsigned*)(KP.ws + WS_CTL) + CTL_TS))[22] = __builtin_amdgcn_s_memrealtime();
#endif
  if constexpr ((MK_MASK >> PH_QK) & 1) run_phase<PH_QK>(KP, lds_raw);
#if MK_TS_PHASE >= 16
  asm volatile("s_waitcnt vmcnt(0)" ::: "memory");
  if (blockIdx.x == 0 && opaque_tid() == 0) ((unsigned long long*)((unsigned*)(KP.ws + WS_CTL) + CTL_TS))[23] = __builtin_amdgcn_s_memrealtime();
#endif
  GRID_BAR(); TS_MARK();
  {
    unsigned* ctr = (unsigned*)(KP.ws + WS_CTL) + CTL_SCAN;
    if (blockIdx.x * NWAVES < 128) {
#if MK_TS_PHASE >= 16
      if (blockIdx.x == 0 && opaque_tid() == 0) ((unsigned long long*)((unsigned*)(KP.ws + WS_CTL) + CTL_TS))[16] = __builtin_amdgcn_s_memrealtime();
#endif
      if constexpr ((MK_MASK >> PH_SCAN) & 1) run_phase<PH_SCAN>(KP, lds_raw);
#if MK_TS_PHASE >= 16
      asm volatile("s_waitcnt vmcnt(0)" ::: "memory");
      if (blockIdx.x == 0 && opaque_tid() == 0) ((unsigned long long*)((unsigned*)(KP.ws + WS_CTL) + CTL_TS))[17] = __builtin_amdgcn_s_memrealtime();
#endif
      __threadfence();
      if ((opaque_tid() & 63) == 0 && blockIdx.x * NWAVES + (opaque_tid() >> 6) < 128) __hip_atomic_fetch_add(ctr, 1u, __ATOMIC_RELEASE, __HIP_MEMORY_SCOPE_AGENT);
    }
    if constexpr ((MK_MASK >> PH_ATT) & 1) run_phase<PH_ATT>(KP, lds_raw);
    if (gridDim.x == 256) cvt_idle_slot(KP, (LAS unsigned char*)lds_raw, CV_TOTAL - MK_CV_ATT, CV_TOTAL, 16, 112);
    if (opaque_tid() == 0) { unsigned spins = 0; while (__hip_atomic_load(ctr, __ATOMIC_ACQUIRE, __HIP_MEMORY_SCOPE_AGENT) < 128u && ++spins < (1u << 24)) __builtin_amdgcn_s_sleep(8); }
    __syncthreads();
    __threadfence();
    if constexpr ((MK_MASK >> PH_S5Y) & 1) run_phase<PH_S5Y>(KP, lds_raw);
  }
#endif
  GRID_BAR(); TS_MARK();
  REP_PHASE(PH_S5Y);
  REP_PHASE(PH_G1);
#if MK_ATT_ALIGN
  asm volatile(".p2align 8");
#endif
#if MK_POST_NOPS > 0
  asm volatile(".rept %0\n\ts_nop 0\n\t.endr" :: "n"(MK_POST_NOPS));
#endif
#if MK_G12_MERGE
  if constexpr ((MK_MASK >> PH_G1) & 1) run_phase<PH_G1>(KP, lds_raw);
  if (gridDim.x != 256) { GRID_BAR(); } else { asm volatile("s_waitcnt vmcnt(0)" ::: "memory"); __syncthreads(); }
  TS_MARK();
#else
  if constexpr ((MK_MASK >> PH_G1) & 1) run_phase<PH_G1>(KP, lds_raw);   GRID_BAR(); TS_MARK();
#endif
  if constexpr ((MK_MASK >> PH_G2) & 1) run_phase<PH_G2>(KP, lds_raw);   GRID_BAR(); TS_MARK();
  REP_PHASE(PH_G3);
  if constexpr ((MK_MASK >> PH_G3) & 1) run_phase<PH_G3>(KP, lds_raw);   GRID_BAR(); TS_MARK();
  if constexpr ((MK_MASK >> PH_RT) & 1) run_phase<PH_RT>(KP, lds_raw);   GRID_BAR(); TS_MARK();
#if MK_POSTRT_NOPS > 0
  asm volatile(".rept %0\n\ts_nop 0\n\t.endr" :: "n"(MK_POSTRT_NOPS));
#endif
  REP_PHASE(PH_UP);
  if constexpr ((MK_MASK >> PH_UP) & 1) run_phase<PH_UP>(KP, lds_raw);   GRID_BAR(); TS_MARK();
  REP_PHASE(PH_DOWN);
  if constexpr ((MK_MASK >> PH_DOWN) & 1) run_phase<PH_DOWN>(KP, lds_raw); GRID_BAR(); TS_MARK();
#if MK_TS_PHASE >= 0
  GRID_BAR();
#endif
  if constexpr ((MK_MASK >> PH_FIN) & 1) run_phase<PH_FIN>(KP, lds_raw);
}
#endif

extern "C" void kernel_launch(void* const* d_in, const int* in_sizes, int n_in, void* d_out, int out_size, void* d_ws, size_t ws_size, hipStream_t stream) {
  static int grid = 0;
  if (grid == 0) {
    if (n_in != 32 || out_size != NLAT * DM || ws_size < WS_END) { fprintf(stderr, "kernel_launch: unexpected shapes n_in %d out %d ws %zu\n", n_in, out_size, ws_size); grid = -1; return; }
    int dev = 0, cus = 0;
    hipGetDevice(&dev); hipDeviceGetAttribute(&cus, hipDeviceAttributeMultiprocessorCount, dev);
#if !MK_FUSED
    bool ok = set_lds<0>() && set_lds<1>() && set_lds<2>() && set_lds<3>() && set_lds<4>() && set_lds<5>() && set_lds<6>() && set_lds<7>() && set_lds<8>() && set_lds<9>() && set_lds<10>() && set_lds<11>() && set_lds<12>() && set_lds<13>() && set_lds<14>();
    if (!ok) { fprintf(stderr, "kernel_launch: hipFuncSetAttribute failed\n"); grid = -1; return; }
    grid = cus > 0 ? cus : 256;
#else
    if (hipFuncSetAttribute((const void*)k_mega, hipFuncAttributeMaxDynamicSharedMemorySize, LDS_BYTES) != hipSuccess) { fprintf(stderr, "kernel_launch: hipFuncSetAttribute failed\n"); grid = -1; return; }
    int per_cu = 0;
    if (hipOccupancyMaxActiveBlocksPerMultiprocessor(&per_cu, (const void*)k_mega, 512, LDS_BYTES) != hipSuccess || per_cu < 1) { fprintf(stderr, "kernel_launch: occupancy query says %d blocks per CU\n", per_cu); grid = -1; return; }
    grid = (cus > 0 ? cus : 256) * 1;
#endif
  }
  if (grid < 0) return;
  Params p{};
  for (int i = 0; i < 32; ++i) p.in[i] = (const float*)d_in[i];
  p.out = (float*)d_out; p.ws = (unsigned char*)d_ws;
  hipMemsetAsync((char*)d_ws + WS_CTL, 0, 64 * 1024, stream);
#if !MK_FUSED
  launch_ph<PH_PRO>(grid, stream, p);
  launch_ph<PH_LN>(grid, stream, p);
  launch_ph<PH_GIN>(grid, stream, p);
  launch_ph<PH_QK>(grid, stream, p);
  launch_ph<PH_S5S>(grid, stream, p);
  launch_ph<PH_SCAN>(grid, stream, p);
  launch_ph<PH_ATT>(grid, stream, p);
  launch_ph<PH_S5Y>(grid, stream, p);
  launch_ph<PH_G1>(grid, stream, p);
  launch_ph<PH_G2>(grid, stream, p);
  launch_ph<PH_G3>(grid, stream, p);
  launch_ph<PH_RT>(grid, stream, p);
  launch_ph<PH_UP>(grid, stream, p);
  launch_ph<PH_DOWN>(grid, stream, p);
  launch_ph<PH_FIN>(grid, stream, p);
#else
  void* args[] = {&p};
  hipError_t e = hipLaunchCooperativeKernel((const void*)k_mega, dim3(grid), dim3(512), args, LDS_BYTES, stream);
  if (e != hipSuccess) fprintf(stderr, "kernel_launch: cooperative launch failed: %s (grid %d)\n", hipGetErrorString(e), grid);
#endif
}
```
